# Optimizing an MI355X kernel written in HIP

```python
import jax, jax.numpy as jnp
from jax import lax
import numpy as np

D_MODEL = 1024
BATCH = 8
SEQ = 2048
DEPTH = 2
DEC_BATCH = 128
DEC_SEQ = 1
PAST_LEN = 16384
PAGE_SIZE = 128

RET_HEADS = 4
RET_WIDTH = D_MODEL // 2
RET_DV = RET_WIDTH // RET_HEADS
RET_DK = RET_DV // 2
CONV_A_WIDTH = D_MODEL // 4
CONV_A_K = 31
CONV_C_WIDTH = D_MODEL - RET_WIDTH - CONV_A_WIDTH
CONV_C_K = 3
MIX_WIDTH = RET_WIDTH + CONV_A_WIDTH + CONV_C_WIDTH
IN_SPLITS = (RET_HEADS * RET_DK, RET_HEADS * RET_DK, RET_WIDTH, RET_WIDTH,
             CONV_A_WIDTH, CONV_A_WIDTH, CONV_C_WIDTH, CONV_C_WIDTH, CONV_C_WIDTH)
IN_WIDTH = sum(IN_SPLITS)
D_FF = ((8 * D_MODEL // 3 + 255) // 256) * 256
RET_CHUNK = 128
ROPE_BASE = 10000.0
EPS = 1e-6

kernel_name = "hybrid_retention_conformer_shortconv_decoder_step"


def _rmsnorm(x, g):
    xf = x.astype(jnp.float32)
    y = xf * lax.rsqrt(jnp.mean(xf * xf, axis=-1, keepdims=True) + EPS)
    return (y * g.astype(jnp.float32)).astype(x.dtype)


def _layernorm(x, g, b):
    xf = x.astype(jnp.float32)
    mu = jnp.mean(xf, axis=-1, keepdims=True)
    var = jnp.mean(jnp.square(xf - mu), axis=-1, keepdims=True)
    y = (xf - mu) * lax.rsqrt(var + EPS)
    return (y * g.astype(jnp.float32) + b.astype(jnp.float32)).astype(x.dtype)


def _rope(x, pos):
    half = x.shape[-1] // 2
    inv = ROPE_BASE ** (-jnp.arange(half, dtype=jnp.float32) / half)
    ang = pos[:, None] * inv[None, :]
    cos = jnp.cos(ang)[None, :, None, :]
    sin = jnp.sin(ang)[None, :, None, :]
    xf = x.astype(jnp.float32)
    x1, x2 = xf[..., :half], xf[..., half:]
    return jnp.concatenate([x1 * cos - x2 * sin, x1 * sin + x2 * cos], axis=-1).astype(x.dtype)


def _retention(q, k, v, s0, chunk):
    B, L, H, DK = q.shape
    DV = v.shape[-1]
    nc = L // chunk
    dt = q.dtype
    log_g = jnp.log(1.0 - jnp.exp2(-5.0 - jnp.arange(H, dtype=jnp.float32)))
    idx = jnp.arange(chunk, dtype=jnp.float32)
    diff = idx[:, None] - idx[None, :]
    dmat = jnp.where(diff[None] >= 0, jnp.exp(jnp.maximum(diff, 0.0)[None] * log_g[:, None, None]), 0.0).astype(dt)
    read_dec = jnp.exp((idx + 1.0)[:, None] * log_g[None, :]).astype(dt)
    upd_dec = jnp.exp((chunk - 1.0 - idx)[:, None] * log_g[None, :]).astype(dt)
    chunk_dec = jnp.exp(chunk * log_g).astype(dt)

    def to_chunks(t):
        return jnp.moveaxis(t.reshape(B, nc, chunk, H, t.shape[-1]), 1, 0)

    def step(s, inp):
        qi, ki, vi = inp
        scores = jnp.einsum('bnhd,bmhd->bhnm', qi, ki) * dmat[None]
        o = (jnp.einsum('bhnm,bmhe->bnhe', scores, vi)
             + jnp.einsum('bnhd,bhde->bnhe', qi, s) * read_dec[None, :, :, None])
        s = (s * chunk_dec[None, :, None, None]
             + jnp.einsum('bmhd,bmhe->bhde', ki * upd_dec[None, :, :, None], vi))
        return s, o

    s_new, o = lax.scan(step, s0, (to_chunks(q), to_chunks(k), to_chunks(v)))
    o = jnp.moveaxis(o, 0, 1).reshape(B, L, H, DV)
    return o, s_new


def _causal_dwconv(x, buf, w):
    K, C = w.shape
    xp = jnp.concatenate([buf, x], axis=1)
    y = lax.conv_general_dilated(xp, w[:, None, :], window_strides=(1,), padding='VALID',
                                 dimension_numbers=('NWC', 'WIO', 'NWC'), feature_group_count=C)
    return y, xp[:, -(K - 1):, :]


def _layer(x, c, s_ret, buf_a, buf_c, pos,
           ada_w, ada_b, g_pre_mix, g_post_mix, g_pre_ffn, g_post_ffn,
           w_in, w_out, ret_gn_g, conv_a_w, conv_a_b, conv_a_ln_g, conv_a_ln_b,
           conv_c_w, ffn_w1, ffn_w3, ffn_w2):
    B, L, _ = x.shape
    mod = jax.nn.silu(c) @ ada_w + ada_b
    sh_m, sc_m, gt_m, sh_f, sc_f, gt_f = [m[:, None, :] for m in jnp.split(mod, 6, axis=-1)]

    h = _rmsnorm(x, g_pre_mix) * (1.0 + sc_m) + sh_m
    proj = h @ w_in
    bounds = np.cumsum(IN_SPLITS)[:-1].tolist()
    q, k, v, g, a_val, a_gate, cb, cc, cx = jnp.split(proj, bounds, axis=-1)

    q = _rope(q.reshape(B, L, RET_HEADS, RET_DK), pos)
    k = _rope(k.reshape(B, L, RET_HEADS, RET_DK), pos) * (RET_DK ** -0.5)
    v = v.reshape(B, L, RET_HEADS, RET_DV)
    chunk = RET_CHUNK if L % RET_CHUNK == 0 else L
    o_ret, s_ret_new = _retention(q, k, v, s_ret, chunk)
    o_ret = _layernorm(o_ret, ret_gn_g.reshape(RET_HEADS, RET_DV), jnp.zeros_like(ret_gn_g).reshape(RET_HEADS, RET_DV))
    o_ret = o_ret.reshape(B, L, RET_WIDTH) * jax.nn.silu(g)

    u = a_val * jax.nn.sigmoid(a_gate)
    ua, buf_a_new = _causal_dwconv(u, buf_a, conv_a_w)
    o_a = jax.nn.silu(_layernorm(ua + conv_a_b, conv_a_ln_g, conv_a_ln_b))

    z = cc * cx
    zc, buf_c_new = _causal_dwconv(z, buf_c, conv_c_w)
    o_c = cb * zc

    mix = jnp.concatenate([o_ret, o_a, o_c], axis=-1) @ w_out
    x = x + gt_m * _rmsnorm(mix, g_post_mix)

    h = _rmsnorm(x, g_pre_ffn) * (1.0 + sc_f) + sh_f
    f = (jax.nn.silu(h @ ffn_w1) * (h @ ffn_w3)) @ ffn_w2
    x = x + gt_f * _rmsnorm(f, g_post_ffn)
    return x, s_ret_new, buf_a_new, buf_c_new


def setup_inputs(seed: int = 0) -> dict:
    key = jax.random.key(seed)
    ks = jax.random.split(key, 24)
    f32 = jnp.float32
    n = lambda k, shape, s: (jax.random.normal(k, shape, f32) * s)
    return {
        "x_prompt": n(ks[0], (BATCH, SEQ, D_MODEL), 1.0),
        "x_sample": n(ks[1], (DEC_BATCH, DEC_SEQ, D_MODEL), 1.0),
        "c_prompt": n(ks[2], (BATCH, D_MODEL), 1.0),
        "c_sample": n(ks[3], (DEC_BATCH, D_MODEL), 1.0),
        "state_ret": n(ks[4], (DEPTH, DEC_BATCH, RET_HEADS, RET_DK, RET_DV), 0.5),
        "state_conv_a": n(ks[5], (DEPTH, DEC_BATCH, CONV_A_K - 1, CONV_A_WIDTH), 0.5),
        "state_conv_c": n(ks[6], (DEPTH, DEC_BATCH, CONV_C_K - 1, CONV_C_WIDTH), 0.5),
        "ada_w": n(ks[7], (DEPTH, D_MODEL, 6 * D_MODEL), 0.5 * D_MODEL ** -0.5),
        "ada_b": n(ks[8], (DEPTH, 6 * D_MODEL), 0.01),
        "norm_pre_mix": 1.0 + n(ks[9], (DEPTH, D_MODEL), 0.05),
        "norm_post_mix": 1.0 + n(ks[10], (DEPTH, D_MODEL), 0.05),
        "norm_pre_ffn": 1.0 + n(ks[11], (DEPTH, D_MODEL), 0.05),
        "norm_post_ffn": 1.0 + n(ks[12], (DEPTH, D_MODEL), 0.05),
        "w_in": n(ks[13], (DEPTH, D_MODEL, IN_WIDTH), D_MODEL ** -0.5),
        "w_out": n(ks[14], (DEPTH, MIX_WIDTH, D_MODEL), MIX_WIDTH ** -0.5),
        "ret_gn_g": 1.0 + n(ks[15], (DEPTH, RET_WIDTH), 0.05),
        "conv_a_w": n(ks[16], (DEPTH, CONV_A_K, CONV_A_WIDTH), CONV_A_K ** -0.5),
        "conv_a_b": n(ks[17], (DEPTH, CONV_A_WIDTH), 0.01),
        "conv_a_ln_g": 1.0 + n(ks[18], (DEPTH, CONV_A_WIDTH), 0.05),
        "conv_a_ln_b": n(ks[19], (DEPTH, CONV_A_WIDTH), 0.01),
        "conv_c_w": n(ks[20], (DEPTH, CONV_C_K, CONV_C_WIDTH), CONV_C_K ** -0.5),
        "ffn_w1": n(ks[21], (DEPTH, D_MODEL, D_FF), D_MODEL ** -0.5),
        "ffn_w3": n(ks[22], (DEPTH, D_MODEL, D_FF), D_MODEL ** -0.5),
        "ffn_w2": n(ks[23], (DEPTH, D_FF, D_MODEL), D_FF ** -0.5),
    }


def reference(x_prompt, x_sample, c_prompt, c_sample, state_ret, state_conv_a, state_conv_c,
              ada_w, ada_b, norm_pre_mix, norm_post_mix, norm_pre_ffn, norm_post_ffn,
              w_in, w_out, ret_gn_g, conv_a_w, conv_a_b, conv_a_ln_g, conv_a_ln_b,
              conv_c_w, ffn_w1, ffn_w3, ffn_w2):
    Bp, Lp, _ = x_prompt.shape
    Ls = x_sample.shape[1]
    dt = x_prompt.dtype
    pos_p = jnp.arange(Lp, dtype=jnp.float32)
    pos_s = PAST_LEN + jnp.arange(Ls, dtype=jnp.float32)
    yp, ys = x_prompt, x_sample
    ret_p, ca_p, cc_p, ret_s, ca_s, cc_s = [], [], [], [], [], []
    for l in range(DEPTH):
        params = (ada_w[l], ada_b[l], norm_pre_mix[l], norm_post_mix[l], norm_pre_ffn[l],
                  norm_post_ffn[l], w_in[l], w_out[l], ret_gn_g[l], conv_a_w[l], conv_a_b[l],
                  conv_a_ln_g[l], conv_a_ln_b[l], conv_c_w[l], ffn_w1[l], ffn_w3[l], ffn_w2[l])
        s0 = jnp.zeros((Bp, RET_HEADS, RET_DK, RET_DV), dt)
        ba0 = jnp.zeros((Bp, CONV_A_K - 1, CONV_A_WIDTH), dt)
        bc0 = jnp.zeros((Bp, CONV_C_K - 1, CONV_C_WIDTH), dt)
        yp, sr, ba, bc = _layer(yp, c_prompt, s0, ba0, bc0, pos_p, *params)
        ret_p.append(sr); ca_p.append(ba); cc_p.append(bc)
        ys, sr, ba, bc = _layer(ys, c_sample, state_ret[l], state_conv_a[l], state_conv_c[l], pos_s, *params)
        ret_s.append(sr); ca_s.append(ba); cc_s.append(bc)
    return (yp, ys, jnp.stack(ret_p), jnp.stack(ca_p), jnp.stack(cc_p),
            jnp.stack(ret_s), jnp.stack(ca_s), jnp.stack(cc_s))
```

```cpp
#include <hip/hip_runtime.h>
#include <cstdio>
#include <cstdint>
namespace pg8 {
#define PG8_LAS __attribute__((address_space(3)))
typedef unsigned short bf16_t;
typedef short bf16x8 __attribute__((ext_vector_type(8)));
typedef float f32x4 __attribute__((ext_vector_type(4)));
typedef unsigned u32x4 __attribute__((ext_vector_type(4)));
constexpr int BM = 256, BK = 64, HALF = 128, HTB = HALF * BK * 2  , STAGE_BYTES = 8 * HTB, NXCD = 8, WGM = 8;

__host__ __device__ __forceinline__ int lds_byte(int r, int c) { const int st = (r >> 4) * 2 + (c >> 5), rr = r & 15, cc = c & 31, ob = rr * 64 + cc * 2; return st * 1024 + (ob ^ (((ob >> 9) & 1) << 5)); }
__host__ __device__ __forceinline__ void stage_rc(int b, int& R, int& C) { const int st = b / 1024, sb = b % 1024, swz = sb ^ (((sb >> 9) & 1) << 5); R = (st >> 1) * 16 + swz / 64; C = (st & 1) * 32 + (swz % 64) / 2; }
__host__ __device__ __forceinline__ int perm32(int rho) { const int n = rho >> 4, i = rho & 15; return 8 * (i >> 2) + 4 * n + (i & 3); }

struct Unit { int pm, pn; };
struct Gemm { const bf16_t* A; const bf16_t* Bt; int M, N, K; };

struct StaticOrder {
    int nM, nN, nwg, G, c;
    __host__ __device__ void init(int M, int N, int G_, int c_) { nM = M / BM; nN = N / BM; nwg = nM * nN; G = G_; c = c_; }
    __host__ __device__ bool next(int i, Unit& u) const {
        const long L = (long)i * G + c; if (L >= nwg) return false;
        int wgid = (int)L; { const int q = nwg / NXCD, r = nwg % NXCD, xcd = wgid % NXCD, off = wgid / NXCD; wgid = (xcd < r ? xcd * (q + 1) : r * (q + 1) + (xcd - r) * q) + off; }
        const int nig = WGM * nN, gid = wgid / nig, fm = gid * WGM, gsz = (nM - fm) < WGM ? (nM - fm) : WGM;
        u.pm = fm + ((wgid % nig) % gsz); u.pn = (wgid % nig) / gsz; return true;
    }
    __device__ __forceinline__ void a_ready(const Unit&) const {}
    __device__ __forceinline__ void done(const Unit&) const {}
};

__device__ __forceinline__ unsigned cvt_pk_bf16(float lo, float hi) { unsigned r; asm volatile("v_cvt_pk_bf16_f32 %0, %1, %2" : "=v"(r) : "v"(lo), "v"(hi)); return r; }
typedef float f32x2 __attribute__((ext_vector_type(2)));
__device__ __forceinline__ f32x2 gelu_pk(f32x2 v) {
    const f32x2 av = __builtin_elementwise_abs(v), d = av * 0.2316418882f + 1.0f;
    f32x2 t; t.x = __builtin_amdgcn_rcpf(d.x); t.y = __builtin_amdgcn_rcpf(d.y);
    f32x2 q = t * 0.5307027145f + (-0.7265760135f); q = q * t + 0.7107068705f; q = q * t + (-0.142248368f); q = q * t + 0.127414796f; q = q * t;
    const f32x2 s = (v * v) * (-0.72134752044f);
    f32x2 e; e.x = __builtin_amdgcn_exp2f(s.x); e.y = __builtin_amdgcn_exp2f(s.y);
    const f32x2 m = v * (q * e), r = v - m;
    f32x2 o; o.x = v.x < 0.f ? m.x : r.x; o.y = v.y < 0.f ? m.y : r.y; return o;
}

template <int ACT  > struct EpiBf16 {
    static constexpr bool PERM = true, AFTER_DRAIN = false; static_assert(ACT == 0 || ACT == 1, "EpiBf16: ACT is 0 (none) or 1 (gelu_pk)");
    bf16_t* O; int ldc; const float* bias; int split_cols; size_t split_stride; float scale0;
    __device__ __forceinline__ void operator()(const f32x4 (&acc)[2][2][4][2], const Unit& u, int wr, int wc, int fr, int fq) const {
        const int row0 = u.pm * BM + wr * 64 + fr; int colt = u.pn * BM; bf16_t* base = O;
        float sc = 1.f; if (split_cols) { const int t = colt / split_cols; base += (size_t)t * split_stride; colt -= t * split_cols; if (t == 0) sc = scale0; }
        const int col0 = colt + wc * 32 + 8 * fq, bcol0 = u.pn * BM + wc * 32 + 8 * fq;
        f32x4 bv[2][2];
#pragma unroll
        for (int bj = 0; bj < 2; ++bj)
#pragma unroll
            for (int n = 0; n < 2; ++n) bv[bj][n] = bias ? *(const f32x4*)(bias + bcol0 + bj * HALF + 4 * n) : (f32x4){0.f, 0.f, 0.f, 0.f};
#pragma unroll
        for (int ai = 0; ai < 2; ++ai)
#pragma unroll
            for (int m = 0; m < 4; ++m) { bf16_t* rowp = base + (size_t)(row0 + ai * HALF + m * 16) * ldc + col0;
#pragma unroll
                for (int bj = 0; bj < 2; ++bj) { f32x4 v0 = acc[ai][bj][m][0] + bv[bj][0], v1 = acc[ai][bj][m][1] + bv[bj][1];
                    if (ACT == 1) { f32x2 a = gelu_pk((f32x2){v0[0], v0[1]}), b = gelu_pk((f32x2){v0[2], v0[3]}), c = gelu_pk((f32x2){v1[0], v1[1]}), d = gelu_pk((f32x2){v1[2], v1[3]});
                        v0 = (f32x4){a.x, a.y, b.x, b.y}; v1 = (f32x4){c.x, c.y, d.x, d.y}; }
                    v0 = v0 * sc; v1 = v1 * sc; u32x4 w; w.x = cvt_pk_bf16(v0[0], v0[1]); w.y = cvt_pk_bf16(v0[2], v0[3]); w.z = cvt_pk_bf16(v1[0], v1[1]); w.w = cvt_pk_bf16(v1[2], v1[3]);
                    *(u32x4*)(rowp + bj * HALF) = w; } }
    }
};

struct PanelStats {
    unsigned* xbuf;
    unsigned* cnt;
    unsigned* tmo;
    int ntn; float eps;
    unsigned code;
    __device__ __forceinline__ bool run(const f32x4 (&v)[2][2][4][2], const Unit& u, int wr, int wc, int fr, int fq, PG8_LAS unsigned char* lds, int wid, int lane) const {
        typedef float f32x2v __attribute__((ext_vector_type(2)));
        PG8_LAS f32x2v* P = (PG8_LAS f32x2v*)lds;
        PG8_LAS f32x2v* S = (PG8_LAS f32x2v*)(lds + 8192);
        PG8_LAS unsigned* flag = (PG8_LAS unsigned*)(lds + 8192 + 2048);
#pragma unroll
        for (int ai = 0; ai < 2; ++ai)
#pragma unroll
            for (int m = 0; m < 4; ++m) {
                float s = 0.f;
#pragma unroll
                for (int bj = 0; bj < 2; ++bj)
#pragma unroll
                    for (int n = 0; n < 2; ++n) { const f32x4 x = v[ai][bj][m][n]; s += (x[0] + x[1]) + (x[2] + x[3]); }
                s += __shfl_xor(s, 16); s += __shfl_xor(s, 32);
                const float mw = s * (1.0f / 64.0f); float q = 0.f;
#pragma unroll
                for (int bj = 0; bj < 2; ++bj)
#pragma unroll
                    for (int n = 0; n < 2; ++n) { const f32x4 d = v[ai][bj][m][n] - mw; q += (d[0] * d[0] + d[1] * d[1]) + (d[2] * d[2] + d[3] * d[3]); }
                q += __shfl_xor(q, 16); q += __shfl_xor(q, 32);
                if (fq == 0) P[(ai * HALF + wr * 64 + m * 16 + fr) * 4 + wc] = (f32x2v){mw, q};
            }
        asm volatile("s_waitcnt lgkmcnt(0)" ::: "memory"); __builtin_amdgcn_s_barrier(); asm volatile("" ::: "memory");
#if defined(BROKEN_EXCHANGE_NO_WAIT)
#warning BROKEN CONTROL BUILD: the row-statistics exchange does not wait; results are wrong by design
        if (blockIdx.x >= 64) { const long long t0_ = clock64(); while (clock64() - t0_ < 60000) __builtin_amdgcn_s_sleep(8); }
#endif
        const int row = wid * 32 + (lane & 31);
        if (lane < 32) {
            const f32x2v a = P[row * 4 + 0], b = P[row * 4 + 1], c = P[row * 4 + 2], d = P[row * 4 + 3];
            const float mt = (a.x + b.x + c.x + d.x) * 0.25f;
            const float da = a.x - mt, db = b.x - mt, dc = c.x - mt, dd = d.x - mt;
            const float m2 = (a.y + b.y) + (c.y + d.y) + 64.0f * ((da * da + db * db) + (dc * dc + dd * dd));
            unsigned long long* slot = (unsigned long long*)xbuf + ((size_t)(u.pm * BM + row) * 4 + u.pn);
            __hip_atomic_store(slot, ((unsigned long long)__float_as_uint(m2) << 32) | __float_as_uint(mt), __ATOMIC_RELAXED, __HIP_MEMORY_SCOPE_AGENT);
        }
        asm volatile("s_waitcnt vmcnt(0)" ::: "memory");
        if (lane == 0) __hip_atomic_fetch_add(cnt + 64 * u.pm, 1u, __ATOMIC_RELAXED, __HIP_MEMORY_SCOPE_AGENT);
        if (wid == 0) {
            bool dead = false; const unsigned long long t0 = __builtin_amdgcn_s_memrealtime(); const unsigned want = 8u * (unsigned)ntn;
            for (;;) {
#if defined(BROKEN_EXCHANGE_NO_WAIT)
                break;
#endif
                if ((unsigned)__builtin_amdgcn_readfirstlane(__hip_atomic_load(cnt + 64 * u.pm, __ATOMIC_RELAXED, __HIP_MEMORY_SCOPE_AGENT)) >= want) break;
                if (__builtin_amdgcn_s_memrealtime() - t0 > 2000000ull) {
                    if (lane == 0) { unsigned expect = 0u; __hip_atomic_compare_exchange_strong(tmo + 1, &expect, code | (unsigned)(u.pm & 0xff), __ATOMIC_RELAXED, __ATOMIC_RELAXED, __HIP_MEMORY_SCOPE_AGENT);
                                     __hip_atomic_store(tmo, 1u, __ATOMIC_RELAXED, __HIP_MEMORY_SCOPE_AGENT); }
                    dead = true; break; }
                __builtin_amdgcn_s_sleep(2);
            }
            __builtin_amdgcn_fence(__ATOMIC_ACQUIRE, "agent");
            if (lane == 0) flag[0] = dead ? 1u : 0u;
        }
        asm volatile("s_waitcnt vmcnt(0) lgkmcnt(0)" ::: "memory"); __builtin_amdgcn_s_barrier(); asm volatile("" ::: "memory");
        const bool bad = flag[0] != 0u;
        if (lane < 32) {
            const unsigned long long* slot = (const unsigned long long*)xbuf + (size_t)(u.pm * BM + row) * 4; float mt[4], m2[4]; float ms = 0.f;
#pragma unroll
            for (int t = 0; t < 4; ++t) { if (t < ntn) { const unsigned long long w = __hip_atomic_load(slot + t, __ATOMIC_RELAXED, __HIP_MEMORY_SCOPE_AGENT); mt[t] = __uint_as_float((unsigned)w); m2[t] = __uint_as_float((unsigned)(w >> 32)); } else { mt[t] = 0.f; m2[t] = 0.f; } ms += mt[t]; }
            const float mean = ms / (float)ntn; float q = 0.f;
#pragma unroll
            for (int t = 0; t < 4; ++t) if (t < ntn) { const float dm = mt[t] - mean; q += m2[t] + 256.0f * dm * dm; }
            S[row] = (f32x2v){mean, 1.0f / sqrtf(q / (256.0f * (float)ntn) + eps)};
        }
        asm volatile("s_waitcnt lgkmcnt(0)" ::: "memory"); __builtin_amdgcn_s_barrier(); asm volatile("" ::: "memory");
        return bad;
    }
};
struct EpiLnRes {
    static constexpr bool PERM = false, AFTER_DRAIN = true;
    const float* base; float* out; int ldc; const float* bias; PanelStats st; unsigned poison;
    __device__ __forceinline__ void fused(f32x4 (&acc)[2][2][4][2], const Unit& u, int wr, int wc, int fr, int fq, PG8_LAS unsigned char* lds, int wid, int lane) const {
        typedef float f32x2v __attribute__((ext_vector_type(2)));
        const PG8_LAS f32x2v* S = (const PG8_LAS f32x2v*)(lds + 8192);
        const int col0 = u.pn * BM + wc * 32 + 4 * fq;
#pragma unroll
        for (int bj = 0; bj < 2; ++bj)
#pragma unroll
            for (int n = 0; n < 2; ++n) { const f32x4 bv = bias ? *(const f32x4*)(bias + col0 + bj * HALF + n * 16) : (f32x4){0.f, 0.f, 0.f, 0.f};
#pragma unroll
                for (int ai = 0; ai < 2; ++ai)
#pragma unroll
                    for (int m = 0; m < 4; ++m) acc[ai][bj][m][n] += bv; }
        f32x4 pre[4][2][2];
#pragma unroll
        for (int m = 0; m < 4; ++m) { const size_t off = (size_t)(u.pm * BM + wr * 64 + m * 16 + fr) * ldc + col0;
#pragma unroll
            for (int bj = 0; bj < 2; ++bj)
#pragma unroll
                for (int n = 0; n < 2; ++n) pre[m][bj][n] = *(const f32x4*)(base + off + bj * HALF + n * 16); }
        const bool bad = st.run(acc, u, wr, wc, fr, fq, lds, wid, lane) || poison != 0u;
        const float qnan = __builtin_nanf("");
#pragma unroll
        for (int ai = 0; ai < 2; ++ai)
#pragma unroll
            for (int m = 0; m < 4; ++m) { const int r = ai * HALF + wr * 64 + m * 16 + fr; const f32x2v sr = S[r]; const size_t off = (size_t)(u.pm * BM + r) * ldc + col0;
#pragma unroll
                for (int bj = 0; bj < 2; ++bj)
#pragma unroll
                    for (int n = 0; n < 2; ++n) { const f32x4 bs = ai == 0 ? pre[m][bj][n] : *(const f32x4*)(base + off + bj * HALF + n * 16); f32x4 o = bs + (acc[ai][bj][m][n] - sr.x) * sr.y;
                        if (bad) o = (f32x4){qnan, qnan, qnan, qnan}; *(f32x4*)(out + off + bj * HALF + n * 16) = o; }
                if (m & 1) asm volatile("" ::: "memory"); }
    }
};
struct EpiLnResLn {
    static constexpr bool PERM = false, AFTER_DRAIN = true;
    const float* base; float* out; bf16_t* xn; int ldc; const float* bias; PanelStats st1, st2; unsigned poison;
    __device__ __forceinline__ void fused(f32x4 (&acc)[2][2][4][2], const Unit& u, int wr, int wc, int fr, int fq, PG8_LAS unsigned char* lds, int wid, int lane) const {
        typedef float f32x2v __attribute__((ext_vector_type(2))); typedef unsigned u32x2v __attribute__((ext_vector_type(2)));
        const PG8_LAS f32x2v* S = (const PG8_LAS f32x2v*)(lds + 8192);
        const int col0 = u.pn * BM + wc * 32 + 4 * fq;
#pragma unroll
        for (int bj = 0; bj < 2; ++bj)
#pragma unroll
            for (int n = 0; n < 2; ++n) { const f32x4 bv = bias ? *(const f32x4*)(bias + col0 + bj * HALF + n * 16) : (f32x4){0.f, 0.f, 0.f, 0.f};
#pragma unroll
                for (int ai = 0; ai < 2; ++ai)
#pragma unroll
                    for (int m = 0; m < 4; ++m) acc[ai][bj][m][n] += bv; }
        bool bad = st1.run(acc, u, wr, wc, fr, fq, lds, wid, lane) || poison != 0u;
        const float qnan = __builtin_nanf("");
#pragma unroll
        for (int ai = 0; ai < 2; ++ai)
#pragma unroll
            for (int m = 0; m < 4; ++m) { const int r = ai * HALF + wr * 64 + m * 16 + fr; const f32x2v sr = S[r]; const size_t off = (size_t)(u.pm * BM + r) * ldc + col0;
#pragma unroll
                for (int bj = 0; bj < 2; ++bj)
#pragma unroll
                    for (int n = 0; n < 2; ++n) { const f32x4 bs = *(const f32x4*)(base + off + bj * HALF + n * 16); acc[ai][bj][m][n] = bs + (acc[ai][bj][m][n] - sr.x) * sr.y; }
                asm volatile("" : "+v"(acc[ai][0][m][0]), "+v"(acc[ai][0][m][1]), "+v"(acc[ai][1][m][0]), "+v"(acc[ai][1][m][1]));
                if (m & 1) asm volatile("" ::: "memory"); }
        const bool bad1 = bad;
        bad = st2.run(acc, u, wr, wc, fr, fq, lds, wid, lane) || bad;
#pragma unroll
        for (int ai = 0; ai < 2; ++ai)
#pragma unroll
            for (int m = 0; m < 4; ++m) { const int r = ai * HALF + wr * 64 + m * 16 + fr; const f32x2v sr = S[r]; const size_t off = (size_t)(u.pm * BM + r) * ldc + col0;
#pragma unroll
                for (int bj = 0; bj < 2; ++bj)
#pragma unroll
                    for (int n = 0; n < 2; ++n) { const f32x4 x1 = acc[ai][bj][m][n]; *(f32x4*)(out + off + bj * HALF + n * 16) = bad1 ? (f32x4){qnan, qnan, qnan, qnan} : x1;
                        const f32x4 o = (x1 - sr.x) * sr.y; u32x2v w; w.x = cvt_pk_bf16(o[0], o[1]); w.y = cvt_pk_bf16(o[2], o[3]);
                        if (bad) { w.x = 0x7fc07fc0u; w.y = 0x7fc07fc0u; } *(u32x2v*)(xn + off + bj * HALF + n * 16) = w; }
                asm volatile("" ::: "memory"); }
    }
};

template <class Epi, class Sched, bool ALIGN_EPI = false, bool SP2 = false>
__device__ __forceinline__ void gemm_phase(PG8_LAS unsigned char* lds, const Gemm g, const Sched& S, const Epi& E) {
    int tid_ = threadIdx.x; asm volatile("" : "+v"(tid_));
    const int tid = tid_, wid = __builtin_amdgcn_readfirstlane(tid >> 6), lane = tid & 63, wr = wid >> 2, wc = wid & 3, fr = lane & 15, fq = lane >> 4;
    const int K = g.K, nt = K / BK;
    unsigned voffA[2], voffB[2];
#pragma unroll
    for (int i = 0; i < 2; ++i) { int R, C; stage_rc(tid * 16 + i * 8192, R, C); const int Rb = Epi::PERM ? ((R & ~31) + perm32(R & 31)) : R;
        voffA[i] = (unsigned)(R * K + C) * 2u; voffB[i] = (unsigned)(Rb * K + C) * 2u; }
    const size_t kstep = (size_t)(BK * 2);
    const size_t hstep = (size_t)HALF * K * 2;
    const size_t tstep = 2 * hstep;
    const unsigned ldsw = (unsigned)wid * 1024u;
    const int aoff = lds_byte(wr * 64 + fr, fq * 8), boff = lds_byte(wc * 32 + fr, fq * 8);
#define PG8_SA(b, h) (((b) * 2 + (h)) * HTB)
#define PG8_SB(b, h) ((4 + (b) * 2 + (h)) * HTB)
#define PG8_STAGE(bufoff, gbase, voff) do { _Pragma("unroll") for (int _i = 0; _i < 2; ++_i) \
        __builtin_amdgcn_global_load_lds((const unsigned*)((const char*)(gbase) + (voff)[_i]), (PG8_LAS unsigned*)(lds + (bufoff) + ldsw + _i * 8192), 16, 0, 0); } while (0)
#define PG8_LDA(dst, b, h) do { _Pragma("unroll") for (int m = 0; m < 4; ++m) _Pragma("unroll") for (int k = 0; k < 2; ++k) dst[m][k] = *(const PG8_LAS bf16x8*)(lds + PG8_SA(b, h) + aoff + m * 2048 + k * 1024); } while (0)
#define PG8_LDB(dst, b, h) do { _Pragma("unroll") for (int n = 0; n < 2; ++n) _Pragma("unroll") for (int k = 0; k < 2; ++k) dst[n][k] = *(const PG8_LAS bf16x8*)(lds + PG8_SB(b, h) + boff + n * 2048 + k * 1024); } while (0)
#define PG8_MMA(ai, bj, At, Bt) do { __builtin_amdgcn_s_setprio(1); _Pragma("unroll") for (int m = 0; m < 4; ++m) _Pragma("unroll") for (int n = 0; n < 2; ++n) _Pragma("unroll") for (int k = 0; k < 2; ++k) \
        acc[ai][bj][m][n] = __builtin_amdgcn_mfma_f32_16x16x32_bf16(Bt[n][k], At[m][k], acc[ai][bj][m][n], 0, 0, 0); __builtin_amdgcn_s_setprio(0); } while (0)
#define PG8_WAIT_V(n) asm volatile("s_waitcnt vmcnt(" #n ")" ::: "memory")
#define PG8_WAIT_L(n) asm volatile("s_waitcnt lgkmcnt(" #n ")" ::: "memory")
#define PG8_BAR __builtin_amdgcn_s_barrier()
#define PG8_SCHED __builtin_amdgcn_sched_barrier(0)
    Unit cur, nxt; int ui = 0;
    if (!S.next(0, cur)) return;
    f32x4 acc[2][2][4][2];
#pragma unroll
    for (int a = 0; a < 2; ++a)
#pragma unroll
        for (int b = 0; b < 2; ++b)
#pragma unroll
            for (int m = 0; m < 4; ++m)
#pragma unroll
                for (int n = 0; n < 2; ++n) acc[a][b][m][n] = (f32x4){0.f, 0.f, 0.f, 0.f};
    bf16x8 At[4][2], B0[2][2], B1[2][2];
    const char* cA = (const char*)g.A + (size_t)cur.pm * tstep; const char* cB = (const char*)g.Bt + (size_t)cur.pn * tstep;
    S.a_ready(cur);
    if constexpr (SP2) {
        PG8_STAGE(PG8_SB(0, 0), cB, voffB); PG8_STAGE(PG8_SB(0, 1), cB + hstep, voffB); PG8_STAGE(PG8_SA(0, 0), cA, voffA); PG8_STAGE(PG8_SA(0, 1), cA + hstep, voffA);
        if (wr == 1) PG8_BAR;
        PG8_WAIT_V(2); PG8_BAR;
        PG8_STAGE(PG8_SB(1, 0), cB + kstep, voffB); PG8_STAGE(PG8_SA(1, 0), cA + kstep, voffA); PG8_STAGE(PG8_SB(1, 1), cB + hstep + kstep, voffB);
        PG8_WAIT_V(6); PG8_BAR;
    } else {
        PG8_STAGE(PG8_SB(0, 0), cB, voffB); PG8_STAGE(PG8_SA(0, 0), cA, voffA); PG8_STAGE(PG8_SB(0, 1), cB + hstep, voffB); PG8_STAGE(PG8_SA(0, 1), cA + hstep, voffA);
        if (wr == 1) PG8_BAR;
        PG8_WAIT_V(4); PG8_BAR;
        PG8_STAGE(PG8_SB(1, 0), cB + kstep, voffB); PG8_STAGE(PG8_SA(1, 0), cA + kstep, voffA); PG8_STAGE(PG8_SB(1, 1), cB + hstep + kstep, voffB);
        PG8_WAIT_V(6); PG8_BAR;
    }
    for (;;) {
        const bool has_next = S.next(ui + 1, nxt);
        const char* nA = has_next ? (const char*)g.A + (size_t)nxt.pm * tstep : cA; const char* nB = has_next ? (const char*)g.Bt + (size_t)nxt.pn * tstep : cB;
        for (int t = 0; t < nt; t += 2) {
            const bool last = (t == nt - 2);
            const char* a1 = cA + (size_t)(t + 1) * kstep;
            const char* a2 = last ? nA : cA + (size_t)(t + 2) * kstep; const char* b2 = last ? nB : cB + (size_t)(t + 2) * kstep;
            const char* a3 = a2 + kstep; const char* b3 = b2 + kstep;
            if (last && has_next) S.a_ready(nxt);
            if constexpr (SP2) {
            PG8_LDB(B0, 0, 0); PG8_LDB(B1, 0, 1); PG8_SCHED; PG8_LDA(At, 0, 0); PG8_STAGE(PG8_SA(1, 1), a1 + hstep, voffA);
            PG8_WAIT_V(8); PG8_WAIT_L(0); PG8_BAR; PG8_MMA(0, 0, At, B0); PG8_MMA(0, 1, At, B1); PG8_BAR; PG8_SCHED;
            PG8_LDA(At, 0, 1); PG8_STAGE(PG8_SB(0, 0), b2, voffB); PG8_STAGE(PG8_SB(0, 1), b2 + hstep, voffB); PG8_STAGE(PG8_SA(0, 0), a2, voffA);
            PG8_WAIT_V(8); PG8_WAIT_L(0); PG8_BAR; PG8_MMA(1, 0, At, B0); PG8_MMA(1, 1, At, B1); PG8_BAR; PG8_SCHED;
            PG8_LDB(B0, 1, 0); PG8_LDB(B1, 1, 1); PG8_SCHED; PG8_LDA(At, 1, 0); PG8_STAGE(PG8_SA(0, 1), a2 + hstep, voffA);
            PG8_WAIT_V(8); PG8_WAIT_L(0); PG8_BAR; PG8_MMA(0, 0, At, B0); PG8_MMA(0, 1, At, B1); PG8_BAR; PG8_SCHED;
            PG8_LDA(At, 1, 1); PG8_STAGE(PG8_SB(1, 0), b3, voffB); PG8_STAGE(PG8_SB(1, 1), b3 + hstep, voffB); PG8_STAGE(PG8_SA(1, 0), a3, voffA);
            PG8_WAIT_V(8); PG8_WAIT_L(0); PG8_BAR; PG8_MMA(1, 0, At, B0); PG8_MMA(1, 1, At, B1); PG8_BAR; PG8_SCHED;
            } else {
            PG8_LDB(B0, 0, 0); PG8_SCHED; PG8_LDA(At, 0, 0); PG8_STAGE(PG8_SA(1, 1), a1 + hstep, voffA);
            PG8_WAIT_L(8); PG8_BAR; PG8_WAIT_L(0); PG8_MMA(0, 0, At, B0); PG8_BAR; PG8_SCHED;
            PG8_LDB(B1, 0, 1); PG8_STAGE(PG8_SB(0, 0), b2, voffB);
            PG8_BAR; PG8_WAIT_L(0); PG8_MMA(0, 1, At, B1); PG8_BAR;
            PG8_LDA(At, 0, 1); PG8_STAGE(PG8_SA(0, 0), a2, voffA);
            PG8_BAR; PG8_WAIT_L(0); PG8_MMA(1, 0, At, B0); PG8_BAR; PG8_SCHED;
            PG8_STAGE(PG8_SB(0, 1), b2 + hstep, voffB);
            PG8_WAIT_V(6); PG8_BAR; PG8_MMA(1, 1, At, B1); PG8_BAR;
            PG8_LDB(B0, 1, 0); PG8_SCHED; PG8_LDA(At, 1, 0); PG8_STAGE(PG8_SA(0, 1), a2 + hstep, voffA);
            PG8_WAIT_L(8); PG8_BAR; PG8_WAIT_L(0); PG8_MMA(0, 0, At, B0); PG8_BAR; PG8_SCHED;
            PG8_LDB(B1, 1, 1); PG8_STAGE(PG8_SB(1, 0), b3, voffB);
            PG8_BAR; PG8_WAIT_L(0); PG8_MMA(0, 1, At, B1); PG8_BAR;
            PG8_LDA(At, 1, 1); PG8_STAGE(PG8_SA(1, 0), a3, voffA);
            PG8_BAR; PG8_WAIT_L(0); PG8_MMA(1, 0, At, B0); PG8_BAR; PG8_SCHED;
            PG8_STAGE(PG8_SB(1, 1), b3 + hstep, voffB);
            PG8_WAIT_V(6); PG8_BAR; PG8_MMA(1, 1, At, B1); PG8_BAR;
            }
        }
        if constexpr (ALIGN_EPI) { if (wr == 0) PG8_BAR; }
        if constexpr (!Epi::AFTER_DRAIN) { E(acc, cur, wr, wc, fr, fq); S.done(cur); }
        if (!has_next) break;
#pragma unroll
        for (int a = 0; a < 2; ++a)
#pragma unroll
            for (int b = 0; b < 2; ++b)
#pragma unroll
                for (int m = 0; m < 4; ++m)
#pragma unroll
                    for (int n = 0; n < 2; ++n) acc[a][b][m][n] = (f32x4){0.f, 0.f, 0.f, 0.f};
        cur = nxt; cA = nA; cB = nB; ++ui;
        if constexpr (ALIGN_EPI) { if (wr == 1) PG8_BAR; }
    }
    PG8_WAIT_V(0);
    if constexpr (!ALIGN_EPI) { if (wr == 0) PG8_BAR; }
    PG8_BAR;
    if constexpr (Epi::AFTER_DRAIN) { E.fused(acc, cur, wr, wc, fr, fq, lds, wid, lane); S.done(cur); }
#undef PG8_SA
#undef PG8_SB
#undef PG8_STAGE
#undef PG8_LDA
#undef PG8_LDB
#undef PG8_MMA
#undef PG8_WAIT_V
#undef PG8_WAIT_L
#undef PG8_BAR
#undef PG8_SCHED
}
}

#include <hip/hip_cooperative_groups.h>
namespace cg = cooperative_groups;
namespace mk {
using pg8::bf16_t; using pg8::bf16x8; using pg8::f32x4; using pg8::u32x4;
#define MK_LAS __attribute__((address_space(3)))
typedef unsigned u32x2 __attribute__((ext_vector_type(2)));
typedef float f32x2v __attribute__((ext_vector_type(2)));

constexpr int D = 1024, NP = 16384, NS = 128, MR = NP + NS, MP = 16640, SEQ = 2048, NB = 8;
constexpr int INW = 2816, DFF = 2816, NFF1 = 5632, NMOD = 12288, MODROWS = 136, DEPTH = 2;
constexpr float EPS = 1e-6f;
constexpr int NWAVES = 8, NTHREADS = 512;
constexpr int LDS_BYTES = 147456;

constexpr int PQ = 0, PK = 256, PV = 512, PG = 1024, PAV = 1536, PAG = 1792, PCB = 2048, PCC = 2304, PCX = 2560;

constexpr size_t MiB = 1u << 20;
constexpr size_t WS_WIN = 1 * MiB, WS_WOUT = 12 * MiB, WS_W13 = 16 * MiB, WS_W2 = 38 * MiB, WS_MOD = 49 * MiB, WS_HM = 56 * MiB,
                 WS_T1 = 89 * MiB, WS_PROJ = 122 * MiB, WS_U = 212 * MiB, WS_END = 228 * MiB;
constexpr size_t WS_ADAT = WS_T1, WS_AC = WS_T1 + 24 * MiB;
static_assert(WS_WIN + (size_t)DEPTH * INW * D * 2 <= WS_WOUT && WS_WOUT + (size_t)DEPTH * D * D * 2 <= WS_W13 && WS_W13 + (size_t)DEPTH * NFF1 * D * 2 <= WS_W2 &&
              WS_W2 + (size_t)DEPTH * D * DFF * 2 <= WS_MOD && WS_MOD + (size_t)MODROWS * NMOD * 4 <= WS_HM && WS_HM + (size_t)MP * D * 2 <= WS_T1 &&
              WS_T1 + (size_t)MP * D * 2 <= WS_PROJ && WS_AC + 256 * D * 2 <= WS_PROJ && WS_PROJ + (size_t)MP * INW * 2 <= WS_U && WS_U + (size_t)512 * 8192 * 4 <= WS_END, "ws map");

constexpr size_t O_Y = 0, O_YS = (size_t)NP * D, O_RETP = O_YS + (size_t)NS * D, O_CAP = O_RETP + (size_t)DEPTH * NB * 4 * 64 * 128,
                 O_CCP = O_CAP + (size_t)DEPTH * NB * 30 * 256, O_RETS = O_CCP + (size_t)DEPTH * NB * 2 * 256,
                 O_CAS = O_RETS + (size_t)DEPTH * NS * 4 * 64 * 128, O_CCS = O_CAS + (size_t)DEPTH * NS * 30 * 256, O_END = O_CCS + (size_t)DEPTH * NS * 2 * 256;

struct Params { const float* in[24]; float* out; unsigned char* ws; };

__device__ const double kInvRev[32] = {
0.15915494309189535, 0.11934937021124886, 0.08949940160889101, 0.06711508300522726, 0.050329212104487035, 0.03774158471741977, 0.0283021958306234, 0.02122365276477766,
0.015915494309189534, 0.011934937021124886, 0.008949940160889102, 0.006711508300522725, 0.005032921210448704, 0.003774158471741977, 0.00283021958306234, 0.0021223652764777662,
0.0015915494309189536, 0.0011934937021124885, 0.0008949940160889102, 0.0006711508300522726, 0.0005032921210448703, 0.00037741584717419774, 0.00028302195830623395, 0.0002122365276477766,
0.00015915494309189535, 0.00011934937021124886, 8.949940160889102e-05, 6.711508300522725e-05, 5.0329212104487035e-05, 3.774158471741978e-05, 2.8302195830623396e-05, 2.122365276477766e-05};

__device__ __forceinline__ float bf2f(unsigned short b) { return __uint_as_float((unsigned)b << 16); }
__device__ __forceinline__ float bflo(unsigned w) { return __uint_as_float(w << 16); }
__device__ __forceinline__ float bfhi(unsigned w) { return __uint_as_float(w & 0xffff0000u); }
__device__ __forceinline__ f32x4 unpack4(u32x2 w) { return (f32x4){bflo(w.x), bfhi(w.x), bflo(w.y), bfhi(w.y)}; }
__device__ __forceinline__ u32x2 pack4(f32x4 v) { u32x2 w; w.x = pg8::cvt_pk_bf16(v[0], v[1]); w.y = pg8::cvt_pk_bf16(v[2], v[3]); return w; }
__device__ __forceinline__ float sigmoidf_(float x) { return __builtin_amdgcn_rcpf(1.0f + __expf(-x)); }
__device__ __forceinline__ float siluf_(float x) { return x * sigmoidf_(x); }
__device__ __forceinline__ float wave_sum(float v) {
#pragma unroll
    for (int o = 1; o < 64; o <<= 1) v += __shfl_xor(v, o);
    return v;
}
__device__ __forceinline__ float log2_gamma(int h) { return __log2f(1.0f - exp2f(-5.0f - (float)h)); }

struct EpiMod {
    static constexpr bool PERM = false, AFTER_DRAIN = false;
    float* O; const float* bias;
    __device__ __forceinline__ void operator()(const f32x4 (&acc)[2][2][4][2], const pg8::Unit& u, int wr, int wc, int fr, int fq) const {
        const int col0 = u.pn * 256 + wc * 32 + 4 * fq;
#pragma unroll
        for (int ai = 0; ai < 2; ++ai)
#pragma unroll
            for (int m = 0; m < 4; ++m) { const int row = u.pm * 256 + ai * 128 + wr * 64 + m * 16 + fr;
                if (row < MODROWS) {
#pragma unroll
                    for (int bj = 0; bj < 2; ++bj)
#pragma unroll
                        for (int n = 0; n < 2; ++n) { const int col = col0 + bj * 128 + n * 16; *(f32x4*)(O + (size_t)row * NMOD + col) = acc[ai][bj][m][n] + *(const f32x4*)(bias + col); } } }
    }
};
struct EpiSwiGLU {
    static constexpr bool PERM = true, AFTER_DRAIN = false;
    bf16_t* O;
    __device__ __forceinline__ void operator()(const f32x4 (&acc)[2][2][4][2], const pg8::Unit& u, int wr, int wc, int fr, int fq) const {
        const int col0 = u.pn * 128 + wc * 32 + 8 * fq;
#pragma unroll
        for (int ai = 0; ai < 2; ++ai)
#pragma unroll
            for (int m = 0; m < 4; ++m) { bf16_t* rowp = O + (size_t)(u.pm * 256 + ai * 128 + wr * 64 + m * 16 + fr) * DFF + col0;
                f32x4 a0 = acc[ai][0][m][0], a1 = acc[ai][0][m][1]; const f32x4 b0 = acc[ai][1][m][0], b1 = acc[ai][1][m][1];
#pragma unroll
                for (int i = 0; i < 4; ++i) { a0[i] = siluf_(a0[i]) * b0[i]; a1[i] = siluf_(a1[i]) * b1[i]; }
                u32x4 w; w.x = pg8::cvt_pk_bf16(a0[0], a0[1]); w.y = pg8::cvt_pk_bf16(a0[2], a0[3]); w.z = pg8::cvt_pk_bf16(a1[0], a1[1]); w.w = pg8::cvt_pk_bf16(a1[2], a1[3]);
                *(u32x4*)rowp = w; }
    }
};

__device__ __forceinline__ void p0_transpose_item(const float* W, int K, int N, bf16_t* WT, int k0, int n0, int orow, MK_LAS float* scr, int lane) {
#pragma unroll 8
    for (int i = 0; i < 32; ++i) { const int kk = 2 * i + (lane >> 5); scr[kk * 33 + (lane & 31)] = W[(size_t)(k0 + kk) * N + n0 + (lane & 31)]; }
    asm volatile("s_waitcnt lgkmcnt(0)" ::: "memory");
    const int c = lane & 7;
#pragma unroll
    for (int j = 0; j < 4; ++j) { const int n = (lane >> 3) + 8 * j; const MK_LAS float* s = scr + (8 * c) * 33 + n;
        u32x4 o; o.x = pg8::cvt_pk_bf16(s[0 * 33], s[1 * 33]); o.y = pg8::cvt_pk_bf16(s[2 * 33], s[3 * 33]); o.z = pg8::cvt_pk_bf16(s[4 * 33], s[5 * 33]); o.w = pg8::cvt_pk_bf16(s[6 * 33], s[7 * 33]);
        *(u32x4*)(WT + (size_t)(orow + n) * K + k0 + 8 * c) = o; }
    asm volatile("s_waitcnt lgkmcnt(0)" ::: "memory");
}
__device__ __forceinline__ void p0_prologue(const Params& P, MK_LAS unsigned char* lds) {
    int tid_ = threadIdx.x; asm volatile("" : "+v"(tid_)); const int tid = tid_, lane = tid & 63, wave = __builtin_amdgcn_readfirstlane(tid >> 6); (void)tid; (void)lane; (void)wave;
    MK_LAS float* scr = (MK_LAS float*)(lds + wave * 16384);
    const int gw = blockIdx.x * NWAVES + wave, NGW = gridDim.x * NWAVES;
    unsigned char* ws = P.ws;
    constexpr int I_IN = 16 * 88, I_OUT = 16 * 32, I_F = 16 * 88, I_2 = 44 * 32, I_ADA = 16 * 192;
    constexpr int PER_L = I_IN + I_OUT + 2 * I_F + I_2 + I_ADA;
    for (int it = gw; it < DEPTH * PER_L; it += NGW) {
        const int l = it / PER_L; int r = it % PER_L;
        if (r < I_IN) { const int kb = r / 88, nb = r % 88; p0_transpose_item(P.in[13] + (size_t)l * D * INW, D, INW, (bf16_t*)(ws + WS_WIN) + (size_t)l * INW * D, 64 * kb, 32 * nb, 32 * nb, scr, lane); continue; } r -= I_IN;
        if (r < I_OUT) { const int kb = r / 32, nb = r % 32; p0_transpose_item(P.in[14] + (size_t)l * D * D, D, D, (bf16_t*)(ws + WS_WOUT) + (size_t)l * D * D, 64 * kb, 32 * nb, 32 * nb, scr, lane); continue; } r -= I_OUT;
        if (r < I_F) { const int kb = r / 88, nb = r % 88, n0 = 32 * nb; p0_transpose_item(P.in[21] + (size_t)l * D * DFF, D, DFF, (bf16_t*)(ws + WS_W13) + (size_t)l * NFF1 * D, 64 * kb, n0, 256 * (n0 >> 7) + (n0 & 127), scr, lane); continue; } r -= I_F;
        if (r < I_F) { const int kb = r / 88, nb = r % 88, n0 = 32 * nb; p0_transpose_item(P.in[22] + (size_t)l * D * DFF, D, DFF, (bf16_t*)(ws + WS_W13) + (size_t)l * NFF1 * D, 64 * kb, n0, 256 * (n0 >> 7) + 128 + (n0 & 127), scr, lane); continue; } r -= I_F;
        if (r < I_2) { const int kb = r / 32, nb = r % 32; p0_transpose_item(P.in[23] + (size_t)l * DFF * D, DFF, D, (bf16_t*)(ws + WS_W2) + (size_t)l * D * DFF, 64 * kb, 32 * nb, 32 * nb, scr, lane); continue; } r -= I_2;
        { const int kb = r / 192, nb = r % 192; p0_transpose_item(P.in[7] + (size_t)l * D * 6144, D, 6144, (bf16_t*)(ws + WS_ADAT), 64 * kb, 32 * nb, l * 6144 + 32 * nb, scr, lane); }
    }
    for (int r = gw; r < 256; r += NGW) {
        bf16_t* o = (bf16_t*)(ws + WS_AC) + (size_t)r * D;
        const float* src = r < NB ? P.in[2] + (size_t)r * D : P.in[3] + (size_t)(r - NB) * D;
#pragma unroll
        for (int j = 0; j < 4; ++j) { f32x4 v = (f32x4){0.f, 0.f, 0.f, 0.f};
            if (r < MODROWS) { v = *(const f32x4*)(src + 4 * lane + 256 * j); v[0] = siluf_(v[0]); v[1] = siluf_(v[1]); v[2] = siluf_(v[2]); v[3] = siluf_(v[3]); }
            *(u32x2*)(o + 4 * lane + 256 * j) = pack4(v); }
    }
}

template <int KIND>
__device__ __forceinline__ void rowpass(const Params& P, int l) {
    int tid_ = threadIdx.x; asm volatile("" : "+v"(tid_)); const int tid = tid_, lane = tid & 63, wave = __builtin_amdgcn_readfirstlane(tid >> 6); (void)tid; (void)lane; (void)wave;
    const int gw = blockIdx.x * NWAVES + wave, NGW = gridDim.x * NWAVES;
    unsigned char* ws = P.ws;
    const float* mod = (const float*)(ws + WS_MOD);
    bf16_t* HM = (bf16_t*)(ws + WS_HM); const bf16_t* T1 = (const bf16_t*)(ws + WS_T1);
    for (int r = gw; r < MR; r += NGW) {
        const int mrow = r < NP ? (r >> 11) : NB + (r - NP);
        const float* mp = mod + (size_t)mrow * NMOD + l * 6144;
        f32x4 x[4];
        const float* xin = (KIND == 0 || (KIND == 1 && l == 0)) ? (r < NP ? P.in[0] + (size_t)r * D : P.in[1] + (size_t)(r - NP) * D) : P.out + (size_t)r * D;
#pragma unroll
        for (int j = 0; j < 4; ++j) x[j] = *(const f32x4*)(xin + 4 * lane + 256 * j);
        if (KIND != 0) {
            f32x4 t[4]; float s = 0.f;
#pragma unroll
            for (int j = 0; j < 4; ++j) { t[j] = unpack4(*(const u32x2*)(T1 + (size_t)r * D + 4 * lane + 256 * j)); s += (t[j][0] * t[j][0] + t[j][1] * t[j][1]) + (t[j][2] * t[j][2] + t[j][3] * t[j][3]); }
            const float rstd = rsqrtf(wave_sum(s) * (1.0f / D) + EPS);
            const float* gpost = P.in[KIND == 1 ? 10 : 12] + l * D;
            const float* gt = mp + (KIND == 1 ? 2 : 5) * D;
#pragma unroll
            for (int j = 0; j < 4; ++j) { const f32x4 g = *(const f32x4*)(gpost + 4 * lane + 256 * j), gg = *(const f32x4*)(gt + 4 * lane + 256 * j);
                x[j] = x[j] + gg * (t[j] * rstd * g);
                *(f32x4*)(P.out + (size_t)r * D + 4 * lane + 256 * j) = x[j]; }
        }
        if (KIND == 2 && l == DEPTH - 1) continue;
        const int ln = (KIND == 2) ? l + 1 : l;
        const float* mpn = mod + (size_t)mrow * NMOD + ln * 6144;
        const float* gpre = P.in[KIND == 1 ? 11 : 9] + ln * D;
        const float* sh = mpn + (KIND == 1 ? 3 : 0) * D; const float* sc = mpn + (KIND == 1 ? 4 : 1) * D;
        float s = 0.f;
#pragma unroll
        for (int j = 0; j < 4; ++j) s += (x[j][0] * x[j][0] + x[j][1] * x[j][1]) + (x[j][2] * x[j][2] + x[j][3] * x[j][3]);
        const float rstd = rsqrtf(wave_sum(s) * (1.0f / D) + EPS);
#pragma unroll
        for (int j = 0; j < 4; ++j) { const f32x4 g = *(const f32x4*)(gpre + 4 * lane + 256 * j), a = *(const f32x4*)(sc + 4 * lane + 256 * j), b = *(const f32x4*)(sh + 4 * lane + 256 * j);
            const f32x4 h = (x[j] * rstd * g) * (a + 1.0f) + b;
            *(u32x2*)(HM + (size_t)r * D + 4 * lane + 256 * j) = pack4(h); }
    }
}

__device__ __forceinline__ bf16x8 lfrag(const MK_LAS bf16_t* base, int row, int stride, int k0, int fq) { return *(const MK_LAS bf16x8*)(base + row * stride + k0 + fq * 8); }
#define MK_MFMA(b, a, c) __builtin_amdgcn_mfma_f32_16x16x32_bf16((b), (a), (c), 0, 0, 0)

__device__ __forceinline__ void rope8(const bf16_t* src  , int j, float pos, float scale, u32x4& o1, u32x4& o2, float extra  ) {
    const u32x4 w1 = *(const u32x4*)(src + 8 * j), w2 = *(const u32x4*)(src + 32 + 8 * j);
    float a[8], b[8];
#pragma unroll
    for (int q = 0; q < 4; ++q) { a[2 * q] = bflo(w1[q]); a[2 * q + 1] = bfhi(w1[q]); b[2 * q] = bflo(w2[q]); b[2 * q + 1] = bfhi(w2[q]); }
    float r1[8], r2[8]; const float sc = scale * extra;
#pragma unroll
    for (int i = 0; i < 8; ++i) { const double rev = (double)pos * kInvRev[8 * j + i]; const float fr_ = (float)(rev - floor(rev));
        const float sn = __builtin_amdgcn_sinf(fr_), cs = __builtin_amdgcn_cosf(fr_);
        r1[i] = (a[i] * cs - b[i] * sn) * sc; r2[i] = (a[i] * sn + b[i] * cs) * sc; }
#pragma unroll
    for (int q = 0; q < 4; ++q) { o1[q] = pg8::cvt_pk_bf16(r1[2 * q], r1[2 * q + 1]); o2[q] = pg8::cvt_pk_bf16(r2[2 * q], r2[2 * q + 1]); }
}

constexpr int SQ = 72, SV = 136;
constexpr int L_QS = 0, L_KS = L_QS + 128 * SQ * 2, L_VT = L_KS + 128 * SQ * 2, L_PS = L_VT + 128 * SV * 2, L_ST = L_PS + 128 * SV * 2, L_RET_END = L_ST + 128 * SQ * 2;
static_assert(L_RET_END <= 131072, "retention LDS");

__device__ __forceinline__ void load_vt(const bf16_t* PROJ, int row0, int h, MK_LAS bf16_t* Vt, int wave, int lane) {
#pragma unroll
    for (int it = 0; it < 4; ++it) { const int chunk = wave * 2 + (it & 1), m = lane + 64 * (it >> 1);
        const u32x4 w = *(const u32x4*)(PROJ + (size_t)(row0 + m) * INW + PV + h * 128 + chunk * 8);
#pragma unroll
        for (int q = 0; q < 4; ++q) { Vt[(chunk * 8 + 2 * q) * SV + m] = (bf16_t)(w[q] & 0xffffu); Vt[(chunk * 8 + 2 * q + 1) * SV + m] = (bf16_t)(w[q] >> 16); } }
}

__device__ __forceinline__ void ret_u_item(const Params& P, MK_LAS unsigned char* lds, int item) {
    int tid_ = threadIdx.x; asm volatile("" : "+v"(tid_)); const int tid = tid_, lane = tid & 63, wave = __builtin_amdgcn_readfirstlane(tid >> 6); (void)tid; (void)lane; (void)wave;
    const int h = item & 3, c = (item >> 2) & 15, b = item >> 6;
    const bf16_t* PROJ = (const bf16_t*)(P.ws + WS_PROJ);
    float* UT = (float*)(P.ws + WS_U) + (size_t)((b * 4 + h) * 16 + c) * 8192;
    MK_LAS bf16_t* Kt = (MK_LAS bf16_t*)(lds + L_KS);
    MK_LAS bf16_t* Vt = (MK_LAS bf16_t*)(lds + L_VT);
    const int row0 = b * SEQ + c * 128; const float lg = log2_gamma(h);
    __syncthreads();
    load_vt(PROJ, row0, h, Vt, wave, lane);
    { const int m = tid & 127, j = tid >> 7; u32x4 o1, o2;
      rope8(PROJ + (size_t)(row0 + m) * INW + PK + h * 64, j, (float)(c * 128 + m), 0.125f, o1, o2, exp2f((float)(127 - m) * lg));
#pragma unroll
      for (int q = 0; q < 4; ++q) { Kt[(8 * j + 2 * q) * SV + m] = (bf16_t)(o1[q] & 0xffffu); Kt[(8 * j + 2 * q + 1) * SV + m] = (bf16_t)(o1[q] >> 16);
                                    Kt[(32 + 8 * j + 2 * q) * SV + m] = (bf16_t)(o2[q] & 0xffffu); Kt[(32 + 8 * j + 2 * q + 1) * SV + m] = (bf16_t)(o2[q] >> 16); } }
    __syncthreads();
    const int fr = lane & 15, fq = lane >> 4, e0 = 16 * wave;
    f32x4 u[4];
#pragma unroll
    for (int j = 0; j < 4; ++j) u[j] = (f32x4){0.f, 0.f, 0.f, 0.f};
#pragma unroll
    for (int ks = 0; ks < 4; ++ks) { const bf16x8 a = lfrag(Vt, e0 + fr, SV, ks * 32, fq);
#pragma unroll
        for (int j = 0; j < 4; ++j) { const bf16x8 bb = lfrag(Kt, 16 * j + fr, SV, ks * 32, fq); u[j] = MK_MFMA(bb, a, u[j]); } }
#pragma unroll
    for (int j = 0; j < 4; ++j) *(f32x4*)(UT + (e0 + fr) * 64 + 16 * j + 4 * fq) = u[j];
}

__device__ __forceinline__ void ret_o_item(const Params& P, MK_LAS unsigned char* lds, int l, int item) {
    int tid_ = threadIdx.x; asm volatile("" : "+v"(tid_)); const int tid = tid_, lane = tid & 63, wave = __builtin_amdgcn_readfirstlane(tid >> 6); (void)tid; (void)lane; (void)wave;
    const int h = item & 3, c = (item >> 2) & 15, b = item >> 6;
    const bf16_t* PROJ = (const bf16_t*)(P.ws + WS_PROJ);
    bf16_t* MIX = (bf16_t*)(P.ws + WS_HM);
    const float* UTb = (const float*)(P.ws + WS_U) + (size_t)((b * 4 + h) * 16) * 8192;
    MK_LAS bf16_t* Qs = (MK_LAS bf16_t*)(lds + L_QS); MK_LAS bf16_t* Ks = (MK_LAS bf16_t*)(lds + L_KS); MK_LAS bf16_t* Vt = (MK_LAS bf16_t*)(lds + L_VT);
    MK_LAS bf16_t* Ps = (MK_LAS bf16_t*)(lds + L_PS); MK_LAS bf16_t* St = (MK_LAS bf16_t*)(lds + L_ST);
    const int row0 = b * SEQ + c * 128; const float lg = log2_gamma(h); const float cd = exp2f(128.0f * lg);
    __syncthreads();
    load_vt(PROJ, row0, h, Vt, wave, lane);
    { const int m = tid & 127, j = tid >> 7; u32x4 o1, o2; const float pos = (float)(c * 128 + m);
      rope8(PROJ + (size_t)(row0 + m) * INW + PQ + h * 64, j, pos, 1.0f, o1, o2, 1.0f);
      *(MK_LAS u32x4*)(Qs + m * SQ + 8 * j) = o1; *(MK_LAS u32x4*)(Qs + m * SQ + 32 + 8 * j) = o2;
      rope8(PROJ + (size_t)(row0 + m) * INW + PK + h * 64, j, pos, 0.125f, o1, o2, 1.0f);
      *(MK_LAS u32x4*)(Ks + m * SQ + 8 * j) = o1; *(MK_LAS u32x4*)(Ks + m * SQ + 32 + 8 * j) = o2; }
#pragma unroll 1
    for (int it = 0; it < 4; ++it) { const int idx = tid + 512 * it, e = idx >> 4, dq = idx & 15;
        f32x4 s = (f32x4){0.f, 0.f, 0.f, 0.f};
        for (int j = 0; j < c; ++j) s = s * cd + *(const f32x4*)(UTb + (size_t)j * 8192 + e * 64 + 4 * dq);
        *(MK_LAS u32x2*)(St + e * SQ + 4 * dq) = pack4(s);
        if (c == 15) { s = s * cd + *(const f32x4*)(UTb + (size_t)15 * 8192 + e * 64 + 4 * dq);
            float* o = P.out + O_RETP + (size_t)((l * NB + b) * 4 + h) * 8192 + e;
#pragma unroll
            for (int i = 0; i < 4; ++i) o[(4 * dq + i) * 128] = s[i]; } }
    __syncthreads();
    const int fr = lane & 15, fq = lane >> 4, n0 = 16 * wave, n = n0 + fr;
    {
        f32x4 sc[8];
#pragma unroll
        for (int j = 0; j < 8; ++j) sc[j] = (f32x4){0.f, 0.f, 0.f, 0.f};
#pragma unroll
        for (int ks = 0; ks < 2; ++ks) { const bf16x8 a = lfrag(Qs, n, SQ, ks * 32, fq);
#pragma unroll
            for (int j = 0; j < 8; ++j) { const bf16x8 bb = lfrag(Ks, 16 * j + fr, SQ, ks * 32, fq); sc[j] = MK_MFMA(bb, a, sc[j]); } }
#pragma unroll
        for (int j = 0; j < 8; ++j) { f32x4 p;
#pragma unroll
            for (int i = 0; i < 4; ++i) { const int dlt = n - (16 * j + 4 * fq + i); p[i] = dlt >= 0 ? sc[j][i] * exp2f((float)dlt * lg) : 0.f; }
            *(MK_LAS u32x2*)(Ps + n * SV + 16 * j + 4 * fq) = pack4(p); }
    }
    __syncthreads();
    f32x4 o1[8], o2[8];
#pragma unroll
    for (int j = 0; j < 8; ++j) { o1[j] = (f32x4){0.f, 0.f, 0.f, 0.f}; o2[j] = (f32x4){0.f, 0.f, 0.f, 0.f}; }
#pragma unroll
    for (int ks = 0; ks < 4; ++ks) { const bf16x8 a = lfrag(Ps, n, SV, ks * 32, fq);
#pragma unroll
        for (int j = 0; j < 8; ++j) { const bf16x8 bb = lfrag(Vt, 16 * j + fr, SV, ks * 32, fq); o1[j] = MK_MFMA(bb, a, o1[j]); } }
#pragma unroll
    for (int ks = 0; ks < 2; ++ks) { const bf16x8 a = lfrag(Qs, n, SQ, ks * 32, fq);
#pragma unroll
        for (int j = 0; j < 8; ++j) { const bf16x8 bb = lfrag(St, 16 * j + fr, SQ, ks * 32, fq); o2[j] = MK_MFMA(bb, a, o2[j]); } }
    const float rd = exp2f((float)(n + 1) * lg);
    float s = 0.f;
#pragma unroll
    for (int j = 0; j < 8; ++j) { o1[j] = o1[j] + o2[j] * rd; s += (o1[j][0] + o1[j][1]) + (o1[j][2] + o1[j][3]); }
    s += __shfl_xor(s, 16); s += __shfl_xor(s, 32);
    const float mean = s * (1.0f / 128.0f); float q = 0.f;
#pragma unroll
    for (int j = 0; j < 8; ++j) { o1[j] = o1[j] - mean; q += (o1[j][0] * o1[j][0] + o1[j][1] * o1[j][1]) + (o1[j][2] * o1[j][2] + o1[j][3] * o1[j][3]); }
    q += __shfl_xor(q, 16); q += __shfl_xor(q, 32);
    const float rstd = rsqrtf(q * (1.0f / 128.0f) + EPS);
    const float* gn = P.in[15] + l * 512 + h * 128;
    const size_t row = (size_t)(row0 + n);
#pragma unroll
    for (int j = 0; j < 8; ++j) { const int e = 16 * j + 4 * fq;
        const f32x4 g = *(const f32x4*)(gn + e); const f32x4 gate = unpack4(*(const u32x2*)(PROJ + row * INW + PG + h * 128 + e));
        f32x4 o;
#pragma unroll
        for (int i = 0; i < 4; ++i) o[i] = o1[j][i] * rstd * g[i] * siluf_(gate[i]);
        *(u32x2*)(MIX + row * D + h * 128 + e) = pack4(o); }
}

__device__ __forceinline__ void conva_finish(const Params& P, int l, f32x4 acc, size_t row, int lane) {
    bf16_t* MIX = (bf16_t*)(P.ws + WS_HM);
    const float mean = wave_sum((acc[0] + acc[1]) + (acc[2] + acc[3])) * (1.0f / 256.0f);
    const f32x4 d = acc - mean;
    const float var = wave_sum((d[0] * d[0] + d[1] * d[1]) + (d[2] * d[2] + d[3] * d[3])) * (1.0f / 256.0f);
    const float rstd = rsqrtf(var + EPS);
    const f32x4 g = *(const f32x4*)(P.in[18] + l * 256 + 4 * lane), bb = *(const f32x4*)(P.in[19] + l * 256 + 4 * lane);
    f32x4 y = d * rstd * g + bb;
#pragma unroll
    for (int i = 0; i < 4; ++i) y[i] = siluf_(y[i]);
    *(u32x2*)(MIX + row * D + 512 + 4 * lane) = pack4(y);
}

__device__ __forceinline__ void conv_item(const Params& P, MK_LAS unsigned char* lds, int l, int item) {
    int tid_ = threadIdx.x; asm volatile("" : "+v"(tid_)); const int tid = tid_, lane = tid & 63, wave = __builtin_amdgcn_readfirstlane(tid >> 6); (void)tid; (void)lane; (void)wave;
    const int b = item >> 5, tb = item & 31, t0 = tb * 64;
    const bf16_t* PROJ = (const bf16_t*)(P.ws + WS_PROJ);
    bf16_t* MIX = (bf16_t*)(P.ws + WS_HM);
    MK_LAS float* Us = (MK_LAS float*)lds;
    __syncthreads();
    for (int idx = tid; idx < 94 * 64; idx += NTHREADS) { const int lr = idx >> 6, q = idx & 63, t = t0 - 30 + lr;
        f32x4 u = (f32x4){0.f, 0.f, 0.f, 0.f};
        if (t >= 0) { const bf16_t* rp = PROJ + (size_t)(b * SEQ + t) * INW; const f32x4 v = unpack4(*(const u32x2*)(rp + PAV + 4 * q)), g = unpack4(*(const u32x2*)(rp + PAG + 4 * q));
#pragma unroll
            for (int i = 0; i < 4; ++i) u[i] = v[i] * sigmoidf_(g[i]); }
        *(MK_LAS f32x4*)(Us + lr * 256 + 4 * q) = u;
        if (tb == 31 && lr >= 64) *(f32x4*)(P.out + O_CAP + (size_t)((l * NB + b) * 30 + (lr - 64)) * 256 + 4 * q) = u; }
    __syncthreads();
    const float* cw = P.in[16] + l * 31 * 256 + 4 * lane;
    f32x4 acc[8]; const f32x4 bias = *(const f32x4*)(P.in[17] + l * 256 + 4 * lane);
#pragma unroll
    for (int k = 0; k < 8; ++k) acc[k] = bias;
#pragma unroll 1
    for (int j = 0; j < 31; ++j) { const f32x4 w = *(const f32x4*)(cw + j * 256);
#pragma unroll
        for (int k = 0; k < 8; ++k) acc[k] = acc[k] + w * *(const MK_LAS f32x4*)(Us + (8 * wave + k + j) * 256 + 4 * lane); }
#pragma unroll
    for (int k = 0; k < 8; ++k) conva_finish(P, l, acc[k], (size_t)(b * SEQ + t0 + 8 * wave + k), lane);
    const f32x4 w0 = *(const f32x4*)(P.in[20] + l * 768 + 4 * lane), w1 = *(const f32x4*)(P.in[20] + l * 768 + 256 + 4 * lane), w2 = *(const f32x4*)(P.in[20] + l * 768 + 512 + 4 * lane);
    f32x4 zm2 = (f32x4){0.f, 0.f, 0.f, 0.f}, zm1 = zm2;
#pragma unroll
    for (int k = -2; k < 8; ++k) { const int t = t0 + 8 * wave + k;
        f32x4 z = (f32x4){0.f, 0.f, 0.f, 0.f};
        if (t >= 0) { const bf16_t* rp = PROJ + (size_t)(b * SEQ + t) * INW; z = unpack4(*(const u32x2*)(rp + PCC + 4 * lane)) * unpack4(*(const u32x2*)(rp + PCX + 4 * lane)); }
        if (k >= 0) { const bf16_t* rp = PROJ + (size_t)(b * SEQ + t) * INW; const f32x4 cb = unpack4(*(const u32x2*)(rp + PCB + 4 * lane));
            const f32x4 o = cb * (w0 * zm2 + w1 * zm1 + w2 * z);
            *(u32x2*)(MIX + (size_t)(b * SEQ + t) * D + 768 + 4 * lane) = pack4(o);
            if (t >= SEQ - 2) *(f32x4*)(P.out + O_CCP + (size_t)((l * NB + b) * 2 + (t - (SEQ - 2))) * 256 + 4 * lane) = z; }
        zm2 = zm1; zm1 = z; }
}

__device__ __forceinline__ void sample_conv(const Params& P, int l, int grp) {
    int tid_ = threadIdx.x; asm volatile("" : "+v"(tid_)); const int tid = tid_, lane = tid & 63, wave = __builtin_amdgcn_readfirstlane(tid >> 6); (void)tid; (void)lane; (void)wave;
    const int s = grp * 8 + wave;
    const bf16_t* PROJ = (const bf16_t*)(P.ws + WS_PROJ);
    bf16_t* MIX = (bf16_t*)(P.ws + WS_HM);
    const size_t row = (size_t)(NP + s); const bf16_t* rp = PROJ + row * INW;
    const f32x4 v = unpack4(*(const u32x2*)(rp + PAV + 4 * lane)), g = unpack4(*(const u32x2*)(rp + PAG + 4 * lane));
    f32x4 u;
#pragma unroll
    for (int i = 0; i < 4; ++i) u[i] = v[i] * sigmoidf_(g[i]);
    const float* buf = P.in[5] + (size_t)((l * NS + s) * 30) * 256 + 4 * lane; float* nb = P.out + O_CAS + (size_t)((l * NS + s) * 30) * 256 + 4 * lane;
    const float* cw = P.in[16] + l * 31 * 256 + 4 * lane;
    f32x4 acc = *(const f32x4*)(P.in[17] + l * 256 + 4 * lane);
#pragma unroll 6
    for (int j = 0; j < 30; ++j) { const f32x4 x = *(const f32x4*)(buf + j * 256); acc = acc + *(const f32x4*)(cw + j * 256) * x; if (j >= 1) *(f32x4*)(nb + (j - 1) * 256) = x; }
    acc = acc + *(const f32x4*)(cw + 30 * 256) * u; *(f32x4*)(nb + 29 * 256) = u;
    conva_finish(P, l, acc, row, lane);
    const f32x4 w0 = *(const f32x4*)(P.in[20] + l * 768 + 4 * lane), w1 = *(const f32x4*)(P.in[20] + l * 768 + 256 + 4 * lane), w2 = *(const f32x4*)(P.in[20] + l * 768 + 512 + 4 * lane);
    const float* bc = P.in[6] + (size_t)((l * NS + s) * 2) * 256 + 4 * lane; float* nc = P.out + O_CCS + (size_t)((l * NS + s) * 2) * 256 + 4 * lane;
    const f32x4 z0 = *(const f32x4*)bc, z1 = *(const f32x4*)(bc + 256);
    const f32x4 z = unpack4(*(const u32x2*)(rp + PCC + 4 * lane)) * unpack4(*(const u32x2*)(rp + PCX + 4 * lane));
    const f32x4 cb = unpack4(*(const u32x2*)(rp + PCB + 4 * lane));
    *(u32x2*)(MIX + row * D + 768 + 4 * lane) = pack4(cb * (w0 * z0 + w1 * z1 + w2 * z));
    *(f32x4*)nc = z1; *(f32x4*)(nc + 256) = z;
}

__device__ __forceinline__ void sample_ret(const Params& P, int l, int grp) {
    int tid_ = threadIdx.x; asm volatile("" : "+v"(tid_)); const int tid = tid_, lane = tid & 63, wave = __builtin_amdgcn_readfirstlane(tid >> 6); (void)tid; (void)lane; (void)wave;
    const int s = (grp * 8 + wave) >> 2, h = (grp * 8 + wave) & 3;
    const bf16_t* PROJ = (const bf16_t*)(P.ws + WS_PROJ);
    bf16_t* MIX = (bf16_t*)(P.ws + WS_HM);
    const size_t row = (size_t)(NP + s); const bf16_t* rp = PROJ + row * INW;
    const float lg = log2_gamma(h), gam = exp2f(lg);
    const int i5 = lane & 31;
    const double rev = 16384.0 * kInvRev[i5]; const float fr_ = (float)(rev - floor(rev));
    const float sn = __builtin_amdgcn_sinf(fr_), cs = __builtin_amdgcn_cosf(fr_);
    const float q1 = bf2f(rp[PQ + h * 64 + i5]), q2 = bf2f(rp[PQ + h * 64 + 32 + i5]), k1 = bf2f(rp[PK + h * 64 + i5]), k2 = bf2f(rp[PK + h * 64 + 32 + i5]);
    const float qr = bflo(pg8::cvt_pk_bf16(lane < 32 ? q1 * cs - q2 * sn : q1 * sn + q2 * cs, 0.f));
    const float kr = bflo(pg8::cvt_pk_bf16((lane < 32 ? k1 * cs - k2 * sn : k1 * sn + k2 * cs) * 0.125f, 0.f));
    const int eq = lane & 31, dpar = lane >> 5;
    const f32x4 v = unpack4(*(const u32x2*)(rp + PV + h * 128 + 4 * eq));
    const float* S0 = P.in[4] + (size_t)((l * NS + s) * 4 + h) * 8192 + 4 * eq; float* S1 = P.out + O_RETS + (size_t)((l * NS + s) * 4 + h) * 8192 + 4 * eq;
    f32x4 o = (f32x4){0.f, 0.f, 0.f, 0.f};
#pragma unroll 8
    for (int it = 0; it < 32; ++it) { const int d = 2 * it + dpar;
        const float qa = __uint_as_float(__builtin_amdgcn_readlane(__float_as_uint(qr), 2 * it)), qb = __uint_as_float(__builtin_amdgcn_readlane(__float_as_uint(qr), 2 * it + 1));
        const float ka = __uint_as_float(__builtin_amdgcn_readlane(__float_as_uint(kr), 2 * it)), kb = __uint_as_float(__builtin_amdgcn_readlane(__float_as_uint(kr), 2 * it + 1));
        const float qd = dpar ? qb : qa, kd = dpar ? kb : ka;
        f32x4 sv = *(const f32x4*)(S0 + d * 128); sv = sv * gam + v * kd; *(f32x4*)(S1 + d * 128) = sv; o = o + sv * qd; }
#pragma unroll
    for (int i = 0; i < 4; ++i) o[i] += __shfl_xor(o[i], 32);
    float sm = (o[0] + o[1]) + (o[2] + o[3]);
#pragma unroll
    for (int x = 1; x < 32; x <<= 1) sm += __shfl_xor(sm, x);
    const float mean = sm * (1.0f / 128.0f); const f32x4 dd = o - mean; float qq = (dd[0] * dd[0] + dd[1] * dd[1]) + (dd[2] * dd[2] + dd[3] * dd[3]);
#pragma unroll
    for (int x = 1; x < 32; x <<= 1) qq += __shfl_xor(qq, x);
    const float rstd = rsqrtf(qq * (1.0f / 128.0f) + EPS);
    if (lane < 32) { const f32x4 g = *(const f32x4*)(P.in[15] + l * 512 + h * 128 + 4 * eq); const f32x4 gate = unpack4(*(const u32x2*)(rp + PG + h * 128 + 4 * eq));
        f32x4 y;
#pragma unroll
        for (int i = 0; i < 4; ++i) y[i] = dd[i] * rstd * g[i] * siluf_(gate[i]);
        *(u32x2*)(MIX + row * D + h * 128 + 4 * eq) = pack4(y); }
}

__global__ void __launch_bounds__(NTHREADS, 2) mk_fwd(Params P) {
    extern __shared__ __attribute__((aligned(16))) unsigned char lds_raw[];
    MK_LAS unsigned char* lds = (MK_LAS unsigned char*)lds_raw;
    cg::grid_group grid = cg::this_grid();
    const int G = gridDim.x, bx = blockIdx.x;
    unsigned char* ws = P.ws;
    bf16_t* HM = (bf16_t*)(ws + WS_HM); bf16_t* T1 = (bf16_t*)(ws + WS_T1); bf16_t* PROJ = (bf16_t*)(ws + WS_PROJ);

    p0_prologue(P, lds);
    grid.sync();
    { pg8::Gemm g{(const bf16_t*)(ws + WS_AC), (const bf16_t*)(ws + WS_ADAT), 256, NMOD, D}; pg8::StaticOrder S; S.init(256, NMOD, G, bx);
      EpiMod E{(float*)(ws + WS_MOD), P.in[8]};
      pg8::gemm_phase<EpiMod, pg8::StaticOrder, true, true>(lds, g, S, E); }
    grid.sync();
    rowpass<0>(P, 0);
    grid.sync();
#pragma unroll 1
    for (int l = 0; l < DEPTH; ++l) {
        { pg8::Gemm g{HM, (const bf16_t*)(ws + WS_WIN) + (size_t)l * INW * D, MP, INW, D}; pg8::StaticOrder S; S.init(MP, INW, G, bx);
          pg8::EpiBf16<0> E{PROJ, INW, nullptr, 0, 0, 1.f};
          pg8::gemm_phase<pg8::EpiBf16<0>, pg8::StaticOrder, true, true>(lds, g, S, E); }
        grid.sync();
        for (int it = bx; it < 512 + 256 + 64 + 16; it += G) {
            if (it < 512) ret_u_item(P, lds, it);
            else if (it < 768) conv_item(P, lds, l, it - 512);
            else if (it < 832) sample_ret(P, l, it - 768);
            else sample_conv(P, l, it - 832);
        }
        grid.sync();
        for (int it = bx; it < 512; it += G) ret_o_item(P, lds, l, it);
        grid.sync();
        { pg8::Gemm g{HM, (const bf16_t*)(ws + WS_WOUT) + (size_t)l * D * D, MP, D, D}; pg8::StaticOrder S; S.init(MP, D, G, bx);
          pg8::EpiBf16<0> E{T1, D, nullptr, 0, 0, 1.f};
          pg8::gemm_phase<pg8::EpiBf16<0>, pg8::StaticOrder, true, true>(lds, g, S, E); }
        grid.sync();
        rowpass<1>(P, l);
        grid.sync();
        { pg8::Gemm g{HM, (const bf16_t*)(ws + WS_W13) + (size_t)l * NFF1 * D, MP, NFF1, D}; pg8::StaticOrder S; S.init(MP, NFF1, G, bx);
          EpiSwiGLU E{PROJ};
          pg8::gemm_phase<EpiSwiGLU, pg8::StaticOrder, true, true>(lds, g, S, E); }
        grid.sync();
        { pg8::Gemm g{PROJ, (const bf16_t*)(ws + WS_W2) + (size_t)l * D * DFF, MP, D, DFF}; pg8::StaticOrder S; S.init(MP, D, G, bx);
          pg8::EpiBf16<0> E{T1, D, nullptr, 0, 0, 1.f};
          pg8::gemm_phase<pg8::EpiBf16<0>, pg8::StaticOrder, true, true>(lds, g, S, E); }
        grid.sync();
        rowpass<2>(P, l);
        if (l + 1 < DEPTH) grid.sync();
    }
}
}

extern "C" void kernel_launch(void* const* d_in, const int* in_sizes, int n_in, void* d_out, int out_size, void* d_ws, size_t ws_size, hipStream_t stream) {
    static int grid = 0;
    if (grid == 0) {
        if (n_in != 24 || (size_t)out_size != mk::O_END || ws_size < mk::WS_END) { fprintf(stderr, "kernel_launch: unexpected shapes: n_in %d out %d ws %zu\n", n_in, out_size, ws_size); grid = -1; return; }
        int dev = 0, cus = 0, per_cu = 0;
        hipGetDevice(&dev); hipDeviceGetAttribute(&cus, hipDeviceAttributeMultiprocessorCount, dev);
        hipFuncSetAttribute((const void*)mk::mk_fwd, hipFuncAttributeMaxDynamicSharedMemorySize, mk::LDS_BYTES);
        hipOccupancyMaxActiveBlocksPerMultiprocessor(&per_cu, (const void*)mk::mk_fwd, mk::NTHREADS, mk::LDS_BYTES);
        (void)hipGetLastError();
        if (per_cu < 1) { fprintf(stderr, "kernel_launch: occupancy query says %d blocks per CU\n", per_cu); per_cu = 1; }
        grid = cus;
    }
    if (grid < 0) return;
    mk::Params p{};
    for (int i = 0; i < 24; ++i) p.in[i] = (const float*)d_in[i];
    p.out = (float*)d_out; p.ws = (unsigned char*)d_ws;
    void* args[] = {&p};
    hipError_t e = hipLaunchCooperativeKernel((const void*)mk::mk_fwd, dim3(grid), dim3(mk::NTHREADS), args, mk::LDS_BYTES, stream);
    if (e != hipSuccess) fprintf(stderr, "kernel_launch: cooperative launch failed: %s (grid %d)\n", hipGetErrorString(e), grid);
}
```

```cpp
#include <hip/hip_runtime.h>
#include <cstdio>
#include <cstdint>
namespace pg8 {
#define PG8_LAS __attribute__((address_space(3)))
typedef unsigned short bf16_t;
typedef short bf16x8 __attribute__((ext_vector_type(8)));
typedef float f32x4 __attribute__((ext_vector_type(4)));
typedef unsigned u32x4 __attribute__((ext_vector_type(4)));
constexpr int BM = 256, BK = 64, HALF = 128, HTB = HALF * BK * 2  , STAGE_BYTES = 8 * HTB, NXCD = 8, WGM = 8;

__host__ __device__ __forceinline__ int lds_byte(int r, int c) { const int st = (r >> 4) * 2 + (c >> 5), rr = r & 15, cc = c & 31, ob = rr * 64 + cc * 2; return st * 1024 + (ob ^ (((ob >> 9) & 1) << 5)); }
__host__ __device__ __forceinline__ void stage_rc(int b, int& R, int& C) { const int st = b / 1024, sb = b % 1024, swz = sb ^ (((sb >> 9) & 1) << 5); R = (st >> 1) * 16 + swz / 64; C = (st & 1) * 32 + (swz % 64) / 2; }
__host__ __device__ __forceinline__ int perm32(int rho) { const int n = rho >> 4, i = rho & 15; return 8 * (i >> 2) + 4 * n + (i & 3); }

struct Unit { int pm, pn; };
struct Gemm { const bf16_t* A; const bf16_t* Bt; int M, N, K; };

struct StaticOrder {
    int nM, nN, nwg, G, c;
    __host__ __device__ void init(int M, int N, int G_, int c_) { nM = M / BM; nN = N / BM; nwg = nM * nN; G = G_; c = c_; }
    __host__ __device__ bool next(int i, Unit& u) const {
        const long L = (long)i * G + c; if (L >= nwg) return false;
        int wgid = (int)L; { const int q = nwg / NXCD, r = nwg % NXCD, xcd = wgid % NXCD, off = wgid / NXCD; wgid = (xcd < r ? xcd * (q + 1) : r * (q + 1) + (xcd - r) * q) + off; }
        const int nig = WGM * nN, gid = wgid / nig, fm = gid * WGM, gsz = (nM - fm) < WGM ? (nM - fm) : WGM;
        u.pm = fm + ((wgid % nig) % gsz); u.pn = (wgid % nig) / gsz; return true;
    }
    __device__ __forceinline__ void a_ready(const Unit&) const {}
    __device__ __forceinline__ void done(const Unit&) const {}
};

__device__ __forceinline__ unsigned cvt_pk_bf16(float lo, float hi) { unsigned r; asm volatile("v_cvt_pk_bf16_f32 %0, %1, %2" : "=v"(r) : "v"(lo), "v"(hi)); return r; }
typedef float f32x2 __attribute__((ext_vector_type(2)));
__device__ __forceinline__ f32x2 gelu_pk(f32x2 v) {
    const f32x2 av = __builtin_elementwise_abs(v), d = av * 0.2316418882f + 1.0f;
    f32x2 t; t.x = __builtin_amdgcn_rcpf(d.x); t.y = __builtin_amdgcn_rcpf(d.y);
    f32x2 q = t * 0.5307027145f + (-0.7265760135f); q = q * t + 0.7107068705f; q = q * t + (-0.142248368f); q = q * t + 0.127414796f; q = q * t;
    const f32x2 s = (v * v) * (-0.72134752044f);
    f32x2 e; e.x = __builtin_amdgcn_exp2f(s.x); e.y = __builtin_amdgcn_exp2f(s.y);
    const f32x2 m = v * (q * e), r = v - m;
    f32x2 o; o.x = v.x < 0.f ? m.x : r.x; o.y = v.y < 0.f ? m.y : r.y; return o;
}

template <int ACT  > struct EpiBf16 {
    static constexpr bool PERM = true, AFTER_DRAIN = false; static_assert(ACT == 0 || ACT == 1, "EpiBf16: ACT is 0 (none) or 1 (gelu_pk)");
    bf16_t* O; int ldc; const float* bias; int split_cols; size_t split_stride; float scale0;
    __device__ __forceinline__ void operator()(const f32x4 (&acc)[2][2][4][2], const Unit& u, int wr, int wc, int fr, int fq) const {
        const int row0 = u.pm * BM + wr * 64 + fr; int colt = u.pn * BM; bf16_t* base = O;
        float sc = 1.f; if (split_cols) { const int t = colt / split_cols; base += (size_t)t * split_stride; colt -= t * split_cols; if (t == 0) sc = scale0; }
        const int col0 = colt + wc * 32 + 8 * fq, bcol0 = u.pn * BM + wc * 32 + 8 * fq;
        f32x4 bv[2][2];
#pragma unroll
        for (int bj = 0; bj < 2; ++bj)
#pragma unroll
            for (int n = 0; n < 2; ++n) bv[bj][n] = bias ? *(const f32x4*)(bias + bcol0 + bj * HALF + 4 * n) : (f32x4){0.f, 0.f, 0.f, 0.f};
#pragma unroll
        for (int ai = 0; ai < 2; ++ai)
#pragma unroll
            for (int m = 0; m < 4; ++m) { bf16_t* rowp = base + (size_t)(row0 + ai * HALF + m * 16) * ldc + col0;
#pragma unroll
                for (int bj = 0; bj < 2; ++bj) { f32x4 v0 = acc[ai][bj][m][0] + bv[bj][0], v1 = acc[ai][bj][m][1] + bv[bj][1];
                    if (ACT == 1) { f32x2 a = gelu_pk((f32x2){v0[0], v0[1]}), b = gelu_pk((f32x2){v0[2], v0[3]}), c = gelu_pk((f32x2){v1[0], v1[1]}), d = gelu_pk((f32x2){v1[2], v1[3]});
                        v0 = (f32x4){a.x, a.y, b.x, b.y}; v1 = (f32x4){c.x, c.y, d.x, d.y}; }
                    v0 = v0 * sc; v1 = v1 * sc; u32x4 w; w.x = cvt_pk_bf16(v0[0], v0[1]); w.y = cvt_pk_bf16(v0[2], v0[3]); w.z = cvt_pk_bf16(v1[0], v1[1]); w.w = cvt_pk_bf16(v1[2], v1[3]);
                    *(u32x4*)(rowp + bj * HALF) = w; } }
    }
};

struct PanelStats {
    unsigned* xbuf;
    unsigned* cnt;
    unsigned* tmo;
    int ntn; float eps;
    unsigned code;
    __device__ __forceinline__ bool run(const f32x4 (&v)[2][2][4][2], const Unit& u, int wr, int wc, int fr, int fq, PG8_LAS unsigned char* lds, int wid, int lane) const {
        typedef float f32x2v __attribute__((ext_vector_type(2)));
        PG8_LAS f32x2v* P = (PG8_LAS f32x2v*)lds;
        PG8_LAS f32x2v* S = (PG8_LAS f32x2v*)(lds + 8192);
        PG8_LAS unsigned* flag = (PG8_LAS unsigned*)(lds + 8192 + 2048);
#pragma unroll
        for (int ai = 0; ai < 2; ++ai)
#pragma unroll
            for (int m = 0; m < 4; ++m) {
                float s = 0.f;
#pragma unroll
                for (int bj = 0; bj < 2; ++bj)
#pragma unroll
                    for (int n = 0; n < 2; ++n) { const f32x4 x = v[ai][bj][m][n]; s += (x[0] + x[1]) + (x[2] + x[3]); }
                s += __shfl_xor(s, 16); s += __shfl_xor(s, 32);
                const float mw = s * (1.0f / 64.0f); float q = 0.f;
#pragma unroll
                for (int bj = 0; bj < 2; ++bj)
#pragma unroll
                    for (int n = 0; n < 2; ++n) { const f32x4 d = v[ai][bj][m][n] - mw; q += (d[0] * d[0] + d[1] * d[1]) + (d[2] * d[2] + d[3] * d[3]); }
                q += __shfl_xor(q, 16); q += __shfl_xor(q, 32);
                if (fq == 0) P[(ai * HALF + wr * 64 + m * 16 + fr) * 4 + wc] = (f32x2v){mw, q};
            }
        asm volatile("s_waitcnt lgkmcnt(0)" ::: "memory"); __builtin_amdgcn_s_barrier(); asm volatile("" ::: "memory");
#if defined(BROKEN_EXCHANGE_NO_WAIT)
#warning BROKEN CONTROL BUILD: the row-statistics exchange does not wait; results are wrong by design
        if (blockIdx.x >= 64) { const long long t0_ = clock64(); while (clock64() - t0_ < 60000) __builtin_amdgcn_s_sleep(8); }
#endif
        const int row = wid * 32 + (lane & 31);
        if (lane < 32) {
            const f32x2v a = P[row * 4 + 0], b = P[row * 4 + 1], c = P[row * 4 + 2], d = P[row * 4 + 3];
            const float mt = (a.x + b.x + c.x + d.x) * 0.25f;
            const float da = a.x - mt, db = b.x - mt, dc = c.x - mt, dd = d.x - mt;
            const float m2 = (a.y + b.y) + (c.y + d.y) + 64.0f * ((da * da + db * db) + (dc * dc + dd * dd));
            unsigned long long* slot = (unsigned long long*)xbuf + ((size_t)(u.pm * BM + row) * 4 + u.pn);
            __hip_atomic_store(slot, ((unsigned long long)__float_as_uint(m2) << 32) | __float_as_uint(mt), __ATOMIC_RELAXED, __HIP_MEMORY_SCOPE_AGENT);
        }
        asm volatile("s_waitcnt vmcnt(0)" ::: "memory");
        if (lane == 0) __hip_atomic_fetch_add(cnt + 64 * u.pm, 1u, __ATOMIC_RELAXED, __HIP_MEMORY_SCOPE_AGENT);
        if (wid == 0) {
            bool dead = false; const unsigned long long t0 = __builtin_amdgcn_s_memrealtime(); const unsigned want = 8u * (unsigned)ntn;
            for (;;) {
#if defined(BROKEN_EXCHANGE_NO_WAIT)
                break;
#endif
                if ((unsigned)__builtin_amdgcn_readfirstlane(__hip_atomic_load(cnt + 64 * u.pm, __ATOMIC_RELAXED, __HIP_MEMORY_SCOPE_AGENT)) >= want) break;
                if (__builtin_amdgcn_s_memrealtime() - t0 > 2000000ull) {
                    if (lane == 0) { unsigned expect = 0u; __hip_atomic_compare_exchange_strong(tmo + 1, &expect, code | (unsigned)(u.pm & 0xff), __ATOMIC_RELAXED, __ATOMIC_RELAXED, __HIP_MEMORY_SCOPE_AGENT);
                                     __hip_atomic_store(tmo, 1u, __ATOMIC_RELAXED, __HIP_MEMORY_SCOPE_AGENT); }
                    dead = true; break; }
                __builtin_amdgcn_s_sleep(2);
            }
            __builtin_amdgcn_fence(__ATOMIC_ACQUIRE, "agent");
            if (lane == 0) flag[0] = dead ? 1u : 0u;
        }
        asm volatile("s_waitcnt vmcnt(0) lgkmcnt(0)" ::: "memory"); __builtin_amdgcn_s_barrier(); asm volatile("" ::: "memory");
        const bool bad = flag[0] != 0u;
        if (lane < 32) {
            const unsigned long long* slot = (const unsigned long long*)xbuf + (size_t)(u.pm * BM + row) * 4; float mt[4], m2[4]; float ms = 0.f;
#pragma unroll
            for (int t = 0; t < 4; ++t) { if (t < ntn) { const unsigned long long w = __hip_atomic_load(slot + t, __ATOMIC_RELAXED, __HIP_MEMORY_SCOPE_AGENT); mt[t] = __uint_as_float((unsigned)w); m2[t] = __uint_as_float((unsigned)(w >> 32)); } else { mt[t] = 0.f; m2[t] = 0.f; } ms += mt[t]; }
            const float mean = ms / (float)ntn; float q = 0.f;
#pragma unroll
            for (int t = 0; t < 4; ++t) if (t < ntn) { const float dm = mt[t] - mean; q += m2[t] + 256.0f * dm * dm; }
            S[row] = (f32x2v){mean, 1.0f / sqrtf(q / (256.0f * (float)ntn) + eps)};
        }
        asm volatile("s_waitcnt lgkmcnt(0)" ::: "memory"); __builtin_amdgcn_s_barrier(); asm volatile("" ::: "memory");
        return bad;
    }
};
struct EpiLnRes {
    static constexpr bool PERM = false, AFTER_DRAIN = true;
    const float* base; float* out; int ldc; const float* bias; PanelStats st; unsigned poison;
    __device__ __forceinline__ void fused(f32x4 (&acc)[2][2][4][2], const Unit& u, int wr, int wc, int fr, int fq, PG8_LAS unsigned char* lds, int wid, int lane) const {
        typedef float f32x2v __attribute__((ext_vector_type(2)));
        const PG8_LAS f32x2v* S = (const PG8_LAS f32x2v*)(lds + 8192);
        const int col0 = u.pn * BM + wc * 32 + 4 * fq;
#pragma unroll
        for (int bj = 0; bj < 2; ++bj)
#pragma unroll
            for (int n = 0; n < 2; ++n) { const f32x4 bv = bias ? *(const f32x4*)(bias + col0 + bj * HALF + n * 16) : (f32x4){0.f, 0.f, 0.f, 0.f};
#pragma unroll
                for (int ai = 0; ai < 2; ++ai)
#pragma unroll
                    for (int m = 0; m < 4; ++m) acc[ai][bj][m][n] += bv; }
        f32x4 pre[4][2][2];
#pragma unroll
        for (int m = 0; m < 4; ++m) { const size_t off = (size_t)(u.pm * BM + wr * 64 + m * 16 + fr) * ldc + col0;
#pragma unroll
            for (int bj = 0; bj < 2; ++bj)
#pragma unroll
                for (int n = 0; n < 2; ++n) pre[m][bj][n] = *(const f32x4*)(base + off + bj * HALF + n * 16); }
        const bool bad = st.run(acc, u, wr, wc, fr, fq, lds, wid, lane) || poison != 0u;
        const float qnan = __builtin_nanf("");
#pragma unroll
        for (int ai = 0; ai < 2; ++ai)
#pragma unroll
            for (int m = 0; m < 4; ++m) { const int r = ai * HALF + wr * 64 + m * 16 + fr; const f32x2v sr = S[r]; const size_t off = (size_t)(u.pm * BM + r) * ldc + col0;
#pragma unroll
                for (int bj = 0; bj < 2; ++bj)
#pragma unroll
                    for (int n = 0; n < 2; ++n) { const f32x4 bs = ai == 0 ? pre[m][bj][n] : *(const f32x4*)(base + off + bj * HALF + n * 16); f32x4 o = bs + (acc[ai][bj][m][n] - sr.x) * sr.y;
                        if (bad) o = (f32x4){qnan, qnan, qnan, qnan}; *(f32x4*)(out + off + bj * HALF + n * 16) = o; }
                if (m & 1) asm volatile("" ::: "memory"); }
    }
};
struct EpiLnResLn {
    static constexpr bool PERM = false, AFTER_DRAIN = true;
    const float* base; float* out; bf16_t* xn; int ldc; const float* bias; PanelStats st1, st2; unsigned poison;
    __device__ __forceinline__ void fused(f32x4 (&acc)[2][2][4][2], const Unit& u, int wr, int wc, int fr, int fq, PG8_LAS unsigned char* lds, int wid, int lane) const {
        typedef float f32x2v __attribute__((ext_vector_type(2))); typedef unsigned u32x2v __attribute__((ext_vector_type(2)));
        const PG8_LAS f32x2v* S = (const PG8_LAS f32x2v*)(lds + 8192);
        const int col0 = u.pn * BM + wc * 32 + 4 * fq;
#pragma unroll
        for (int bj = 0; bj < 2; ++bj)
#pragma unroll
            for (int n = 0; n < 2; ++n) { const f32x4 bv = bias ? *(const f32x4*)(bias + col0 + bj * HALF + n * 16) : (f32x4){0.f, 0.f, 0.f, 0.f};
#pragma unroll
                for (int ai = 0; ai < 2; ++ai)
#pragma unroll
                    for (int m = 0; m < 4; ++m) acc[ai][bj][m][n] += bv; }
        bool bad = st1.run(acc, u, wr, wc, fr, fq, lds, wid, lane) || poison != 0u;
        const float qnan = __builtin_nanf("");
#pragma unroll
        for (int ai = 0; ai < 2; ++ai)
#pragma unroll
            for (int m = 0; m < 4; ++m) { const int r = ai * HALF + wr * 64 + m * 16 + fr; const f32x2v sr = S[r]; const size_t off = (size_t)(u.pm * BM + r) * ldc + col0;
#pragma unroll
                for (int bj = 0; bj < 2; ++bj)
#pragma unroll
                    for (int n = 0; n < 2; ++n) { const f32x4 bs = *(const f32x4*)(base + off + bj * HALF + n * 16); acc[ai][bj][m][n] = bs + (acc[ai][bj][m][n] - sr.x) * sr.y; }
                asm volatile("" : "+v"(acc[ai][0][m][0]), "+v"(acc[ai][0][m][1]), "+v"(acc[ai][1][m][0]), "+v"(acc[ai][1][m][1]));
                if (m & 1) asm volatile("" ::: "memory"); }
        const bool bad1 = bad;
        bad = st2.run(acc, u, wr, wc, fr, fq, lds, wid, lane) || bad;
#pragma unroll
        for (int ai = 0; ai < 2; ++ai)
#pragma unroll
            for (int m = 0; m < 4; ++m) { const int r = ai * HALF + wr * 64 + m * 16 + fr; const f32x2v sr = S[r]; const size_t off = (size_t)(u.pm * BM + r) * ldc + col0;
#pragma unroll
                for (int bj = 0; bj < 2; ++bj)
#pragma unroll
                    for (int n = 0; n < 2; ++n) { const f32x4 x1 = acc[ai][bj][m][n]; *(f32x4*)(out + off + bj * HALF + n * 16) = bad1 ? (f32x4){qnan, qnan, qnan, qnan} : x1;
                        const f32x4 o = (x1 - sr.x) * sr.y; u32x2v w; w.x = cvt_pk_bf16(o[0], o[1]); w.y = cvt_pk_bf16(o[2], o[3]);
                        if (bad) { w.x = 0x7fc07fc0u; w.y = 0x7fc07fc0u; } *(u32x2v*)(xn + off + bj * HALF + n * 16) = w; }
                asm volatile("" ::: "memory"); }
    }
};

template <class Epi, class Sched, bool ALIGN_EPI = false, bool SP2 = false>
__device__ __forceinline__ void gemm_phase(PG8_LAS unsigned char* lds, const Gemm g, const Sched& S, const Epi& E) {
    int tid_ = threadIdx.x; asm volatile("" : "+v"(tid_));
    const int tid = tid_, wid = __builtin_amdgcn_readfirstlane(tid >> 6), lane = tid & 63, wr = wid >> 2, wc = wid & 3, fr = lane & 15, fq = lane >> 4;
    const int K = g.K, nt = K / BK;
    unsigned voffA[2], voffB[2];
#pragma unroll
    for (int i = 0; i < 2; ++i) { int R, C; stage_rc(tid * 16 + i * 8192, R, C); const int Rb = Epi::PERM ? ((R & ~31) + perm32(R & 31)) : R;
        voffA[i] = (unsigned)(R * K + C) * 2u; voffB[i] = (unsigned)(Rb * K + C) * 2u; }
    const size_t kstep = (size_t)(BK * 2);
    const size_t hstep = (size_t)HALF * K * 2;
    const size_t tstep = 2 * hstep;
    const unsigned ldsw = (unsigned)wid * 1024u;
    const int aoff = lds_byte(wr * 64 + fr, fq * 8), boff = lds_byte(wc * 32 + fr, fq * 8);
#define PG8_SA(b, h) (((b) * 2 + (h)) * HTB)
#define PG8_SB(b, h) ((4 + (b) * 2 + (h)) * HTB)
#define PG8_STAGE(bufoff, gbase, voff) do { _Pragma("unroll") for (int _i = 0; _i < 2; ++_i) \
        __builtin_amdgcn_global_load_lds((const unsigned*)((const char*)(gbase) + (voff)[_i]), (PG8_LAS unsigned*)(lds + (bufoff) + ldsw + _i * 8192), 16, 0, 0); } while (0)
#define PG8_LDA(dst, b, h) do { _Pragma("unroll") for (int m = 0; m < 4; ++m) _Pragma("unroll") for (int k = 0; k < 2; ++k) dst[m][k] = *(const PG8_LAS bf16x8*)(lds + PG8_SA(b, h) + aoff + m * 2048 + k * 1024); } while (0)
#define PG8_LDB(dst, b, h) do { _Pragma("unroll") for (int n = 0; n < 2; ++n) _Pragma("unroll") for (int k = 0; k < 2; ++k) dst[n][k] = *(const PG8_LAS bf16x8*)(lds + PG8_SB(b, h) + boff + n * 2048 + k * 1024); } while (0)
#define PG8_MMA(ai, bj, At, Bt) do { __builtin_amdgcn_s_setprio(1); _Pragma("unroll") for (int m = 0; m < 4; ++m) _Pragma("unroll") for (int n = 0; n < 2; ++n) _Pragma("unroll") for (int k = 0; k < 2; ++k) \
        acc[ai][bj][m][n] = __builtin_amdgcn_mfma_f32_16x16x32_bf16(Bt[n][k], At[m][k], acc[ai][bj][m][n], 0, 0, 0); __builtin_amdgcn_s_setprio(0); } while (0)
#define PG8_WAIT_V(n) asm volatile("s_waitcnt vmcnt(" #n ")" ::: "memory")
#define PG8_WAIT_L(n) asm volatile("s_waitcnt lgkmcnt(" #n ")" ::: "memory")
#define PG8_BAR __builtin_amdgcn_s_barrier()
#define PG8_SCHED __builtin_amdgcn_sched_barrier(0)
    Unit cur, nxt; int ui = 0;
    if (!S.next(0, cur)) return;
    f32x4 acc[2][2][4][2];
#pragma unroll
    for (int a = 0; a < 2; ++a)
#pragma unroll
        for (int b = 0; b < 2; ++b)
#pragma unroll
            for (int m = 0; m < 4; ++m)
#pragma unroll
                for (int n = 0; n < 2; ++n) acc[a][b][m][n] = (f32x4){0.f, 0.f, 0.f, 0.f};
    bf16x8 At[4][2], B0[2][2], B1[2][2];
    const char* cA = (const char*)g.A + (size_t)cur.pm * tstep; const char* cB = (const char*)g.Bt + (size_t)cur.pn * tstep;
    S.a_ready(cur);
    if constexpr (SP2) {
        PG8_STAGE(PG8_SB(0, 0), cB, voffB); PG8_STAGE(PG8_SB(0, 1), cB + hstep, voffB); PG8_STAGE(PG8_SA(0, 0), cA, voffA); PG8_STAGE(PG8_SA(0, 1), cA + hstep, voffA);
        if (wr == 1) PG8_BAR;
        PG8_WAIT_V(2); PG8_BAR;
        PG8_STAGE(PG8_SB(1, 0), cB + kstep, voffB); PG8_STAGE(PG8_SA(1, 0), cA + kstep, voffA); PG8_STAGE(PG8_SB(1, 1), cB + hstep + kstep, voffB);
        PG8_WAIT_V(6); PG8_BAR;
    } else {
        PG8_STAGE(PG8_SB(0, 0), cB, voffB); PG8_STAGE(PG8_SA(0, 0), cA, voffA); PG8_STAGE(PG8_SB(0, 1), cB + hstep, voffB); PG8_STAGE(PG8_SA(0, 1), cA + hstep, voffA);
        if (wr == 1) PG8_BAR;
        PG8_WAIT_V(4); PG8_BAR;
        PG8_STAGE(PG8_SB(1, 0), cB + kstep, voffB); PG8_STAGE(PG8_SA(1, 0), cA + kstep, voffA); PG8_STAGE(PG8_SB(1, 1), cB + hstep + kstep, voffB);
        PG8_WAIT_V(6); PG8_BAR;
    }
    for (;;) {
        const bool has_next = S.next(ui + 1, nxt);
        const char* nA = has_next ? (const char*)g.A + (size_t)nxt.pm * tstep : cA; const char* nB = has_next ? (const char*)g.Bt + (size_t)nxt.pn * tstep : cB;
        for (int t = 0; t < nt; t += 2) {
            const bool last = (t == nt - 2);
            const char* a1 = cA + (size_t)(t + 1) * kstep;
            const char* a2 = last ? nA : cA + (size_t)(t + 2) * kstep; const char* b2 = last ? nB : cB + (size_t)(t + 2) * kstep;
            const char* a3 = a2 + kstep; const char* b3 = b2 + kstep;
            if (last && has_next) S.a_ready(nxt);
            if constexpr (SP2) {
            PG8_LDB(B0, 0, 0); PG8_LDB(B1, 0, 1); PG8_SCHED; PG8_LDA(At, 0, 0); PG8_STAGE(PG8_SA(1, 1), a1 + hstep, voffA);
            PG8_WAIT_V(8); PG8_WAIT_L(0); PG8_BAR; PG8_MMA(0, 0, At, B0); PG8_MMA(0, 1, At, B1); PG8_BAR; PG8_SCHED;
            PG8_LDA(At, 0, 1); PG8_STAGE(PG8_SB(0, 0), b2, voffB); PG8_STAGE(PG8_SB(0, 1), b2 + hstep, voffB); PG8_STAGE(PG8_SA(0, 0), a2, voffA);
            PG8_WAIT_V(8); PG8_WAIT_L(0); PG8_BAR; PG8_MMA(1, 0, At, B0); PG8_MMA(1, 1, At, B1); PG8_BAR; PG8_SCHED;
            PG8_LDB(B0, 1, 0); PG8_LDB(B1, 1, 1); PG8_SCHED; PG8_LDA(At, 1, 0); PG8_STAGE(PG8_SA(0, 1), a2 + hstep, voffA);
            PG8_WAIT_V(8); PG8_WAIT_L(0); PG8_BAR; PG8_MMA(0, 0, At, B0); PG8_MMA(0, 1, At, B1); PG8_BAR; PG8_SCHED;
            PG8_LDA(At, 1, 1); PG8_STAGE(PG8_SB(1, 0), b3, voffB); PG8_STAGE(PG8_SB(1, 1), b3 + hstep, voffB); PG8_STAGE(PG8_SA(1, 0), a3, voffA);
            PG8_WAIT_V(8); PG8_WAIT_L(0); PG8_BAR; PG8_MMA(1, 0, At, B0); PG8_MMA(1, 1, At, B1); PG8_BAR; PG8_SCHED;
            } else {
            PG8_LDB(B0, 0, 0); PG8_SCHED; PG8_LDA(At, 0, 0); PG8_STAGE(PG8_SA(1, 1), a1 + hstep, voffA);
            PG8_WAIT_L(8); PG8_BAR; PG8_WAIT_L(0); PG8_MMA(0, 0, At, B0); PG8_BAR; PG8_SCHED;
            PG8_LDB(B1, 0, 1); PG8_STAGE(PG8_SB(0, 0), b2, voffB);
            PG8_BAR; PG8_WAIT_L(0); PG8_MMA(0, 1, At, B1); PG8_BAR;
            PG8_LDA(At, 0, 1); PG8_STAGE(PG8_SA(0, 0), a2, voffA);
            PG8_BAR; PG8_WAIT_L(0); PG8_MMA(1, 0, At, B0); PG8_BAR; PG8_SCHED;
            PG8_STAGE(PG8_SB(0, 1), b2 + hstep, voffB);
            PG8_WAIT_V(6); PG8_BAR; PG8_MMA(1, 1, At, B1); PG8_BAR;
            PG8_LDB(B0, 1, 0); PG8_SCHED; PG8_LDA(At, 1, 0); PG8_STAGE(PG8_SA(0, 1), a2 + hstep, voffA);
            PG8_WAIT_L(8); PG8_BAR; PG8_WAIT_L(0); PG8_MMA(0, 0, At, B0); PG8_BAR; PG8_SCHED;
            PG8_LDB(B1, 1, 1); PG8_STAGE(PG8_SB(1, 0), b3, voffB);
            PG8_BAR; PG8_WAIT_L(0); PG8_MMA(0, 1, At, B1); PG8_BAR;
            PG8_LDA(At, 1, 1); PG8_STAGE(PG8_SA(1, 0), a3, voffA);
            PG8_BAR; PG8_WAIT_L(0); PG8_MMA(1, 0, At, B0); PG8_BAR; PG8_SCHED;
            PG8_STAGE(PG8_SB(1, 1), b3 + hstep, voffB);
            PG8_WAIT_V(6); PG8_BAR; PG8_MMA(1, 1, At, B1); PG8_BAR;
            }
        }
        if constexpr (ALIGN_EPI) { if (wr == 0) PG8_BAR; }
        if constexpr (!Epi::AFTER_DRAIN) { E(acc, cur, wr, wc, fr, fq); S.done(cur); }
        if (!has_next) break;
#pragma unroll
        for (int a = 0; a < 2; ++a)
#pragma unroll
            for (int b = 0; b < 2; ++b)
#pragma unroll
                for (int m = 0; m < 4; ++m)
#pragma unroll
                    for (int n = 0; n < 2; ++n) acc[a][b][m][n] = (f32x4){0.f, 0.f, 0.f, 0.f};
        cur = nxt; cA = nA; cB = nB; ++ui;
        if constexpr (ALIGN_EPI) { if (wr == 1) PG8_BAR; }
    }
    PG8_WAIT_V(0);
    if constexpr (!ALIGN_EPI) { if (wr == 0) PG8_BAR; }
    PG8_BAR;
    if constexpr (Epi::AFTER_DRAIN) { E.fused(acc, cur, wr, wc, fr, fq, lds, wid, lane); S.done(cur); }
#undef PG8_SA
#undef PG8_SB
#undef PG8_STAGE
#undef PG8_LDA
#undef PG8_LDB
#undef PG8_MMA
#undef PG8_WAIT_V
#undef PG8_WAIT_L
#undef PG8_BAR
#undef PG8_SCHED
}
}

#include <hip/hip_cooperative_groups.h>
namespace cg = cooperative_groups;
namespace mk {
using pg8::bf16_t; using pg8::bf16x8; using pg8::f32x4; using pg8::u32x4;
#define MK_LAS __attribute__((address_space(3)))
typedef unsigned u32x2 __attribute__((ext_vector_type(2)));
typedef float f32x2v __attribute__((ext_vector_type(2)));

#define LAS MK_LAS
#define XB_TMO      128
#define XB_XCNT(j)  (256  + 64 * (j))
#define XB_XSUB(j)  (1280 + 64 * (j))
#define XB_XGEN(j)  (2304 + 64 * (j))
#define XB_TOP      3328
#define XB_TOPGEN   3392
#define XCD_BAR_WORDS 3456
#define XB_SPIN_CAP (1u << 18)

__device__ __forceinline__ unsigned xb_ld(unsigned* p)              { return __hip_atomic_load(p, __ATOMIC_RELAXED, __HIP_MEMORY_SCOPE_AGENT); }
__device__ __forceinline__ unsigned xb_add(unsigned* p, unsigned v) { return __hip_atomic_fetch_add(p, v, __ATOMIC_RELAXED, __HIP_MEMORY_SCOPE_AGENT); }
__device__ __forceinline__ unsigned xb_xcc_id() { return (unsigned)__builtin_amdgcn_s_getreg((3 << 11) | 20) & 0xFu; }
#define XB_SPIN(cond, bar) do { unsigned _sp = 0; while (cond) { __builtin_amdgcn_s_sleep(1); \
    if ((++_sp & 255u) == 0u) { if (xb_ld(&(bar)[XB_TMO])) break; if (_sp > XB_SPIN_CAP) { atomicAdd(&(bar)[XB_TMO], 1u); break; } } } } while (0)

struct XcdBarrier {
    unsigned* bar; unsigned x;
    volatile LAS unsigned* st;
};

__device__ __forceinline__ XcdBarrier xcd_barrier_post(unsigned* bar, volatile LAS unsigned* st) {
    XcdBarrier b; b.bar = bar; b.x = xb_xcc_id(); b.st = st;
    if (threadIdx.x == 0) (void)xb_add(&bar[XB_XCNT(b.x)], 1u);
    return b;
}
__device__ __forceinline__ void xcd_barrier_complete(unsigned* bar, unsigned x, unsigned& nloc, unsigned& nx) {
    const unsigned G = gridDim.x * gridDim.y * gridDim.z;
    unsigned sum, cnt, mine, sp = 0u;
    for (;;) {
        sum = 0u; cnt = 0u; mine = 0u;
#pragma unroll
        for (unsigned j = 0; j < 16; ++j) { const unsigned c = xb_ld(&bar[XB_XCNT(j)]); sum += c; cnt += (c > 0u) ? 1u : 0u; mine = (j == x) ? c : mine; }
        if (sum == G) break;
        __builtin_amdgcn_s_sleep(1);
        if ((++sp & 255u) == 0u) { if (xb_ld(&bar[XB_TMO])) break; if (sp > XB_SPIN_CAP) { atomicAdd(&bar[XB_TMO], 1u); break; } }
    }
    nloc = mine > 0u ? mine : 1u; nx = cnt > 0u ? cnt : 1u;
}

__device__ __forceinline__ void xcd_barrier(const XcdBarrier& b) {
    asm volatile("s_waitcnt vmcnt(0)" ::: "memory");
    __syncthreads();
    if (threadIdx.x == 0) {
        unsigned* bar = b.bar;
        __builtin_amdgcn_s_waitcnt(0);
        unsigned nloc = b.st[0], nx = b.st[1];
        if (nloc == 0u) { xcd_barrier_complete(bar, b.x, nloc, nx); b.st[0] = nloc; b.st[1] = nx; }
        const unsigned old = xb_add(&bar[XB_XSUB(b.x)], 1u);
        const unsigned gen = old / nloc;
        if (old + 1u == (gen + 1u) * nloc) {
            __builtin_amdgcn_fence(__ATOMIC_RELEASE, "agent");
            asm volatile("s_waitcnt vmcnt(0)" ::: "memory");
            const unsigned og = xb_add(&bar[XB_TOP], 1u);
            const unsigned tg = og / nx;
            if (og + 1u == (tg + 1u) * nx) xb_add(&bar[XB_TOPGEN], 1u);
            else XB_SPIN(xb_ld(&bar[XB_TOPGEN]) == tg, bar);
            __builtin_amdgcn_fence(__ATOMIC_ACQUIRE, "agent");
            xb_add(&bar[XB_XGEN(b.x)], 1u);
            asm volatile("s_waitcnt vmcnt(0)" ::: "memory");
        } else {
            XB_SPIN(xb_ld(&bar[XB_XGEN(b.x)]) == gen, bar);
            __builtin_amdgcn_fence(__ATOMIC_ACQUIRE, "agent");
            asm volatile("s_waitcnt vmcnt(0)" ::: "memory");
        }
    }
    __syncthreads();
}

#undef LAS
constexpr int D = 1024, NP = 16384, NS = 128, MR = NP + NS, MP = 16640, SEQ = 2048, NB = 8;
constexpr int INW = 2816, DFF = 2816, NFF1 = 5632, NMOD = 12288, MODROWS = 136, DEPTH = 2;
constexpr float EPS = 1e-6f;
constexpr int NWAVES = 8, NTHREADS = 512;
constexpr int LDS_BYTES = 147456;

constexpr int PQ = 0, PK = 256, PV = 512, PG = 1024, PAV = 1536, PAG = 1792, PCB = 2048, PCC = 2304, PCX = 2560;

constexpr size_t MiB = 1u << 20;
constexpr size_t WS_CTL = 0, CTL_ZERO_BYTES = 16384;
constexpr int LDS_CTL_OFF = 131072;
static_assert(XCD_BAR_WORDS * 4 <= CTL_ZERO_BYTES, "ctl");
constexpr size_t WS_WIN = 1 * MiB, WS_WOUT = 12 * MiB, WS_W13 = 16 * MiB, WS_W2 = 38 * MiB, WS_MOD = 49 * MiB, WS_HM = 56 * MiB,
                 WS_T1 = 89 * MiB, WS_PROJ = 122 * MiB, WS_U = 212 * MiB, WS_END = 228 * MiB;
constexpr size_t WS_ADAT = WS_T1, WS_AC = WS_T1 + 24 * MiB;
static_assert(WS_WIN + (size_t)DEPTH * INW * D * 2 <= WS_WOUT && WS_WOUT + (size_t)DEPTH * D * D * 2 <= WS_W13 && WS_W13 + (size_t)DEPTH * NFF1 * D * 2 <= WS_W2 &&
              WS_W2 + (size_t)DEPTH * D * DFF * 2 <= WS_MOD && WS_MOD + (size_t)MODROWS * NMOD * 4 <= WS_HM && WS_HM + (size_t)MP * D * 2 <= WS_T1 &&
              WS_T1 + (size_t)MP * D * 2 <= WS_PROJ && WS_AC + 256 * D * 2 <= WS_PROJ && WS_PROJ + (size_t)MP * INW * 2 <= WS_U && WS_U + (size_t)512 * 8192 * 4 <= WS_END, "ws map");

constexpr size_t O_Y = 0, O_YS = (size_t)NP * D, O_RETP = O_YS + (size_t)NS * D, O_CAP = O_RETP + (size_t)DEPTH * NB * 4 * 64 * 128,
                 O_CCP = O_CAP + (size_t)DEPTH * NB * 30 * 256, O_RETS = O_CCP + (size_t)DEPTH * NB * 2 * 256,
                 O_CAS = O_RETS + (size_t)DEPTH * NS * 4 * 64 * 128, O_CCS = O_CAS + (size_t)DEPTH * NS * 30 * 256, O_END = O_CCS + (size_t)DEPTH * NS * 2 * 256;

struct Params { const float* in[24]; float* out; unsigned char* ws; };

__device__ const double kInvRev[32] = {
0.15915494309189535, 0.11934937021124886, 0.08949940160889101, 0.06711508300522726, 0.050329212104487035, 0.03774158471741977, 0.0283021958306234, 0.02122365276477766,
0.015915494309189534, 0.011934937021124886, 0.008949940160889102, 0.006711508300522725, 0.005032921210448704, 0.003774158471741977, 0.00283021958306234, 0.0021223652764777662,
0.0015915494309189536, 0.0011934937021124885, 0.0008949940160889102, 0.0006711508300522726, 0.0005032921210448703, 0.00037741584717419774, 0.00028302195830623395, 0.0002122365276477766,
0.00015915494309189535, 0.00011934937021124886, 8.949940160889102e-05, 6.711508300522725e-05, 5.0329212104487035e-05, 3.774158471741978e-05, 2.8302195830623396e-05, 2.122365276477766e-05};

__device__ __forceinline__ float bf2f(unsigned short b) { return __uint_as_float((unsigned)b << 16); }
__device__ __forceinline__ float bflo(unsigned w) { return __uint_as_float(w << 16); }
__device__ __forceinline__ float bfhi(unsigned w) { return __uint_as_float(w & 0xffff0000u); }
__device__ __forceinline__ f32x4 unpack4(u32x2 w) { return (f32x4){bflo(w.x), bfhi(w.x), bflo(w.y), bfhi(w.y)}; }
__device__ __forceinline__ u32x2 pack4(f32x4 v) { u32x2 w; w.x = pg8::cvt_pk_bf16(v[0], v[1]); w.y = pg8::cvt_pk_bf16(v[2], v[3]); return w; }
__device__ __forceinline__ float sigmoidf_(float x) { return __builtin_amdgcn_rcpf(1.0f + __expf(-x)); }
__device__ __forceinline__ float siluf_(float x) { return x * sigmoidf_(x); }
__device__ __forceinline__ float wave_sum(float v) {
#pragma unroll
    for (int o = 1; o < 64; o <<= 1) v += __shfl_xor(v, o);
    return v;
}
__device__ __forceinline__ float log2_gamma(int h) { return __log2f(1.0f - exp2f(-5.0f - (float)h)); }

struct EpiMod {
    static constexpr bool PERM = false, AFTER_DRAIN = false;
    float* O; const float* bias;
    __device__ __forceinline__ void operator()(const f32x4 (&acc)[2][2][4][2], const pg8::Unit& u, int wr, int wc, int fr, int fq) const {
        const int col0 = u.pn * 256 + wc * 32 + 4 * fq;
#pragma unroll
        for (int ai = 0; ai < 2; ++ai)
#pragma unroll
            for (int m = 0; m < 4; ++m) { const int row = u.pm * 256 + ai * 128 + wr * 64 + m * 16 + fr;
                if (row < MODROWS) {
#pragma unroll
                    for (int bj = 0; bj < 2; ++bj)
#pragma unroll
                        for (int n = 0; n < 2; ++n) { const int col = col0 + bj * 128 + n * 16; *(f32x4*)(O + (size_t)row * NMOD + col) = acc[ai][bj][m][n] + *(const f32x4*)(bias + col); } } }
    }
};
struct EpiSwiGLU {
    static constexpr bool PERM = true, AFTER_DRAIN = false;
    bf16_t* O;
    __device__ __forceinline__ void operator()(const f32x4 (&acc)[2][2][4][2], const pg8::Unit& u, int wr, int wc, int fr, int fq) const {
        const int col0 = u.pn * 128 + wc * 32 + 8 * fq;
#pragma unroll
        for (int ai = 0; ai < 2; ++ai)
#pragma unroll
            for (int m = 0; m < 4; ++m) { bf16_t* rowp = O + (size_t)(u.pm * 256 + ai * 128 + wr * 64 + m * 16 + fr) * DFF + col0;
                f32x4 a0 = acc[ai][0][m][0], a1 = acc[ai][0][m][1]; const f32x4 b0 = acc[ai][1][m][0], b1 = acc[ai][1][m][1];
#pragma unroll
                for (int i = 0; i < 4; ++i) { a0[i] = siluf_(a0[i]) * b0[i]; a1[i] = siluf_(a1[i]) * b1[i]; }
                u32x4 w; w.x = pg8::cvt_pk_bf16(a0[0], a0[1]); w.y = pg8::cvt_pk_bf16(a0[2], a0[3]); w.z = pg8::cvt_pk_bf16(a1[0], a1[1]); w.w = pg8::cvt_pk_bf16(a1[2], a1[3]);
                *(u32x4*)rowp = w; }
    }
};

__device__ __forceinline__ void p0_transpose_item(const float* W, int K, int N, bf16_t* WT, int k0, int n0, int orow, MK_LAS float* scr, int lane) {
#pragma unroll 8
    for (int i = 0; i < 32; ++i) { const int kk = 2 * i + (lane >> 5); scr[kk * 33 + (lane & 31)] = W[(size_t)(k0 + kk) * N + n0 + (lane & 31)]; }
    asm volatile("s_waitcnt lgkmcnt(0)" ::: "memory");
    const int c = lane & 7;
#pragma unroll
    for (int j = 0; j < 4; ++j) { const int n = (lane >> 3) + 8 * j; const MK_LAS float* s = scr + (8 * c) * 33 + n;
        u32x4 o; o.x = pg8::cvt_pk_bf16(s[0 * 33], s[1 * 33]); o.y = pg8::cvt_pk_bf16(s[2 * 33], s[3 * 33]); o.z = pg8::cvt_pk_bf16(s[4 * 33], s[5 * 33]); o.w = pg8::cvt_pk_bf16(s[6 * 33], s[7 * 33]);
        *(u32x4*)(WT + (size_t)(orow + n) * K + k0 + 8 * c) = o; }
    asm volatile("s_waitcnt lgkmcnt(0)" ::: "memory");
}
__device__ __forceinline__ void p0_prologue(const Params& P, MK_LAS unsigned char* lds) {
    int tid_ = threadIdx.x; asm volatile("" : "+v"(tid_)); const int tid = tid_, lane = tid & 63, wave = __builtin_amdgcn_readfirstlane(tid >> 6); (void)tid; (void)lane; (void)wave;
    MK_LAS float* scr = (MK_LAS float*)(lds + wave * 16384);
    const int gw = blockIdx.x * NWAVES + wave, NGW = gridDim.x * NWAVES;
    unsigned char* ws = P.ws;
    constexpr int I_IN = 16 * 88, I_OUT = 16 * 32, I_F = 16 * 88, I_2 = 44 * 32, I_ADA = 16 * 192;
    constexpr int PER_L = I_IN + I_OUT + 2 * I_F + I_2 + I_ADA;
    for (int it = gw; it < DEPTH * PER_L; it += NGW) {
        const int l = it / PER_L; int r = it % PER_L;
        if (r < I_IN) { const int kb = r / 88, nb = r % 88; p0_transpose_item(P.in[13] + (size_t)l * D * INW, D, INW, (bf16_t*)(ws + WS_WIN) + (size_t)l * INW * D, 64 * kb, 32 * nb, 32 * nb, scr, lane); continue; } r -= I_IN;
        if (r < I_OUT) { const int kb = r / 32, nb = r % 32; p0_transpose_item(P.in[14] + (size_t)l * D * D, D, D, (bf16_t*)(ws + WS_WOUT) + (size_t)l * D * D, 64 * kb, 32 * nb, 32 * nb, scr, lane); continue; } r -= I_OUT;
        if (r < I_F) { const int kb = r / 88, nb = r % 88, n0 = 32 * nb; p0_transpose_item(P.in[21] + (size_t)l * D * DFF, D, DFF, (bf16_t*)(ws + WS_W13) + (size_t)l * NFF1 * D, 64 * kb, n0, 256 * (n0 >> 7) + (n0 & 127), scr, lane); continue; } r -= I_F;
        if (r < I_F) { const int kb = r / 88, nb = r % 88, n0 = 32 * nb; p0_transpose_item(P.in[22] + (size_t)l * D * DFF, D, DFF, (bf16_t*)(ws + WS_W13) + (size_t)l * NFF1 * D, 64 * kb, n0, 256 * (n0 >> 7) + 128 + (n0 & 127), scr, lane); continue; } r -= I_F;
        if (r < I_2) { const int kb = r / 32, nb = r % 32; p0_transpose_item(P.in[23] + (size_t)l * DFF * D, DFF, D, (bf16_t*)(ws + WS_W2) + (size_t)l * D * DFF, 64 * kb, 32 * nb, 32 * nb, scr, lane); continue; } r -= I_2;
        { const int kb = r / 192, nb = r % 192; p0_transpose_item(P.in[7] + (size_t)l * D * 6144, D, 6144, (bf16_t*)(ws + WS_ADAT), 64 * kb, 32 * nb, l * 6144 + 32 * nb, scr, lane); }
    }
    for (int r = gw; r < 256; r += NGW) {
        bf16_t* o = (bf16_t*)(ws + WS_AC) + (size_t)r * D;
        const float* src = r < NB ? P.in[2] + (size_t)r * D : P.in[3] + (size_t)(r - NB) * D;
#pragma unroll
        for (int j = 0; j < 4; ++j) { f32x4 v = (f32x4){0.f, 0.f, 0.f, 0.f};
            if (r < MODROWS) { v = *(const f32x4*)(src + 4 * lane + 256 * j); v[0] = siluf_(v[0]); v[1] = siluf_(v[1]); v[2] = siluf_(v[2]); v[3] = siluf_(v[3]); }
            *(u32x2*)(o + 4 * lane + 256 * j) = pack4(v); }
    }
}

template <int KIND>
__device__ __forceinline__ void rowpass(const Params& P, int l) {
    int tid_ = threadIdx.x; asm volatile("" : "+v"(tid_)); const int tid = tid_, lane = tid & 63, wave = __builtin_amdgcn_readfirstlane(tid >> 6); (void)tid; (void)lane; (void)wave;
    const int gw = blockIdx.x * NWAVES + wave, NGW = gridDim.x * NWAVES;
    unsigned char* ws = P.ws;
    const float* mod = (const float*)(ws + WS_MOD);
    bf16_t* HM = (bf16_t*)(ws + WS_HM); const bf16_t* T1 = (const bf16_t*)(ws + WS_T1);
    for (int r = gw; r < MR; r += NGW) {
        const int mrow = r < NP ? (r >> 11) : NB + (r - NP);
        const float* mp = mod + (size_t)mrow * NMOD + l * 6144;
        f32x4 x[4];
        const float* xin = (KIND == 0 || (KIND == 1 && l == 0)) ? (r < NP ? P.in[0] + (size_t)r * D : P.in[1] + (size_t)(r - NP) * D) : P.out + (size_t)r * D;
#pragma unroll
        for (int j = 0; j < 4; ++j) x[j] = *(const f32x4*)(xin + 4 * lane + 256 * j);
        if (KIND != 0) {
            f32x4 t[4]; float s = 0.f;
#pragma unroll
            for (int j = 0; j < 4; ++j) { t[j] = unpack4(*(const u32x2*)(T1 + (size_t)r * D + 4 * lane + 256 * j)); s += (t[j][0] * t[j][0] + t[j][1] * t[j][1]) + (t[j][2] * t[j][2] + t[j][3] * t[j][3]); }
            const float rstd = rsqrtf(wave_sum(s) * (1.0f / D) + EPS);
            const float* gpost = P.in[KIND == 1 ? 10 : 12] + l * D;
            const float* gt = mp + (KIND == 1 ? 2 : 5) * D;
#pragma unroll
            for (int j = 0; j < 4; ++j) { const f32x4 g = *(const f32x4*)(gpost + 4 * lane + 256 * j), gg = *(const f32x4*)(gt + 4 * lane + 256 * j);
                x[j] = x[j] + gg * (t[j] * rstd * g);
                *(f32x4*)(P.out + (size_t)r * D + 4 * lane + 256 * j) = x[j]; }
        }
        if (KIND == 2 && l == DEPTH - 1) continue;
        const int ln = (KIND == 2) ? l + 1 : l;
        const float* mpn = mod + (size_t)mrow * NMOD + ln * 6144;
        const float* gpre = P.in[KIND == 1 ? 11 : 9] + ln * D;
        const float* sh = mpn + (KIND == 1 ? 3 : 0) * D; const float* sc = mpn + (KIND == 1 ? 4 : 1) * D;
        float s = 0.f;
#pragma unroll
        for (int j = 0; j < 4; ++j) s += (x[j][0] * x[j][0] + x[j][1] * x[j][1]) + (x[j][2] * x[j][2] + x[j][3] * x[j][3]);
        const float rstd = rsqrtf(wave_sum(s) * (1.0f / D) + EPS);
#pragma unroll
        for (int j = 0; j < 4; ++j) { const f32x4 g = *(const f32x4*)(gpre + 4 * lane + 256 * j), a = *(const f32x4*)(sc + 4 * lane + 256 * j), b = *(const f32x4*)(sh + 4 * lane + 256 * j);
            const f32x4 h = (x[j] * rstd * g) * (a + 1.0f) + b;
            *(u32x2*)(HM + (size_t)r * D + 4 * lane + 256 * j) = pack4(h); }
    }
}

__device__ __forceinline__ bf16x8 lfrag(const MK_LAS bf16_t* base, int row, int stride, int k0, int fq) { return *(const MK_LAS bf16x8*)(base + row * stride + k0 + fq * 8); }
#define MK_MFMA(b, a, c) __builtin_amdgcn_mfma_f32_16x16x32_bf16((b), (a), (c), 0, 0, 0)

__device__ __forceinline__ void rope8(const bf16_t* src  , int j, float pos, float scale, u32x4& o1, u32x4& o2, float extra  ) {
    const u32x4 w1 = *(const u32x4*)(src + 8 * j), w2 = *(const u32x4*)(src + 32 + 8 * j);
    float a[8], b[8];
#pragma unroll
    for (int q = 0; q < 4; ++q) { a[2 * q] = bflo(w1[q]); a[2 * q + 1] = bfhi(w1[q]); b[2 * q] = bflo(w2[q]); b[2 * q + 1] = bfhi(w2[q]); }
    float r1[8], r2[8]; const float sc = scale * extra;
#pragma unroll
    for (int i = 0; i < 8; ++i) { const double rev = (double)pos * kInvRev[8 * j + i]; const float fr_ = (float)(rev - floor(rev));
        const float sn = __builtin_amdgcn_sinf(fr_), cs = __builtin_amdgcn_cosf(fr_);
        r1[i] = (a[i] * cs - b[i] * sn) * sc; r2[i] = (a[i] * sn + b[i] * cs) * sc; }
#pragma unroll
    for (int q = 0; q < 4; ++q) { o1[q] = pg8::cvt_pk_bf16(r1[2 * q], r1[2 * q + 1]); o2[q] = pg8::cvt_pk_bf16(r2[2 * q], r2[2 * q + 1]); }
}

constexpr int SQ = 72, SV = 136;
constexpr int L_QS = 0, L_KS = L_QS + 128 * SQ * 2, L_VT = L_KS + 128 * SQ * 2, L_PS = L_VT + 128 * SV * 2, L_ST = L_PS + 128 * SV * 2, L_RET_END = L_ST + 128 * SQ * 2;
static_assert(L_RET_END <= 131072, "retention LDS");

__device__ __forceinline__ void load_vt(const bf16_t* PROJ, int row0, int h, MK_LAS bf16_t* Vt, int wave, int lane) {
#pragma unroll
    for (int it = 0; it < 4; ++it) { const int chunk = wave * 2 + (it & 1), m = lane + 64 * (it >> 1);
        const u32x4 w = *(const u32x4*)(PROJ + (size_t)(row0 + m) * INW + PV + h * 128 + chunk * 8);
#pragma unroll
        for (int q = 0; q < 4; ++q) { Vt[(chunk * 8 + 2 * q) * SV + m] = (bf16_t)(w[q] & 0xffffu); Vt[(chunk * 8 + 2 * q + 1) * SV + m] = (bf16_t)(w[q] >> 16); } }
}

__device__ __forceinline__ void ret_u_item(const Params& P, MK_LAS unsigned char* lds, int item) {
    int tid_ = threadIdx.x; asm volatile("" : "+v"(tid_)); const int tid = tid_, lane = tid & 63, wave = __builtin_amdgcn_readfirstlane(tid >> 6); (void)tid; (void)lane; (void)wave;
    const int h = item & 3, c = (item >> 2) & 15, b = item >> 6;
    const bf16_t* PROJ = (const bf16_t*)(P.ws + WS_PROJ);
    float* UT = (float*)(P.ws + WS_U) + (size_t)((b * 4 + h) * 16 + c) * 8192;
    MK_LAS bf16_t* Kt = (MK_LAS bf16_t*)(lds + L_KS);
    MK_LAS bf16_t* Vt = (MK_LAS bf16_t*)(lds + L_VT);
    const int row0 = b * SEQ + c * 128; const float lg = log2_gamma(h);
    __syncthreads();
    load_vt(PROJ, row0, h, Vt, wave, lane);
    { const int m = tid & 127, j = tid >> 7; u32x4 o1, o2;
      rope8(PROJ + (size_t)(row0 + m) * INW + PK + h * 64, j, (float)(c * 128 + m), 0.125f, o1, o2, exp2f((float)(127 - m) * lg));
#pragma unroll
      for (int q = 0; q < 4; ++q) { Kt[(8 * j + 2 * q) * SV + m] = (bf16_t)(o1[q] & 0xffffu); Kt[(8 * j + 2 * q + 1) * SV + m] = (bf16_t)(o1[q] >> 16);
                                    Kt[(32 + 8 * j + 2 * q) * SV + m] = (bf16_t)(o2[q] & 0xffffu); Kt[(32 + 8 * j + 2 * q + 1) * SV + m] = (bf16_t)(o2[q] >> 16); } }
    __syncthreads();
    const int fr = lane & 15, fq = lane >> 4, e0 = 16 * wave;
    f32x4 u[4];
#pragma unroll
    for (int j = 0; j < 4; ++j) u[j] = (f32x4){0.f, 0.f, 0.f, 0.f};
#pragma unroll
    for (int ks = 0; ks < 4; ++ks) { const bf16x8 a = lfrag(Vt, e0 + fr, SV, ks * 32, fq);
#pragma unroll
        for (int j = 0; j < 4; ++j) { const bf16x8 bb = lfrag(Kt, 16 * j + fr, SV, ks * 32, fq); u[j] = MK_MFMA(bb, a, u[j]); } }
#pragma unroll
    for (int j = 0; j < 4; ++j) *(f32x4*)(UT + (e0 + fr) * 64 + 16 * j + 4 * fq) = u[j];
}

__device__ __forceinline__ void ret_o_item(const Params& P, MK_LAS unsigned char* lds, int l, int item) {
    int tid_ = threadIdx.x; asm volatile("" : "+v"(tid_)); const int tid = tid_, lane = tid & 63, wave = __builtin_amdgcn_readfirstlane(tid >> 6); (void)tid; (void)lane; (void)wave;
    const int h = item & 3, c = (item >> 2) & 15, b = item >> 6;
    const bf16_t* PROJ = (const bf16_t*)(P.ws + WS_PROJ);
    bf16_t* MIX = (bf16_t*)(P.ws + WS_HM);
    const float* UTb = (const float*)(P.ws + WS_U) + (size_t)((b * 4 + h) * 16) * 8192;
    MK_LAS bf16_t* Qs = (MK_LAS bf16_t*)(lds + L_QS); MK_LAS bf16_t* Ks = (MK_LAS bf16_t*)(lds + L_KS); MK_LAS bf16_t* Vt = (MK_LAS bf16_t*)(lds + L_VT);
    MK_LAS bf16_t* Ps = (MK_LAS bf16_t*)(lds + L_PS); MK_LAS bf16_t* St = (MK_LAS bf16_t*)(lds + L_ST);
    const int row0 = b * SEQ + c * 128; const float lg = log2_gamma(h); const float cd = exp2f(128.0f * lg);
    __syncthreads();
    load_vt(PROJ, row0, h, Vt, wave, lane);
    { const int m = tid & 127, j = tid >> 7; u32x4 o1, o2; const float pos = (float)(c * 128 + m);
      rope8(PROJ + (size_t)(row0 + m) * INW + PQ + h * 64, j, pos, 1.0f, o1, o2, 1.0f);
      *(MK_LAS u32x4*)(Qs + m * SQ + 8 * j) = o1; *(MK_LAS u32x4*)(Qs + m * SQ + 32 + 8 * j) = o2;
      rope8(PROJ + (size_t)(row0 + m) * INW + PK + h * 64, j, pos, 0.125f, o1, o2, 1.0f);
      *(MK_LAS u32x4*)(Ks + m * SQ + 8 * j) = o1; *(MK_LAS u32x4*)(Ks + m * SQ + 32 + 8 * j) = o2; }
#pragma unroll 1
    for (int it = 0; it < 4; ++it) { const int idx = tid + 512 * it, e = idx >> 4, dq = idx & 15;
        f32x4 s = (f32x4){0.f, 0.f, 0.f, 0.f};
        for (int j = 0; j < c; ++j) s = s * cd + *(const f32x4*)(UTb + (size_t)j * 8192 + e * 64 + 4 * dq);
        *(MK_LAS u32x2*)(St + e * SQ + 4 * dq) = pack4(s);
        if (c == 15) { s = s * cd + *(const f32x4*)(UTb + (size_t)15 * 8192 + e * 64 + 4 * dq);
            float* o = P.out + O_RETP + (size_t)((l * NB + b) * 4 + h) * 8192 + e;
#pragma unroll
            for (int i = 0; i < 4; ++i) o[(4 * dq + i) * 128] = s[i]; } }
    __syncthreads();
    const int fr = lane & 15, fq = lane >> 4, n0 = 16 * wave, n = n0 + fr;
    {
        f32x4 sc[8];
#pragma unroll
        for (int j = 0; j < 8; ++j) sc[j] = (f32x4){0.f, 0.f, 0.f, 0.f};
#pragma unroll
        for (int ks = 0; ks < 2; ++ks) { const bf16x8 a = lfrag(Qs, n, SQ, ks * 32, fq);
#pragma unroll
            for (int j = 0; j < 8; ++j) { const bf16x8 bb = lfrag(Ks, 16 * j + fr, SQ, ks * 32, fq); sc[j] = MK_MFMA(bb, a, sc[j]); } }
#pragma unroll
        for (int j = 0; j < 8; ++j) { f32x4 p;
#pragma unroll
            for (int i = 0; i < 4; ++i) { const int dlt = n - (16 * j + 4 * fq + i); p[i] = dlt >= 0 ? sc[j][i] * exp2f((float)dlt * lg) : 0.f; }
            *(MK_LAS u32x2*)(Ps + n * SV + 16 * j + 4 * fq) = pack4(p); }
    }
    __syncthreads();
    f32x4 o1[8], o2[8];
#pragma unroll
    for (int j = 0; j < 8; ++j) { o1[j] = (f32x4){0.f, 0.f, 0.f, 0.f}; o2[j] = (f32x4){0.f, 0.f, 0.f, 0.f}; }
#pragma unroll
    for (int ks = 0; ks < 4; ++ks) { const bf16x8 a = lfrag(Ps, n, SV, ks * 32, fq);
#pragma unroll
        for (int j = 0; j < 8; ++j) { const bf16x8 bb = lfrag(Vt, 16 * j + fr, SV, ks * 32, fq); o1[j] = MK_MFMA(bb, a, o1[j]); } }
#pragma unroll
    for (int ks = 0; ks < 2; ++ks) { const bf16x8 a = lfrag(Qs, n, SQ, ks * 32, fq);
#pragma unroll
        for (int j = 0; j < 8; ++j) { const bf16x8 bb = lfrag(St, 16 * j + fr, SQ, ks * 32, fq); o2[j] = MK_MFMA(bb, a, o2[j]); } }
    const float rd = exp2f((float)(n + 1) * lg);
    float s = 0.f;
#pragma unroll
    for (int j = 0; j < 8; ++j) { o1[j] = o1[j] + o2[j] * rd; s += (o1[j][0] + o1[j][1]) + (o1[j][2] + o1[j][3]); }
    s += __shfl_xor(s, 16); s += __shfl_xor(s, 32);
    const float mean = s * (1.0f / 128.0f); float q = 0.f;
#pragma unroll
    for (int j = 0; j < 8; ++j) { o1[j] = o1[j] - mean; q += (o1[j][0] * o1[j][0] + o1[j][1] * o1[j][1]) + (o1[j][2] * o1[j][2] + o1[j][3] * o1[j][3]); }
    q += __shfl_xor(q, 16); q += __shfl_xor(q, 32);
    const float rstd = rsqrtf(q * (1.0f / 128.0f) + EPS);
    const float* gn = P.in[15] + l * 512 + h * 128;
    const size_t row = (size_t)(row0 + n);
#pragma unroll
    for (int j = 0; j < 8; ++j) { const int e = 16 * j + 4 * fq;
        const f32x4 g = *(const f32x4*)(gn + e); const f32x4 gate = unpack4(*(const u32x2*)(PROJ + row * INW + PG + h * 128 + e));
        f32x4 o;
#pragma unroll
        for (int i = 0; i < 4; ++i) o[i] = o1[j][i] * rstd * g[i] * siluf_(gate[i]);
        *(u32x2*)(MIX + row * D + h * 128 + e) = pack4(o); }
}

__device__ __forceinline__ void conva_finish(const Params& P, int l, f32x4 acc, size_t row, int lane) {
    bf16_t* MIX = (bf16_t*)(P.ws + WS_HM);
    const float mean = wave_sum((acc[0] + acc[1]) + (acc[2] + acc[3])) * (1.0f / 256.0f);
    const f32x4 d = acc - mean;
    const float var = wave_sum((d[0] * d[0] + d[1] * d[1]) + (d[2] * d[2] + d[3] * d[3])) * (1.0f / 256.0f);
    const float rstd = rsqrtf(var + EPS);
    const f32x4 g = *(const f32x4*)(P.in[18] + l * 256 + 4 * lane), bb = *(const f32x4*)(P.in[19] + l * 256 + 4 * lane);
    f32x4 y = d * rstd * g + bb;
#pragma unroll
    for (int i = 0; i < 4; ++i) y[i] = siluf_(y[i]);
    *(u32x2*)(MIX + row * D + 512 + 4 * lane) = pack4(y);
}

__device__ __forceinline__ void conv_item(const Params& P, MK_LAS unsigned char* lds, int l, int item) {
    int tid_ = threadIdx.x; asm volatile("" : "+v"(tid_)); const int tid = tid_, lane = tid & 63, wave = __builtin_amdgcn_readfirstlane(tid >> 6); (void)tid; (void)lane; (void)wave;
    const int b = item >> 5, tb = item & 31, t0 = tb * 64;
    const bf16_t* PROJ = (const bf16_t*)(P.ws + WS_PROJ);
    bf16_t* MIX = (bf16_t*)(P.ws + WS_HM);
    MK_LAS float* Us = (MK_LAS float*)lds;
    __syncthreads();
    for (int idx = tid; idx < 94 * 64; idx += NTHREADS) { const int lr = idx >> 6, q = idx & 63, t = t0 - 30 + lr;
        f32x4 u = (f32x4){0.f, 0.f, 0.f, 0.f};
        if (t >= 0) { const bf16_t* rp = PROJ + (size_t)(b * SEQ + t) * INW; const f32x4 v = unpack4(*(const u32x2*)(rp + PAV + 4 * q)), g = unpack4(*(const u32x2*)(rp + PAG + 4 * q));
#pragma unroll
            for (int i = 0; i < 4; ++i) u[i] = v[i] * sigmoidf_(g[i]); }
        *(MK_LAS f32x4*)(Us + lr * 256 + 4 * q) = u;
        if (tb == 31 && lr >= 64) *(f32x4*)(P.out + O_CAP + (size_t)((l * NB + b) * 30 + (lr - 64)) * 256 + 4 * q) = u; }
    __syncthreads();
    const float* cw = P.in[16] + l * 31 * 256 + 4 * lane;
    f32x4 acc[8]; const f32x4 bias = *(const f32x4*)(P.in[17] + l * 256 + 4 * lane);
#pragma unroll
    for (int k = 0; k < 8; ++k) acc[k] = bias;
#pragma unroll 1
    for (int j = 0; j < 31; ++j) { const f32x4 w = *(const f32x4*)(cw + j * 256);
#pragma unroll
        for (int k = 0; k < 8; ++k) acc[k] = acc[k] + w * *(const MK_LAS f32x4*)(Us + (8 * wave + k + j) * 256 + 4 * lane); }
#pragma unroll
    for (int k = 0; k < 8; ++k) conva_finish(P, l, acc[k], (size_t)(b * SEQ + t0 + 8 * wave + k), lane);
    const f32x4 w0 = *(const f32x4*)(P.in[20] + l * 768 + 4 * lane), w1 = *(const f32x4*)(P.in[20] + l * 768 + 256 + 4 * lane), w2 = *(const f32x4*)(P.in[20] + l * 768 + 512 + 4 * lane);
    f32x4 zm2 = (f32x4){0.f, 0.f, 0.f, 0.f}, zm1 = zm2;
#pragma unroll
    for (int k = -2; k < 8; ++k) { const int t = t0 + 8 * wave + k;
        f32x4 z = (f32x4){0.f, 0.f, 0.f, 0.f};
        if (t >= 0) { const bf16_t* rp = PROJ + (size_t)(b * SEQ + t) * INW; z = unpack4(*(const u32x2*)(rp + PCC + 4 * lane)) * unpack4(*(const u32x2*)(rp + PCX + 4 * lane)); }
        if (k >= 0) { const bf16_t* rp = PROJ + (size_t)(b * SEQ + t) * INW; const f32x4 cb = unpack4(*(const u32x2*)(rp + PCB + 4 * lane));
            const f32x4 o = cb * (w0 * zm2 + w1 * zm1 + w2 * z);
            *(u32x2*)(MIX + (size_t)(b * SEQ + t) * D + 768 + 4 * lane) = pack4(o);
            if (t >= SEQ - 2) *(f32x4*)(P.out + O_CCP + (size_t)((l * NB + b) * 2 + (t - (SEQ - 2))) * 256 + 4 * lane) = z; }
        zm2 = zm1; zm1 = z; }
}

__device__ __forceinline__ void sample_conv(const Params& P, int l, int grp) {
    int tid_ = threadIdx.x; asm volatile("" : "+v"(tid_)); const int tid = tid_, lane = tid & 63, wave = __builtin_amdgcn_readfirstlane(tid >> 6); (void)tid; (void)lane; (void)wave;
    const int s = grp * 8 + wave;
    const bf16_t* PROJ = (const bf16_t*)(P.ws + WS_PROJ);
    bf16_t* MIX = (bf16_t*)(P.ws + WS_HM);
    const size_t row = (size_t)(NP + s); const bf16_t* rp = PROJ + row * INW;
    const f32x4 v = unpack4(*(const u32x2*)(rp + PAV + 4 * lane)), g = unpack4(*(const u32x2*)(rp + PAG + 4 * lane));
    f32x4 u;
#pragma unroll
    for (int i = 0; i < 4; ++i) u[i] = v[i] * sigmoidf_(g[i]);
    const float* buf = P.in[5] + (size_t)((l * NS + s) * 30) * 256 + 4 * lane; float* nb = P.out + O_CAS + (size_t)((l * NS + s) * 30) * 256 + 4 * lane;
    const float* cw = P.in[16] + l * 31 * 256 + 4 * lane;
    f32x4 acc = *(const f32x4*)(P.in[17] + l * 256 + 4 * lane);
#pragma unroll 6
    for (int j = 0; j < 30; ++j) { const f32x4 x = *(const f32x4*)(buf + j * 256); acc = acc + *(const f32x4*)(cw + j * 256) * x; if (j >= 1) *(f32x4*)(nb + (j - 1) * 256) = x; }
    acc = acc + *(const f32x4*)(cw + 30 * 256) * u; *(f32x4*)(nb + 29 * 256) = u;
    conva_finish(P, l, acc, row, lane);
    const f32x4 w0 = *(const f32x4*)(P.in[20] + l * 768 + 4 * lane), w1 = *(const f32x4*)(P.in[20] + l * 768 + 256 + 4 * lane), w2 = *(const f32x4*)(P.in[20] + l * 768 + 512 + 4 * lane);
    const float* bc = P.in[6] + (size_t)((l * NS + s) * 2) * 256 + 4 * lane; float* nc = P.out + O_CCS + (size_t)((l * NS + s) * 2) * 256 + 4 * lane;
    const f32x4 z0 = *(const f32x4*)bc, z1 = *(const f32x4*)(bc + 256);
    const f32x4 z = unpack4(*(const u32x2*)(rp + PCC + 4 * lane)) * unpack4(*(const u32x2*)(rp + PCX + 4 * lane));
    const f32x4 cb = unpack4(*(const u32x2*)(rp + PCB + 4 * lane));
    *(u32x2*)(MIX + row * D + 768 + 4 * lane) = pack4(cb * (w0 * z0 + w1 * z1 + w2 * z));
    *(f32x4*)nc = z1; *(f32x4*)(nc + 256) = z;
}

__device__ __forceinline__ void sample_ret(const Params& P, int l, int grp) {
    int tid_ = threadIdx.x; asm volatile("" : "+v"(tid_)); const int tid = tid_, lane = tid & 63, wave = __builtin_amdgcn_readfirstlane(tid >> 6); (void)tid; (void)lane; (void)wave;
    const int s = (grp * 8 + wave) >> 2, h = (grp * 8 + wave) & 3;
    const bf16_t* PROJ = (const bf16_t*)(P.ws + WS_PROJ);
    bf16_t* MIX = (bf16_t*)(P.ws + WS_HM);
    const size_t row = (size_t)(NP + s); const bf16_t* rp = PROJ + row * INW;
    const float lg = log2_gamma(h), gam = exp2f(lg);
    const int i5 = lane & 31;
    const double rev = 16384.0 * kInvRev[i5]; const float fr_ = (float)(rev - floor(rev));
    const float sn = __builtin_amdgcn_sinf(fr_), cs = __builtin_amdgcn_cosf(fr_);
    const float q1 = bf2f(rp[PQ + h * 64 + i5]), q2 = bf2f(rp[PQ + h * 64 + 32 + i5]), k1 = bf2f(rp[PK + h * 64 + i5]), k2 = bf2f(rp[PK + h * 64 + 32 + i5]);
    const float qr = bflo(pg8::cvt_pk_bf16(lane < 32 ? q1 * cs - q2 * sn : q1 * sn + q2 * cs, 0.f));
    const float kr = bflo(pg8::cvt_pk_bf16((lane < 32 ? k1 * cs - k2 * sn : k1 * sn + k2 * cs) * 0.125f, 0.f));
    const int eq = lane & 31, dpar = lane >> 5;
    const f32x4 v = unpack4(*(const u32x2*)(rp + PV + h * 128 + 4 * eq));
    const float* S0 = P.in[4] + (size_t)((l * NS + s) * 4 + h) * 8192 + 4 * eq; float* S1 = P.out + O_RETS + (size_t)((l * NS + s) * 4 + h) * 8192 + 4 * eq;
    f32x4 o = (f32x4){0.f, 0.f, 0.f, 0.f};
#pragma unroll 8
    for (int it = 0; it < 32; ++it) { const int d = 2 * it + dpar;
        const float qa = __uint_as_float(__builtin_amdgcn_readlane(__float_as_uint(qr), 2 * it)), qb = __uint_as_float(__builtin_amdgcn_readlane(__float_as_uint(qr), 2 * it + 1));
        const float ka = __uint_as_float(__builtin_amdgcn_readlane(__float_as_uint(kr), 2 * it)), kb = __uint_as_float(__builtin_amdgcn_readlane(__float_as_uint(kr), 2 * it + 1));
        const float qd = dpar ? qb : qa, kd = dpar ? kb : ka;
        f32x4 sv = *(const f32x4*)(S0 + d * 128); sv = sv * gam + v * kd; *(f32x4*)(S1 + d * 128) = sv; o = o + sv * qd; }
#pragma unroll
    for (int i = 0; i < 4; ++i) o[i] += __shfl_xor(o[i], 32);
    float sm = (o[0] + o[1]) + (o[2] + o[3]);
#pragma unroll
    for (int x = 1; x < 32; x <<= 1) sm += __shfl_xor(sm, x);
    const float mean = sm * (1.0f / 128.0f); const f32x4 dd = o - mean; float qq = (dd[0] * dd[0] + dd[1] * dd[1]) + (dd[2] * dd[2] + dd[3] * dd[3]);
#pragma unroll
    for (int x = 1; x < 32; x <<= 1) qq += __shfl_xor(qq, x);
    const float rstd = rsqrtf(qq * (1.0f / 128.0f) + EPS);
    if (lane < 32) { const f32x4 g = *(const f32x4*)(P.in[15] + l * 512 + h * 128 + 4 * eq); const f32x4 gate = unpack4(*(const u32x2*)(rp + PG + h * 128 + 4 * eq));
        f32x4 y;
#pragma unroll
        for (int i = 0; i < 4; ++i) y[i] = dd[i] * rstd * g[i] * siluf_(gate[i]);
        *(u32x2*)(MIX + row * D + h * 128 + 4 * eq) = pack4(y); }
}

__global__ void __launch_bounds__(NTHREADS, 2) mk_fwd(Params P) {
    extern __shared__ __attribute__((aligned(16))) unsigned char lds_raw[];
    MK_LAS unsigned char* lds = (MK_LAS unsigned char*)lds_raw;
    cg::grid_group grid = cg::this_grid();
    if (threadIdx.x < 16) ((MK_LAS unsigned*)(lds + LDS_CTL_OFF))[threadIdx.x] = 0u;
    __syncthreads();
    const XcdBarrier xbar = xcd_barrier_post((unsigned*)(P.ws + WS_CTL), (volatile MK_LAS unsigned*)(lds + LDS_CTL_OFF));
    if (P.ws == nullptr) grid.sync();
    const int G = gridDim.x, bx = blockIdx.x;
    unsigned char* ws = P.ws;
    bf16_t* HM = (bf16_t*)(ws + WS_HM); bf16_t* T1 = (bf16_t*)(ws + WS_T1); bf16_t* PROJ = (bf16_t*)(ws + WS_PROJ);

    p0_prologue(P, lds);
    xcd_barrier(xbar);
    { pg8::Gemm g{(const bf16_t*)(ws + WS_AC), (const bf16_t*)(ws + WS_ADAT), 256, NMOD, D}; pg8::StaticOrder S; S.init(256, NMOD, G, bx);
      EpiMod E{(float*)(ws + WS_MOD), P.in[8]};
      pg8::gemm_phase<EpiMod, pg8::StaticOrder, true, true>(lds, g, S, E); }
    xcd_barrier(xbar);
    rowpass<0>(P, 0);
    xcd_barrier(xbar);
#pragma unroll 1
    for (int l = 0; l < DEPTH; ++l) {
        { pg8::Gemm g{HM, (const bf16_t*)(ws + WS_WIN) + (size_t)l * INW * D, MP, INW, D}; pg8::StaticOrder S; S.init(MP, INW, G, bx);
          pg8::EpiBf16<0> E{PROJ, INW, nullptr, 0, 0, 1.f};
          pg8::gemm_phase<pg8::EpiBf16<0>, pg8::StaticOrder, true, true>(lds, g, S, E); }
        xcd_barrier(xbar);
        for (int it = bx; it < 512 + 256 + 64 + 16; it += G) {
            if (it < 512) ret_u_item(P, lds, it);
            else if (it < 768) conv_item(P, lds, l, it - 512);
            else if (it < 832) sample_ret(P, l, it - 768);
            else sample_conv(P, l, it - 832);
        }
        xcd_barrier(xbar);
        for (int it = bx; it < 512; it += G) ret_o_item(P, lds, l, it);
        xcd_barrier(xbar);
        { pg8::Gemm g{HM, (const bf16_t*)(ws + WS_WOUT) + (size_t)l * D * D, MP, D, D}; pg8::StaticOrder S; S.init(MP, D, G, bx);
          pg8::EpiBf16<0> E{T1, D, nullptr, 0, 0, 1.f};
          pg8::gemm_phase<pg8::EpiBf16<0>, pg8::StaticOrder, true, true>(lds, g, S, E); }
        xcd_barrier(xbar);
        rowpass<1>(P, l);
        xcd_barrier(xbar);
        { pg8::Gemm g{HM, (const bf16_t*)(ws + WS_W13) + (size_t)l * NFF1 * D, MP, NFF1, D}; pg8::StaticOrder S; S.init(MP, NFF1, G, bx);
          EpiSwiGLU E{PROJ};
          pg8::gemm_phase<EpiSwiGLU, pg8::StaticOrder, true, true>(lds, g, S, E); }
        xcd_barrier(xbar);
        { pg8::Gemm g{PROJ, (const bf16_t*)(ws + WS_W2) + (size_t)l * D * DFF, MP, D, DFF}; pg8::StaticOrder S; S.init(MP, D, G, bx);
          pg8::EpiBf16<0> E{T1, D, nullptr, 0, 0, 1.f};
          pg8::gemm_phase<pg8::EpiBf16<0>, pg8::StaticOrder, true, true>(lds, g, S, E); }
        xcd_barrier(xbar);
        rowpass<2>(P, l);
        if (l + 1 < DEPTH) xcd_barrier(xbar);
    }
}
}

extern "C" void kernel_launch(void* const* d_in, const int* in_sizes, int n_in, void* d_out, int out_size, void* d_ws, size_t ws_size, hipStream_t stream) {
    static int grid = 0;
    if (grid == 0) {
        if (n_in != 24 || (size_t)out_size != mk::O_END || ws_size < mk::WS_END) { fprintf(stderr, "kernel_launch: unexpected shapes: n_in %d out %d ws %zu\n", n_in, out_size, ws_size); grid = -1; return; }
        int dev = 0, cus = 0, per_cu = 0;
        hipGetDevice(&dev); hipDeviceGetAttribute(&cus, hipDeviceAttributeMultiprocessorCount, dev);
        hipFuncSetAttribute((const void*)mk::mk_fwd, hipFuncAttributeMaxDynamicSharedMemorySize, mk::LDS_BYTES);
        hipOccupancyMaxActiveBlocksPerMultiprocessor(&per_cu, (const void*)mk::mk_fwd, mk::NTHREADS, mk::LDS_BYTES);
        (void)hipGetLastError();
        if (per_cu < 1) { fprintf(stderr, "kernel_launch: occupancy query says %d blocks per CU\n", per_cu); per_cu = 1; }
        grid = cus;
    }
    if (grid < 0) return;
    if (hipMemsetAsync((char*)d_ws + mk::WS_CTL, 0, mk::CTL_ZERO_BYTES, stream) != hipSuccess) { fprintf(stderr, "kernel_launch: memset failed\n"); return; }
    mk::Params p{};
    for (int i = 0; i < 24; ++i) p.in[i] = (const float*)d_in[i];
    p.out = (float*)d_out; p.ws = (unsigned char*)d_ws;
    void* args[] = {&p};
    hipError_t e = hipLaunchCooperativeKernel((const void*)mk::mk_fwd, dim3(grid), dim3(mk::NTHREADS), args, mk::LDS_BYTES, stream);
    if (e != hipSuccess) fprintf(stderr, "kernel_launch: cooperative launch failed: %s (grid %d)\n", hipGetErrorString(e), grid);
}
```

```cpp
#include <hip/hip_runtime.h>
#include <cstdio>
#include <cstdint>
namespace pg8 {
#define PG8_LAS __attribute__((address_space(3)))
typedef unsigned short bf16_t;
typedef short bf16x8 __attribute__((ext_vector_type(8)));
typedef float f32x4 __attribute__((ext_vector_type(4)));
typedef unsigned u32x4 __attribute__((ext_vector_type(4)));
constexpr int BM = 256, BK = 64, HALF = 128, HTB = HALF * BK * 2  , STAGE_BYTES = 8 * HTB, NXCD = 8, WGM = 8;

__host__ __device__ __forceinline__ int lds_byte(int r, int c) { const int st = (r >> 4) * 2 + (c >> 5), rr = r & 15, cc = c & 31, ob = rr * 64 + cc * 2; return st * 1024 + (ob ^ (((ob >> 9) & 1) << 5)); }
__host__ __device__ __forceinline__ void stage_rc(int b, int& R, int& C) { const int st = b / 1024, sb = b % 1024, swz = sb ^ (((sb >> 9) & 1) << 5); R = (st >> 1) * 16 + swz / 64; C = (st & 1) * 32 + (swz % 64) / 2; }
__host__ __device__ __forceinline__ int perm32(int rho) { const int n = rho >> 4, i = rho & 15; return 8 * (i >> 2) + 4 * n + (i & 3); }

struct Unit { int pm, pn; };
struct Gemm { const bf16_t* A; const bf16_t* Bt; int M, N, K; };

struct StaticOrder {
    int nM, nN, nwg, G, c;
    __host__ __device__ void init(int M, int N, int G_, int c_) { nM = M / BM; nN = N / BM; nwg = nM * nN; G = G_; c = c_; }
    __host__ __device__ bool next(int i, Unit& u) const {
        const long L = (long)i * G + c; if (L >= nwg) return false;
        int wgid = (int)L; { const int q = nwg / NXCD, r = nwg % NXCD, xcd = wgid % NXCD, off = wgid / NXCD; wgid = (xcd < r ? xcd * (q + 1) : r * (q + 1) + (xcd - r) * q) + off; }
        const int nig = WGM * nN, gid = wgid / nig, fm = gid * WGM, gsz = (nM - fm) < WGM ? (nM - fm) : WGM;
        u.pm = fm + ((wgid % nig) % gsz); u.pn = (wgid % nig) / gsz; return true;
    }
    __device__ __forceinline__ void a_ready(const Unit&) const {}
    __device__ __forceinline__ void done(const Unit&) const {}
};

__device__ __forceinline__ unsigned cvt_pk_bf16(float lo, float hi) { unsigned r; asm volatile("v_cvt_pk_bf16_f32 %0, %1, %2" : "=v"(r) : "v"(lo), "v"(hi)); return r; }
typedef float f32x2 __attribute__((ext_vector_type(2)));
__device__ __forceinline__ f32x2 gelu_pk(f32x2 v) {
    const f32x2 av = __builtin_elementwise_abs(v), d = av * 0.2316418882f + 1.0f;
    f32x2 t; t.x = __builtin_amdgcn_rcpf(d.x); t.y = __builtin_amdgcn_rcpf(d.y);
    f32x2 q = t * 0.5307027145f + (-0.7265760135f); q = q * t + 0.7107068705f; q = q * t + (-0.142248368f); q = q * t + 0.127414796f; q = q * t;
    const f32x2 s = (v * v) * (-0.72134752044f);
    f32x2 e; e.x = __builtin_amdgcn_exp2f(s.x); e.y = __builtin_amdgcn_exp2f(s.y);
    const f32x2 m = v * (q * e), r = v - m;
    f32x2 o; o.x = v.x < 0.f ? m.x : r.x; o.y = v.y < 0.f ? m.y : r.y; return o;
}

template <int ACT  > struct EpiBf16 {
    static constexpr bool PERM = true, AFTER_DRAIN = false; static_assert(ACT == 0 || ACT == 1, "EpiBf16: ACT is 0 (none) or 1 (gelu_pk)");
    bf16_t* O; int ldc; const float* bias; int split_cols; size_t split_stride; float scale0;
    __device__ __forceinline__ void operator()(const f32x4 (&acc)[2][2][4][2], const Unit& u, int wr, int wc, int fr, int fq) const {
        const int row0 = u.pm * BM + wr * 64 + fr; int colt = u.pn * BM; bf16_t* base = O;
        float sc = 1.f; if (split_cols) { const int t = colt / split_cols; base += (size_t)t * split_stride; colt -= t * split_cols; if (t == 0) sc = scale0; }
        const int col0 = colt + wc * 32 + 8 * fq, bcol0 = u.pn * BM + wc * 32 + 8 * fq;
        f32x4 bv[2][2];
#pragma unroll
        for (int bj = 0; bj < 2; ++bj)
#pragma unroll
            for (int n = 0; n < 2; ++n) bv[bj][n] = bias ? *(const f32x4*)(bias + bcol0 + bj * HALF + 4 * n) : (f32x4){0.f, 0.f, 0.f, 0.f};
#pragma unroll
        for (int ai = 0; ai < 2; ++ai)
#pragma unroll
            for (int m = 0; m < 4; ++m) { bf16_t* rowp = base + (size_t)(row0 + ai * HALF + m * 16) * ldc + col0;
#pragma unroll
                for (int bj = 0; bj < 2; ++bj) { f32x4 v0 = acc[ai][bj][m][0] + bv[bj][0], v1 = acc[ai][bj][m][1] + bv[bj][1];
                    if (ACT == 1) { f32x2 a = gelu_pk((f32x2){v0[0], v0[1]}), b = gelu_pk((f32x2){v0[2], v0[3]}), c = gelu_pk((f32x2){v1[0], v1[1]}), d = gelu_pk((f32x2){v1[2], v1[3]});
                        v0 = (f32x4){a.x, a.y, b.x, b.y}; v1 = (f32x4){c.x, c.y, d.x, d.y}; }
                    v0 = v0 * sc; v1 = v1 * sc; u32x4 w; w.x = cvt_pk_bf16(v0[0], v0[1]); w.y = cvt_pk_bf16(v0[2], v0[3]); w.z = cvt_pk_bf16(v1[0], v1[1]); w.w = cvt_pk_bf16(v1[2], v1[3]);
                    *(u32x4*)(rowp + bj * HALF) = w; } }
    }
};

struct PanelStats {
    unsigned* xbuf;
    unsigned* cnt;
    unsigned* tmo;
    int ntn; float eps;
    unsigned code;
    __device__ __forceinline__ bool run(const f32x4 (&v)[2][2][4][2], const Unit& u, int wr, int wc, int fr, int fq, PG8_LAS unsigned char* lds, int wid, int lane) const {
        typedef float f32x2v __attribute__((ext_vector_type(2)));
        PG8_LAS f32x2v* P = (PG8_LAS f32x2v*)lds;
        PG8_LAS f32x2v* S = (PG8_LAS f32x2v*)(lds + 8192);
        PG8_LAS unsigned* flag = (PG8_LAS unsigned*)(lds + 8192 + 2048);
#pragma unroll
        for (int ai = 0; ai < 2; ++ai)
#pragma unroll
            for (int m = 0; m < 4; ++m) {
                float s = 0.f;
#pragma unroll
                for (int bj = 0; bj < 2; ++bj)
#pragma unroll
                    for (int n = 0; n < 2; ++n) { const f32x4 x = v[ai][bj][m][n]; s += (x[0] + x[1]) + (x[2] + x[3]); }
                s += __shfl_xor(s, 16); s += __shfl_xor(s, 32);
                const float mw = s * (1.0f / 64.0f); float q = 0.f;
#pragma unroll
                for (int bj = 0; bj < 2; ++bj)
#pragma unroll
                    for (int n = 0; n < 2; ++n) { const f32x4 d = v[ai][bj][m][n] - mw; q += (d[0] * d[0] + d[1] * d[1]) + (d[2] * d[2] + d[3] * d[3]); }
                q += __shfl_xor(q, 16); q += __shfl_xor(q, 32);
                if (fq == 0) P[(ai * HALF + wr * 64 + m * 16 + fr) * 4 + wc] = (f32x2v){mw, q};
            }
        asm volatile("s_waitcnt lgkmcnt(0)" ::: "memory"); __builtin_amdgcn_s_barrier(); asm volatile("" ::: "memory");
#if defined(BROKEN_EXCHANGE_NO_WAIT)
#warning BROKEN CONTROL BUILD: the row-statistics exchange does not wait; results are wrong by design
        if (blockIdx.x >= 64) { const long long t0_ = clock64(); while (clock64() - t0_ < 60000) __builtin_amdgcn_s_sleep(8); }
#endif
        const int row = wid * 32 + (lane & 31);
        if (lane < 32) {
            const f32x2v a = P[row * 4 + 0], b = P[row * 4 + 1], c = P[row * 4 + 2], d = P[row * 4 + 3];
            const float mt = (a.x + b.x + c.x + d.x) * 0.25f;
            const float da = a.x - mt, db = b.x - mt, dc = c.x - mt, dd = d.x - mt;
            const float m2 = (a.y + b.y) + (c.y + d.y) + 64.0f * ((da * da + db * db) + (dc * dc + dd * dd));
            unsigned long long* slot = (unsigned long long*)xbuf + ((size_t)(u.pm * BM + row) * 4 + u.pn);
            __hip_atomic_store(slot, ((unsigned long long)__float_as_uint(m2) << 32) | __float_as_uint(mt), __ATOMIC_RELAXED, __HIP_MEMORY_SCOPE_AGENT);
        }
        asm volatile("s_waitcnt vmcnt(0)" ::: "memory");
        if (lane == 0) __hip_atomic_fetch_add(cnt + 64 * u.pm, 1u, __ATOMIC_RELAXED, __HIP_MEMORY_SCOPE_AGENT);
        if (wid == 0) {
            bool dead = false; const unsigned long long t0 = __builtin_amdgcn_s_memrealtime(); const unsigned want = 8u * (unsigned)ntn;
            for (;;) {
#if defined(BROKEN_EXCHANGE_NO_WAIT)
                break;
#endif
                if ((unsigned)__builtin_amdgcn_readfirstlane(__hip_atomic_load(cnt + 64 * u.pm, __ATOMIC_RELAXED, __HIP_MEMORY_SCOPE_AGENT)) >= want) break;
                if (__builtin_amdgcn_s_memrealtime() - t0 > 2000000ull) {
                    if (lane == 0) { unsigned expect = 0u; __hip_atomic_compare_exchange_strong(tmo + 1, &expect, code | (unsigned)(u.pm & 0xff), __ATOMIC_RELAXED, __ATOMIC_RELAXED, __HIP_MEMORY_SCOPE_AGENT);
                                     __hip_atomic_store(tmo, 1u, __ATOMIC_RELAXED, __HIP_MEMORY_SCOPE_AGENT); }
                    dead = true; break; }
                __builtin_amdgcn_s_sleep(2);
            }
            __builtin_amdgcn_fence(__ATOMIC_ACQUIRE, "agent");
            if (lane == 0) flag[0] = dead ? 1u : 0u;
        }
        asm volatile("s_waitcnt vmcnt(0) lgkmcnt(0)" ::: "memory"); __builtin_amdgcn_s_barrier(); asm volatile("" ::: "memory");
        const bool bad = flag[0] != 0u;
        if (lane < 32) {
            const unsigned long long* slot = (const unsigned long long*)xbuf + (size_t)(u.pm * BM + row) * 4; float mt[4], m2[4]; float ms = 0.f;
#pragma unroll
            for (int t = 0; t < 4; ++t) { if (t < ntn) { const unsigned long long w = __hip_atomic_load(slot + t, __ATOMIC_RELAXED, __HIP_MEMORY_SCOPE_AGENT); mt[t] = __uint_as_float((unsigned)w); m2[t] = __uint_as_float((unsigned)(w >> 32)); } else { mt[t] = 0.f; m2[t] = 0.f; } ms += mt[t]; }
            const float mean = ms / (float)ntn; float q = 0.f;
#pragma unroll
            for (int t = 0; t < 4; ++t) if (t < ntn) { const float dm = mt[t] - mean; q += m2[t] + 256.0f * dm * dm; }
            S[row] = (f32x2v){mean, 1.0f / sqrtf(q / (256.0f * (float)ntn) + eps)};
        }
        asm volatile("s_waitcnt lgkmcnt(0)" ::: "memory"); __builtin_amdgcn_s_barrier(); asm volatile("" ::: "memory");
        return bad;
    }
};
struct EpiLnRes {
    static constexpr bool PERM = false, AFTER_DRAIN = true;
    const float* base; float* out; int ldc; const float* bias; PanelStats st; unsigned poison;
    __device__ __forceinline__ void fused(f32x4 (&acc)[2][2][4][2], const Unit& u, int wr, int wc, int fr, int fq, PG8_LAS unsigned char* lds, int wid, int lane) const {
        typedef float f32x2v __attribute__((ext_vector_type(2)));
        const PG8_LAS f32x2v* S = (const PG8_LAS f32x2v*)(lds + 8192);
        const int col0 = u.pn * BM + wc * 32 + 4 * fq;
#pragma unroll
        for (int bj = 0; bj < 2; ++bj)
#pragma unroll
            for (int n = 0; n < 2; ++n) { const f32x4 bv = bias ? *(const f32x4*)(bias + col0 + bj * HALF + n * 16) : (f32x4){0.f, 0.f, 0.f, 0.f};
#pragma unroll
                for (int ai = 0; ai < 2; ++ai)
#pragma unroll
                    for (int m = 0; m < 4; ++m) acc[ai][bj][m][n] += bv; }
        f32x4 pre[4][2][2];
#pragma unroll
        for (int m = 0; m < 4; ++m) { const size_t off = (size_t)(u.pm * BM + wr * 64 + m * 16 + fr) * ldc + col0;
#pragma unroll
            for (int bj = 0; bj < 2; ++bj)
#pragma unroll
                for (int n = 0; n < 2; ++n) pre[m][bj][n] = *(const f32x4*)(base + off + bj * HALF + n * 16); }
        const bool bad = st.run(acc, u, wr, wc, fr, fq, lds, wid, lane) || poison != 0u;
        const float qnan = __builtin_nanf("");
#pragma unroll
        for (int ai = 0; ai < 2; ++ai)
#pragma unroll
            for (int m = 0; m < 4; ++m) { const int r = ai * HALF + wr * 64 + m * 16 + fr; const f32x2v sr = S[r]; const size_t off = (size_t)(u.pm * BM + r) * ldc + col0;
#pragma unroll
                for (int bj = 0; bj < 2; ++bj)
#pragma unroll
                    for (int n = 0; n < 2; ++n) { const f32x4 bs = ai == 0 ? pre[m][bj][n] : *(const f32x4*)(base + off + bj * HALF + n * 16); f32x4 o = bs + (acc[ai][bj][m][n] - sr.x) * sr.y;
                        if (bad) o = (f32x4){qnan, qnan, qnan, qnan}; *(f32x4*)(out + off + bj * HALF + n * 16) = o; }
                if (m & 1) asm volatile("" ::: "memory"); }
    }
};
struct EpiLnResLn {
    static constexpr bool PERM = false, AFTER_DRAIN = true;
    const float* base; float* out; bf16_t* xn; int ldc; const float* bias; PanelStats st1, st2; unsigned poison;
    __device__ __forceinline__ void fused(f32x4 (&acc)[2][2][4][2], const Unit& u, int wr, int wc, int fr, int fq, PG8_LAS unsigned char* lds, int wid, int lane) const {
        typedef float f32x2v __attribute__((ext_vector_type(2))); typedef unsigned u32x2v __attribute__((ext_vector_type(2)));
        const PG8_LAS f32x2v* S = (const PG8_LAS f32x2v*)(lds + 8192);
        const int col0 = u.pn * BM + wc * 32 + 4 * fq;
#pragma unroll
        for (int bj = 0; bj < 2; ++bj)
#pragma unroll
            for (int n = 0; n < 2; ++n) { const f32x4 bv = bias ? *(const f32x4*)(bias + col0 + bj * HALF + n * 16) : (f32x4){0.f, 0.f, 0.f, 0.f};
#pragma unroll
                for (int ai = 0; ai < 2; ++ai)
#pragma unroll
                    for (int m = 0; m < 4; ++m) acc[ai][bj][m][n] += bv; }
        bool bad = st1.run(acc, u, wr, wc, fr, fq, lds, wid, lane) || poison != 0u;
        const float qnan = __builtin_nanf("");
#pragma unroll
        for (int ai = 0; ai < 2; ++ai)
#pragma unroll
            for (int m = 0; m < 4; ++m) { const int r = ai * HALF + wr * 64 + m * 16 + fr; const f32x2v sr = S[r]; const size_t off = (size_t)(u.pm * BM + r) * ldc + col0;
#pragma unroll
                for (int bj = 0; bj < 2; ++bj)
#pragma unroll
                    for (int n = 0; n < 2; ++n) { const f32x4 bs = *(const f32x4*)(base + off + bj * HALF + n * 16); acc[ai][bj][m][n] = bs + (acc[ai][bj][m][n] - sr.x) * sr.y; }
                asm volatile("" : "+v"(acc[ai][0][m][0]), "+v"(acc[ai][0][m][1]), "+v"(acc[ai][1][m][0]), "+v"(acc[ai][1][m][1]));
                if (m & 1) asm volatile("" ::: "memory"); }
        const bool bad1 = bad;
        bad = st2.run(acc, u, wr, wc, fr, fq, lds, wid, lane) || bad;
#pragma unroll
        for (int ai = 0; ai < 2; ++ai)
#pragma unroll
            for (int m = 0; m < 4; ++m) { const int r = ai * HALF + wr * 64 + m * 16 + fr; const f32x2v sr = S[r]; const size_t off = (size_t)(u.pm * BM + r) * ldc + col0;
#pragma unroll
                for (int bj = 0; bj < 2; ++bj)
#pragma unroll
                    for (int n = 0; n < 2; ++n) { const f32x4 x1 = acc[ai][bj][m][n]; *(f32x4*)(out + off + bj * HALF + n * 16) = bad1 ? (f32x4){qnan, qnan, qnan, qnan} : x1;
                        const f32x4 o = (x1 - sr.x) * sr.y; u32x2v w; w.x = cvt_pk_bf16(o[0], o[1]); w.y = cvt_pk_bf16(o[2], o[3]);
                        if (bad) { w.x = 0x7fc07fc0u; w.y = 0x7fc07fc0u; } *(u32x2v*)(xn + off + bj * HALF + n * 16) = w; }
                asm volatile("" ::: "memory"); }
    }
};

template <class Epi, class Sched, bool ALIGN_EPI = false, bool SP2 = false>
__device__ __forceinline__ void gemm_phase(PG8_LAS unsigned char* lds, const Gemm g, const Sched& S, const Epi& E) {
    int tid_ = threadIdx.x; asm volatile("" : "+v"(tid_));
    const int tid = tid_, wid = __builtin_amdgcn_readfirstlane(tid >> 6), lane = tid & 63, wr = wid >> 2, wc = wid & 3, fr = lane & 15, fq = lane >> 4;
    const int K = g.K, nt = K / BK;
    unsigned voffA[2], voffB[2];
#pragma unroll
    for (int i = 0; i < 2; ++i) { int R, C; stage_rc(tid * 16 + i * 8192, R, C); const int Rb = Epi::PERM ? ((R & ~31) + perm32(R & 31)) : R;
        voffA[i] = (unsigned)(R * K + C) * 2u; voffB[i] = (unsigned)(Rb * K + C) * 2u; }
    const size_t kstep = (size_t)(BK * 2);
    const size_t hstep = (size_t)HALF * K * 2;
    const size_t tstep = 2 * hstep;
    const unsigned ldsw = (unsigned)wid * 1024u;
    const int aoff = lds_byte(wr * 64 + fr, fq * 8), boff = lds_byte(wc * 32 + fr, fq * 8);
#define PG8_SA(b, h) (((b) * 2 + (h)) * HTB)
#define PG8_SB(b, h) ((4 + (b) * 2 + (h)) * HTB)
#define PG8_STAGE(bufoff, gbase, voff) do { _Pragma("unroll") for (int _i = 0; _i < 2; ++_i) \
        __builtin_amdgcn_global_load_lds((const unsigned*)((const char*)(gbase) + (voff)[_i]), (PG8_LAS unsigned*)(lds + (bufoff) + ldsw + _i * 8192), 16, 0, 0); } while (0)
#define PG8_LDA(dst, b, h) do { _Pragma("unroll") for (int m = 0; m < 4; ++m) _Pragma("unroll") for (int k = 0; k < 2; ++k) dst[m][k] = *(const PG8_LAS bf16x8*)(lds + PG8_SA(b, h) + aoff + m * 2048 + k * 1024); } while (0)
#define PG8_LDB(dst, b, h) do { _Pragma("unroll") for (int n = 0; n < 2; ++n) _Pragma("unroll") for (int k = 0; k < 2; ++k) dst[n][k] = *(const PG8_LAS bf16x8*)(lds + PG8_SB(b, h) + boff + n * 2048 + k * 1024); } while (0)
#define PG8_MMA(ai, bj, At, Bt) do { __builtin_amdgcn_s_setprio(1); _Pragma("unroll") for (int m = 0; m < 4; ++m) _Pragma("unroll") for (int n = 0; n < 2; ++n) _Pragma("unroll") for (int k = 0; k < 2; ++k) \
        acc[ai][bj][m][n] = __builtin_amdgcn_mfma_f32_16x16x32_bf16(Bt[n][k], At[m][k], acc[ai][bj][m][n], 0, 0, 0); __builtin_amdgcn_s_setprio(0); } while (0)
#define PG8_WAIT_V(n) asm volatile("s_waitcnt vmcnt(" #n ")" ::: "memory")
#define PG8_WAIT_L(n) asm volatile("s_waitcnt lgkmcnt(" #n ")" ::: "memory")
#define PG8_BAR __builtin_amdgcn_s_barrier()
#define PG8_SCHED __builtin_amdgcn_sched_barrier(0)
    Unit cur, nxt; int ui = 0;
    if (!S.next(0, cur)) return;
    f32x4 acc[2][2][4][2];
#pragma unroll
    for (int a = 0; a < 2; ++a)
#pragma unroll
        for (int b = 0; b < 2; ++b)
#pragma unroll
            for (int m = 0; m < 4; ++m)
#pragma unroll
                for (int n = 0; n < 2; ++n) acc[a][b][m][n] = (f32x4){0.f, 0.f, 0.f, 0.f};
    bf16x8 At[4][2], B0[2][2], B1[2][2];
    const char* cA = (const char*)g.A + (size_t)cur.pm * tstep; const char* cB = (const char*)g.Bt + (size_t)cur.pn * tstep;
    S.a_ready(cur);
    if constexpr (SP2) {
        PG8_STAGE(PG8_SB(0, 0), cB, voffB); PG8_STAGE(PG8_SB(0, 1), cB + hstep, voffB); PG8_STAGE(PG8_SA(0, 0), cA, voffA); PG8_STAGE(PG8_SA(0, 1), cA + hstep, voffA);
        if (wr == 1) PG8_BAR;
        PG8_WAIT_V(2); PG8_BAR;
        PG8_STAGE(PG8_SB(1, 0), cB + kstep, voffB); PG8_STAGE(PG8_SA(1, 0), cA + kstep, voffA); PG8_STAGE(PG8_SB(1, 1), cB + hstep + kstep, voffB);
        PG8_WAIT_V(6); PG8_BAR;
    } else {
        PG8_STAGE(PG8_SB(0, 0), cB, voffB); PG8_STAGE(PG8_SA(0, 0), cA, voffA); PG8_STAGE(PG8_SB(0, 1), cB + hstep, voffB); PG8_STAGE(PG8_SA(0, 1), cA + hstep, voffA);
        if (wr == 1) PG8_BAR;
        PG8_WAIT_V(4); PG8_BAR;
        PG8_STAGE(PG8_SB(1, 0), cB + kstep, voffB); PG8_STAGE(PG8_SA(1, 0), cA + kstep, voffA); PG8_STAGE(PG8_SB(1, 1), cB + hstep + kstep, voffB);
        PG8_WAIT_V(6); PG8_BAR;
    }
    for (;;) {
        const bool has_next = S.next(ui + 1, nxt);
        const char* nA = has_next ? (const char*)g.A + (size_t)nxt.pm * tstep : cA; const char* nB = has_next ? (const char*)g.Bt + (size_t)nxt.pn * tstep : cB;
        for (int t = 0; t < nt; t += 2) {
            const bool last = (t == nt - 2);
            const char* a1 = cA + (size_t)(t + 1) * kstep;
            const char* a2 = last ? nA : cA + (size_t)(t + 2) * kstep; const char* b2 = last ? nB : cB + (size_t)(t + 2) * kstep;
            const char* a3 = a2 + kstep; const char* b3 = b2 + kstep;
            if (last && has_next) S.a_ready(nxt);
            if constexpr (SP2) {
            PG8_LDB(B0, 0, 0); PG8_LDB(B1, 0, 1); PG8_SCHED; PG8_LDA(At, 0, 0); PG8_STAGE(PG8_SA(1, 1), a1 + hstep, voffA);
            PG8_WAIT_V(8); PG8_WAIT_L(0); PG8_BAR; PG8_MMA(0, 0, At, B0); PG8_MMA(0, 1, At, B1); PG8_BAR; PG8_SCHED;
            PG8_LDA(At, 0, 1); PG8_STAGE(PG8_SB(0, 0), b2, voffB); PG8_STAGE(PG8_SB(0, 1), b2 + hstep, voffB); PG8_STAGE(PG8_SA(0, 0), a2, voffA);
            PG8_WAIT_V(8); PG8_WAIT_L(0); PG8_BAR; PG8_MMA(1, 0, At, B0); PG8_MMA(1, 1, At, B1); PG8_BAR; PG8_SCHED;
            PG8_LDB(B0, 1, 0); PG8_LDB(B1, 1, 1); PG8_SCHED; PG8_LDA(At, 1, 0); PG8_STAGE(PG8_SA(0, 1), a2 + hstep, voffA);
            PG8_WAIT_V(8); PG8_WAIT_L(0); PG8_BAR; PG8_MMA(0, 0, At, B0); PG8_MMA(0, 1, At, B1); PG8_BAR; PG8_SCHED;
            PG8_LDA(At, 1, 1); PG8_STAGE(PG8_SB(1, 0), b3, voffB); PG8_STAGE(PG8_SB(1, 1), b3 + hstep, voffB); PG8_STAGE(PG8_SA(1, 0), a3, voffA);
            PG8_WAIT_V(8); PG8_WAIT_L(0); PG8_BAR; PG8_MMA(1, 0, At, B0); PG8_MMA(1, 1, At, B1); PG8_BAR; PG8_SCHED;
            } else {
            PG8_LDB(B0, 0, 0); PG8_SCHED; PG8_LDA(At, 0, 0); PG8_STAGE(PG8_SA(1, 1), a1 + hstep, voffA);
            PG8_WAIT_L(8); PG8_BAR; PG8_WAIT_L(0); PG8_MMA(0, 0, At, B0); PG8_BAR; PG8_SCHED;
            PG8_LDB(B1, 0, 1); PG8_STAGE(PG8_SB(0, 0), b2, voffB);
            PG8_BAR; PG8_WAIT_L(0); PG8_MMA(0, 1, At, B1); PG8_BAR;
            PG8_LDA(At, 0, 1); PG8_STAGE(PG8_SA(0, 0), a2, voffA);
            PG8_BAR; PG8_WAIT_L(0); PG8_MMA(1, 0, At, B0); PG8_BAR; PG8_SCHED;
            PG8_STAGE(PG8_SB(0, 1), b2 + hstep, voffB);
            PG8_WAIT_V(6); PG8_BAR; PG8_MMA(1, 1, At, B1); PG8_BAR;
            PG8_LDB(B0, 1, 0); PG8_SCHED; PG8_LDA(At, 1, 0); PG8_STAGE(PG8_SA(0, 1), a2 + hstep, voffA);
            PG8_WAIT_L(8); PG8_BAR; PG8_WAIT_L(0); PG8_MMA(0, 0, At, B0); PG8_BAR; PG8_SCHED;
            PG8_LDB(B1, 1, 1); PG8_STAGE(PG8_SB(1, 0), b3, voffB);
            PG8_BAR; PG8_WAIT_L(0); PG8_MMA(0, 1, At, B1); PG8_BAR;
            PG8_LDA(At, 1, 1); PG8_STAGE(PG8_SA(1, 0), a3, voffA);
            PG8_BAR; PG8_WAIT_L(0); PG8_MMA(1, 0, At, B0); PG8_BAR; PG8_SCHED;
            PG8_STAGE(PG8_SB(1, 1), b3 + hstep, voffB);
            PG8_WAIT_V(6); PG8_BAR; PG8_MMA(1, 1, At, B1); PG8_BAR;
            }
        }
        if constexpr (ALIGN_EPI) { if (wr == 0) PG8_BAR; }
        if constexpr (!Epi::AFTER_DRAIN) { E(acc, cur, wr, wc, fr, fq); S.done(cur); }
        if (!has_next) break;
#pragma unroll
        for (int a = 0; a < 2; ++a)
#pragma unroll
            for (int b = 0; b < 2; ++b)
#pragma unroll
                for (int m = 0; m < 4; ++m)
#pragma unroll
                    for (int n = 0; n < 2; ++n) acc[a][b][m][n] = (f32x4){0.f, 0.f, 0.f, 0.f};
        cur = nxt; cA = nA; cB = nB; ++ui;
        if constexpr (ALIGN_EPI) { if (wr == 1) PG8_BAR; }
    }
    PG8_WAIT_V(0);
    if constexpr (!ALIGN_EPI) { if (wr == 0) PG8_BAR; }
    PG8_BAR;
    if constexpr (Epi::AFTER_DRAIN) { E.fused(acc, cur, wr, wc, fr, fq, lds, wid, lane); S.done(cur); }
#undef PG8_SA
#undef PG8_SB
#undef PG8_STAGE
#undef PG8_LDA
#undef PG8_LDB
#undef PG8_MMA
#undef PG8_WAIT_V
#undef PG8_WAIT_L
#undef PG8_BAR
#undef PG8_SCHED
}
}

#include <hip/hip_cooperative_groups.h>
namespace cg = cooperative_groups;
namespace mk {
using pg8::bf16_t; using pg8::bf16x8; using pg8::f32x4; using pg8::u32x4;
#define MK_LAS __attribute__((address_space(3)))
typedef unsigned u32x2 __attribute__((ext_vector_type(2)));
typedef float f32x2v __attribute__((ext_vector_type(2)));

#define LAS MK_LAS
#define XB_TMO      128
#define XB_XCNT(j)  (256  + 64 * (j))
#define XB_XSUB(j)  (1280 + 64 * (j))
#define XB_XGEN(j)  (2304 + 64 * (j))
#define XB_TOP      3328
#define XB_TOPGEN   3392
#define XCD_BAR_WORDS 3456
#define XB_SPIN_CAP (1u << 18)

__device__ __forceinline__ unsigned xb_ld(unsigned* p)              { return __hip_atomic_load(p, __ATOMIC_RELAXED, __HIP_MEMORY_SCOPE_AGENT); }
__device__ __forceinline__ unsigned xb_add(unsigned* p, unsigned v) { return __hip_atomic_fetch_add(p, v, __ATOMIC_RELAXED, __HIP_MEMORY_SCOPE_AGENT); }
__device__ __forceinline__ unsigned xb_xcc_id() { return (unsigned)__builtin_amdgcn_s_getreg((3 << 11) | 20) & 0xFu; }
#define XB_SPIN(cond, bar) do { unsigned _sp = 0; while (cond) { __builtin_amdgcn_s_sleep(1); \
    if ((++_sp & 255u) == 0u) { if (xb_ld(&(bar)[XB_TMO])) break; if (_sp > XB_SPIN_CAP) { atomicAdd(&(bar)[XB_TMO], 1u); break; } } } } while (0)

struct XcdBarrier {
    unsigned* bar; unsigned x;
    volatile LAS unsigned* st;
};

__device__ __forceinline__ XcdBarrier xcd_barrier_post(unsigned* bar, volatile LAS unsigned* st) {
    XcdBarrier b; b.bar = bar; b.x = xb_xcc_id(); b.st = st;
    if (threadIdx.x == 0) (void)xb_add(&bar[XB_XCNT(b.x)], 1u);
    return b;
}
__device__ __forceinline__ void xcd_barrier_complete(unsigned* bar, unsigned x, unsigned& nloc, unsigned& nx) {
    const unsigned G = gridDim.x * gridDim.y * gridDim.z;
    unsigned sum, cnt, mine, sp = 0u;
    for (;;) {
        sum = 0u; cnt = 0u; mine = 0u;
#pragma unroll
        for (unsigned j = 0; j < 16; ++j) { const unsigned c = xb_ld(&bar[XB_XCNT(j)]); sum += c; cnt += (c > 0u) ? 1u : 0u; mine = (j == x) ? c : mine; }
        if (sum == G) break;
        __builtin_amdgcn_s_sleep(1);
        if ((++sp & 255u) == 0u) { if (xb_ld(&bar[XB_TMO])) break; if (sp > XB_SPIN_CAP) { atomicAdd(&bar[XB_TMO], 1u); break; } }
    }
    nloc = mine > 0u ? mine : 1u; nx = cnt > 0u ? cnt : 1u;
}

__device__ __forceinline__ void xcd_barrier(const XcdBarrier& b) {
    asm volatile("s_waitcnt vmcnt(0)" ::: "memory");
    __syncthreads();
    if (threadIdx.x == 0) {
        unsigned* bar = b.bar;
        __builtin_amdgcn_s_waitcnt(0);
        unsigned nloc = b.st[0], nx = b.st[1];
        if (nloc == 0u) { xcd_barrier_complete(bar, b.x, nloc, nx); b.st[0] = nloc; b.st[1] = nx; }
        const unsigned old = xb_add(&bar[XB_XSUB(b.x)], 1u);
        const unsigned gen = old / nloc;
        if (old + 1u == (gen + 1u) * nloc) {
            __builtin_amdgcn_fence(__ATOMIC_RELEASE, "agent");
            asm volatile("s_waitcnt vmcnt(0)" ::: "memory");
            const unsigned og = xb_add(&bar[XB_TOP], 1u);
            const unsigned tg = og / nx;
            if (og + 1u == (tg + 1u) * nx) xb_add(&bar[XB_TOPGEN], 1u);
            else XB_SPIN(xb_ld(&bar[XB_TOPGEN]) == tg, bar);
            __builtin_amdgcn_fence(__ATOMIC_ACQUIRE, "agent");
            xb_add(&bar[XB_XGEN(b.x)], 1u);
            asm volatile("s_waitcnt vmcnt(0)" ::: "memory");
        } else {
            XB_SPIN(xb_ld(&bar[XB_XGEN(b.x)]) == gen, bar);
            __builtin_amdgcn_fence(__ATOMIC_ACQUIRE, "agent");
            asm volatile("s_waitcnt vmcnt(0)" ::: "memory");
        }
    }
    __syncthreads();
}

#undef LAS
constexpr int D = 1024, NP = 16384, NS = 128, MR = NP + NS, MP = 16640, SEQ = 2048, NB = 8;
constexpr int INW = 2816, DFF = 2816, NFF1 = 5632, NMOD = 12288, MODROWS = 136, DEPTH = 2;
constexpr float EPS = 1e-6f;
constexpr int NWAVES = 8, NTHREADS = 512;
constexpr int LDS_BYTES = 147456;

constexpr int PQ = 0, PK = 256, PV = 512, PG = 1024, PAV = 1536, PAG = 1792, PCB = 2048, PCC = 2304, PCX = 2560;

constexpr size_t MiB = 1u << 20;
constexpr size_t WS_CTL = 0, CTL_ZERO_BYTES = 16384;
constexpr int LDS_CTL_OFF = 131072;
static_assert(XCD_BAR_WORDS * 4 <= CTL_ZERO_BYTES, "ctl");
constexpr size_t WS_WIN = 1 * MiB, WS_WOUT = 12 * MiB, WS_W13 = 16 * MiB, WS_W2 = 38 * MiB, WS_MOD = 49 * MiB, WS_HM = 56 * MiB,
                 WS_T1 = 89 * MiB, WS_PROJ = 122 * MiB, WS_U = 212 * MiB, WS_END = 228 * MiB;
constexpr size_t WS_ADAT = WS_T1, WS_AC = WS_T1 + 24 * MiB;
static_assert(WS_WIN + (size_t)DEPTH * INW * D * 2 <= WS_WOUT && WS_WOUT + (size_t)DEPTH * D * D * 2 <= WS_W13 && WS_W13 + (size_t)DEPTH * NFF1 * D * 2 <= WS_W2 &&
              WS_W2 + (size_t)DEPTH * D * DFF * 2 <= WS_MOD && WS_MOD + (size_t)MODROWS * NMOD * 4 <= WS_HM && WS_HM + (size_t)MP * D * 2 <= WS_T1 &&
              WS_T1 + (size_t)MP * D * 2 <= WS_PROJ && WS_AC + 256 * D * 2 <= WS_PROJ && WS_PROJ + (size_t)MP * INW * 2 <= WS_U && WS_U + (size_t)512 * 8192 * 4 <= WS_END, "ws map");

constexpr size_t O_Y = 0, O_YS = (size_t)NP * D, O_RETP = O_YS + (size_t)NS * D, O_CAP = O_RETP + (size_t)DEPTH * NB * 4 * 64 * 128,
                 O_CCP = O_CAP + (size_t)DEPTH * NB * 30 * 256, O_RETS = O_CCP + (size_t)DEPTH * NB * 2 * 256,
                 O_CAS = O_RETS + (size_t)DEPTH * NS * 4 * 64 * 128, O_CCS = O_CAS + (size_t)DEPTH * NS * 30 * 256, O_END = O_CCS + (size_t)DEPTH * NS * 2 * 256;

struct Params { const float* in[24]; float* out; unsigned char* ws; };

__device__ const double kInvRev[32] = {
0.15915494309189535, 0.11934937021124886, 0.08949940160889101, 0.06711508300522726, 0.050329212104487035, 0.03774158471741977, 0.0283021958306234, 0.02122365276477766,
0.015915494309189534, 0.011934937021124886, 0.008949940160889102, 0.006711508300522725, 0.005032921210448704, 0.003774158471741977, 0.00283021958306234, 0.0021223652764777662,
0.0015915494309189536, 0.0011934937021124885, 0.0008949940160889102, 0.0006711508300522726, 0.0005032921210448703, 0.00037741584717419774, 0.00028302195830623395, 0.0002122365276477766,
0.00015915494309189535, 0.00011934937021124886, 8.949940160889102e-05, 6.711508300522725e-05, 5.0329212104487035e-05, 3.774158471741978e-05, 2.8302195830623396e-05, 2.122365276477766e-05};

__device__ __forceinline__ float bf2f(unsigned short b) { return __uint_as_float((unsigned)b << 16); }
__device__ __forceinline__ float bflo(unsigned w) { return __uint_as_float(w << 16); }
__device__ __forceinline__ float bfhi(unsigned w) { return __uint_as_float(w & 0xffff0000u); }
__device__ __forceinline__ f32x4 unpack4(u32x2 w) { return (f32x4){bflo(w.x), bfhi(w.x), bflo(w.y), bfhi(w.y)}; }
__device__ __forceinline__ u32x2 pack4(f32x4 v) { u32x2 w; w.x = pg8::cvt_pk_bf16(v[0], v[1]); w.y = pg8::cvt_pk_bf16(v[2], v[3]); return w; }
__device__ __forceinline__ float sigmoidf_(float x) { return __builtin_amdgcn_rcpf(1.0f + __expf(-x)); }
__device__ __forceinline__ float siluf_(float x) { return x * sigmoidf_(x); }
__device__ __forceinline__ float wave_sum(float v) {
#pragma unroll
    for (int o = 1; o < 64; o <<= 1) v += __shfl_xor(v, o);
    return v;
}
__device__ __forceinline__ float log2_gamma(int h) { return __log2f(1.0f - exp2f(-5.0f - (float)h)); }

struct EpiMod {
    static constexpr bool PERM = false, AFTER_DRAIN = false;
    float* O; const float* bias;
    __device__ __forceinline__ void operator()(const f32x4 (&acc)[2][2][4][2], const pg8::Unit& u, int wr, int wc, int fr, int fq) const {
        const int col0 = u.pn * 256 + wc * 32 + 4 * fq;
#pragma unroll
        for (int ai = 0; ai < 2; ++ai)
#pragma unroll
            for (int m = 0; m < 4; ++m) { const int row = u.pm * 256 + ai * 128 + wr * 64 + m * 16 + fr;
                if (row < MODROWS) {
#pragma unroll
                    for (int bj = 0; bj < 2; ++bj)
#pragma unroll
                        for (int n = 0; n < 2; ++n) { const int col = col0 + bj * 128 + n * 16; *(f32x4*)(O + (size_t)row * NMOD + col) = acc[ai][bj][m][n] + *(const f32x4*)(bias + col); } } }
    }
};
struct EpiSwiGLU {
    static constexpr bool PERM = true, AFTER_DRAIN = false;
    bf16_t* O;
    __device__ __forceinline__ void operator()(const f32x4 (&acc)[2][2][4][2], const pg8::Unit& u, int wr, int wc, int fr, int fq) const {
        const int col0 = u.pn * 128 + wc * 32 + 8 * fq;
#pragma unroll
        for (int ai = 0; ai < 2; ++ai)
#pragma unroll
            for (int m = 0; m < 4; ++m) { bf16_t* rowp = O + (size_t)(u.pm * 256 + ai * 128 + wr * 64 + m * 16 + fr) * DFF + col0;
                f32x4 a0 = acc[ai][0][m][0], a1 = acc[ai][0][m][1]; const f32x4 b0 = acc[ai][1][m][0], b1 = acc[ai][1][m][1];
#pragma unroll
                for (int i = 0; i < 4; ++i) { a0[i] = siluf_(a0[i]) * b0[i]; a1[i] = siluf_(a1[i]) * b1[i]; }
                u32x4 w; w.x = pg8::cvt_pk_bf16(a0[0], a0[1]); w.y = pg8::cvt_pk_bf16(a0[2], a0[3]); w.z = pg8::cvt_pk_bf16(a1[0], a1[1]); w.w = pg8::cvt_pk_bf16(a1[2], a1[3]);
                *(u32x4*)rowp = w; }
    }
};

__device__ __forceinline__ void p0_transpose_item(const float* W, int K, int N, bf16_t* WT, int k0, int n0, int orow, MK_LAS float* scr, int lane) {
#pragma unroll 8
    for (int i = 0; i < 32; ++i) { const int kk = 2 * i + (lane >> 5); scr[kk * 33 + (lane & 31)] = W[(size_t)(k0 + kk) * N + n0 + (lane & 31)]; }
    asm volatile("s_waitcnt lgkmcnt(0)" ::: "memory");
    const int c = lane & 7;
#pragma unroll
    for (int j = 0; j < 4; ++j) { const int n = (lane >> 3) + 8 * j; const MK_LAS float* s = scr + (8 * c) * 33 + n;
        u32x4 o; o.x = pg8::cvt_pk_bf16(s[0 * 33], s[1 * 33]); o.y = pg8::cvt_pk_bf16(s[2 * 33], s[3 * 33]); o.z = pg8::cvt_pk_bf16(s[4 * 33], s[5 * 33]); o.w = pg8::cvt_pk_bf16(s[6 * 33], s[7 * 33]);
        *(u32x4*)(WT + (size_t)(orow + n) * K + k0 + 8 * c) = o; }
    asm volatile("s_waitcnt lgkmcnt(0)" ::: "memory");
}
__device__ __forceinline__ void p0_prologue(const Params& P, MK_LAS unsigned char* lds) {
    int tid_ = threadIdx.x; asm volatile("" : "+v"(tid_)); const int tid = tid_, lane = tid & 63, wave = __builtin_amdgcn_readfirstlane(tid >> 6); (void)tid; (void)lane; (void)wave;
    MK_LAS float* scr = (MK_LAS float*)(lds + wave * 16384);
    const int gw = blockIdx.x * NWAVES + wave, NGW = gridDim.x * NWAVES;
    unsigned char* ws = P.ws;
    constexpr int I_IN = 16 * 88, I_OUT = 16 * 32, I_F = 16 * 88, I_2 = 44 * 32, I_ADA = 16 * 192;
    constexpr int PER_L = I_IN + I_OUT + 2 * I_F + I_2 + I_ADA;
    for (int it = gw; it < DEPTH * PER_L; it += NGW) {
        const int l = it / PER_L; int r = it % PER_L;
        if (r < I_IN) { const int kb = r / 88, nb = r % 88; p0_transpose_item(P.in[13] + (size_t)l * D * INW, D, INW, (bf16_t*)(ws + WS_WIN) + (size_t)l * INW * D, 64 * kb, 32 * nb, 32 * nb, scr, lane); continue; } r -= I_IN;
        if (r < I_OUT) { const int kb = r / 32, nb = r % 32; p0_transpose_item(P.in[14] + (size_t)l * D * D, D, D, (bf16_t*)(ws + WS_WOUT) + (size_t)l * D * D, 64 * kb, 32 * nb, 32 * nb, scr, lane); continue; } r -= I_OUT;
        if (r < I_F) { const int kb = r / 88, nb = r % 88, n0 = 32 * nb; p0_transpose_item(P.in[21] + (size_t)l * D * DFF, D, DFF, (bf16_t*)(ws + WS_W13) + (size_t)l * NFF1 * D, 64 * kb, n0, 256 * (n0 >> 7) + (n0 & 127), scr, lane); continue; } r -= I_F;
        if (r < I_F) { const int kb = r / 88, nb = r % 88, n0 = 32 * nb; p0_transpose_item(P.in[22] + (size_t)l * D * DFF, D, DFF, (bf16_t*)(ws + WS_W13) + (size_t)l * NFF1 * D, 64 * kb, n0, 256 * (n0 >> 7) + 128 + (n0 & 127), scr, lane); continue; } r -= I_F;
        if (r < I_2) { const int kb = r / 32, nb = r % 32; p0_transpose_item(P.in[23] + (size_t)l * DFF * D, DFF, D, (bf16_t*)(ws + WS_W2) + (size_t)l * D * DFF, 64 * kb, 32 * nb, 32 * nb, scr, lane); continue; } r -= I_2;
        { const int kb = r / 192, nb = r % 192; p0_transpose_item(P.in[7] + (size_t)l * D * 6144, D, 6144, (bf16_t*)(ws + WS_ADAT), 64 * kb, 32 * nb, l * 6144 + 32 * nb, scr, lane); }
    }
    for (int r = gw; r < 256; r += NGW) {
        bf16_t* o = (bf16_t*)(ws + WS_AC) + (size_t)r * D;
        const float* src = r < NB ? P.in[2] + (size_t)r * D : P.in[3] + (size_t)(r - NB) * D;
#pragma unroll
        for (int j = 0; j < 4; ++j) { f32x4 v = (f32x4){0.f, 0.f, 0.f, 0.f};
            if (r < MODROWS) { v = *(const f32x4*)(src + 4 * lane + 256 * j); v[0] = siluf_(v[0]); v[1] = siluf_(v[1]); v[2] = siluf_(v[2]); v[3] = siluf_(v[3]); }
            *(u32x2*)(o + 4 * lane + 256 * j) = pack4(v); }
    }
}

template <int KIND>
__device__ __forceinline__ void rowpass(const Params& P, int l) {
    int tid_ = threadIdx.x; asm volatile("" : "+v"(tid_)); const int tid = tid_, lane = tid & 63, wave = __builtin_amdgcn_readfirstlane(tid >> 6); (void)tid; (void)lane; (void)wave;
    const int gw = blockIdx.x * NWAVES + wave, NGW = gridDim.x * NWAVES;
    unsigned char* ws = P.ws;
    const float* mod = (const float*)(ws + WS_MOD);
    bf16_t* HM = (bf16_t*)(ws + WS_HM); const bf16_t* T1 = (const bf16_t*)(ws + WS_T1);
    for (int r = gw; r < MR; r += NGW) {
        const int mrow = r < NP ? (r >> 11) : NB + (r - NP);
        const float* mp = mod + (size_t)mrow * NMOD + l * 6144;
        f32x4 x[4];
        const float* xin = (KIND == 0 || (KIND == 1 && l == 0)) ? (r < NP ? P.in[0] + (size_t)r * D : P.in[1] + (size_t)(r - NP) * D) : P.out + (size_t)r * D;
#pragma unroll
        for (int j = 0; j < 4; ++j) x[j] = *(const f32x4*)(xin + 4 * lane + 256 * j);
        if (KIND != 0) {
            f32x4 t[4]; float s = 0.f;
#pragma unroll
            for (int j = 0; j < 4; ++j) { t[j] = unpack4(*(const u32x2*)(T1 + (size_t)r * D + 4 * lane + 256 * j)); s += (t[j][0] * t[j][0] + t[j][1] * t[j][1]) + (t[j][2] * t[j][2] + t[j][3] * t[j][3]); }
            const float rstd = rsqrtf(wave_sum(s) * (1.0f / D) + EPS);
            const float* gpost = P.in[KIND == 1 ? 10 : 12] + l * D;
            const float* gt = mp + (KIND == 1 ? 2 : 5) * D;
#pragma unroll
            for (int j = 0; j < 4; ++j) { const f32x4 g = *(const f32x4*)(gpost + 4 * lane + 256 * j), gg = *(const f32x4*)(gt + 4 * lane + 256 * j);
                x[j] = x[j] + gg * (t[j] * rstd * g);
                *(f32x4*)(P.out + (size_t)r * D + 4 * lane + 256 * j) = x[j]; }
        }
        if (KIND == 2 && l == DEPTH - 1) continue;
        const int ln = (KIND == 2) ? l + 1 : l;
        const float* mpn = mod + (size_t)mrow * NMOD + ln * 6144;
        const float* gpre = P.in[KIND == 1 ? 11 : 9] + ln * D;
        const float* sh = mpn + (KIND == 1 ? 3 : 0) * D; const float* sc = mpn + (KIND == 1 ? 4 : 1) * D;
        float s = 0.f;
#pragma unroll
        for (int j = 0; j < 4; ++j) s += (x[j][0] * x[j][0] + x[j][1] * x[j][1]) + (x[j][2] * x[j][2] + x[j][3] * x[j][3]);
        const float rstd = rsqrtf(wave_sum(s) * (1.0f / D) + EPS);
#pragma unroll
        for (int j = 0; j < 4; ++j) { const f32x4 g = *(const f32x4*)(gpre + 4 * lane + 256 * j), a = *(const f32x4*)(sc + 4 * lane + 256 * j), b = *(const f32x4*)(sh + 4 * lane + 256 * j);
            const f32x4 h = (x[j] * rstd * g) * (a + 1.0f) + b;
            *(u32x2*)(HM + (size_t)r * D + 4 * lane + 256 * j) = pack4(h); }
    }
}

__device__ __forceinline__ bf16x8 lfrag(const MK_LAS bf16_t* base, int row, int stride, int k0, int fq) { return *(const MK_LAS bf16x8*)(base + row * stride + k0 + fq * 8); }
#define MK_MFMA(b, a, c) __builtin_amdgcn_mfma_f32_16x16x32_bf16((b), (a), (c), 0, 0, 0)

__device__ __forceinline__ void rope8(const bf16_t* src  , int j, float pos, float scale, u32x4& o1, u32x4& o2, float extra  ) {
    const u32x4 w1 = *(const u32x4*)(src + 8 * j), w2 = *(const u32x4*)(src + 32 + 8 * j);
    float a[8], b[8];
#pragma unroll
    for (int q = 0; q < 4; ++q) { a[2 * q] = bflo(w1[q]); a[2 * q + 1] = bfhi(w1[q]); b[2 * q] = bflo(w2[q]); b[2 * q + 1] = bfhi(w2[q]); }
    float r1[8], r2[8]; const float sc = scale * extra;
#pragma unroll
    for (int i = 0; i < 8; ++i) { const double rev = (double)pos * kInvRev[8 * j + i]; const float fr_ = (float)(rev - floor(rev));
        const float sn = __builtin_amdgcn_sinf(fr_), cs = __builtin_amdgcn_cosf(fr_);
        r1[i] = (a[i] * cs - b[i] * sn) * sc; r2[i] = (a[i] * sn + b[i] * cs) * sc; }
#pragma unroll
    for (int q = 0; q < 4; ++q) { o1[q] = pg8::cvt_pk_bf16(r1[2 * q], r1[2 * q + 1]); o2[q] = pg8::cvt_pk_bf16(r2[2 * q], r2[2 * q + 1]); }
}

constexpr int SQ = 72, SV = 136;
constexpr int L_QS = 0, L_KS = L_QS + 128 * SQ * 2, L_VT = L_KS + 128 * SQ * 2, L_PS = L_VT + 128 * SV * 2, L_ST = L_PS + 128 * SV * 2, L_RET_END = L_ST + 128 * SQ * 2;
static_assert(L_RET_END <= 131072, "retention LDS");

__device__ __forceinline__ void load_vt(const bf16_t* PROJ, int row0, int h, MK_LAS bf16_t* Vt, int wave, int lane) {
#pragma unroll
    for (int it = 0; it < 4; ++it) { const int chunk = wave * 2 + (it & 1), m = lane + 64 * (it >> 1);
        const u32x4 w = *(const u32x4*)(PROJ + (size_t)(row0 + m) * INW + PV + h * 128 + chunk * 8);
#pragma unroll
        for (int q = 0; q < 4; ++q) { Vt[(chunk * 8 + 2 * q) * SV + m] = (bf16_t)(w[q] & 0xffffu); Vt[(chunk * 8 + 2 * q + 1) * SV + m] = (bf16_t)(w[q] >> 16); } }
}

__device__ __forceinline__ void ret_u_item(const Params& P, MK_LAS unsigned char* lds, int item) {
    int tid_ = threadIdx.x; asm volatile("" : "+v"(tid_)); const int tid = tid_, lane = tid & 63, wave = __builtin_amdgcn_readfirstlane(tid >> 6); (void)tid; (void)lane; (void)wave;
    const int h = item & 3, c = (item >> 2) & 15, b = item >> 6;
    const bf16_t* PROJ = (const bf16_t*)(P.ws + WS_PROJ);
    float* UT = (float*)(P.ws + WS_U) + (size_t)((b * 4 + h) * 16 + c) * 8192;
    MK_LAS bf16_t* Kt = (MK_LAS bf16_t*)(lds + L_KS);
    MK_LAS bf16_t* Vt = (MK_LAS bf16_t*)(lds + L_VT);
    const int row0 = b * SEQ + c * 128; const float lg = log2_gamma(h);
    __syncthreads();
    load_vt(PROJ, row0, h, Vt, wave, lane);
    { const int m = tid & 127, j = tid >> 7; u32x4 o1, o2;
      rope8(PROJ + (size_t)(row0 + m) * INW + PK + h * 64, j, (float)(c * 128 + m), 0.125f, o1, o2, exp2f((float)(127 - m) * lg));
#pragma unroll
      for (int q = 0; q < 4; ++q) { Kt[(8 * j + 2 * q) * SV + m] = (bf16_t)(o1[q] & 0xffffu); Kt[(8 * j + 2 * q + 1) * SV + m] = (bf16_t)(o1[q] >> 16);
                                    Kt[(32 + 8 * j + 2 * q) * SV + m] = (bf16_t)(o2[q] & 0xffffu); Kt[(32 + 8 * j + 2 * q + 1) * SV + m] = (bf16_t)(o2[q] >> 16); } }
    __syncthreads();
    const int fr = lane & 15, fq = lane >> 4, e0 = 16 * wave;
    f32x4 u[4];
#pragma unroll
    for (int j = 0; j < 4; ++j) u[j] = (f32x4){0.f, 0.f, 0.f, 0.f};
#pragma unroll
    for (int ks = 0; ks < 4; ++ks) { const bf16x8 a = lfrag(Vt, e0 + fr, SV, ks * 32, fq);
#pragma unroll
        for (int j = 0; j < 4; ++j) { const bf16x8 bb = lfrag(Kt, 16 * j + fr, SV, ks * 32, fq); u[j] = MK_MFMA(bb, a, u[j]); } }
#pragma unroll
    for (int j = 0; j < 4; ++j) *(f32x4*)(UT + (e0 + fr) * 64 + 16 * j + 4 * fq) = u[j];
}

__device__ __forceinline__ void ret_o_item(const Params& P, MK_LAS unsigned char* lds, int l, int item) {
    int tid_ = threadIdx.x; asm volatile("" : "+v"(tid_)); const int tid = tid_, lane = tid & 63, wave = __builtin_amdgcn_readfirstlane(tid >> 6); (void)tid; (void)lane; (void)wave;
    const int h = item & 3, c = (item >> 2) & 15, b = item >> 6;
    const bf16_t* PROJ = (const bf16_t*)(P.ws + WS_PROJ);
    bf16_t* MIX = (bf16_t*)(P.ws + WS_HM);
    const float* UTb = (const float*)(P.ws + WS_U) + (size_t)((b * 4 + h) * 16) * 8192;
    MK_LAS bf16_t* Qs = (MK_LAS bf16_t*)(lds + L_QS); MK_LAS bf16_t* Ks = (MK_LAS bf16_t*)(lds + L_KS); MK_LAS bf16_t* Vt = (MK_LAS bf16_t*)(lds + L_VT);
    MK_LAS bf16_t* Ps = (MK_LAS bf16_t*)(lds + L_PS); MK_LAS bf16_t* St = (MK_LAS bf16_t*)(lds + L_ST);
    const int row0 = b * SEQ + c * 128; const float lg = log2_gamma(h); const float cd = exp2f(128.0f * lg);
    __syncthreads();
    load_vt(PROJ, row0, h, Vt, wave, lane);
    { const int m = tid & 127, j = tid >> 7; u32x4 o1, o2; const float pos = (float)(c * 128 + m);
      rope8(PROJ + (size_t)(row0 + m) * INW + PQ + h * 64, j, pos, 1.0f, o1, o2, 1.0f);
      *(MK_LAS u32x4*)(Qs + m * SQ + 8 * j) = o1; *(MK_LAS u32x4*)(Qs + m * SQ + 32 + 8 * j) = o2;
      rope8(PROJ + (size_t)(row0 + m) * INW + PK + h * 64, j, pos, 0.125f, o1, o2, 1.0f);
      *(MK_LAS u32x4*)(Ks + m * SQ + 8 * j) = o1; *(MK_LAS u32x4*)(Ks + m * SQ + 32 + 8 * j) = o2; }
#pragma unroll 1
    for (int it = 0; it < 4; ++it) { const int idx = tid + 512 * it, e = idx >> 4, dq = idx & 15;
        f32x4 s = (f32x4){0.f, 0.f, 0.f, 0.f};
        for (int j = 0; j < c; ++j) s = s * cd + *(const f32x4*)(UTb + (size_t)j * 8192 + e * 64 + 4 * dq);
        *(MK_LAS u32x2*)(St + e * SQ + 4 * dq) = pack4(s);
        if (c == 15) { s = s * cd + *(const f32x4*)(UTb + (size_t)15 * 8192 + e * 64 + 4 * dq);
            float* o = P.out + O_RETP + (size_t)((l * NB + b) * 4 + h) * 8192 + e;
#pragma unroll
            for (int i = 0; i < 4; ++i) o[(4 * dq + i) * 128] = s[i]; } }
    __syncthreads();
    const int fr = lane & 15, fq = lane >> 4, n0 = 16 * wave, n = n0 + fr;
    {
        f32x4 sc[8];
#pragma unroll
        for (int j = 0; j < 8; ++j) sc[j] = (f32x4){0.f, 0.f, 0.f, 0.f};
#pragma unroll
        for (int ks = 0; ks < 2; ++ks) { const bf16x8 a = lfrag(Qs, n, SQ, ks * 32, fq);
#pragma unroll
            for (int j = 0; j < 8; ++j) { const bf16x8 bb = lfrag(Ks, 16 * j + fr, SQ, ks * 32, fq); sc[j] = MK_MFMA(bb, a, sc[j]); } }
#pragma unroll
        for (int j = 0; j < 8; ++j) { f32x4 p;
#pragma unroll
            for (int i = 0; i < 4; ++i) { const int dlt = n - (16 * j + 4 * fq + i); p[i] = dlt >= 0 ? sc[j][i] * exp2f((float)dlt * lg) : 0.f; }
            *(MK_LAS u32x2*)(Ps + n * SV + 16 * j + 4 * fq) = pack4(p); }
    }
    __syncthreads();
    f32x4 o1[8], o2[8];
#pragma unroll
    for (int j = 0; j < 8; ++j) { o1[j] = (f32x4){0.f, 0.f, 0.f, 0.f}; o2[j] = (f32x4){0.f, 0.f, 0.f, 0.f}; }
#pragma unroll
    for (int ks = 0; ks < 4; ++ks) { const bf16x8 a = lfrag(Ps, n, SV, ks * 32, fq);
#pragma unroll
        for (int j = 0; j < 8; ++j) { const bf16x8 bb = lfrag(Vt, 16 * j + fr, SV, ks * 32, fq); o1[j] = MK_MFMA(bb, a, o1[j]); } }
#pragma unroll
    for (int ks = 0; ks < 2; ++ks) { const bf16x8 a = lfrag(Qs, n, SQ, ks * 32, fq);
#pragma unroll
        for (int j = 0; j < 8; ++j) { const bf16x8 bb = lfrag(St, 16 * j + fr, SQ, ks * 32, fq); o2[j] = MK_MFMA(bb, a, o2[j]); } }
    const float rd = exp2f((float)(n + 1) * lg);
    float s = 0.f;
#pragma unroll
    for (int j = 0; j < 8; ++j) { o1[j] = o1[j] + o2[j] * rd; s += (o1[j][0] + o1[j][1]) + (o1[j][2] + o1[j][3]); }
    s += __shfl_xor(s, 16); s += __shfl_xor(s, 32);
    const float mean = s * (1.0f / 128.0f); float q = 0.f;
#pragma unroll
    for (int j = 0; j < 8; ++j) { o1[j] = o1[j] - mean; q += (o1[j][0] * o1[j][0] + o1[j][1] * o1[j][1]) + (o1[j][2] * o1[j][2] + o1[j][3] * o1[j][3]); }
    q += __shfl_xor(q, 16); q += __shfl_xor(q, 32);
    const float rstd = rsqrtf(q * (1.0f / 128.0f) + EPS);
    const float* gn = P.in[15] + l * 512 + h * 128;
    const size_t row = (size_t)(row0 + n);
#pragma unroll
    for (int j = 0; j < 8; ++j) { const int e = 16 * j + 4 * fq;
        const f32x4 g = *(const f32x4*)(gn + e); const f32x4 gate = unpack4(*(const u32x2*)(PROJ + row * INW + PG + h * 128 + e));
        f32x4 o;
#pragma unroll
        for (int i = 0; i < 4; ++i) o[i] = o1[j][i] * rstd * g[i] * siluf_(gate[i]);
        *(u32x2*)(MIX + row * D + h * 128 + e) = pack4(o); }
}

__device__ __forceinline__ void conva_finish(const Params& P, int l, f32x4 acc, size_t row, int lane) {
    bf16_t* MIX = (bf16_t*)(P.ws + WS_HM);
    const float mean = wave_sum((acc[0] + acc[1]) + (acc[2] + acc[3])) * (1.0f / 256.0f);
    const f32x4 d = acc - mean;
    const float var = wave_sum((d[0] * d[0] + d[1] * d[1]) + (d[2] * d[2] + d[3] * d[3])) * (1.0f / 256.0f);
    const float rstd = rsqrtf(var + EPS);
    const f32x4 g = *(const f32x4*)(P.in[18] + l * 256 + 4 * lane), bb = *(const f32x4*)(P.in[19] + l * 256 + 4 * lane);
    f32x4 y = d * rstd * g + bb;
#pragma unroll
    for (int i = 0; i < 4; ++i) y[i] = siluf_(y[i]);
    *(u32x2*)(MIX + row * D + 512 + 4 * lane) = pack4(y);
}

__device__ __forceinline__ void conv_item(const Params& P, MK_LAS unsigned char* lds, int l, int item) {
    int tid_ = threadIdx.x; asm volatile("" : "+v"(tid_)); const int tid = tid_, lane = tid & 63, wave = __builtin_amdgcn_readfirstlane(tid >> 6); (void)tid; (void)lane; (void)wave;
    const int b = item >> 5, tb = item & 31, t0 = tb * 64;
    const bf16_t* PROJ = (const bf16_t*)(P.ws + WS_PROJ);
    bf16_t* MIX = (bf16_t*)(P.ws + WS_HM);
    MK_LAS float* Us = (MK_LAS float*)lds;
    __syncthreads();
    for (int idx = tid; idx < 94 * 64; idx += NTHREADS) { const int lr = idx >> 6, q = idx & 63, t = t0 - 30 + lr;
        f32x4 u = (f32x4){0.f, 0.f, 0.f, 0.f};
        if (t >= 0) { const bf16_t* rp = PROJ + (size_t)(b * SEQ + t) * INW; const f32x4 v = unpack4(*(const u32x2*)(rp + PAV + 4 * q)), g = unpack4(*(const u32x2*)(rp + PAG + 4 * q));
#pragma unroll
            for (int i = 0; i < 4; ++i) u[i] = v[i] * sigmoidf_(g[i]); }
        *(MK_LAS f32x4*)(Us + lr * 256 + 4 * q) = u;
        if (tb == 31 && lr >= 64) *(f32x4*)(P.out + O_CAP + (size_t)((l * NB + b) * 30 + (lr - 64)) * 256 + 4 * q) = u; }
    __syncthreads();
    const float* cw = P.in[16] + l * 31 * 256 + 4 * lane;
    f32x4 acc[8]; const f32x4 bias = *(const f32x4*)(P.in[17] + l * 256 + 4 * lane);
#pragma unroll
    for (int k = 0; k < 8; ++k) acc[k] = bias;
#pragma unroll 1
    for (int j = 0; j < 31; ++j) { const f32x4 w = *(const f32x4*)(cw + j * 256);
#pragma unroll
        for (int k = 0; k < 8; ++k) acc[k] = acc[k] + w * *(const MK_LAS f32x4*)(Us + (8 * wave + k + j) * 256 + 4 * lane); }
#pragma unroll
    for (int k = 0; k < 8; ++k) conva_finish(P, l, acc[k], (size_t)(b * SEQ + t0 + 8 * wave + k), lane);
    const f32x4 w0 = *(const f32x4*)(P.in[20] + l * 768 + 4 * lane), w1 = *(const f32x4*)(P.in[20] + l * 768 + 256 + 4 * lane), w2 = *(const f32x4*)(P.in[20] + l * 768 + 512 + 4 * lane);
    f32x4 zm2 = (f32x4){0.f, 0.f, 0.f, 0.f}, zm1 = zm2;
#pragma unroll
    for (int k = -2; k < 8; ++k) { const int t = t0 + 8 * wave + k;
        f32x4 z = (f32x4){0.f, 0.f, 0.f, 0.f};
        if (t >= 0) { const bf16_t* rp = PROJ + (size_t)(b * SEQ + t) * INW; z = unpack4(*(const u32x2*)(rp + PCC + 4 * lane)) * unpack4(*(const u32x2*)(rp + PCX + 4 * lane)); }
        if (k >= 0) { const bf16_t* rp = PROJ + (size_t)(b * SEQ + t) * INW; const f32x4 cb = unpack4(*(const u32x2*)(rp + PCB + 4 * lane));
            const f32x4 o = cb * (w0 * zm2 + w1 * zm1 + w2 * z);
            *(u32x2*)(MIX + (size_t)(b * SEQ + t) * D + 768 + 4 * lane) = pack4(o);
            if (t >= SEQ - 2) *(f32x4*)(P.out + O_CCP + (size_t)((l * NB + b) * 2 + (t - (SEQ - 2))) * 256 + 4 * lane) = z; }
        zm2 = zm1; zm1 = z; }
}

__device__ __forceinline__ void sample_conv(const Params& P, int l, int grp) {
    int tid_ = threadIdx.x; asm volatile("" : "+v"(tid_)); const int tid = tid_, lane = tid & 63, wave = __builtin_amdgcn_readfirstlane(tid >> 6); (void)tid; (void)lane; (void)wave;
    const int s = grp * 8 + wave;
    const bf16_t* PROJ = (const bf16_t*)(P.ws + WS_PROJ);
    bf16_t* MIX = (bf16_t*)(P.ws + WS_HM);
    const size_t row = (size_t)(NP + s); const bf16_t* rp = PROJ + row * INW;
    const f32x4 v = unpack4(*(const u32x2*)(rp + PAV + 4 * lane)), g = unpack4(*(const u32x2*)(rp + PAG + 4 * lane));
    f32x4 u;
#pragma unroll
    for (int i = 0; i < 4; ++i) u[i] = v[i] * sigmoidf_(g[i]);
    const float* buf = P.in[5] + (size_t)((l * NS + s) * 30) * 256 + 4 * lane; float* nb = P.out + O_CAS + (size_t)((l * NS + s) * 30) * 256 + 4 * lane;
    const float* cw = P.in[16] + l * 31 * 256 + 4 * lane;
    f32x4 acc = *(const f32x4*)(P.in[17] + l * 256 + 4 * lane);
#pragma unroll 6
    for (int j = 0; j < 30; ++j) { const f32x4 x = *(const f32x4*)(buf + j * 256); acc = acc + *(const f32x4*)(cw + j * 256) * x; if (j >= 1) *(f32x4*)(nb + (j - 1) * 256) = x; }
    acc = acc + *(const f32x4*)(cw + 30 * 256) * u; *(f32x4*)(nb + 29 * 256) = u;
    conva_finish(P, l, acc, row, lane);
    const f32x4 w0 = *(const f32x4*)(P.in[20] + l * 768 + 4 * lane), w1 = *(const f32x4*)(P.in[20] + l * 768 + 256 + 4 * lane), w2 = *(const f32x4*)(P.in[20] + l * 768 + 512 + 4 * lane);
    const float* bc = P.in[6] + (size_t)((l * NS + s) * 2) * 256 + 4 * lane; float* nc = P.out + O_CCS + (size_t)((l * NS + s) * 2) * 256 + 4 * lane;
    const f32x4 z0 = *(const f32x4*)bc, z1 = *(const f32x4*)(bc + 256);
    const f32x4 z = unpack4(*(const u32x2*)(rp + PCC + 4 * lane)) * unpack4(*(const u32x2*)(rp + PCX + 4 * lane));
    const f32x4 cb = unpack4(*(const u32x2*)(rp + PCB + 4 * lane));
    *(u32x2*)(MIX + row * D + 768 + 4 * lane) = pack4(cb * (w0 * z0 + w1 * z1 + w2 * z));
    *(f32x4*)nc = z1; *(f32x4*)(nc + 256) = z;
}

__device__ __forceinline__ void sample_ret(const Params& P, int l, int grp) {
    int tid_ = threadIdx.x; asm volatile("" : "+v"(tid_)); const int tid = tid_, lane = tid & 63, wave = __builtin_amdgcn_readfirstlane(tid >> 6); (void)tid; (void)lane; (void)wave;
    const int s = (grp * 8 + wave) >> 2, h = (grp * 8 + wave) & 3;
    const bf16_t* PROJ = (const bf16_t*)(P.ws + WS_PROJ);
    bf16_t* MIX = (bf16_t*)(P.ws + WS_HM);
    const size_t row = (size_t)(NP + s); const bf16_t* rp = PROJ + row * INW;
    const float lg = log2_gamma(h), gam = exp2f(lg);
    const int i5 = lane & 31;
    const double rev = 16384.0 * kInvRev[i5]; const float fr_ = (float)(rev - floor(rev));
    const float sn = __builtin_amdgcn_sinf(fr_), cs = __builtin_amdgcn_cosf(fr_);
    const float q1 = bf2f(rp[PQ + h * 64 + i5]), q2 = bf2f(rp[PQ + h * 64 + 32 + i5]), k1 = bf2f(rp[PK + h * 64 + i5]), k2 = bf2f(rp[PK + h * 64 + 32 + i5]);
    const float qr = bflo(pg8::cvt_pk_bf16(lane < 32 ? q1 * cs - q2 * sn : q1 * sn + q2 * cs, 0.f));
    const float kr = bflo(pg8::cvt_pk_bf16((lane < 32 ? k1 * cs - k2 * sn : k1 * sn + k2 * cs) * 0.125f, 0.f));
    const int eq = lane & 31, dpar = lane >> 5;
    const f32x4 v = unpack4(*(const u32x2*)(rp + PV + h * 128 + 4 * eq));
    const float* S0 = P.in[4] + (size_t)((l * NS + s) * 4 + h) * 8192 + 4 * eq; float* S1 = P.out + O_RETS + (size_t)((l * NS + s) * 4 + h) * 8192 + 4 * eq;
    f32x4 o = (f32x4){0.f, 0.f, 0.f, 0.f};
#pragma unroll 8
    for (int it = 0; it < 32; ++it) { const int d = 2 * it + dpar;
        const float qa = __uint_as_float(__builtin_amdgcn_readlane(__float_as_uint(qr), 2 * it)), qb = __uint_as_float(__builtin_amdgcn_readlane(__float_as_uint(qr), 2 * it + 1));
        const float ka = __uint_as_float(__builtin_amdgcn_readlane(__float_as_uint(kr), 2 * it)), kb = __uint_as_float(__builtin_amdgcn_readlane(__float_as_uint(kr), 2 * it + 1));
        const float qd = dpar ? qb : qa, kd = dpar ? kb : ka;
        f32x4 sv = *(const f32x4*)(S0 + d * 128); sv = sv * gam + v * kd; *(f32x4*)(S1 + d * 128) = sv; o = o + sv * qd; }
#pragma unroll
    for (int i = 0; i < 4; ++i) o[i] += __shfl_xor(o[i], 32);
    float sm = (o[0] + o[1]) + (o[2] + o[3]);
#pragma unroll
    for (int x = 1; x < 32; x <<= 1) sm += __shfl_xor(sm, x);
    const float mean = sm * (1.0f / 128.0f); const f32x4 dd = o - mean; float qq = (dd[0] * dd[0] + dd[1] * dd[1]) + (dd[2] * dd[2] + dd[3] * dd[3]);
#pragma unroll
    for (int x = 1; x < 32; x <<= 1) qq += __shfl_xor(qq, x);
    const float rstd = rsqrtf(qq * (1.0f / 128.0f) + EPS);
    if (lane < 32) { const f32x4 g = *(const f32x4*)(P.in[15] + l * 512 + h * 128 + 4 * eq); const f32x4 gate = unpack4(*(const u32x2*)(rp + PG + h * 128 + 4 * eq));
        f32x4 y;
#pragma unroll
        for (int i = 0; i < 4; ++i) y[i] = dd[i] * rstd * g[i] * siluf_(gate[i]);
        *(u32x2*)(MIX + row * D + h * 128 + 4 * eq) = pack4(y); }
}


__device__ __forceinline__ void skinny_gemm(const bf16_t* A  , const bf16_t* Bt  , int K, bf16_t* O  ) {
    int tid_ = threadIdx.x; asm volatile("" : "+v"(tid_)); const int tid = tid_, lane = tid & 63, wave = __builtin_amdgcn_readfirstlane(tid >> 6);
    const int fr = lane & 15, fq = lane >> 4;
    for (int it = blockIdx.x; it < 64; it += gridDim.x) {
        const bf16_t* ap = A + (size_t)(NP + 16 * wave + fr) * K + 8 * fq;
        const bf16_t* bp = Bt + (size_t)(16 * it + fr) * K + 8 * fq;
        f32x4 acc0 = (f32x4){0.f, 0.f, 0.f, 0.f}, acc1 = acc0;
#pragma unroll 4
        for (int k0 = 0; k0 < K; k0 += 64) {
            const bf16x8 a0 = *(const bf16x8*)(ap + k0), b0 = *(const bf16x8*)(bp + k0), a1 = *(const bf16x8*)(ap + k0 + 32), b1 = *(const bf16x8*)(bp + k0 + 32);
            acc0 = MK_MFMA(b0, a0, acc0); acc1 = MK_MFMA(b1, a1, acc1); }
        *(u32x2*)(O + (size_t)(NP + 16 * wave + fr) * D + 16 * it + 4 * fq) = pack4(acc0 + acc1);
    }
}
__global__ void __launch_bounds__(NTHREADS, 2) mk_fwd(Params P) {
    extern __shared__ __attribute__((aligned(16))) unsigned char lds_raw[];
    MK_LAS unsigned char* lds = (MK_LAS unsigned char*)lds_raw;
    cg::grid_group grid = cg::this_grid();
    if (threadIdx.x < 16) ((MK_LAS unsigned*)(lds + LDS_CTL_OFF))[threadIdx.x] = 0u;
    __syncthreads();
    const XcdBarrier xbar = xcd_barrier_post((unsigned*)(P.ws + WS_CTL), (volatile MK_LAS unsigned*)(lds + LDS_CTL_OFF));
    if (P.ws == nullptr) grid.sync();
    const int G = gridDim.x, bx = blockIdx.x;
    unsigned char* ws = P.ws;
    bf16_t* HM = (bf16_t*)(ws + WS_HM); bf16_t* T1 = (bf16_t*)(ws + WS_T1); bf16_t* PROJ = (bf16_t*)(ws + WS_PROJ);

    p0_prologue(P, lds);
    xcd_barrier(xbar);
    { pg8::Gemm g{(const bf16_t*)(ws + WS_AC), (const bf16_t*)(ws + WS_ADAT), 256, NMOD, D}; pg8::StaticOrder S; S.init(256, NMOD, G, bx);
      EpiMod E{(float*)(ws + WS_MOD), P.in[8]};
      pg8::gemm_phase<EpiMod, pg8::StaticOrder, true, true>(lds, g, S, E); }
    xcd_barrier(xbar);
    rowpass<0>(P, 0);
    xcd_barrier(xbar);
#pragma unroll 1
    for (int l = 0; l < DEPTH; ++l) {
        { pg8::Gemm g{HM, (const bf16_t*)(ws + WS_WIN) + (size_t)l * INW * D, MP, INW, D}; pg8::StaticOrder S; S.init(MP, INW, G, bx);
          pg8::EpiBf16<0> E{PROJ, INW, nullptr, 0, 0, 1.f};
          pg8::gemm_phase<pg8::EpiBf16<0>, pg8::StaticOrder, true, true>(lds, g, S, E); }
        xcd_barrier(xbar);
        for (int it = bx; it < 512 + 256 + 64 + 16; it += G) {
            if (it < 512) ret_u_item(P, lds, it);
            else if (it < 768) conv_item(P, lds, l, it - 512);
            else if (it < 832) sample_ret(P, l, it - 768);
            else sample_conv(P, l, it - 832);
        }
        xcd_barrier(xbar);
        for (int it = bx; it < 512; it += G) ret_o_item(P, lds, l, it);
        xcd_barrier(xbar);
        { pg8::Gemm g{HM, (const bf16_t*)(ws + WS_WOUT) + (size_t)l * D * D, NP, D, D}; pg8::StaticOrder S; S.init(NP, D, G, bx);
          pg8::EpiBf16<0> E{T1, D, nullptr, 0, 0, 1.f};
          pg8::gemm_phase<pg8::EpiBf16<0>, pg8::StaticOrder, true, true>(lds, g, S, E); }
        skinny_gemm(HM, (const bf16_t*)(ws + WS_WOUT) + (size_t)l * D * D, D, T1);
        xcd_barrier(xbar);
        rowpass<1>(P, l);
        xcd_barrier(xbar);
        { pg8::Gemm g{HM, (const bf16_t*)(ws + WS_W13) + (size_t)l * NFF1 * D, MP, NFF1, D}; pg8::StaticOrder S; S.init(MP, NFF1, G, bx);
          EpiSwiGLU E{PROJ};
          pg8::gemm_phase<EpiSwiGLU, pg8::StaticOrder, true, true>(lds, g, S, E); }
        xcd_barrier(xbar);
        { pg8::Gemm g{PROJ, (const bf16_t*)(ws + WS_W2) + (size_t)l * D * DFF, NP, D, DFF}; pg8::StaticOrder S; S.init(NP, D, G, bx);
          pg8::EpiBf16<0> E{T1, D, nullptr, 0, 0, 1.f};
          pg8::gemm_phase<pg8::EpiBf16<0>, pg8::StaticOrder, true, true>(lds, g, S, E); }
        skinny_gemm(PROJ, (const bf16_t*)(ws + WS_W2) + (size_t)l * D * DFF, DFF, T1);
        xcd_barrier(xbar);
        rowpass<2>(P, l);
        if (l + 1 < DEPTH) xcd_barrier(xbar);
    }
}
}

extern "C" void kernel_launch(void* const* d_in, const int* in_sizes, int n_in, void* d_out, int out_size, void* d_ws, size_t ws_size, hipStream_t stream) {
    static int grid = 0;
    if (grid == 0) {
        if (n_in != 24 || (size_t)out_size != mk::O_END || ws_size < mk::WS_END) { fprintf(stderr, "kernel_launch: unexpected shapes: n_in %d out %d ws %zu\n", n_in, out_size, ws_size); grid = -1; return; }
        int dev = 0, cus = 0, per_cu = 0;
        hipGetDevice(&dev); hipDeviceGetAttribute(&cus, hipDeviceAttributeMultiprocessorCount, dev);
        hipFuncSetAttribute((const void*)mk::mk_fwd, hipFuncAttributeMaxDynamicSharedMemorySize, mk::LDS_BYTES);
        hipOccupancyMaxActiveBlocksPerMultiprocessor(&per_cu, (const void*)mk::mk_fwd, mk::NTHREADS, mk::LDS_BYTES);
        (void)hipGetLastError();
        if (per_cu < 1) { fprintf(stderr, "kernel_launch: occupancy query says %d blocks per CU\n", per_cu); per_cu = 1; }
        grid = cus;
    }
    if (grid < 0) return;
    if (hipMemsetAsync((char*)d_ws + mk::WS_CTL, 0, mk::CTL_ZERO_BYTES, stream) != hipSuccess) { fprintf(stderr, "kernel_launch: memset failed\n"); return; }
    mk::Params p{};
    for (int i = 0; i < 24; ++i) p.in[i] = (const float*)d_in[i];
    p.out = (float*)d_out; p.ws = (unsigned char*)d_ws;
    void* args[] = {&p};
    hipError_t e = hipLaunchCooperativeKernel((const void*)mk::mk_fwd, dim3(grid), dim3(mk::NTHREADS), args, mk::LDS_BYTES, stream);
    if (e != hipSuccess) fprintf(stderr, "kernel_launch: cooperative launch failed: %s (grid %d)\n", hipGetErrorString(e), grid);
}
```

```cpp
#include <hip/hip_runtime.h>
#include <cstdio>
#include <cstdint>
namespace pg8 {
#define PG8_LAS __attribute__((address_space(3)))
typedef unsigned short bf16_t;
typedef short bf16x8 __attribute__((ext_vector_type(8)));
typedef float f32x4 __attribute__((ext_vector_type(4)));
typedef unsigned u32x4 __attribute__((ext_vector_type(4)));
constexpr int BM = 256, BK = 64, HALF = 128, HTB = HALF * BK * 2  , STAGE_BYTES = 8 * HTB, NXCD = 8, WGM = 8;

__host__ __device__ __forceinline__ int lds_byte(int r, int c) { const int st = (r >> 4) * 2 + (c >> 5), rr = r & 15, cc = c & 31, ob = rr * 64 + cc * 2; return st * 1024 + (ob ^ (((ob >> 9) & 1) << 5)); }
__host__ __device__ __forceinline__ void stage_rc(int b, int& R, int& C) { const int st = b / 1024, sb = b % 1024, swz = sb ^ (((sb >> 9) & 1) << 5); R = (st >> 1) * 16 + swz / 64; C = (st & 1) * 32 + (swz % 64) / 2; }
__host__ __device__ __forceinline__ int perm32(int rho) { const int n = rho >> 4, i = rho & 15; return 8 * (i >> 2) + 4 * n + (i & 3); }

struct Unit { int pm, pn; };
struct Gemm { const bf16_t* A; const bf16_t* Bt; int M, N, K; };

struct StaticOrder {
    int nM, nN, nwg, G, c;
    __host__ __device__ void init(int M, int N, int G_, int c_) { nM = M / BM; nN = N / BM; nwg = nM * nN; G = G_; c = c_; }
    __host__ __device__ bool next(int i, Unit& u) const {
        const long L = (long)i * G + c; if (L >= nwg) return false;
        int wgid = (int)L; { const int q = nwg / NXCD, r = nwg % NXCD, xcd = wgid % NXCD, off = wgid / NXCD; wgid = (xcd < r ? xcd * (q + 1) : r * (q + 1) + (xcd - r) * q) + off; }
        const int nig = WGM * nN, gid = wgid / nig, fm = gid * WGM, gsz = (nM - fm) < WGM ? (nM - fm) : WGM;
        u.pm = fm + ((wgid % nig) % gsz); u.pn = (wgid % nig) / gsz; return true;
    }
    __device__ __forceinline__ void a_ready(const Unit&) const {}
    __device__ __forceinline__ void done(const Unit&) const {}
};

__device__ __forceinline__ unsigned cvt_pk_bf16(float lo, float hi) { unsigned r; asm volatile("v_cvt_pk_bf16_f32 %0, %1, %2" : "=v"(r) : "v"(lo), "v"(hi)); return r; }
typedef float f32x2 __attribute__((ext_vector_type(2)));
__device__ __forceinline__ f32x2 gelu_pk(f32x2 v) {
    const f32x2 av = __builtin_elementwise_abs(v), d = av * 0.2316418882f + 1.0f;
    f32x2 t; t.x = __builtin_amdgcn_rcpf(d.x); t.y = __builtin_amdgcn_rcpf(d.y);
    f32x2 q = t * 0.5307027145f + (-0.7265760135f); q = q * t + 0.7107068705f; q = q * t + (-0.142248368f); q = q * t + 0.127414796f; q = q * t;
    const f32x2 s = (v * v) * (-0.72134752044f);
    f32x2 e; e.x = __builtin_amdgcn_exp2f(s.x); e.y = __builtin_amdgcn_exp2f(s.y);
    const f32x2 m = v * (q * e), r = v - m;
    f32x2 o; o.x = v.x < 0.f ? m.x : r.x; o.y = v.y < 0.f ? m.y : r.y; return o;
}

template <int ACT  > struct EpiBf16 {
    static constexpr bool PERM = true, AFTER_DRAIN = false; static_assert(ACT == 0 || ACT == 1, "EpiBf16: ACT is 0 (none) or 1 (gelu_pk)");
    bf16_t* O; int ldc; const float* bias; int split_cols; size_t split_stride; float scale0;
    __device__ __forceinline__ void operator()(const f32x4 (&acc)[2][2][4][2], const Unit& u, int wr, int wc, int fr, int fq) const {
        const int row0 = u.pm * BM + wr * 64 + fr; int colt = u.pn * BM; bf16_t* base = O;
        float sc = 1.f; if (split_cols) { const int t = colt / split_cols; base += (size_t)t * split_stride; colt -= t * split_cols; if (t == 0) sc = scale0; }
        const int col0 = colt + wc * 32 + 8 * fq, bcol0 = u.pn * BM + wc * 32 + 8 * fq;
        f32x4 bv[2][2];
#pragma unroll
        for (int bj = 0; bj < 2; ++bj)
#pragma unroll
            for (int n = 0; n < 2; ++n) bv[bj][n] = bias ? *(const f32x4*)(bias + bcol0 + bj * HALF + 4 * n) : (f32x4){0.f, 0.f, 0.f, 0.f};
#pragma unroll
        for (int ai = 0; ai < 2; ++ai)
#pragma unroll
            for (int m = 0; m < 4; ++m) { bf16_t* rowp = base + (size_t)(row0 + ai * HALF + m * 16) * ldc + col0;
#pragma unroll
                for (int bj = 0; bj < 2; ++bj) { f32x4 v0 = acc[ai][bj][m][0] + bv[bj][0], v1 = acc[ai][bj][m][1] + bv[bj][1];
                    if (ACT == 1) { f32x2 a = gelu_pk((f32x2){v0[0], v0[1]}), b = gelu_pk((f32x2){v0[2], v0[3]}), c = gelu_pk((f32x2){v1[0], v1[1]}), d = gelu_pk((f32x2){v1[2], v1[3]});
                        v0 = (f32x4){a.x, a.y, b.x, b.y}; v1 = (f32x4){c.x, c.y, d.x, d.y}; }
                    v0 = v0 * sc; v1 = v1 * sc; u32x4 w; w.x = cvt_pk_bf16(v0[0], v0[1]); w.y = cvt_pk_bf16(v0[2], v0[3]); w.z = cvt_pk_bf16(v1[0], v1[1]); w.w = cvt_pk_bf16(v1[2], v1[3]);
                    *(u32x4*)(rowp + bj * HALF) = w; } }
    }
};

struct PanelStats {
    unsigned* xbuf;
    unsigned* cnt;
    unsigned* tmo;
    int ntn; float eps;
    unsigned code;
    __device__ __forceinline__ bool run(const f32x4 (&v)[2][2][4][2], const Unit& u, int wr, int wc, int fr, int fq, PG8_LAS unsigned char* lds, int wid, int lane) const {
        typedef float f32x2v __attribute__((ext_vector_type(2)));
        PG8_LAS f32x2v* P = (PG8_LAS f32x2v*)lds;
        PG8_LAS f32x2v* S = (PG8_LAS f32x2v*)(lds + 8192);
        PG8_LAS unsigned* flag = (PG8_LAS unsigned*)(lds + 8192 + 2048);
#pragma unroll
        for (int ai = 0; ai < 2; ++ai)
#pragma unroll
            for (int m = 0; m < 4; ++m) {
                float s = 0.f;
#pragma unroll
                for (int bj = 0; bj < 2; ++bj)
#pragma unroll
                    for (int n = 0; n < 2; ++n) { const f32x4 x = v[ai][bj][m][n]; s += (x[0] + x[1]) + (x[2] + x[3]); }
                s += __shfl_xor(s, 16); s += __shfl_xor(s, 32);
                const float mw = s * (1.0f / 64.0f); float q = 0.f;
#pragma unroll
                for (int bj = 0; bj < 2; ++bj)
#pragma unroll
                    for (int n = 0; n < 2; ++n) { const f32x4 d = v[ai][bj][m][n] - mw; q += (d[0] * d[0] + d[1] * d[1]) + (d[2] * d[2] + d[3] * d[3]); }
                q += __shfl_xor(q, 16); q += __shfl_xor(q, 32);
                if (fq == 0) P[(ai * HALF + wr * 64 + m * 16 + fr) * 4 + wc] = (f32x2v){mw, q};
            }
        asm volatile("s_waitcnt lgkmcnt(0)" ::: "memory"); __builtin_amdgcn_s_barrier(); asm volatile("" ::: "memory");
#if defined(BROKEN_EXCHANGE_NO_WAIT)
#warning BROKEN CONTROL BUILD: the row-statistics exchange does not wait; results are wrong by design
        if (blockIdx.x >= 64) { const long long t0_ = clock64(); while (clock64() - t0_ < 60000) __builtin_amdgcn_s_sleep(8); }
#endif
        const int row = wid * 32 + (lane & 31);
        if (lane < 32) {
            const f32x2v a = P[row * 4 + 0], b = P[row * 4 + 1], c = P[row * 4 + 2], d = P[row * 4 + 3];
            const float mt = (a.x + b.x + c.x + d.x) * 0.25f;
            const float da = a.x - mt, db = b.x - mt, dc = c.x - mt, dd = d.x - mt;
            const float m2 = (a.y + b.y) + (c.y + d.y) + 64.0f * ((da * da + db * db) + (dc * dc + dd * dd));
            unsigned long long* slot = (unsigned long long*)xbuf + ((size_t)(u.pm * BM + row) * 4 + u.pn);
            __hip_atomic_store(slot, ((unsigned long long)__float_as_uint(m2) << 32) | __float_as_uint(mt), __ATOMIC_RELAXED, __HIP_MEMORY_SCOPE_AGENT);
        }
        asm volatile("s_waitcnt vmcnt(0)" ::: "memory");
        if (lane == 0) __hip_atomic_fetch_add(cnt + 64 * u.pm, 1u, __ATOMIC_RELAXED, __HIP_MEMORY_SCOPE_AGENT);
        if (wid == 0) {
            bool dead = false; const unsigned long long t0 = __builtin_amdgcn_s_memrealtime(); const unsigned want = 8u * (unsigned)ntn;
            for (;;) {
#if defined(BROKEN_EXCHANGE_NO_WAIT)
                break;
#endif
                if ((unsigned)__builtin_amdgcn_readfirstlane(__hip_atomic_load(cnt + 64 * u.pm, __ATOMIC_RELAXED, __HIP_MEMORY_SCOPE_AGENT)) >= want) break;
                if (__builtin_amdgcn_s_memrealtime() - t0 > 2000000ull) {
                    if (lane == 0) { unsigned expect = 0u; __hip_atomic_compare_exchange_strong(tmo + 1, &expect, code | (unsigned)(u.pm & 0xff), __ATOMIC_RELAXED, __ATOMIC_RELAXED, __HIP_MEMORY_SCOPE_AGENT);
                                     __hip_atomic_store(tmo, 1u, __ATOMIC_RELAXED, __HIP_MEMORY_SCOPE_AGENT); }
                    dead = true; break; }
                __builtin_amdgcn_s_sleep(2);
            }
            __builtin_amdgcn_fence(__ATOMIC_ACQUIRE, "agent");
            if (lane == 0) flag[0] = dead ? 1u : 0u;
        }
        asm volatile("s_waitcnt vmcnt(0) lgkmcnt(0)" ::: "memory"); __builtin_amdgcn_s_barrier(); asm volatile("" ::: "memory");
        const bool bad = flag[0] != 0u;
        if (lane < 32) {
            const unsigned long long* slot = (const unsigned long long*)xbuf + (size_t)(u.pm * BM + row) * 4; float mt[4], m2[4]; float ms = 0.f;
#pragma unroll
            for (int t = 0; t < 4; ++t) { if (t < ntn) { const unsigned long long w = __hip_atomic_load(slot + t, __ATOMIC_RELAXED, __HIP_MEMORY_SCOPE_AGENT); mt[t] = __uint_as_float((unsigned)w); m2[t] = __uint_as_float((unsigned)(w >> 32)); } else { mt[t] = 0.f; m2[t] = 0.f; } ms += mt[t]; }
            const float mean = ms / (float)ntn; float q = 0.f;
#pragma unroll
            for (int t = 0; t < 4; ++t) if (t < ntn) { const float dm = mt[t] - mean; q += m2[t] + 256.0f * dm * dm; }
            S[row] = (f32x2v){mean, 1.0f / sqrtf(q / (256.0f * (float)ntn) + eps)};
        }
        asm volatile("s_waitcnt lgkmcnt(0)" ::: "memory"); __builtin_amdgcn_s_barrier(); asm volatile("" ::: "memory");
        return bad;
    }
};
struct EpiLnRes {
    static constexpr bool PERM = false, AFTER_DRAIN = true;
    const float* base; float* out; int ldc; const float* bias; PanelStats st; unsigned poison;
    __device__ __forceinline__ void fused(f32x4 (&acc)[2][2][4][2], const Unit& u, int wr, int wc, int fr, int fq, PG8_LAS unsigned char* lds, int wid, int lane) const {
        typedef float f32x2v __attribute__((ext_vector_type(2)));
        const PG8_LAS f32x2v* S = (const PG8_LAS f32x2v*)(lds + 8192);
        const int col0 = u.pn * BM + wc * 32 + 4 * fq;
#pragma unroll
        for (int bj = 0; bj < 2; ++bj)
#pragma unroll
            for (int n = 0; n < 2; ++n) { const f32x4 bv = bias ? *(const f32x4*)(bias + col0 + bj * HALF + n * 16) : (f32x4){0.f, 0.f, 0.f, 0.f};
#pragma unroll
                for (int ai = 0; ai < 2; ++ai)
#pragma unroll
                    for (int m = 0; m < 4; ++m) acc[ai][bj][m][n] += bv; }
        f32x4 pre[4][2][2];
#pragma unroll
        for (int m = 0; m < 4; ++m) { const size_t off = (size_t)(u.pm * BM + wr * 64 + m * 16 + fr) * ldc + col0;
#pragma unroll
            for (int bj = 0; bj < 2; ++bj)
#pragma unroll
                for (int n = 0; n < 2; ++n) pre[m][bj][n] = *(const f32x4*)(base + off + bj * HALF + n * 16); }
        const bool bad = st.run(acc, u, wr, wc, fr, fq, lds, wid, lane) || poison != 0u;
        const float qnan = __builtin_nanf("");
#pragma unroll
        for (int ai = 0; ai < 2; ++ai)
#pragma unroll
            for (int m = 0; m < 4; ++m) { const int r = ai * HALF + wr * 64 + m * 16 + fr; const f32x2v sr = S[r]; const size_t off = (size_t)(u.pm * BM + r) * ldc + col0;
#pragma unroll
                for (int bj = 0; bj < 2; ++bj)
#pragma unroll
                    for (int n = 0; n < 2; ++n) { const f32x4 bs = ai == 0 ? pre[m][bj][n] : *(const f32x4*)(base + off + bj * HALF + n * 16); f32x4 o = bs + (acc[ai][bj][m][n] - sr.x) * sr.y;
                        if (bad) o = (f32x4){qnan, qnan, qnan, qnan}; *(f32x4*)(out + off + bj * HALF + n * 16) = o; }
                if (m & 1) asm volatile("" ::: "memory"); }
    }
};
struct EpiLnResLn {
    static constexpr bool PERM = false, AFTER_DRAIN = true;
    const float* base; float* out; bf16_t* xn; int ldc; const float* bias; PanelStats st1, st2; unsigned poison;
    __device__ __forceinline__ void fused(f32x4 (&acc)[2][2][4][2], const Unit& u, int wr, int wc, int fr, int fq, PG8_LAS unsigned char* lds, int wid, int lane) const {
        typedef float f32x2v __attribute__((ext_vector_type(2))); typedef unsigned u32x2v __attribute__((ext_vector_type(2)));
        const PG8_LAS f32x2v* S = (const PG8_LAS f32x2v*)(lds + 8192);
        const int col0 = u.pn * BM + wc * 32 + 4 * fq;
#pragma unroll
        for (int bj = 0; bj < 2; ++bj)
#pragma unroll
            for (int n = 0; n < 2; ++n) { const f32x4 bv = bias ? *(const f32x4*)(bias + col0 + bj * HALF + n * 16) : (f32x4){0.f, 0.f, 0.f, 0.f};
#pragma unroll
                for (int ai = 0; ai < 2; ++ai)
#pragma unroll
                    for (int m = 0; m < 4; ++m) acc[ai][bj][m][n] += bv; }
        bool bad = st1.run(acc, u, wr, wc, fr, fq, lds, wid, lane) || poison != 0u;
        const float qnan = __builtin_nanf("");
#pragma unroll
        for (int ai = 0; ai < 2; ++ai)
#pragma unroll
            for (int m = 0; m < 4; ++m) { const int r = ai * HALF + wr * 64 + m * 16 + fr; const f32x2v sr = S[r]; const size_t off = (size_t)(u.pm * BM + r) * ldc + col0;
#pragma unroll
                for (int bj = 0; bj < 2; ++bj)
#pragma unroll
                    for (int n = 0; n < 2; ++n) { const f32x4 bs = *(const f32x4*)(base + off + bj * HALF + n * 16); acc[ai][bj][m][n] = bs + (acc[ai][bj][m][n] - sr.x) * sr.y; }
                asm volatile("" : "+v"(acc[ai][0][m][0]), "+v"(acc[ai][0][m][1]), "+v"(acc[ai][1][m][0]), "+v"(acc[ai][1][m][1]));
                if (m & 1) asm volatile("" ::: "memory"); }
        const bool bad1 = bad;
        bad = st2.run(acc, u, wr, wc, fr, fq, lds, wid, lane) || bad;
#pragma unroll
        for (int ai = 0; ai < 2; ++ai)
#pragma unroll
            for (int m = 0; m < 4; ++m) { const int r = ai * HALF + wr * 64 + m * 16 + fr; const f32x2v sr = S[r]; const size_t off = (size_t)(u.pm * BM + r) * ldc + col0;
#pragma unroll
                for (int bj = 0; bj < 2; ++bj)
#pragma unroll
                    for (int n = 0; n < 2; ++n) { const f32x4 x1 = acc[ai][bj][m][n]; *(f32x4*)(out + off + bj * HALF + n * 16) = bad1 ? (f32x4){qnan, qnan, qnan, qnan} : x1;
                        const f32x4 o = (x1 - sr.x) * sr.y; u32x2v w; w.x = cvt_pk_bf16(o[0], o[1]); w.y = cvt_pk_bf16(o[2], o[3]);
                        if (bad) { w.x = 0x7fc07fc0u; w.y = 0x7fc07fc0u; } *(u32x2v*)(xn + off + bj * HALF + n * 16) = w; }
                asm volatile("" ::: "memory"); }
    }
};

template <class Epi, class Sched, bool ALIGN_EPI = false, bool SP2 = false>
__device__ __forceinline__ void gemm_phase(PG8_LAS unsigned char* lds, const Gemm g, const Sched& S, const Epi& E) {
    int tid_ = threadIdx.x; asm volatile("" : "+v"(tid_));
    const int tid = tid_, wid = __builtin_amdgcn_readfirstlane(tid >> 6), lane = tid & 63, wr = wid >> 2, wc = wid & 3, fr = lane & 15, fq = lane >> 4;
    const int K = g.K, nt = K / BK;
    unsigned voffA[2], voffB[2];
#pragma unroll
    for (int i = 0; i < 2; ++i) { int R, C; stage_rc(tid * 16 + i * 8192, R, C); const int Rb = Epi::PERM ? ((R & ~31) + perm32(R & 31)) : R;
        voffA[i] = (unsigned)(R * K + C) * 2u; voffB[i] = (unsigned)(Rb * K + C) * 2u; }
    const size_t kstep = (size_t)(BK * 2);
    const size_t hstep = (size_t)HALF * K * 2;
    const size_t tstep = 2 * hstep;
    const unsigned ldsw = (unsigned)wid * 1024u;
    const int aoff = lds_byte(wr * 64 + fr, fq * 8), boff = lds_byte(wc * 32 + fr, fq * 8);
#define PG8_SA(b, h) (((b) * 2 + (h)) * HTB)
#define PG8_SB(b, h) ((4 + (b) * 2 + (h)) * HTB)
#define PG8_STAGE(bufoff, gbase, voff) do { _Pragma("unroll") for (int _i = 0; _i < 2; ++_i) \
        __builtin_amdgcn_global_load_lds((const unsigned*)((const char*)(gbase) + (voff)[_i]), (PG8_LAS unsigned*)(lds + (bufoff) + ldsw + _i * 8192), 16, 0, 0); } while (0)
#define PG8_LDA(dst, b, h) do { _Pragma("unroll") for (int m = 0; m < 4; ++m) _Pragma("unroll") for (int k = 0; k < 2; ++k) dst[m][k] = *(const PG8_LAS bf16x8*)(lds + PG8_SA(b, h) + aoff + m * 2048 + k * 1024); } while (0)
#define PG8_LDB(dst, b, h) do { _Pragma("unroll") for (int n = 0; n < 2; ++n) _Pragma("unroll") for (int k = 0; k < 2; ++k) dst[n][k] = *(const PG8_LAS bf16x8*)(lds + PG8_SB(b, h) + boff + n * 2048 + k * 1024); } while (0)
#define PG8_MMA(ai, bj, At, Bt) do { __builtin_amdgcn_s_setprio(1); _Pragma("unroll") for (int m = 0; m < 4; ++m) _Pragma("unroll") for (int n = 0; n < 2; ++n) _Pragma("unroll") for (int k = 0; k < 2; ++k) \
        acc[ai][bj][m][n] = __builtin_amdgcn_mfma_f32_16x16x32_bf16(Bt[n][k], At[m][k], acc[ai][bj][m][n], 0, 0, 0); __builtin_amdgcn_s_setprio(0); } while (0)
#define PG8_WAIT_V(n) asm volatile("s_waitcnt vmcnt(" #n ")" ::: "memory")
#define PG8_WAIT_L(n) asm volatile("s_waitcnt lgkmcnt(" #n ")" ::: "memory")
#define PG8_BAR __builtin_amdgcn_s_barrier()
#define PG8_SCHED __builtin_amdgcn_sched_barrier(0)
    Unit cur, nxt; int ui = 0;
    if (!S.next(0, cur)) return;
    f32x4 acc[2][2][4][2];
#pragma unroll
    for (int a = 0; a < 2; ++a)
#pragma unroll
        for (int b = 0; b < 2; ++b)
#pragma unroll
            for (int m = 0; m < 4; ++m)
#pragma unroll
                for (int n = 0; n < 2; ++n) acc[a][b][m][n] = (f32x4){0.f, 0.f, 0.f, 0.f};
    bf16x8 At[4][2], B0[2][2], B1[2][2];
    const char* cA = (const char*)g.A + (size_t)cur.pm * tstep; const char* cB = (const char*)g.Bt + (size_t)cur.pn * tstep;
    S.a_ready(cur);
    if constexpr (SP2) {
        PG8_STAGE(PG8_SB(0, 0), cB, voffB); PG8_STAGE(PG8_SB(0, 1), cB + hstep, voffB); PG8_STAGE(PG8_SA(0, 0), cA, voffA); PG8_STAGE(PG8_SA(0, 1), cA + hstep, voffA);
        if (wr == 1) PG8_BAR;
        PG8_WAIT_V(2); PG8_BAR;
        PG8_STAGE(PG8_SB(1, 0), cB + kstep, voffB); PG8_STAGE(PG8_SA(1, 0), cA + kstep, voffA); PG8_STAGE(PG8_SB(1, 1), cB + hstep + kstep, voffB);
        PG8_WAIT_V(6); PG8_BAR;
    } else {
        PG8_STAGE(PG8_SB(0, 0), cB, voffB); PG8_STAGE(PG8_SA(0, 0), cA, voffA); PG8_STAGE(PG8_SB(0, 1), cB + hstep, voffB); PG8_STAGE(PG8_SA(0, 1), cA + hstep, voffA);
        if (wr == 1) PG8_BAR;
        PG8_WAIT_V(4); PG8_BAR;
        PG8_STAGE(PG8_SB(1, 0), cB + kstep, voffB); PG8_STAGE(PG8_SA(1, 0), cA + kstep, voffA); PG8_STAGE(PG8_SB(1, 1), cB + hstep + kstep, voffB);
        PG8_WAIT_V(6); PG8_BAR;
    }
    for (;;) {
        const bool has_next = S.next(ui + 1, nxt);
        const char* nA = has_next ? (const char*)g.A + (size_t)nxt.pm * tstep : cA; const char* nB = has_next ? (const char*)g.Bt + (size_t)nxt.pn * tstep : cB;
        for (int t = 0; t < nt; t += 2) {
            const bool last = (t == nt - 2);
            const char* a1 = cA + (size_t)(t + 1) * kstep;
            const char* a2 = last ? nA : cA + (size_t)(t + 2) * kstep; const char* b2 = last ? nB : cB + (size_t)(t + 2) * kstep;
            const char* a3 = a2 + kstep; const char* b3 = b2 + kstep;
            if (last && has_next) S.a_ready(nxt);
            if constexpr (SP2) {
            PG8_LDB(B0, 0, 0); PG8_LDB(B1, 0, 1); PG8_SCHED; PG8_LDA(At, 0, 0); PG8_STAGE(PG8_SA(1, 1), a1 + hstep, voffA);
            PG8_WAIT_V(8); PG8_WAIT_L(0); PG8_BAR; PG8_MMA(0, 0, At, B0); PG8_MMA(0, 1, At, B1); PG8_BAR; PG8_SCHED;
            PG8_LDA(At, 0, 1); PG8_STAGE(PG8_SB(0, 0), b2, voffB); PG8_STAGE(PG8_SB(0, 1), b2 + hstep, voffB); PG8_STAGE(PG8_SA(0, 0), a2, voffA);
            PG8_WAIT_V(8); PG8_WAIT_L(0); PG8_BAR; PG8_MMA(1, 0, At, B0); PG8_MMA(1, 1, At, B1); PG8_BAR; PG8_SCHED;
            PG8_LDB(B0, 1, 0); PG8_LDB(B1, 1, 1); PG8_SCHED; PG8_LDA(At, 1, 0); PG8_STAGE(PG8_SA(0, 1), a2 + hstep, voffA);
            PG8_WAIT_V(8); PG8_WAIT_L(0); PG8_BAR; PG8_MMA(0, 0, At, B0); PG8_MMA(0, 1, At, B1); PG8_BAR; PG8_SCHED;
            PG8_LDA(At, 1, 1); PG8_STAGE(PG8_SB(1, 0), b3, voffB); PG8_STAGE(PG8_SB(1, 1), b3 + hstep, voffB); PG8_STAGE(PG8_SA(1, 0), a3, voffA);
            PG8_WAIT_V(8); PG8_WAIT_L(0); PG8_BAR; PG8_MMA(1, 0, At, B0); PG8_MMA(1, 1, At, B1); PG8_BAR; PG8_SCHED;
            } else {
            PG8_LDB(B0, 0, 0); PG8_SCHED; PG8_LDA(At, 0, 0); PG8_STAGE(PG8_SA(1, 1), a1 + hstep, voffA);
            PG8_WAIT_L(8); PG8_BAR; PG8_WAIT_L(0); PG8_MMA(0, 0, At, B0); PG8_BAR; PG8_SCHED;
            PG8_LDB(B1, 0, 1); PG8_STAGE(PG8_SB(0, 0), b2, voffB);
            PG8_BAR; PG8_WAIT_L(0); PG8_MMA(0, 1, At, B1); PG8_BAR;
            PG8_LDA(At, 0, 1); PG8_STAGE(PG8_SA(0, 0), a2, voffA);
            PG8_BAR; PG8_WAIT_L(0); PG8_MMA(1, 0, At, B0); PG8_BAR; PG8_SCHED;
            PG8_STAGE(PG8_SB(0, 1), b2 + hstep, voffB);
            PG8_WAIT_V(6); PG8_BAR; PG8_MMA(1, 1, At, B1); PG8_BAR;
            PG8_LDB(B0, 1, 0); PG8_SCHED; PG8_LDA(At, 1, 0); PG8_STAGE(PG8_SA(0, 1), a2 + hstep, voffA);
            PG8_WAIT_L(8); PG8_BAR; PG8_WAIT_L(0); PG8_MMA(0, 0, At, B0); PG8_BAR; PG8_SCHED;
            PG8_LDB(B1, 1, 1); PG8_STAGE(PG8_SB(1, 0), b3, voffB);
            PG8_BAR; PG8_WAIT_L(0); PG8_MMA(0, 1, At, B1); PG8_BAR;
            PG8_LDA(At, 1, 1); PG8_STAGE(PG8_SA(1, 0), a3, voffA);
            PG8_BAR; PG8_WAIT_L(0); PG8_MMA(1, 0, At, B0); PG8_BAR; PG8_SCHED;
            PG8_STAGE(PG8_SB(1, 1), b3 + hstep, voffB);
            PG8_WAIT_V(6); PG8_BAR; PG8_MMA(1, 1, At, B1); PG8_BAR;
            }
        }
        if constexpr (ALIGN_EPI) { if (wr == 0) PG8_BAR; }
        if constexpr (!Epi::AFTER_DRAIN) { E(acc, cur, wr, wc, fr, fq); S.done(cur); }
        if (!has_next) break;
#pragma unroll
        for (int a = 0; a < 2; ++a)
#pragma unroll
            for (int b = 0; b < 2; ++b)
#pragma unroll
                for (int m = 0; m < 4; ++m)
#pragma unroll
                    for (int n = 0; n < 2; ++n) acc[a][b][m][n] = (f32x4){0.f, 0.f, 0.f, 0.f};
        cur = nxt; cA = nA; cB = nB; ++ui;
        if constexpr (ALIGN_EPI) { if (wr == 1) PG8_BAR; }
    }
    PG8_WAIT_V(0);
    if constexpr (!ALIGN_EPI) { if (wr == 0) PG8_BAR; }
    PG8_BAR;
    if constexpr (Epi::AFTER_DRAIN) { E.fused(acc, cur, wr, wc, fr, fq, lds, wid, lane); S.done(cur); }
#undef PG8_SA
#undef PG8_SB
#undef PG8_STAGE
#undef PG8_LDA
#undef PG8_LDB
#undef PG8_MMA
#undef PG8_WAIT_V
#undef PG8_WAIT_L
#undef PG8_BAR
#undef PG8_SCHED
}
}

#include <hip/hip_cooperative_groups.h>
namespace cg = cooperative_groups;
namespace mk {
using pg8::bf16_t; using pg8::bf16x8; using pg8::f32x4; using pg8::u32x4;
#define MK_LAS __attribute__((address_space(3)))
typedef unsigned u32x2 __attribute__((ext_vector_type(2)));
typedef float f32x2v __attribute__((ext_vector_type(2)));

#define LAS MK_LAS
#define XB_TMO      128
#define XB_XCNT(j)  (256  + 64 * (j))
#define XB_XSUB(j)  (1280 + 64 * (j))
#define XB_XGEN(j)  (2304 + 64 * (j))
#define XB_TOP      3328
#define XB_TOPGEN   3392
#define XCD_BAR_WORDS 3456
#define XB_SPIN_CAP (1u << 18)

__device__ __forceinline__ unsigned xb_ld(unsigned* p)              { return __hip_atomic_load(p, __ATOMIC_RELAXED, __HIP_MEMORY_SCOPE_AGENT); }
__device__ __forceinline__ unsigned xb_add(unsigned* p, unsigned v) { return __hip_atomic_fetch_add(p, v, __ATOMIC_RELAXED, __HIP_MEMORY_SCOPE_AGENT); }
__device__ __forceinline__ unsigned xb_xcc_id() { return (unsigned)__builtin_amdgcn_s_getreg((3 << 11) | 20) & 0xFu; }
#define XB_SPIN(cond, bar) do { unsigned _sp = 0; while (cond) { __builtin_amdgcn_s_sleep(1); \
    if ((++_sp & 255u) == 0u) { if (xb_ld(&(bar)[XB_TMO])) break; if (_sp > XB_SPIN_CAP) { atomicAdd(&(bar)[XB_TMO], 1u); break; } } } } while (0)

struct XcdBarrier {
    unsigned* bar; unsigned x;
    volatile LAS unsigned* st;
};

__device__ __forceinline__ XcdBarrier xcd_barrier_post(unsigned* bar, volatile LAS unsigned* st) {
    XcdBarrier b; b.bar = bar; b.x = xb_xcc_id(); b.st = st;
    if (threadIdx.x == 0) (void)xb_add(&bar[XB_XCNT(b.x)], 1u);
    return b;
}
__device__ __forceinline__ void xcd_barrier_complete(unsigned* bar, unsigned x, unsigned& nloc, unsigned& nx) {
    const unsigned G = gridDim.x * gridDim.y * gridDim.z;
    unsigned sum, cnt, mine, sp = 0u;
    for (;;) {
        sum = 0u; cnt = 0u; mine = 0u;
#pragma unroll
        for (unsigned j = 0; j < 16; ++j) { const unsigned c = xb_ld(&bar[XB_XCNT(j)]); sum += c; cnt += (c > 0u) ? 1u : 0u; mine = (j == x) ? c : mine; }
        if (sum == G) break;
        __builtin_amdgcn_s_sleep(1);
        if ((++sp & 255u) == 0u) { if (xb_ld(&bar[XB_TMO])) break; if (sp > XB_SPIN_CAP) { atomicAdd(&bar[XB_TMO], 1u); break; } }
    }
    nloc = mine > 0u ? mine : 1u; nx = cnt > 0u ? cnt : 1u;
}

__device__ __forceinline__ void xcd_barrier(const XcdBarrier& b) {
    asm volatile("s_waitcnt vmcnt(0)" ::: "memory");
    __syncthreads();
    if (threadIdx.x == 0) {
        unsigned* bar = b.bar;
        __builtin_amdgcn_s_waitcnt(0);
        unsigned nloc = b.st[0], nx = b.st[1];
        if (nloc == 0u) { xcd_barrier_complete(bar, b.x, nloc, nx); b.st[0] = nloc; b.st[1] = nx; }
        const unsigned old = xb_add(&bar[XB_XSUB(b.x)], 1u);
        const unsigned gen = old / nloc;
        if (old + 1u == (gen + 1u) * nloc) {
            __builtin_amdgcn_fence(__ATOMIC_RELEASE, "agent");
            asm volatile("s_waitcnt vmcnt(0)" ::: "memory");
            const unsigned og = xb_add(&bar[XB_TOP], 1u);
            const unsigned tg = og / nx;
            if (og + 1u == (tg + 1u) * nx) xb_add(&bar[XB_TOPGEN], 1u);
            else XB_SPIN(xb_ld(&bar[XB_TOPGEN]) == tg, bar);
            __builtin_amdgcn_fence(__ATOMIC_ACQUIRE, "agent");
            xb_add(&bar[XB_XGEN(b.x)], 1u);
            asm volatile("s_waitcnt vmcnt(0)" ::: "memory");
        } else {
            XB_SPIN(xb_ld(&bar[XB_XGEN(b.x)]) == gen, bar);
            __builtin_amdgcn_fence(__ATOMIC_ACQUIRE, "agent");
            asm volatile("s_waitcnt vmcnt(0)" ::: "memory");
        }
    }
    __syncthreads();
}

#undef LAS
constexpr int D = 1024, NP = 16384, NS = 128, MR = NP + NS, MP = 16640, SEQ = 2048, NB = 8;
constexpr int INW = 2816, DFF = 2816, NFF1 = 5632, NMOD = 12288, MODROWS = 136, DEPTH = 2;
constexpr float EPS = 1e-6f;
constexpr int NWAVES = 8, NTHREADS = 512;
#ifndef REP_P0
#define REP_P0 1
#endif
#ifndef REP_MIX
#define REP_MIX 1
#endif
#ifndef REP_R0
#define REP_R0 1
#endif
#ifndef REP_WIN
#define REP_WIN 1
#endif
#ifndef REP_F2
#define REP_F2 1
#endif
constexpr int LDS_BYTES = 147456;

constexpr int PQ = 0, PK = 256, PV = 512, PG = 1024, PAV = 1536, PAG = 1792, PCB = 2048, PCC = 2304, PCX = 2560;

constexpr size_t MiB = 1u << 20;
constexpr size_t WS_CTL = 0, CTL_ZERO_BYTES = 98304;
constexpr int LDS_CTL_OFF = 131072;
constexpr int CW_SAMPLE = 3840, CW_PANEL = 4096;
constexpr int CW_SCAN = 3584;
static_assert(XCD_BAR_WORDS <= CW_SCAN && (CW_SCAN + 64) * 4 <= CTL_ZERO_BYTES && (CW_PANEL + 4 * 4096) * 4 <= CTL_ZERO_BYTES, "ctl");
constexpr size_t WS_WIN = 1 * MiB, WS_WOUT = 12 * MiB, WS_W13 = 16 * MiB, WS_W2 = 38 * MiB, WS_MOD = 49 * MiB, WS_HM = 56 * MiB,
                 WS_T1 = 89 * MiB, WS_PROJ = 122 * MiB, WS_U = 212 * MiB, WS_SS = 228 * MiB, WS_X = 236 * MiB, WS_END = 240 * MiB;
constexpr size_t WS_ADAT = WS_T1, WS_AC = WS_T1 + 24 * MiB;
static_assert(WS_WIN + (size_t)DEPTH * INW * D * 2 <= WS_WOUT && WS_WOUT + (size_t)DEPTH * D * D * 2 <= WS_W13 && WS_W13 + (size_t)DEPTH * NFF1 * D * 2 <= WS_W2 &&
              WS_W2 + (size_t)DEPTH * D * DFF * 2 <= WS_MOD && WS_MOD + (size_t)MODROWS * NMOD * 4 <= WS_HM && WS_HM + (size_t)MP * D * 2 <= WS_T1 &&
              WS_T1 + (size_t)MP * D * 2 <= WS_PROJ && WS_AC + 256 * D * 2 <= WS_PROJ && WS_PROJ + (size_t)MP * INW * 2 <= WS_U && WS_U + (size_t)512 * 8192 * 4 <= WS_SS && WS_SS + (size_t)512 * 8192 * 2 <= WS_END, "ws map");

constexpr size_t O_Y = 0, O_YS = (size_t)NP * D, O_RETP = O_YS + (size_t)NS * D, O_CAP = O_RETP + (size_t)DEPTH * NB * 4 * 64 * 128,
                 O_CCP = O_CAP + (size_t)DEPTH * NB * 30 * 256, O_RETS = O_CCP + (size_t)DEPTH * NB * 2 * 256,
                 O_CAS = O_RETS + (size_t)DEPTH * NS * 4 * 64 * 128, O_CCS = O_CAS + (size_t)DEPTH * NS * 30 * 256, O_END = O_CCS + (size_t)DEPTH * NS * 2 * 256;

struct Params { const float* in[24]; float* out; unsigned char* ws; };

__device__ const double kInvRev[32] = {
0.15915494309189535, 0.11934937021124886, 0.08949940160889101, 0.06711508300522726, 0.050329212104487035, 0.03774158471741977, 0.0283021958306234, 0.02122365276477766,
0.015915494309189534, 0.011934937021124886, 0.008949940160889102, 0.006711508300522725, 0.005032921210448704, 0.003774158471741977, 0.00283021958306234, 0.0021223652764777662,
0.0015915494309189536, 0.0011934937021124885, 0.0008949940160889102, 0.0006711508300522726, 0.0005032921210448703, 0.00037741584717419774, 0.00028302195830623395, 0.0002122365276477766,
0.00015915494309189535, 0.00011934937021124886, 8.949940160889102e-05, 6.711508300522725e-05, 5.0329212104487035e-05, 3.774158471741978e-05, 2.8302195830623396e-05, 2.122365276477766e-05};

__device__ __forceinline__ float bf2f(unsigned short b) { return __uint_as_float((unsigned)b << 16); }
__device__ __forceinline__ float bflo(unsigned w) { return __uint_as_float(w << 16); }
__device__ __forceinline__ float bfhi(unsigned w) { return __uint_as_float(w & 0xffff0000u); }
__device__ __forceinline__ f32x4 unpack4(u32x2 w) { return (f32x4){bflo(w.x), bfhi(w.x), bflo(w.y), bfhi(w.y)}; }
__device__ __forceinline__ u32x2 pack4(f32x4 v) { u32x2 w; w.x = pg8::cvt_pk_bf16(v[0], v[1]); w.y = pg8::cvt_pk_bf16(v[2], v[3]); return w; }
__device__ __forceinline__ float sigmoidf_(float x) { return __builtin_amdgcn_rcpf(1.0f + __expf(-x)); }
__device__ __forceinline__ float siluf_(float x) { return x * sigmoidf_(x); }
__device__ __forceinline__ float wave_sum(float v) {
#pragma unroll
    for (int o = 1; o < 64; o <<= 1) v += __shfl_xor(v, o);
    return v;
}
__device__ __forceinline__ float log2_gamma(int h) { return __log2f(1.0f - exp2f(-5.0f - (float)h)); }

struct EpiMod {
    static constexpr bool PERM = false, AFTER_DRAIN = false;
    float* O; const float* bias;
    __device__ __forceinline__ void operator()(const f32x4 (&acc)[2][2][4][2], const pg8::Unit& u, int wr, int wc, int fr, int fq) const {
        const int col0 = u.pn * 256 + wc * 32 + 4 * fq;
#pragma unroll
        for (int ai = 0; ai < 2; ++ai)
#pragma unroll
            for (int m = 0; m < 4; ++m) { const int row = u.pm * 256 + ai * 128 + wr * 64 + m * 16 + fr;
                if (row < MODROWS) {
#pragma unroll
                    for (int bj = 0; bj < 2; ++bj)
#pragma unroll
                        for (int n = 0; n < 2; ++n) { const int col = col0 + bj * 128 + n * 16; *(f32x4*)(O + (size_t)row * NMOD + col) = acc[ai][bj][m][n] + *(const f32x4*)(bias + col); } } }
    }
};
struct EpiSwiGLU {
    static constexpr bool PERM = true, AFTER_DRAIN = false;
    bf16_t* O;
    __device__ __forceinline__ void operator()(const f32x4 (&acc)[2][2][4][2], const pg8::Unit& u, int wr, int wc, int fr, int fq) const {
        const int col0 = u.pn * 128 + wc * 32 + 8 * fq;
#pragma unroll
        for (int ai = 0; ai < 2; ++ai)
#pragma unroll
            for (int m = 0; m < 4; ++m) { bf16_t* rowp = O + (size_t)(u.pm * 256 + ai * 128 + wr * 64 + m * 16 + fr) * DFF + col0;
                f32x4 a0 = acc[ai][0][m][0], a1 = acc[ai][0][m][1]; const f32x4 b0 = acc[ai][1][m][0], b1 = acc[ai][1][m][1];
#pragma unroll
                for (int i = 0; i < 4; ++i) { a0[i] = siluf_(a0[i]) * b0[i]; a1[i] = siluf_(a1[i]) * b1[i]; }
                u32x4 w; w.x = pg8::cvt_pk_bf16(a0[0], a0[1]); w.y = pg8::cvt_pk_bf16(a0[2], a0[3]); w.z = pg8::cvt_pk_bf16(a1[0], a1[1]); w.w = pg8::cvt_pk_bf16(a1[2], a1[3]);
                *(u32x4*)rowp = w; }
    }
};

__device__ __forceinline__ void p0_transpose_item(const float* W, int K, int N, bf16_t* WT, int k0, int n0, int orow, MK_LAS float* scr, int lane) {
    const int cq = lane & 15, r0 = lane >> 4;
    f32x4 v[16];
#pragma unroll
    for (int i = 0; i < 16; ++i) v[i] = *(const f32x4*)(W + (size_t)(k0 + 4 * i + r0) * N + n0 + 4 * cq);
#pragma unroll
    for (int i = 0; i < 16; ++i) { const int r = 4 * i + r0; *(MK_LAS f32x4*)(scr + r * 64 + ((4 * cq) ^ (8 * (r >> 3)))) = v[i]; }
    asm volatile("s_waitcnt lgkmcnt(0)" ::: "memory");
    const int c = lane & 7, nn0 = lane >> 3;
#pragma unroll
    for (int j = 0; j < 8; ++j) { const int nn = nn0 + 8 * j; const MK_LAS float* sp = scr + (8 * c) * 64 + (nn ^ (8 * c));
        u32x4 o; o.x = pg8::cvt_pk_bf16(sp[0 * 64], sp[1 * 64]); o.y = pg8::cvt_pk_bf16(sp[2 * 64], sp[3 * 64]); o.z = pg8::cvt_pk_bf16(sp[4 * 64], sp[5 * 64]); o.w = pg8::cvt_pk_bf16(sp[6 * 64], sp[7 * 64]);
        *(u32x4*)(WT + (size_t)(orow + nn) * K + k0 + 8 * c) = o; }
    asm volatile("s_waitcnt lgkmcnt(0)" ::: "memory");
}
__device__ __forceinline__ void p0_prologue(const Params& P, MK_LAS unsigned char* lds) {
    int tid_ = threadIdx.x; asm volatile("" : "+v"(tid_)); const int tid = tid_, lane = tid & 63, wave = __builtin_amdgcn_readfirstlane(tid >> 6); (void)tid; (void)lane; (void)wave;
    MK_LAS float* scr = (MK_LAS float*)(lds + wave * 16384);
    const int gw = blockIdx.x * NWAVES + wave, NGW = gridDim.x * NWAVES;
    unsigned char* ws = P.ws;
    constexpr int I_IN = 16 * 44, I_OUT = 16 * 16, I_F = 16 * 44, I_2 = 44 * 16, I_ADA = 16 * 96;
    constexpr int PER_L = I_IN + I_OUT + 2 * I_F + I_2 + I_ADA;
    for (int it = gw; it < DEPTH * PER_L; it += NGW) {
        const int l = it / PER_L; int r = it % PER_L;
        if (r < I_IN) { const int kb = r / 44, nb = r % 44; p0_transpose_item(P.in[13] + (size_t)l * D * INW, D, INW, (bf16_t*)(ws + WS_WIN) + (size_t)l * INW * D, 64 * kb, 64 * nb, 64 * nb, scr, lane); continue; } r -= I_IN;
        if (r < I_OUT) { const int kb = r / 16, nb = r % 16; p0_transpose_item(P.in[14] + (size_t)l * D * D, D, D, (bf16_t*)(ws + WS_WOUT) + (size_t)l * D * D, 64 * kb, 64 * nb, 64 * nb, scr, lane); continue; } r -= I_OUT;
        if (r < I_F) { const int kb = r / 44, nb = r % 44, n0 = 64 * nb; p0_transpose_item(P.in[21] + (size_t)l * D * DFF, D, DFF, (bf16_t*)(ws + WS_W13) + (size_t)l * NFF1 * D, 64 * kb, n0, 256 * (n0 >> 7) + (n0 & 127), scr, lane); continue; } r -= I_F;
        if (r < I_F) { const int kb = r / 44, nb = r % 44, n0 = 64 * nb; p0_transpose_item(P.in[22] + (size_t)l * D * DFF, D, DFF, (bf16_t*)(ws + WS_W13) + (size_t)l * NFF1 * D, 64 * kb, n0, 256 * (n0 >> 7) + 128 + (n0 & 127), scr, lane); continue; } r -= I_F;
        if (r < I_2) { const int kb = r / 16, nb = r % 16; p0_transpose_item(P.in[23] + (size_t)l * DFF * D, DFF, D, (bf16_t*)(ws + WS_W2) + (size_t)l * D * DFF, 64 * kb, 64 * nb, 64 * nb, scr, lane); continue; } r -= I_2;
        { const int kb = r / 96, nb = r % 96; p0_transpose_item(P.in[7] + (size_t)l * D * 6144, D, 6144, (bf16_t*)(ws + WS_ADAT), 64 * kb, 64 * nb, l * 6144 + 64 * nb, scr, lane); }
    }
    for (int r = gw; r < 256; r += NGW) {
        bf16_t* o = (bf16_t*)(ws + WS_AC) + (size_t)r * D;
        const float* src = r < NB ? P.in[2] + (size_t)r * D : P.in[3] + (size_t)(r - NB) * D;
#pragma unroll
        for (int j = 0; j < 4; ++j) { f32x4 v = (f32x4){0.f, 0.f, 0.f, 0.f};
            if (r < MODROWS) { v = *(const f32x4*)(src + 4 * lane + 256 * j); v[0] = siluf_(v[0]); v[1] = siluf_(v[1]); v[2] = siluf_(v[2]); v[3] = siluf_(v[3]); }
            *(u32x2*)(o + 4 * lane + 256 * j) = pack4(v); }
    }
}

template <int KIND>
__device__ __forceinline__ void rowpass_row(const Params& P, int l, int r, int lane) {
    unsigned char* ws = P.ws;
    const float* mod = (const float*)(ws + WS_MOD);
    bf16_t* HM = (bf16_t*)(ws + WS_HM); const bf16_t* T1 = (const bf16_t*)(ws + WS_T1);
    {
        const int mrow = r < NP ? (r >> 11) : NB + (r - NP);
        const float* mp = mod + (size_t)mrow * NMOD + l * 6144;
        f32x4 x[4];
        const float* xin = (KIND == 0 || (KIND == 1 && l == 0)) ? (r < NP ? P.in[0] + (size_t)r * D : P.in[1] + (size_t)(r - NP) * D) : P.out + (size_t)r * D;
#pragma unroll
        for (int j = 0; j < 4; ++j) x[j] = *(const f32x4*)(xin + 4 * lane + 256 * j);
        if (KIND != 0) {
            f32x4 t[4]; float s = 0.f;
#pragma unroll
            for (int j = 0; j < 4; ++j) { t[j] = unpack4(*(const u32x2*)(T1 + (size_t)r * D + 4 * lane + 256 * j)); s += (t[j][0] * t[j][0] + t[j][1] * t[j][1]) + (t[j][2] * t[j][2] + t[j][3] * t[j][3]); }
            const float rstd = rsqrtf(wave_sum(s) * (1.0f / D) + EPS);
            const float* gpost = P.in[KIND == 1 ? 10 : 12] + l * D;
            const float* gt = mp + (KIND == 1 ? 2 : 5) * D;
#pragma unroll
            for (int j = 0; j < 4; ++j) { const f32x4 g = *(const f32x4*)(gpost + 4 * lane + 256 * j), gg = *(const f32x4*)(gt + 4 * lane + 256 * j);
                x[j] = x[j] + gg * (t[j] * rstd * g);
                *(f32x4*)(P.out + (size_t)r * D + 4 * lane + 256 * j) = x[j]; }
        }
        if (KIND == 2 && l == DEPTH - 1) return;
        const int ln = (KIND == 2) ? l + 1 : l;
        const float* mpn = mod + (size_t)mrow * NMOD + ln * 6144;
        const float* gpre = P.in[KIND == 1 ? 11 : 9] + ln * D;
        const float* sh = mpn + (KIND == 1 ? 3 : 0) * D; const float* sc = mpn + (KIND == 1 ? 4 : 1) * D;
        float s = 0.f;
#pragma unroll
        for (int j = 0; j < 4; ++j) s += (x[j][0] * x[j][0] + x[j][1] * x[j][1]) + (x[j][2] * x[j][2] + x[j][3] * x[j][3]);
        const float rstd = rsqrtf(wave_sum(s) * (1.0f / D) + EPS);
#pragma unroll
        for (int j = 0; j < 4; ++j) { const f32x4 g = *(const f32x4*)(gpre + 4 * lane + 256 * j), a = *(const f32x4*)(sc + 4 * lane + 256 * j), b = *(const f32x4*)(sh + 4 * lane + 256 * j);
            const f32x4 h = (x[j] * rstd * g) * (a + 1.0f) + b;
            *(u32x2*)(HM + (size_t)r * D + 4 * lane + 256 * j) = pack4(h); }
    }
}
template <int KIND>
__device__ __forceinline__ void rowpass(const Params& P, int l) {
    int tid_ = threadIdx.x; asm volatile("" : "+v"(tid_)); const int tid = tid_, lane = tid & 63, wave = __builtin_amdgcn_readfirstlane(tid >> 6); (void)tid;
    const int gw = blockIdx.x * NWAVES + wave, NGW = gridDim.x * NWAVES;
    for (int r = gw; r < MR; r += NGW) rowpass_row<KIND>(P, l, r, lane);
}
template <int KIND>
__device__ __forceinline__ void sample_rowpass(const Params& P, int l, unsigned* cnt) {
    int tid_ = threadIdx.x; asm volatile("" : "+v"(tid_)); const int tid = tid_, lane = tid & 63, wave = __builtin_amdgcn_readfirstlane(tid >> 6);
    if (blockIdx.x < 64 || blockIdx.x >= 80) return;
    if (tid == 0) { unsigned sp = 0; while (__hip_atomic_load(cnt, __ATOMIC_RELAXED, __HIP_MEMORY_SCOPE_AGENT) < 256u) { __builtin_amdgcn_s_sleep(2); if (++sp > (1u << 22)) break; }
        __builtin_amdgcn_fence(__ATOMIC_ACQUIRE, "agent"); asm volatile("s_waitcnt vmcnt(0)" ::: "memory"); }
    __syncthreads();
    rowpass_row<KIND>(P, l, NP + (blockIdx.x - 64) * 8 + wave, lane);
}

struct EpiRmsFused {
    static constexpr bool PERM = false, AFTER_DRAIN = true;
    const Params* Pp; int l, kind;
    __device__ __forceinline__ void fused(f32x4 (&acc)[2][2][4][2], const pg8::Unit& u, int wr, int wc, int fr, int fq, MK_LAS unsigned char* lds, int wid, int lane) const {
        const Params& P = *Pp; unsigned char* ws = P.ws;
        const int ln = (kind == 2 && l + 1 < DEPTH) ? l + 1 : l; const int write_h = (kind == 2 && l + 1 >= DEPTH) ? 0 : 1; const int inst = 2 * l + (kind - 1);
        const float* xin = (kind == 1 && l == 0) ? P.in[0] : P.out; float* xout = P.out; bf16_t* hout = (bf16_t*)(ws + WS_HM);
        const float* gpost = P.in[kind == 1 ? 10 : 12] + l * D; const float* gpre = P.in[kind == 1 ? 11 : 9] + ln * D;
        const float* gt = (const float*)(ws + WS_MOD) + l * 6144 + (kind == 1 ? 2 : 5) * D;
        const float* sc = (const float*)(ws + WS_MOD) + ln * 6144 + (kind == 1 ? 4 : 1) * D; const float* sh = (const float*)(ws + WS_MOD) + ln * 6144 + (kind == 1 ? 3 : 0) * D;
        unsigned long long* xbuf = (unsigned long long*)(ws + WS_X + (size_t)inst * MiB); unsigned* cnt = (unsigned*)(ws + WS_CTL) + CW_PANEL + inst * 4096;
        MK_LAS f32x4* Pt = (MK_LAS f32x4*)lds;
        MK_LAS f32x2v* St = (MK_LAS f32x2v*)(lds + 16384);
        const int b = u.pm >> 3;
        const int col0 = u.pn * 256 + wc * 32 + 4 * fq;
        {   f32x4 av[2][2];
#pragma unroll
            for (int bj = 0; bj < 2; ++bj)
#pragma unroll
                for (int n = 0; n < 2; ++n) { const int col = col0 + bj * 128 + n * 16; av[bj][n] = *(const f32x4*)(gt + (size_t)b * NMOD + col) * *(const f32x4*)(gpost + col); }
#pragma unroll
            for (int ai = 0; ai < 2; ++ai)
#pragma unroll
                for (int m = 0; m < 4; ++m) { const int rl = ai * 128 + wr * 64 + m * 16 + fr; const float* xr = xin + (size_t)(u.pm * 256 + rl) * D + col0;
                    float sTT = 0.f, sxa = 0.f, saa = 0.f, sxx = 0.f;
#pragma unroll
                    for (int bj = 0; bj < 2; ++bj)
#pragma unroll
                        for (int n = 0; n < 2; ++n) { const f32x4 T = acc[ai][bj][m][n], aT = av[bj][n] * T, x = *(const f32x4*)(xr + bj * 128 + n * 16);
                            sTT += (T[0] * T[0] + T[1] * T[1]) + (T[2] * T[2] + T[3] * T[3]); sxa += (x[0] * aT[0] + x[1] * aT[1]) + (x[2] * aT[2] + x[3] * aT[3]);
                            saa += (aT[0] * aT[0] + aT[1] * aT[1]) + (aT[2] * aT[2] + aT[3] * aT[3]); sxx += (x[0] * x[0] + x[1] * x[1]) + (x[2] * x[2] + x[3] * x[3]);
                            acc[ai][bj][m][n] = aT; }
                    sTT += __shfl_xor(sTT, 16); sTT += __shfl_xor(sTT, 32); sxa += __shfl_xor(sxa, 16); sxa += __shfl_xor(sxa, 32);
                    saa += __shfl_xor(saa, 16); saa += __shfl_xor(saa, 32); sxx += __shfl_xor(sxx, 16); sxx += __shfl_xor(sxx, 32);
                    if (fq == 0) Pt[rl * 4 + wc] = (f32x4){sTT, sxa, saa, sxx};
                    if (m & 1) asm volatile("" ::: "memory"); }
        }
        asm volatile("s_waitcnt lgkmcnt(0)" ::: "memory"); __builtin_amdgcn_s_barrier(); asm volatile("" ::: "memory");
        const int row = wid * 32 + (lane & 31);
        unsigned long long* slot = xbuf + ((size_t)(u.pm * 256 + row) * 4) * 2;
        if (lane < 32) { const f32x4 p = (Pt[row * 4 + 0] + Pt[row * 4 + 1]) + (Pt[row * 4 + 2] + Pt[row * 4 + 3]);
            __hip_atomic_store(slot + u.pn * 2 + 0, ((unsigned long long)__float_as_uint(p[1]) << 32) | __float_as_uint(p[0]), __ATOMIC_RELAXED, __HIP_MEMORY_SCOPE_AGENT);
            __hip_atomic_store(slot + u.pn * 2 + 1, ((unsigned long long)__float_as_uint(p[3]) << 32) | __float_as_uint(p[2]), __ATOMIC_RELAXED, __HIP_MEMORY_SCOPE_AGENT); }
        asm volatile("s_waitcnt vmcnt(0)" ::: "memory");
        if (lane == 0) __hip_atomic_fetch_add(cnt + 64 * u.pm, 1u, __ATOMIC_RELAXED, __HIP_MEMORY_SCOPE_AGENT);
        if (wid == 0) { unsigned sp = 0;
            while ((unsigned)__builtin_amdgcn_readfirstlane(__hip_atomic_load(cnt + 64 * u.pm, __ATOMIC_RELAXED, __HIP_MEMORY_SCOPE_AGENT)) < 32u) { __builtin_amdgcn_s_sleep(2); if (++sp > (1u << 22)) break; }
            __builtin_amdgcn_fence(__ATOMIC_ACQUIRE, "agent"); }
        asm volatile("s_waitcnt vmcnt(0) lgkmcnt(0)" ::: "memory"); __builtin_amdgcn_s_barrier(); asm volatile("" ::: "memory");
        if (lane < 32) { float TT = 0.f, xa = 0.f, aa = 0.f, xx = 0.f;
#pragma unroll
            for (int t = 0; t < 4; ++t) { const unsigned long long w0 = __hip_atomic_load(slot + t * 2 + 0, __ATOMIC_RELAXED, __HIP_MEMORY_SCOPE_AGENT), w1 = __hip_atomic_load(slot + t * 2 + 1, __ATOMIC_RELAXED, __HIP_MEMORY_SCOPE_AGENT);
                TT += __uint_as_float((unsigned)w0); xa += __uint_as_float((unsigned)(w0 >> 32)); aa += __uint_as_float((unsigned)w1); xx += __uint_as_float((unsigned)(w1 >> 32)); }
            const float rT = rsqrtf(TT * (1.0f / D) + EPS); const float q = xx + 2.0f * rT * xa + rT * rT * aa;
            St[row] = (f32x2v){rT, rsqrtf(fmaxf(q, 0.f) * (1.0f / D) + EPS)}; }
        asm volatile("s_waitcnt lgkmcnt(0)" ::: "memory"); __builtin_amdgcn_s_barrier(); asm volatile("" ::: "memory");
#pragma unroll
        for (int bj = 0; bj < 2; ++bj)
#pragma unroll
            for (int n = 0; n < 2; ++n) { const int col = col0 + bj * 128 + n * 16;
                f32x4 gm = (f32x4){0.f, 0.f, 0.f, 0.f}, sv = gm;
                if (write_h) { gm = *(const f32x4*)(gpre + col) * (*(const f32x4*)(sc + (size_t)b * NMOD + col) + 1.0f); sv = *(const f32x4*)(sh + (size_t)b * NMOD + col); }
#pragma unroll
                for (int ai = 0; ai < 2; ++ai)
#pragma unroll
                    for (int m = 0; m < 4; ++m) { const int rl = ai * 128 + wr * 64 + m * 16 + fr; const f32x2v sr = St[rl]; const size_t off = (size_t)(u.pm * 256 + rl) * D + col;
                        const f32x4 x1 = *(const f32x4*)(xin + off) + acc[ai][bj][m][n] * sr.x;
                        *(f32x4*)(xout + off) = x1;
                        if (write_h) *(u32x2*)(hout + off) = pack4(x1 * sr.y * gm + sv);
                        if (m & 1) asm volatile("" ::: "memory"); } }
    }
};

__device__ __forceinline__ bf16x8 lfrag(const MK_LAS bf16_t* base, int row, int stride, int k0, int fq) { return *(const MK_LAS bf16x8*)(base + row * stride + k0 + fq * 8); }
#define MK_MFMA(b, a, c) __builtin_amdgcn_mfma_f32_16x16x32_bf16((b), (a), (c), 0, 0, 0)

__device__ __forceinline__ void rope8(const bf16_t* src  , int j, float pos, float scale, u32x4& o1, u32x4& o2, float extra  ) {
    const u32x4 w1 = *(const u32x4*)(src + 8 * j), w2 = *(const u32x4*)(src + 32 + 8 * j);
    float a[8], b[8];
#pragma unroll
    for (int q = 0; q < 4; ++q) { a[2 * q] = bflo(w1[q]); a[2 * q + 1] = bfhi(w1[q]); b[2 * q] = bflo(w2[q]); b[2 * q + 1] = bfhi(w2[q]); }
    float r1[8], r2[8]; const float sc = scale * extra;
#pragma unroll
    for (int i = 0; i < 8; ++i) { const double rev = (double)pos * kInvRev[8 * j + i]; const float fr_ = (float)(rev - floor(rev));
        const float sn = __builtin_amdgcn_sinf(fr_), cs = __builtin_amdgcn_cosf(fr_);
        r1[i] = (a[i] * cs - b[i] * sn) * sc; r2[i] = (a[i] * sn + b[i] * cs) * sc; }
#pragma unroll
    for (int q = 0; q < 4; ++q) { o1[q] = pg8::cvt_pk_bf16(r1[2 * q], r1[2 * q + 1]); o2[q] = pg8::cvt_pk_bf16(r2[2 * q], r2[2 * q + 1]); }
}

constexpr int SQ = 72, SV = 136;
constexpr int L_QS = 0, L_KS = L_QS + 128 * SQ * 2, L_VT = L_KS + 128 * SQ * 2, L_PS = L_VT + 128 * SV * 2, L_ST = L_PS + 128 * SV * 2, L_RET_END = L_ST + 128 * SQ * 2;
static_assert(L_RET_END <= 131072, "retention LDS");

__device__ __forceinline__ void load_vt(const bf16_t* PROJ, int row0, int h, MK_LAS bf16_t* Vt, int wave, int lane) {
#pragma unroll
    for (int it = 0; it < 4; ++it) { const int chunk = wave * 2 + (it & 1), m = lane + 64 * (it >> 1);
        const u32x4 w = *(const u32x4*)(PROJ + (size_t)(row0 + m) * INW + PV + h * 128 + chunk * 8);
#pragma unroll
        for (int q = 0; q < 4; ++q) { Vt[(chunk * 8 + 2 * q) * SV + m] = (bf16_t)(w[q] & 0xffffu); Vt[(chunk * 8 + 2 * q + 1) * SV + m] = (bf16_t)(w[q] >> 16); } }
}

__device__ __forceinline__ void ret_u_item(const Params& P, MK_LAS unsigned char* lds, int item) {
    int tid_ = threadIdx.x; asm volatile("" : "+v"(tid_)); const int tid = tid_, lane = tid & 63, wave = __builtin_amdgcn_readfirstlane(tid >> 6); (void)tid; (void)lane; (void)wave;
    const int h = item & 3, c = (item >> 2) & 15, b = item >> 6;
    const bf16_t* PROJ = (const bf16_t*)(P.ws + WS_PROJ);
    float* UT = (float*)(P.ws + WS_U) + (size_t)((b * 4 + h) * 16 + c) * 8192;
    MK_LAS bf16_t* Kt = (MK_LAS bf16_t*)(lds + L_KS);
    MK_LAS bf16_t* Vt = (MK_LAS bf16_t*)(lds + L_VT);
    const int row0 = b * SEQ + c * 128; const float lg = log2_gamma(h);
    __syncthreads();
    load_vt(PROJ, row0, h, Vt, wave, lane);
    { const int m = tid & 127, j = tid >> 7; u32x4 o1, o2;
      rope8(PROJ + (size_t)(row0 + m) * INW + PK + h * 64, j, (float)(c * 128 + m), 0.125f, o1, o2, exp2f((float)(127 - m) * lg));
#pragma unroll
      for (int q = 0; q < 4; ++q) { Kt[(8 * j + 2 * q) * SV + m] = (bf16_t)(o1[q] & 0xffffu); Kt[(8 * j + 2 * q + 1) * SV + m] = (bf16_t)(o1[q] >> 16);
                                    Kt[(32 + 8 * j + 2 * q) * SV + m] = (bf16_t)(o2[q] & 0xffffu); Kt[(32 + 8 * j + 2 * q + 1) * SV + m] = (bf16_t)(o2[q] >> 16); } }
    __syncthreads();
    const int fr = lane & 15, fq = lane >> 4, e0 = 16 * wave;
    f32x4 u[4];
#pragma unroll
    for (int j = 0; j < 4; ++j) u[j] = (f32x4){0.f, 0.f, 0.f, 0.f};
#pragma unroll
    for (int ks = 0; ks < 4; ++ks) { const bf16x8 a = lfrag(Vt, e0 + fr, SV, ks * 32, fq);
#pragma unroll
        for (int j = 0; j < 4; ++j) { const bf16x8 bb = lfrag(Kt, 16 * j + fr, SV, ks * 32, fq); u[j] = MK_MFMA(bb, a, u[j]); } }
#pragma unroll
    for (int j = 0; j < 4; ++j) *(f32x4*)(UT + (e0 + fr) * 64 + 16 * j + 4 * fq) = u[j];
}

__device__ __forceinline__ void ret_o_item(const Params& P, MK_LAS unsigned char* lds, int l, int item) {
    int tid_ = threadIdx.x; asm volatile("" : "+v"(tid_)); const int tid = tid_, lane = tid & 63, wave = __builtin_amdgcn_readfirstlane(tid >> 6); (void)tid; (void)lane; (void)wave;
    const int h = item & 3, b = item >> 6, c = item < 256 ? (item >> 2) & 15 : 15 - ((item >> 2) & 15);
    const bf16_t* PROJ = (const bf16_t*)(P.ws + WS_PROJ);
    bf16_t* MIX = (bf16_t*)(P.ws + WS_HM);
    MK_LAS bf16_t* Qs = (MK_LAS bf16_t*)(lds + L_QS); MK_LAS bf16_t* Ks = (MK_LAS bf16_t*)(lds + L_KS); MK_LAS bf16_t* Vt = (MK_LAS bf16_t*)(lds + L_VT);
    MK_LAS bf16_t* Ps = (MK_LAS bf16_t*)(lds + L_PS); MK_LAS bf16_t* St = (MK_LAS bf16_t*)(lds + L_ST);
    const int row0 = b * SEQ + c * 128; const float lg = log2_gamma(h);
    __syncthreads();
    load_vt(PROJ, row0, h, Vt, wave, lane);
    { const int m = tid & 127, j = tid >> 7; u32x4 o1, o2; const float pos = (float)(c * 128 + m);
      rope8(PROJ + (size_t)(row0 + m) * INW + PQ + h * 64, j, pos, 1.0f, o1, o2, 1.0f);
      *(MK_LAS u32x4*)(Qs + m * SQ + 8 * j) = o1; *(MK_LAS u32x4*)(Qs + m * SQ + 32 + 8 * j) = o2;
      rope8(PROJ + (size_t)(row0 + m) * INW + PK + h * 64, j, pos, 0.125f, o1, o2, 1.0f);
      *(MK_LAS u32x4*)(Ks + m * SQ + 8 * j) = o1; *(MK_LAS u32x4*)(Ks + m * SQ + 32 + 8 * j) = o2; }
    { const float cd = exp2f(128.0f * lg);
      const float* UTb = (const float*)(P.ws + WS_U) + (size_t)((b * 4 + h) * 16) * 8192;
#pragma unroll 1
      for (int it = 0; it < 4; ++it) { const int idx = tid + 512 * it, e = idx >> 4, dq = idx & 15;
        f32x4 uu[15];
#pragma unroll
        for (int j = 0; j < 15; ++j) { if (j < c) uu[j] = *(const f32x4*)(UTb + (size_t)j * 8192 + 4 * idx); else uu[j] = (f32x4){0.f, 0.f, 0.f, 0.f}; }
        f32x4 sa = (f32x4){0.f, 0.f, 0.f, 0.f};
#pragma unroll
        for (int j = 0; j < 15; ++j) { if (j < c) sa = sa * cd + uu[j]; }
        *(MK_LAS u32x2*)(St + e * SQ + 4 * dq) = pack4(sa);
        if (c == 15) { sa = sa * cd + *(const f32x4*)(UTb + (size_t)15 * 8192 + 4 * idx);
            float* o = P.out + O_RETP + (size_t)((l * NB + b) * 4 + h) * 8192 + e;
#pragma unroll
            for (int i = 0; i < 4; ++i) o[(4 * dq + i) * 128] = sa[i]; } } }
    __syncthreads();
    const int fr = lane & 15, fq = lane >> 4, n0 = 16 * wave, n = n0 + fr;
    {
        f32x4 sc[8];
#pragma unroll
        for (int j = 0; j < 8; ++j) sc[j] = (f32x4){0.f, 0.f, 0.f, 0.f};
#pragma unroll
        for (int ks = 0; ks < 2; ++ks) { const bf16x8 a = lfrag(Qs, n, SQ, ks * 32, fq);
#pragma unroll
            for (int j = 0; j < 8; ++j) { const bf16x8 bb = lfrag(Ks, 16 * j + fr, SQ, ks * 32, fq); sc[j] = MK_MFMA(bb, a, sc[j]); } }
#pragma unroll
        for (int j = 0; j < 8; ++j) { f32x4 p;
#pragma unroll
            for (int i = 0; i < 4; ++i) { const int dlt = n - (16 * j + 4 * fq + i); p[i] = dlt >= 0 ? sc[j][i] * exp2f((float)dlt * lg) : 0.f; }
            *(MK_LAS u32x2*)(Ps + n * SV + 16 * j + 4 * fq) = pack4(p); }
    }
    __syncthreads();
    f32x4 o1[8], o2[8];
#pragma unroll
    for (int j = 0; j < 8; ++j) { o1[j] = (f32x4){0.f, 0.f, 0.f, 0.f}; o2[j] = (f32x4){0.f, 0.f, 0.f, 0.f}; }
#pragma unroll
    for (int ks = 0; ks < 4; ++ks) { const bf16x8 a = lfrag(Ps, n, SV, ks * 32, fq);
#pragma unroll
        for (int j = 0; j < 8; ++j) { const bf16x8 bb = lfrag(Vt, 16 * j + fr, SV, ks * 32, fq); o1[j] = MK_MFMA(bb, a, o1[j]); } }
#pragma unroll
    for (int ks = 0; ks < 2; ++ks) { const bf16x8 a = lfrag(Qs, n, SQ, ks * 32, fq);
#pragma unroll
        for (int j = 0; j < 8; ++j) { const bf16x8 bb = lfrag(St, 16 * j + fr, SQ, ks * 32, fq); o2[j] = MK_MFMA(bb, a, o2[j]); } }
    const float rd = exp2f((float)(n + 1) * lg);
    float s = 0.f;
#pragma unroll
    for (int j = 0; j < 8; ++j) { o1[j] = o1[j] + o2[j] * rd; s += (o1[j][0] + o1[j][1]) + (o1[j][2] + o1[j][3]); }
    s += __shfl_xor(s, 16); s += __shfl_xor(s, 32);
    const float mean = s * (1.0f / 128.0f); float q = 0.f;
#pragma unroll
    for (int j = 0; j < 8; ++j) { o1[j] = o1[j] - mean; q += (o1[j][0] * o1[j][0] + o1[j][1] * o1[j][1]) + (o1[j][2] * o1[j][2] + o1[j][3] * o1[j][3]); }
    q += __shfl_xor(q, 16); q += __shfl_xor(q, 32);
    const float rstd = rsqrtf(q * (1.0f / 128.0f) + EPS);
    const float* gn = P.in[15] + l * 512 + h * 128;
    const size_t row = (size_t)(row0 + n);
#pragma unroll
    for (int j = 0; j < 8; ++j) { const int e = 16 * j + 4 * fq;
        const f32x4 g = *(const f32x4*)(gn + e); const f32x4 gate = unpack4(*(const u32x2*)(PROJ + row * INW + PG + h * 128 + e));
        f32x4 o;
#pragma unroll
        for (int i = 0; i < 4; ++i) o[i] = o1[j][i] * rstd * g[i] * siluf_(gate[i]);
        *(u32x2*)(MIX + row * D + h * 128 + e) = pack4(o); }
}

__device__ __forceinline__ void conva_finish(const Params& P, int l, f32x4 acc, size_t row, int lane) {
    bf16_t* MIX = (bf16_t*)(P.ws + WS_HM);
    const float mean = wave_sum((acc[0] + acc[1]) + (acc[2] + acc[3])) * (1.0f / 256.0f);
    const f32x4 d = acc - mean;
    const float var = wave_sum((d[0] * d[0] + d[1] * d[1]) + (d[2] * d[2] + d[3] * d[3])) * (1.0f / 256.0f);
    const float rstd = rsqrtf(var + EPS);
    const f32x4 g = *(const f32x4*)(P.in[18] + l * 256 + 4 * lane), bb = *(const f32x4*)(P.in[19] + l * 256 + 4 * lane);
    f32x4 y = d * rstd * g + bb;
#pragma unroll
    for (int i = 0; i < 4; ++i) y[i] = siluf_(y[i]);
    *(u32x2*)(MIX + row * D + 512 + 4 * lane) = pack4(y);
}

__device__ __forceinline__ void conv_item(const Params& P, MK_LAS unsigned char* lds, int l, int item) {
    int tid_ = threadIdx.x; asm volatile("" : "+v"(tid_)); const int tid = tid_, lane = tid & 63, wave = __builtin_amdgcn_readfirstlane(tid >> 6); (void)tid; (void)lane; (void)wave;
    const int b = item >> 5, tb = item & 31, t0 = tb * 64;
    const bf16_t* PROJ = (const bf16_t*)(P.ws + WS_PROJ);
    bf16_t* MIX = (bf16_t*)(P.ws + WS_HM);
    MK_LAS float* Us = (MK_LAS float*)lds;
    __syncthreads();
#pragma unroll 4
    for (int idx = tid; idx < 94 * 64; idx += NTHREADS) { const int lr = idx >> 6, q = idx & 63, t = t0 - 30 + lr;
        f32x4 u = (f32x4){0.f, 0.f, 0.f, 0.f};
        if (t >= 0) { const bf16_t* rp = PROJ + (size_t)(b * SEQ + t) * INW; const f32x4 v = unpack4(*(const u32x2*)(rp + PAV + 4 * q)), g = unpack4(*(const u32x2*)(rp + PAG + 4 * q));
#pragma unroll
            for (int i = 0; i < 4; ++i) u[i] = v[i] * sigmoidf_(g[i]); }
        *(MK_LAS f32x4*)(Us + lr * 256 + 4 * q) = u;
        if (tb == 31 && lr >= 64) *(f32x4*)(P.out + O_CAP + (size_t)((l * NB + b) * 30 + (lr - 64)) * 256 + 4 * q) = u; }
    __syncthreads();
    const float* cw = P.in[16] + l * 31 * 256 + 4 * lane;
    f32x4 acc[8]; const f32x4 bias = *(const f32x4*)(P.in[17] + l * 256 + 4 * lane);
#pragma unroll
    for (int k = 0; k < 8; ++k) acc[k] = bias;
    {   f32x4 w[31];
#pragma unroll
        for (int j = 0; j < 31; ++j) w[j] = *(const f32x4*)(cw + j * 256);
#pragma unroll
        for (int r = 0; r < 38; ++r) { const f32x4 uu = *(const MK_LAS f32x4*)(Us + (8 * wave + r) * 256 + 4 * lane);
#pragma unroll
            for (int k = 0; k < 8; ++k) { if (r - k >= 0 && r - k <= 30) acc[k] = acc[k] + w[r - k >= 0 && r - k <= 30 ? r - k : 0] * uu; } } }
#pragma unroll
    for (int k = 0; k < 8; ++k) conva_finish(P, l, acc[k], (size_t)(b * SEQ + t0 + 8 * wave + k), lane);
    const f32x4 w0 = *(const f32x4*)(P.in[20] + l * 768 + 4 * lane), w1 = *(const f32x4*)(P.in[20] + l * 768 + 256 + 4 * lane), w2 = *(const f32x4*)(P.in[20] + l * 768 + 512 + 4 * lane);
    f32x4 zm2 = (f32x4){0.f, 0.f, 0.f, 0.f}, zm1 = zm2;
#pragma unroll
    for (int k = -2; k < 8; ++k) { const int t = t0 + 8 * wave + k;
        f32x4 z = (f32x4){0.f, 0.f, 0.f, 0.f};
        if (t >= 0) { const bf16_t* rp = PROJ + (size_t)(b * SEQ + t) * INW; z = unpack4(*(const u32x2*)(rp + PCC + 4 * lane)) * unpack4(*(const u32x2*)(rp + PCX + 4 * lane)); }
        if (k >= 0) { const bf16_t* rp = PROJ + (size_t)(b * SEQ + t) * INW; const f32x4 cb = unpack4(*(const u32x2*)(rp + PCB + 4 * lane));
            const f32x4 o = cb * (w0 * zm2 + w1 * zm1 + w2 * z);
            *(u32x2*)(MIX + (size_t)(b * SEQ + t) * D + 768 + 4 * lane) = pack4(o);
            if (t >= SEQ - 2) *(f32x4*)(P.out + O_CCP + (size_t)((l * NB + b) * 2 + (t - (SEQ - 2))) * 256 + 4 * lane) = z; }
        zm2 = zm1; zm1 = z; }
}

__device__ __forceinline__ void sample_conv(const Params& P, int l) {
    int tid_ = threadIdx.x; asm volatile("" : "+v"(tid_)); const int tid = tid_, lane = tid & 63, wave = __builtin_amdgcn_readfirstlane(tid >> 6); (void)tid; (void)lane; (void)wave;
    if (wave != 2 || blockIdx.x >= NS) return;
    const int s = blockIdx.x;
    const bf16_t* PROJ = (const bf16_t*)(P.ws + WS_PROJ);
    bf16_t* MIX = (bf16_t*)(P.ws + WS_HM);
    const size_t row = (size_t)(NP + s); const bf16_t* rp = PROJ + row * INW;
    const f32x4 v = unpack4(*(const u32x2*)(rp + PAV + 4 * lane)), g = unpack4(*(const u32x2*)(rp + PAG + 4 * lane));
    f32x4 u;
#pragma unroll
    for (int i = 0; i < 4; ++i) u[i] = v[i] * sigmoidf_(g[i]);
    const float* buf = P.in[5] + (size_t)((l * NS + s) * 30) * 256 + 4 * lane; float* nb = P.out + O_CAS + (size_t)((l * NS + s) * 30) * 256 + 4 * lane;
    const float* cw = P.in[16] + l * 31 * 256 + 4 * lane;
    f32x4 acc = *(const f32x4*)(P.in[17] + l * 256 + 4 * lane);
#pragma unroll 6
    for (int j = 0; j < 30; ++j) { const f32x4 x = *(const f32x4*)(buf + j * 256); acc = acc + *(const f32x4*)(cw + j * 256) * x; if (j >= 1) *(f32x4*)(nb + (j - 1) * 256) = x; }
    acc = acc + *(const f32x4*)(cw + 30 * 256) * u; *(f32x4*)(nb + 29 * 256) = u;
    conva_finish(P, l, acc, row, lane);
    const f32x4 w0 = *(const f32x4*)(P.in[20] + l * 768 + 4 * lane), w1 = *(const f32x4*)(P.in[20] + l * 768 + 256 + 4 * lane), w2 = *(const f32x4*)(P.in[20] + l * 768 + 512 + 4 * lane);
    const float* bc = P.in[6] + (size_t)((l * NS + s) * 2) * 256 + 4 * lane; float* nc = P.out + O_CCS + (size_t)((l * NS + s) * 2) * 256 + 4 * lane;
    const f32x4 z0 = *(const f32x4*)bc, z1 = *(const f32x4*)(bc + 256);
    const f32x4 z = unpack4(*(const u32x2*)(rp + PCC + 4 * lane)) * unpack4(*(const u32x2*)(rp + PCX + 4 * lane));
    const f32x4 cb = unpack4(*(const u32x2*)(rp + PCB + 4 * lane));
    *(u32x2*)(MIX + row * D + 768 + 4 * lane) = pack4(cb * (w0 * z0 + w1 * z1 + w2 * z));
    *(f32x4*)nc = z1; *(f32x4*)(nc + 256) = z;
}

__device__ __forceinline__ void sample_ret(const Params& P, int l) {
    int tid_ = threadIdx.x; asm volatile("" : "+v"(tid_)); const int tid = tid_, lane = tid & 63, wave = __builtin_amdgcn_readfirstlane(tid >> 6); (void)tid; (void)lane; (void)wave;
    if (wave >= 2) return;
    const int s = (blockIdx.x * 2 + wave) >> 2, h = (blockIdx.x * 2 + wave) & 3;
    const bf16_t* PROJ = (const bf16_t*)(P.ws + WS_PROJ);
    bf16_t* MIX = (bf16_t*)(P.ws + WS_HM);
    const size_t row = (size_t)(NP + s); const bf16_t* rp = PROJ + row * INW;
    const float lg = log2_gamma(h), gam = exp2f(lg);
    const int i5 = lane & 31;
    const double rev = 16384.0 * kInvRev[i5]; const float fr_ = (float)(rev - floor(rev));
    const float sn = __builtin_amdgcn_sinf(fr_), cs = __builtin_amdgcn_cosf(fr_);
    const float q1 = bf2f(rp[PQ + h * 64 + i5]), q2 = bf2f(rp[PQ + h * 64 + 32 + i5]), k1 = bf2f(rp[PK + h * 64 + i5]), k2 = bf2f(rp[PK + h * 64 + 32 + i5]);
    const float qr = bflo(pg8::cvt_pk_bf16(lane < 32 ? q1 * cs - q2 * sn : q1 * sn + q2 * cs, 0.f));
    const float kr = bflo(pg8::cvt_pk_bf16((lane < 32 ? k1 * cs - k2 * sn : k1 * sn + k2 * cs) * 0.125f, 0.f));
    const int eq = lane & 31, dpar = lane >> 5;
    const f32x4 v = unpack4(*(const u32x2*)(rp + PV + h * 128 + 4 * eq));
    const float* S0 = P.in[4] + (size_t)((l * NS + s) * 4 + h) * 8192 + 4 * eq; float* S1 = P.out + O_RETS + (size_t)((l * NS + s) * 4 + h) * 8192 + 4 * eq;
    f32x4 o = (f32x4){0.f, 0.f, 0.f, 0.f};
#pragma unroll 8
    for (int it = 0; it < 32; ++it) { const int d = 2 * it + dpar;
        const float qa = __uint_as_float(__builtin_amdgcn_readlane(__float_as_uint(qr), 2 * it)), qb = __uint_as_float(__builtin_amdgcn_readlane(__float_as_uint(qr), 2 * it + 1));
        const float ka = __uint_as_float(__builtin_amdgcn_readlane(__float_as_uint(kr), 2 * it)), kb = __uint_as_float(__builtin_amdgcn_readlane(__float_as_uint(kr), 2 * it + 1));
        const float qd = dpar ? qb : qa, kd = dpar ? kb : ka;
        f32x4 sv = *(const f32x4*)(S0 + d * 128); sv = sv * gam + v * kd; *(f32x4*)(S1 + d * 128) = sv; o = o + sv * qd; }
#pragma unroll
    for (int i = 0; i < 4; ++i) o[i] += __shfl_xor(o[i], 32);
    float sm = (o[0] + o[1]) + (o[2] + o[3]);
#pragma unroll
    for (int x = 1; x < 32; x <<= 1) sm += __shfl_xor(sm, x);
    const float mean = sm * (1.0f / 128.0f); const f32x4 dd = o - mean; float qq = (dd[0] * dd[0] + dd[1] * dd[1]) + (dd[2] * dd[2] + dd[3] * dd[3]);
#pragma unroll
    for (int x = 1; x < 32; x <<= 1) qq += __shfl_xor(qq, x);
    const float rstd = rsqrtf(qq * (1.0f / 128.0f) + EPS);
    if (lane < 32) { const f32x4 g = *(const f32x4*)(P.in[15] + l * 512 + h * 128 + 4 * eq); const f32x4 gate = unpack4(*(const u32x2*)(rp + PG + h * 128 + 4 * eq));
        f32x4 y;
#pragma unroll
        for (int i = 0; i < 4; ++i) y[i] = dd[i] * rstd * g[i] * siluf_(gate[i]);
        *(u32x2*)(MIX + row * D + h * 128 + 4 * eq) = pack4(y); }
}


template <int KS>
__device__ __forceinline__ void skinny_gemm(const bf16_t* A  , const bf16_t* Bt  , bf16_t* O  , unsigned* cnt, MK_LAS unsigned char* lds) {
    int tid_ = threadIdx.x; asm volatile("" : "+v"(tid_)); const int tid = tid_, lane = tid & 63, wave = __builtin_amdgcn_readfirstlane(tid >> 6);
    const int fr = lane & 15, fq = lane >> 4; constexpr int K = KS * 32 * 8;
    for (int it = blockIdx.x; it < 256; it += gridDim.x) {
        const int rb = it & 7, ct = it >> 3;
        const bf16_t* ap = A + (size_t)(NP + 16 * rb + fr) * K + wave * (KS * 32) + 8 * fq;
        const bf16_t* bp = Bt + (size_t)(32 * ct + fr) * K + wave * (KS * 32) + 8 * fq;
        f32x4 acc0 = (f32x4){0.f, 0.f, 0.f, 0.f}, acc1 = acc0;
#pragma unroll
        for (int ks = 0; ks < KS; ++ks) { const bf16x8 a = *(const bf16x8*)(ap + ks * 32), b0 = *(const bf16x8*)(bp + ks * 32), b1 = *(const bf16x8*)(bp + (size_t)16 * K + ks * 32);
            acc0 = MK_MFMA(b0, a, acc0); acc1 = MK_MFMA(b1, a, acc1); }
        MK_LAS f32x4* red = (MK_LAS f32x4*)lds;
        red[(wave * 2 + 0) * 64 + lane] = acc0; red[(wave * 2 + 1) * 64 + lane] = acc1;
        __syncthreads();
        if (wave < 2) { f32x4 sum = red[wave * 64 + lane];
#pragma unroll
            for (int w = 1; w < 8; ++w) sum = sum + red[(w * 2 + wave) * 64 + lane];
            const u32x2 pk = pack4(sum);
            __hip_atomic_store((unsigned long long*)(O + (size_t)(NP + 16 * rb + fr) * D + 32 * ct + 16 * wave + 4 * fq), ((unsigned long long)pk.y << 32) | pk.x, __ATOMIC_RELAXED, __HIP_MEMORY_SCOPE_AGENT);
            asm volatile("s_waitcnt vmcnt(0)" ::: "memory"); }
        __syncthreads();
        if (tid == 0) __hip_atomic_fetch_add(cnt, 1u, __ATOMIC_RELAXED, __HIP_MEMORY_SCOPE_AGENT);
    }
}
__global__ void __launch_bounds__(NTHREADS, 2) mk_fwd(Params P) {
    extern __shared__ __attribute__((aligned(16))) unsigned char lds_raw[];
    MK_LAS unsigned char* lds = (MK_LAS unsigned char*)lds_raw;
    cg::grid_group grid = cg::this_grid();
    if (threadIdx.x < 16) ((MK_LAS unsigned*)(lds + LDS_CTL_OFF))[threadIdx.x] = 0u;
    __syncthreads();
    (void)xcd_barrier_post((unsigned*)(P.ws + WS_CTL), (volatile MK_LAS unsigned*)(lds + LDS_CTL_OFF));
#define GRID_BAR() do { XcdBarrier xb_; xb_.bar = (unsigned*)(P.ws + WS_CTL); xb_.x = xb_xcc_id(); xb_.st = (volatile MK_LAS unsigned*)(lds + LDS_CTL_OFF); xcd_barrier(xb_); } while (0)
    if (P.ws == nullptr) grid.sync();
    const int G = gridDim.x, bx = blockIdx.x;
    unsigned char* ws = P.ws;
    bf16_t* HM = (bf16_t*)(ws + WS_HM); bf16_t* T1 = (bf16_t*)(ws + WS_T1); bf16_t* PROJ = (bf16_t*)(ws + WS_PROJ);

    for (int rep = 0; rep < REP_P0; ++rep) p0_prologue(P, lds);
    GRID_BAR();
    { pg8::Gemm g{(const bf16_t*)(ws + WS_AC), (const bf16_t*)(ws + WS_ADAT), 256, NMOD, D}; pg8::StaticOrder S; S.init(256, NMOD, G, bx);
      EpiMod E{(float*)(ws + WS_MOD), P.in[8]};
      pg8::gemm_phase<EpiMod, pg8::StaticOrder, true, true>(lds, g, S, E); }
    GRID_BAR();
    for (int rep = 0; rep < REP_R0; ++rep) rowpass<0>(P, 0);
    GRID_BAR();
#pragma unroll 1
    for (int l = 0; l < DEPTH; ++l) {
        for (int rep = 0; rep < REP_WIN; ++rep)
        { pg8::Gemm g{HM, (const bf16_t*)(ws + WS_WIN) + (size_t)l * INW * D, MP, INW, D}; pg8::StaticOrder S; S.init(MP, INW, G, bx);
          pg8::EpiBf16<0> E{PROJ, INW, nullptr, 0, 0, 1.f};
          pg8::gemm_phase<pg8::EpiBf16<0>, pg8::StaticOrder, true, true>(lds, g, S, E); }
        GRID_BAR();
        for (int rep = 0; rep < REP_MIX; ++rep) {
        if (rep) GRID_BAR();
        sample_ret(P, l); sample_conv(P, l);
        for (int it = bx; it < 512 + 256; it += G) {
            if (it < 512) ret_u_item(P, lds, it);
            else conv_item(P, lds, l, it - 512);
        }
        GRID_BAR();
        for (int it = bx; it < 512; it += G) ret_o_item(P, lds, l, it);
        }
        GRID_BAR();
        { unsigned* ctl = (unsigned*)(ws + WS_CTL); const int inst = 2 * l;
          skinny_gemm<4>(HM, (const bf16_t*)(ws + WS_WOUT) + (size_t)l * D * D, T1, ctl + CW_SAMPLE + 64 * inst, lds);
          pg8::Gemm g{HM, (const bf16_t*)(ws + WS_WOUT) + (size_t)l * D * D, NP, D, D}; pg8::StaticOrder S; S.init(NP, D, G, bx);
          EpiRmsFused E{&P, l, 1};
          pg8::gemm_phase<EpiRmsFused, pg8::StaticOrder, false, true>(lds, g, S, E);
          sample_rowpass<1>(P, l, ctl + CW_SAMPLE + 64 * inst); }
        GRID_BAR();
        { pg8::Gemm g{HM, (const bf16_t*)(ws + WS_W13) + (size_t)l * NFF1 * D, MP, NFF1, D}; pg8::StaticOrder S; S.init(MP, NFF1, G, bx);
          EpiSwiGLU E{PROJ};
          pg8::gemm_phase<EpiSwiGLU, pg8::StaticOrder, true, true>(lds, g, S, E); }
        GRID_BAR();
        { unsigned* ctl = (unsigned*)(ws + WS_CTL); const int inst = 2 * l + 1;
          skinny_gemm<11>(PROJ, (const bf16_t*)(ws + WS_W2) + (size_t)l * D * DFF, T1, ctl + CW_SAMPLE + 64 * inst, lds);
          pg8::Gemm g{PROJ, (const bf16_t*)(ws + WS_W2) + (size_t)l * D * DFF, NP, D, DFF}; pg8::StaticOrder S; S.init(NP, D, G, bx);
          EpiRmsFused E{&P, l, 2};
          pg8::gemm_phase<EpiRmsFused, pg8::StaticOrder, false, true>(lds, g, S, E);
          sample_rowpass<2>(P, l, ctl + CW_SAMPLE + 64 * inst); }
        if (l + 1 < DEPTH) GRID_BAR();
    }
}
}

extern "C" void kernel_launch(void* const* d_in, const int* in_sizes, int n_in, void* d_out, int out_size, void* d_ws, size_t ws_size, hipStream_t stream) {
    static int grid = 0;
    if (grid == 0) {
        if (n_in != 24 || (size_t)out_size != mk::O_END || ws_size < mk::WS_END) { fprintf(stderr, "kernel_launch: unexpected shapes: n_in %d out %d ws %zu\n", n_in, out_size, ws_size); grid = -1; return; }
        int dev = 0, cus = 0, per_cu = 0;
        hipGetDevice(&dev); hipDeviceGetAttribute(&cus, hipDeviceAttributeMultiprocessorCount, dev);
        hipFuncSetAttribute((const void*)mk::mk_fwd, hipFuncAttributeMaxDynamicSharedMemorySize, mk::LDS_BYTES);
        hipOccupancyMaxActiveBlocksPerMultiprocessor(&per_cu, (const void*)mk::mk_fwd, mk::NTHREADS, mk::LDS_BYTES);
        (void)hipGetLastError();
        if (per_cu < 1) { fprintf(stderr, "kernel_launch: occupancy query says %d blocks per CU\n", per_cu); per_cu = 1; }
        grid = cus;
    }
    if (grid < 0) return;
    if (hipMemsetAsync((char*)d_ws + mk::WS_CTL, 0, mk::CTL_ZERO_BYTES, stream) != hipSuccess) { fprintf(stderr, "kernel_launch: memset failed\n"); return; }
    mk::Params p{};
    for (int i = 0; i < 24; ++i) p.in[i] = (const float*)d_in[i];
    p.out = (float*)d_out; p.ws = (unsigned char*)d_ws;
    void* args[] = {&p};
    hipError_t e = hipLaunchCooperativeKernel((const void*)mk::mk_fwd, dim3(grid), dim3(mk::NTHREADS), args, mk::LDS_BYTES, stream);
    if (e != hipSuccess) fprintf(stderr, "kernel_launch: cooperative launch failed: %s (grid %d)\n", hipGetErrorString(e), grid);
}
```

```cpp
#include <hip/hip_runtime.h>
#include <cstdio>
#include <cstdint>
namespace pg8 {
#define PG8_LAS __attribute__((address_space(3)))
typedef unsigned short bf16_t;
typedef short bf16x8 __attribute__((ext_vector_type(8)));
typedef float f32x4 __attribute__((ext_vector_type(4)));
typedef unsigned u32x4 __attribute__((ext_vector_type(4)));
constexpr int BM = 256, BK = 64, HALF = 128, HTB = HALF * BK * 2  , STAGE_BYTES = 8 * HTB, NXCD = 8, WGM = 8;

__host__ __device__ __forceinline__ int lds_byte(int r, int c) { const int st = (r >> 4) * 2 + (c >> 5), rr = r & 15, cc = c & 31, ob = rr * 64 + cc * 2; return st * 1024 + (ob ^ (((ob >> 9) & 1) << 5)); }
__host__ __device__ __forceinline__ void stage_rc(int b, int& R, int& C) { const int st = b / 1024, sb = b % 1024, swz = sb ^ (((sb >> 9) & 1) << 5); R = (st >> 1) * 16 + swz / 64; C = (st & 1) * 32 + (swz % 64) / 2; }
__host__ __device__ __forceinline__ int perm32(int rho) { const int n = rho >> 4, i = rho & 15; return 8 * (i >> 2) + 4 * n + (i & 3); }

struct Unit { int pm, pn; };
struct Gemm { const bf16_t* A; const bf16_t* Bt; int M, N, K; };

struct StaticOrder {
    int nM, nN, nwg, G, c;
    __host__ __device__ void init(int M, int N, int G_, int c_) { nM = M / BM; nN = N / BM; nwg = nM * nN; G = G_; c = c_; }
    __host__ __device__ bool next(int i, Unit& u) const {
        const long L = (long)i * G + c; if (L >= nwg) return false;
        int wgid = (int)L; { const int q = nwg / NXCD, r = nwg % NXCD, xcd = wgid % NXCD, off = wgid / NXCD; wgid = (xcd < r ? xcd * (q + 1) : r * (q + 1) + (xcd - r) * q) + off; }
        const int nig = WGM * nN, gid = wgid / nig, fm = gid * WGM, gsz = (nM - fm) < WGM ? (nM - fm) : WGM;
        u.pm = fm + ((wgid % nig) % gsz); u.pn = (wgid % nig) / gsz; return true;
    }
    __device__ __forceinline__ void a_ready(const Unit&) const {}
    __device__ __forceinline__ void done(const Unit&) const {}
};

__device__ __forceinline__ unsigned cvt_pk_bf16(float lo, float hi) { unsigned r; asm volatile("v_cvt_pk_bf16_f32 %0, %1, %2" : "=v"(r) : "v"(lo), "v"(hi)); return r; }
typedef float f32x2 __attribute__((ext_vector_type(2)));
__device__ __forceinline__ f32x2 gelu_pk(f32x2 v) {
    const f32x2 av = __builtin_elementwise_abs(v), d = av * 0.2316418882f + 1.0f;
    f32x2 t; t.x = __builtin_amdgcn_rcpf(d.x); t.y = __builtin_amdgcn_rcpf(d.y);
    f32x2 q = t * 0.5307027145f + (-0.7265760135f); q = q * t + 0.7107068705f; q = q * t + (-0.142248368f); q = q * t + 0.127414796f; q = q * t;
    const f32x2 s = (v * v) * (-0.72134752044f);
    f32x2 e; e.x = __builtin_amdgcn_exp2f(s.x); e.y = __builtin_amdgcn_exp2f(s.y);
    const f32x2 m = v * (q * e), r = v - m;
    f32x2 o; o.x = v.x < 0.f ? m.x : r.x; o.y = v.y < 0.f ? m.y : r.y; return o;
}

template <int ACT  > struct EpiBf16 {
    static constexpr bool PERM = true, AFTER_DRAIN = false; static_assert(ACT == 0 || ACT == 1, "EpiBf16: ACT is 0 (none) or 1 (gelu_pk)");
    bf16_t* O; int ldc; const float* bias; int split_cols; size_t split_stride; float scale0;
    __device__ __forceinline__ void operator()(const f32x4 (&acc)[2][2][4][2], const Unit& u, int wr, int wc, int fr, int fq) const {
        const int row0 = u.pm * BM + wr * 64 + fr; int colt = u.pn * BM; bf16_t* base = O;
        float sc = 1.f; if (split_cols) { const int t = colt / split_cols; base += (size_t)t * split_stride; colt -= t * split_cols; if (t == 0) sc = scale0; }
        const int col0 = colt + wc * 32 + 8 * fq, bcol0 = u.pn * BM + wc * 32 + 8 * fq;
        f32x4 bv[2][2];
#pragma unroll
        for (int bj = 0; bj < 2; ++bj)
#pragma unroll
            for (int n = 0; n < 2; ++n) bv[bj][n] = bias ? *(const f32x4*)(bias + bcol0 + bj * HALF + 4 * n) : (f32x4){0.f, 0.f, 0.f, 0.f};
#pragma unroll
        for (int ai = 0; ai < 2; ++ai)
#pragma unroll
            for (int m = 0; m < 4; ++m) { bf16_t* rowp = base + (size_t)(row0 + ai * HALF + m * 16) * ldc + col0;
#pragma unroll
                for (int bj = 0; bj < 2; ++bj) { f32x4 v0 = acc[ai][bj][m][0] + bv[bj][0], v1 = acc[ai][bj][m][1] + bv[bj][1];
                    if (ACT == 1) { f32x2 a = gelu_pk((f32x2){v0[0], v0[1]}), b = gelu_pk((f32x2){v0[2], v0[3]}), c = gelu_pk((f32x2){v1[0], v1[1]}), d = gelu_pk((f32x2){v1[2], v1[3]});
                        v0 = (f32x4){a.x, a.y, b.x, b.y}; v1 = (f32x4){c.x, c.y, d.x, d.y}; }
                    v0 = v0 * sc; v1 = v1 * sc; u32x4 w; w.x = cvt_pk_bf16(v0[0], v0[1]); w.y = cvt_pk_bf16(v0[2], v0[3]); w.z = cvt_pk_bf16(v1[0], v1[1]); w.w = cvt_pk_bf16(v1[2], v1[3]);
                    *(u32x4*)(rowp + bj * HALF) = w; } }
    }
};

struct PanelStats {
    unsigned* xbuf;
    unsigned* cnt;
    unsigned* tmo;
    int ntn; float eps;
    unsigned code;
    __device__ __forceinline__ bool run(const f32x4 (&v)[2][2][4][2], const Unit& u, int wr, int wc, int fr, int fq, PG8_LAS unsigned char* lds, int wid, int lane) const {
        typedef float f32x2v __attribute__((ext_vector_type(2)));
        PG8_LAS f32x2v* P = (PG8_LAS f32x2v*)lds;
        PG8_LAS f32x2v* S = (PG8_LAS f32x2v*)(lds + 8192);
        PG8_LAS unsigned* flag = (PG8_LAS unsigned*)(lds + 8192 + 2048);
#pragma unroll
        for (int ai = 0; ai < 2; ++ai)
#pragma unroll
            for (int m = 0; m < 4; ++m) {
                float s = 0.f;
#pragma unroll
                for (int bj = 0; bj < 2; ++bj)
#pragma unroll
                    for (int n = 0; n < 2; ++n) { const f32x4 x = v[ai][bj][m][n]; s += (x[0] + x[1]) + (x[2] + x[3]); }
                s += __shfl_xor(s, 16); s += __shfl_xor(s, 32);
                const float mw = s * (1.0f / 64.0f); float q = 0.f;
#pragma unroll
                for (int bj = 0; bj < 2; ++bj)
#pragma unroll
                    for (int n = 0; n < 2; ++n) { const f32x4 d = v[ai][bj][m][n] - mw; q += (d[0] * d[0] + d[1] * d[1]) + (d[2] * d[2] + d[3] * d[3]); }
                q += __shfl_xor(q, 16); q += __shfl_xor(q, 32);
                if (fq == 0) P[(ai * HALF + wr * 64 + m * 16 + fr) * 4 + wc] = (f32x2v){mw, q};
            }
        asm volatile("s_waitcnt lgkmcnt(0)" ::: "memory"); __builtin_amdgcn_s_barrier(); asm volatile("" ::: "memory");
#if defined(BROKEN_EXCHANGE_NO_WAIT)
#warning BROKEN CONTROL BUILD: the row-statistics exchange does not wait; results are wrong by design
        if (blockIdx.x >= 64) { const long long t0_ = clock64(); while (clock64() - t0_ < 60000) __builtin_amdgcn_s_sleep(8); }
#endif
        const int row = wid * 32 + (lane & 31);
        if (lane < 32) {
            const f32x2v a = P[row * 4 + 0], b = P[row * 4 + 1], c = P[row * 4 + 2], d = P[row * 4 + 3];
            const float mt = (a.x + b.x + c.x + d.x) * 0.25f;
            const float da = a.x - mt, db = b.x - mt, dc = c.x - mt, dd = d.x - mt;
            const float m2 = (a.y + b.y) + (c.y + d.y) + 64.0f * ((da * da + db * db) + (dc * dc + dd * dd));
            unsigned long long* slot = (unsigned long long*)xbuf + ((size_t)(u.pm * BM + row) * 4 + u.pn);
            __hip_atomic_store(slot, ((unsigned long long)__float_as_uint(m2) << 32) | __float_as_uint(mt), __ATOMIC_RELAXED, __HIP_MEMORY_SCOPE_AGENT);
        }
        asm volatile("s_waitcnt vmcnt(0)" ::: "memory");
        if (lane == 0) __hip_atomic_fetch_add(cnt + 64 * u.pm, 1u, __ATOMIC_RELAXED, __HIP_MEMORY_SCOPE_AGENT);
        if (wid == 0) {
            bool dead = false; const unsigned long long t0 = __builtin_amdgcn_s_memrealtime(); const unsigned want = 8u * (unsigned)ntn;
            for (;;) {
#if defined(BROKEN_EXCHANGE_NO_WAIT)
                break;
#endif
                if ((unsigned)__builtin_amdgcn_readfirstlane(__hip_atomic_load(cnt + 64 * u.pm, __ATOMIC_RELAXED, __HIP_MEMORY_SCOPE_AGENT)) >= want) break;
                if (__builtin_amdgcn_s_memrealtime() - t0 > 2000000ull) {
                    if (lane == 0) { unsigned expect = 0u; __hip_atomic_compare_exchange_strong(tmo + 1, &expect, code | (unsigned)(u.pm & 0xff), __ATOMIC_RELAXED, __ATOMIC_RELAXED, __HIP_MEMORY_SCOPE_AGENT);
                                     __hip_atomic_store(tmo, 1u, __ATOMIC_RELAXED, __HIP_MEMORY_SCOPE_AGENT); }
                    dead = true; break; }
                __builtin_amdgcn_s_sleep(2);
            }
            __builtin_amdgcn_fence(__ATOMIC_ACQUIRE, "agent");
            if (lane == 0) flag[0] = dead ? 1u : 0u;
        }
        asm volatile("s_waitcnt vmcnt(0) lgkmcnt(0)" ::: "memory"); __builtin_amdgcn_s_barrier(); asm volatile("" ::: "memory");
        const bool bad = flag[0] != 0u;
        if (lane < 32) {
            const unsigned long long* slot = (const unsigned long long*)xbuf + (size_t)(u.pm * BM + row) * 4; float mt[4], m2[4]; float ms = 0.f;
#pragma unroll
            for (int t = 0; t < 4; ++t) { if (t < ntn) { const unsigned long long w = __hip_atomic_load(slot + t, __ATOMIC_RELAXED, __HIP_MEMORY_SCOPE_AGENT); mt[t] = __uint_as_float((unsigned)w); m2[t] = __uint_as_float((unsigned)(w >> 32)); } else { mt[t] = 0.f; m2[t] = 0.f; } ms += mt[t]; }
            const float mean = ms / (float)ntn; float q = 0.f;
#pragma unroll
            for (int t = 0; t < 4; ++t) if (t < ntn) { const float dm = mt[t] - mean; q += m2[t] + 256.0f * dm * dm; }
            S[row] = (f32x2v){mean, 1.0f / sqrtf(q / (256.0f * (float)ntn) + eps)};
        }
        asm volatile("s_waitcnt lgkmcnt(0)" ::: "memory"); __builtin_amdgcn_s_barrier(); asm volatile("" ::: "memory");
        return bad;
    }
};
struct EpiLnRes {
    static constexpr bool PERM = false, AFTER_DRAIN = true;
    const float* base; float* out; int ldc; const float* bias; PanelStats st; unsigned poison;
    __device__ __forceinline__ void fused(f32x4 (&acc)[2][2][4][2], const Unit& u, int wr, int wc, int fr, int fq, PG8_LAS unsigned char* lds, int wid, int lane) const {
        typedef float f32x2v __attribute__((ext_vector_type(2)));
        const PG8_LAS f32x2v* S = (const PG8_LAS f32x2v*)(lds + 8192);
        const int col0 = u.pn * BM + wc * 32 + 4 * fq;
#pragma unroll
        for (int bj = 0; bj < 2; ++bj)
#pragma unroll
            for (int n = 0; n < 2; ++n) { const f32x4 bv = bias ? *(const f32x4*)(bias + col0 + bj * HALF + n * 16) : (f32x4){0.f, 0.f, 0.f, 0.f};
#pragma unroll
                for (int ai = 0; ai < 2; ++ai)
#pragma unroll
                    for (int m = 0; m < 4; ++m) acc[ai][bj][m][n] += bv; }
        f32x4 pre[4][2][2];
#pragma unroll
        for (int m = 0; m < 4; ++m) { const size_t off = (size_t)(u.pm * BM + wr * 64 + m * 16 + fr) * ldc + col0;
#pragma unroll
            for (int bj = 0; bj < 2; ++bj)
#pragma unroll
                for (int n = 0; n < 2; ++n) pre[m][bj][n] = *(const f32x4*)(base + off + bj * HALF + n * 16); }
        const bool bad = st.run(acc, u, wr, wc, fr, fq, lds, wid, lane) || poison != 0u;
        const float qnan = __builtin_nanf("");
#pragma unroll
        for (int ai = 0; ai < 2; ++ai)
#pragma unroll
            for (int m = 0; m < 4; ++m) { const int r = ai * HALF + wr * 64 + m * 16 + fr; const f32x2v sr = S[r]; const size_t off = (size_t)(u.pm * BM + r) * ldc + col0;
#pragma unroll
                for (int bj = 0; bj < 2; ++bj)
#pragma unroll
                    for (int n = 0; n < 2; ++n) { const f32x4 bs = ai == 0 ? pre[m][bj][n] : *(const f32x4*)(base + off + bj * HALF + n * 16); f32x4 o = bs + (acc[ai][bj][m][n] - sr.x) * sr.y;
                        if (bad) o = (f32x4){qnan, qnan, qnan, qnan}; *(f32x4*)(out + off + bj * HALF + n * 16) = o; }
                if (m & 1) asm volatile("" ::: "memory"); }
    }
};
struct EpiLnResLn {
    static constexpr bool PERM = false, AFTER_DRAIN = true;
    const float* base; float* out; bf16_t* xn; int ldc; const float* bias; PanelStats st1, st2; unsigned poison;
    __device__ __forceinline__ void fused(f32x4 (&acc)[2][2][4][2], const Unit& u, int wr, int wc, int fr, int fq, PG8_LAS unsigned char* lds, int wid, int lane) const {
        typedef float f32x2v __attribute__((ext_vector_type(2))); typedef unsigned u32x2v __attribute__((ext_vector_type(2)));
        const PG8_LAS f32x2v* S = (const PG8_LAS f32x2v*)(lds + 8192);
        const int col0 = u.pn * BM + wc * 32 + 4 * fq;
#pragma unroll
        for (int bj = 0; bj < 2; ++bj)
#pragma unroll
            for (int n = 0; n < 2; ++n) { const f32x4 bv = bias ? *(const f32x4*)(bias + col0 + bj * HALF + n * 16) : (f32x4){0.f, 0.f, 0.f, 0.f};
#pragma unroll
                for (int ai = 0; ai < 2; ++ai)
#pragma unroll
                    for (int m = 0; m < 4; ++m) acc[ai][bj][m][n] += bv; }
        bool bad = st1.run(acc, u, wr, wc, fr, fq, lds, wid, lane) || poison != 0u;
        const float qnan = __builtin_nanf("");
#pragma unroll
        for (int ai = 0; ai < 2; ++ai)
#pragma unroll
            for (int m = 0; m < 4; ++m) { const int r = ai * HALF + wr * 64 + m * 16 + fr; const f32x2v sr = S[r]; const size_t off = (size_t)(u.pm * BM + r) * ldc + col0;
#pragma unroll
                for (int bj = 0; bj < 2; ++bj)
#pragma unroll
                    for (int n = 0; n < 2; ++n) { const f32x4 bs = *(const f32x4*)(base + off + bj * HALF + n * 16); acc[ai][bj][m][n] = bs + (acc[ai][bj][m][n] - sr.x) * sr.y; }
                asm volatile("" : "+v"(acc[ai][0][m][0]), "+v"(acc[ai][0][m][1]), "+v"(acc[ai][1][m][0]), "+v"(acc[ai][1][m][1]));
                if (m & 1) asm volatile("" ::: "memory"); }
        const bool bad1 = bad;
        bad = st2.run(acc, u, wr, wc, fr, fq, lds, wid, lane) || bad;
#pragma unroll
        for (int ai = 0; ai < 2; ++ai)
#pragma unroll
            for (int m = 0; m < 4; ++m) { const int r = ai * HALF + wr * 64 + m * 16 + fr; const f32x2v sr = S[r]; const size_t off = (size_t)(u.pm * BM + r) * ldc + col0;
#pragma unroll
                for (int bj = 0; bj < 2; ++bj)
#pragma unroll
                    for (int n = 0; n < 2; ++n) { const f32x4 x1 = acc[ai][bj][m][n]; *(f32x4*)(out + off + bj * HALF + n * 16) = bad1 ? (f32x4){qnan, qnan, qnan, qnan} : x1;
                        const f32x4 o = (x1 - sr.x) * sr.y; u32x2v w; w.x = cvt_pk_bf16(o[0], o[1]); w.y = cvt_pk_bf16(o[2], o[3]);
                        if (bad) { w.x = 0x7fc07fc0u; w.y = 0x7fc07fc0u; } *(u32x2v*)(xn + off + bj * HALF + n * 16) = w; }
                asm volatile("" ::: "memory"); }
    }
};

template <class Epi, class Sched, bool ALIGN_EPI = false, bool SP2 = false>
__device__ __forceinline__ void gemm_phase(PG8_LAS unsigned char* lds, const Gemm g, const Sched& S, const Epi& E) {
    int tid_ = threadIdx.x; asm volatile("" : "+v"(tid_));
    const int tid = tid_, wid = __builtin_amdgcn_readfirstlane(tid >> 6), lane = tid & 63, wr = wid >> 2, wc = wid & 3, fr = lane & 15, fq = lane >> 4;
    const int K = g.K, nt = K / BK;
    unsigned voffA[2], voffB[2];
#pragma unroll
    for (int i = 0; i < 2; ++i) { int R, C; stage_rc(tid * 16 + i * 8192, R, C); const int Rb = Epi::PERM ? ((R & ~31) + perm32(R & 31)) : R;
        voffA[i] = (unsigned)(R * K + C) * 2u; voffB[i] = (unsigned)(Rb * K + C) * 2u; }
    const size_t kstep = (size_t)(BK * 2);
    const size_t hstep = (size_t)HALF * K * 2;
    const size_t tstep = 2 * hstep;
    const unsigned ldsw = (unsigned)wid * 1024u;
    const int aoff = lds_byte(wr * 64 + fr, fq * 8), boff = lds_byte(wc * 32 + fr, fq * 8);
#define PG8_SA(b, h) (((b) * 2 + (h)) * HTB)
#define PG8_SB(b, h) ((4 + (b) * 2 + (h)) * HTB)
#define PG8_STAGE(bufoff, gbase, voff) do { _Pragma("unroll") for (int _i = 0; _i < 2; ++_i) \
        __builtin_amdgcn_global_load_lds((const unsigned*)((const char*)(gbase) + (voff)[_i]), (PG8_LAS unsigned*)(lds + (bufoff) + ldsw + _i * 8192), 16, 0, 0); } while (0)
#define PG8_LDA(dst, b, h) do { _Pragma("unroll") for (int m = 0; m < 4; ++m) _Pragma("unroll") for (int k = 0; k < 2; ++k) dst[m][k] = *(const PG8_LAS bf16x8*)(lds + PG8_SA(b, h) + aoff + m * 2048 + k * 1024); } while (0)
#define PG8_LDB(dst, b, h) do { _Pragma("unroll") for (int n = 0; n < 2; ++n) _Pragma("unroll") for (int k = 0; k < 2; ++k) dst[n][k] = *(const PG8_LAS bf16x8*)(lds + PG8_SB(b, h) + boff + n * 2048 + k * 1024); } while (0)
#define PG8_MMA(ai, bj, At, Bt) do { __builtin_amdgcn_s_setprio(1); _Pragma("unroll") for (int m = 0; m < 4; ++m) _Pragma("unroll") for (int n = 0; n < 2; ++n) _Pragma("unroll") for (int k = 0; k < 2; ++k) \
        acc[ai][bj][m][n] = __builtin_amdgcn_mfma_f32_16x16x32_bf16(Bt[n][k], At[m][k], acc[ai][bj][m][n], 0, 0, 0); __builtin_amdgcn_s_setprio(0); } while (0)
#define PG8_WAIT_V(n) asm volatile("s_waitcnt vmcnt(" #n ")" ::: "memory")
#define PG8_WAIT_L(n) asm volatile("s_waitcnt lgkmcnt(" #n ")" ::: "memory")
#define PG8_BAR __builtin_amdgcn_s_barrier()
#define PG8_SCHED __builtin_amdgcn_sched_barrier(0)
    Unit cur, nxt; int ui = 0;
    if (!S.next(0, cur)) return;
    f32x4 acc[2][2][4][2];
#pragma unroll
    for (int a = 0; a < 2; ++a)
#pragma unroll
        for (int b = 0; b < 2; ++b)
#pragma unroll
            for (int m = 0; m < 4; ++m)
#pragma unroll
                for (int n = 0; n < 2; ++n) acc[a][b][m][n] = (f32x4){0.f, 0.f, 0.f, 0.f};
    bf16x8 At[4][2], B0[2][2], B1[2][2];
    const char* cA = (const char*)g.A + (size_t)cur.pm * tstep; const char* cB = (const char*)g.Bt + (size_t)cur.pn * tstep;
    S.a_ready(cur);
    if constexpr (SP2) {
        PG8_STAGE(PG8_SB(0, 0), cB, voffB); PG8_STAGE(PG8_SB(0, 1), cB + hstep, voffB); PG8_STAGE(PG8_SA(0, 0), cA, voffA); PG8_STAGE(PG8_SA(0, 1), cA + hstep, voffA);
        if (wr == 1) PG8_BAR;
        PG8_WAIT_V(2); PG8_BAR;
        PG8_STAGE(PG8_SB(1, 0), cB + kstep, voffB); PG8_STAGE(PG8_SA(1, 0), cA + kstep, voffA); PG8_STAGE(PG8_SB(1, 1), cB + hstep + kstep, voffB);
        PG8_WAIT_V(6); PG8_BAR;
    } else {
        PG8_STAGE(PG8_SB(0, 0), cB, voffB); PG8_STAGE(PG8_SA(0, 0), cA, voffA); PG8_STAGE(PG8_SB(0, 1), cB + hstep, voffB); PG8_STAGE(PG8_SA(0, 1), cA + hstep, voffA);
        if (wr == 1) PG8_BAR;
        PG8_WAIT_V(4); PG8_BAR;
        PG8_STAGE(PG8_SB(1, 0), cB + kstep, voffB); PG8_STAGE(PG8_SA(1, 0), cA + kstep, voffA); PG8_STAGE(PG8_SB(1, 1), cB + hstep + kstep, voffB);
        PG8_WAIT_V(6); PG8_BAR;
    }
    for (;;) {
        const bool has_next = S.next(ui + 1, nxt);
        const char* nA = has_next ? (const char*)g.A + (size_t)nxt.pm * tstep : cA; const char* nB = has_next ? (const char*)g.Bt + (size_t)nxt.pn * tstep : cB;
        for (int t = 0; t < nt; t += 2) {
            const bool last = (t == nt - 2);
            const char* a1 = cA + (size_t)(t + 1) * kstep;
            const char* a2 = last ? nA : cA + (size_t)(t + 2) * kstep; const char* b2 = last ? nB : cB + (size_t)(t + 2) * kstep;
            const char* a3 = a2 + kstep; const char* b3 = b2 + kstep;
            if (last && has_next) S.a_ready(nxt);
            if constexpr (SP2) {
            PG8_LDB(B0, 0, 0); PG8_LDB(B1, 0, 1); PG8_SCHED; PG8_LDA(At, 0, 0); PG8_STAGE(PG8_SA(1, 1), a1 + hstep, voffA);
            PG8_WAIT_V(8); PG8_WAIT_L(0); PG8_BAR; PG8_MMA(0, 0, At, B0); PG8_MMA(0, 1, At, B1); PG8_BAR; PG8_SCHED;
            PG8_LDA(At, 0, 1); PG8_STAGE(PG8_SB(0, 0), b2, voffB); PG8_STAGE(PG8_SB(0, 1), b2 + hstep, voffB); PG8_STAGE(PG8_SA(0, 0), a2, voffA);
            PG8_WAIT_V(8); PG8_WAIT_L(0); PG8_BAR; PG8_MMA(1, 0, At, B0); PG8_MMA(1, 1, At, B1); PG8_BAR; PG8_SCHED;
            PG8_LDB(B0, 1, 0); PG8_LDB(B1, 1, 1); PG8_SCHED; PG8_LDA(At, 1, 0); PG8_STAGE(PG8_SA(0, 1), a2 + hstep, voffA);
            PG8_WAIT_V(8); PG8_WAIT_L(0); PG8_BAR; PG8_MMA(0, 0, At, B0); PG8_MMA(0, 1, At, B1); PG8_BAR; PG8_SCHED;
            PG8_LDA(At, 1, 1); PG8_STAGE(PG8_SB(1, 0), b3, voffB); PG8_STAGE(PG8_SB(1, 1), b3 + hstep, voffB); PG8_STAGE(PG8_SA(1, 0), a3, voffA);
            PG8_WAIT_V(8); PG8_WAIT_L(0); PG8_BAR; PG8_MMA(1, 0, At, B0); PG8_MMA(1, 1, At, B1); PG8_BAR; PG8_SCHED;
            } else {
            PG8_LDB(B0, 0, 0); PG8_SCHED; PG8_LDA(At, 0, 0); PG8_STAGE(PG8_SA(1, 1), a1 + hstep, voffA);
            PG8_WAIT_L(8); PG8_BAR; PG8_WAIT_L(0); PG8_MMA(0, 0, At, B0); PG8_BAR; PG8_SCHED;
            PG8_LDB(B1, 0, 1); PG8_STAGE(PG8_SB(0, 0), b2, voffB);
            PG8_BAR; PG8_WAIT_L(0); PG8_MMA(0, 1, At, B1); PG8_BAR;
            PG8_LDA(At, 0, 1); PG8_STAGE(PG8_SA(0, 0), a2, voffA);
            PG8_BAR; PG8_WAIT_L(0); PG8_MMA(1, 0, At, B0); PG8_BAR; PG8_SCHED;
            PG8_STAGE(PG8_SB(0, 1), b2 + hstep, voffB);
            PG8_WAIT_V(6); PG8_BAR; PG8_MMA(1, 1, At, B1); PG8_BAR;
            PG8_LDB(B0, 1, 0); PG8_SCHED; PG8_LDA(At, 1, 0); PG8_STAGE(PG8_SA(0, 1), a2 + hstep, voffA);
            PG8_WAIT_L(8); PG8_BAR; PG8_WAIT_L(0); PG8_MMA(0, 0, At, B0); PG8_BAR; PG8_SCHED;
            PG8_LDB(B1, 1, 1); PG8_STAGE(PG8_SB(1, 0), b3, voffB);
            PG8_BAR; PG8_WAIT_L(0); PG8_MMA(0, 1, At, B1); PG8_BAR;
            PG8_LDA(At, 1, 1); PG8_STAGE(PG8_SA(1, 0), a3, voffA);
            PG8_BAR; PG8_WAIT_L(0); PG8_MMA(1, 0, At, B0); PG8_BAR; PG8_SCHED;
            PG8_STAGE(PG8_SB(1, 1), b3 + hstep, voffB);
            PG8_WAIT_V(6); PG8_BAR; PG8_MMA(1, 1, At, B1); PG8_BAR;
            }
        }
        if constexpr (ALIGN_EPI) { if (wr == 0) PG8_BAR; }
        if constexpr (!Epi::AFTER_DRAIN) { E(acc, cur, wr, wc, fr, fq); S.done(cur); }
        if (!has_next) break;
#pragma unroll
        for (int a = 0; a < 2; ++a)
#pragma unroll
            for (int b = 0; b < 2; ++b)
#pragma unroll
                for (int m = 0; m < 4; ++m)
#pragma unroll
                    for (int n = 0; n < 2; ++n) acc[a][b][m][n] = (f32x4){0.f, 0.f, 0.f, 0.f};
        cur = nxt; cA = nA; cB = nB; ++ui;
        if constexpr (ALIGN_EPI) { if (wr == 1) PG8_BAR; }
    }
    PG8_WAIT_V(0);
    if constexpr (!ALIGN_EPI) { if (wr == 0) PG8_BAR; }
    PG8_BAR;
    if constexpr (Epi::AFTER_DRAIN) { E.fused(acc, cur, wr, wc, fr, fq, lds, wid, lane); S.done(cur); }
#undef PG8_SA
#undef PG8_SB
#undef PG8_STAGE
#undef PG8_LDA
#undef PG8_LDB
#undef PG8_MMA
#undef PG8_WAIT_V
#undef PG8_WAIT_L
#undef PG8_BAR
#undef PG8_SCHED
}
}

#include <hip/hip_cooperative_groups.h>
namespace cg = cooperative_groups;
namespace mk {
using pg8::bf16_t; using pg8::bf16x8; using pg8::f32x4; using pg8::u32x4;
#define MK_LAS __attribute__((address_space(3)))
typedef unsigned u32x2 __attribute__((ext_vector_type(2)));
typedef float f32x2v __attribute__((ext_vector_type(2)));

#define LAS MK_LAS
#define XB_TMO      128
#define XB_XCNT(j)  (256  + 64 * (j))
#define XB_XSUB(j)  (1280 + 64 * (j))
#define XB_XGEN(j)  (2304 + 64 * (j))
#define XB_TOP      3328
#define XB_TOPGEN   3392
#define XCD_BAR_WORDS 3456
#define XB_SPIN_CAP (1u << 18)

__device__ __forceinline__ unsigned xb_ld(unsigned* p)              { return __hip_atomic_load(p, __ATOMIC_RELAXED, __HIP_MEMORY_SCOPE_AGENT); }
__device__ __forceinline__ unsigned xb_add(unsigned* p, unsigned v) { return __hip_atomic_fetch_add(p, v, __ATOMIC_RELAXED, __HIP_MEMORY_SCOPE_AGENT); }
__device__ __forceinline__ unsigned xb_xcc_id() { return (unsigned)__builtin_amdgcn_s_getreg((3 << 11) | 20) & 0xFu; }
#define XB_SPIN(cond, bar) do { unsigned _sp = 0; while (cond) { __builtin_amdgcn_s_sleep(1); \
    if ((++_sp & 255u) == 0u) { if (xb_ld(&(bar)[XB_TMO])) break; if (_sp > XB_SPIN_CAP) { atomicAdd(&(bar)[XB_TMO], 1u); break; } } } } while (0)

struct XcdBarrier {
    unsigned* bar; unsigned x;
    volatile LAS unsigned* st;
};

__device__ __forceinline__ XcdBarrier xcd_barrier_post(unsigned* bar, volatile LAS unsigned* st) {
    XcdBarrier b; b.bar = bar; b.x = xb_xcc_id(); b.st = st;
    if (threadIdx.x == 0) (void)xb_add(&bar[XB_XCNT(b.x)], 1u);
    return b;
}
__device__ __forceinline__ void xcd_barrier_complete(unsigned* bar, unsigned x, unsigned& nloc, unsigned& nx) {
    const unsigned G = gridDim.x * gridDim.y * gridDim.z;
    unsigned sum, cnt, mine, sp = 0u;
    for (;;) {
        sum = 0u; cnt = 0u; mine = 0u;
#pragma unroll
        for (unsigned j = 0; j < 16; ++j) { const unsigned c = xb_ld(&bar[XB_XCNT(j)]); sum += c; cnt += (c > 0u) ? 1u : 0u; mine = (j == x) ? c : mine; }
        if (sum == G) break;
        __builtin_amdgcn_s_sleep(1);
        if ((++sp & 255u) == 0u) { if (xb_ld(&bar[XB_TMO])) break; if (sp > XB_SPIN_CAP) { atomicAdd(&bar[XB_TMO], 1u); break; } }
    }
    nloc = mine > 0u ? mine : 1u; nx = cnt > 0u ? cnt : 1u;
}

__device__ __forceinline__ void xcd_barrier(const XcdBarrier& b) {
    asm volatile("s_waitcnt vmcnt(0)" ::: "memory");
    __syncthreads();
    if (threadIdx.x == 0) {
        unsigned* bar = b.bar;
        __builtin_amdgcn_s_waitcnt(0);
        unsigned nloc = b.st[0], nx = b.st[1];
        if (nloc == 0u) { xcd_barrier_complete(bar, b.x, nloc, nx); b.st[0] = nloc; b.st[1] = nx; }
        const unsigned old = xb_add(&bar[XB_XSUB(b.x)], 1u);
        const unsigned gen = old / nloc;
        if (old + 1u == (gen + 1u) * nloc) {
            __builtin_amdgcn_fence(__ATOMIC_RELEASE, "agent");
            asm volatile("s_waitcnt vmcnt(0)" ::: "memory");
            const unsigned og = xb_add(&bar[XB_TOP], 1u);
            const unsigned tg = og / nx;
            if (og + 1u == (tg + 1u) * nx) xb_add(&bar[XB_TOPGEN], 1u);
            else XB_SPIN(xb_ld(&bar[XB_TOPGEN]) == tg, bar);
            __builtin_amdgcn_fence(__ATOMIC_ACQUIRE, "agent");
            xb_add(&bar[XB_XGEN(b.x)], 1u);
            asm volatile("s_waitcnt vmcnt(0)" ::: "memory");
        } else {
            XB_SPIN(xb_ld(&bar[XB_XGEN(b.x)]) == gen, bar);
            __builtin_amdgcn_fence(__ATOMIC_ACQUIRE, "agent");
            asm volatile("s_waitcnt vmcnt(0)" ::: "memory");
        }
    }
    __syncthreads();
}

#undef LAS
constexpr int D = 1024, NP = 16384, NS = 128, MR = NP + NS, MP = 16640, SEQ = 2048, NB = 8;
constexpr int INW = 2816, DFF = 2816, NFF1 = 5632, NMOD = 12288, MODROWS = 136, DEPTH = 2;
constexpr float EPS = 1e-6f;
constexpr int NWAVES = 8, NTHREADS = 512;
#ifndef REP_P0
#define REP_P0 1
#endif
#ifndef REP_MIX
#define REP_MIX 1
#endif
#ifndef REP_R0
#define REP_R0 1
#endif
#ifndef REP_WIN
#define REP_WIN 1
#endif
#ifndef REP_F2
#define REP_F2 1
#endif
constexpr int LDS_BYTES = 163840;

constexpr int PQ = 0, PK = 256, PV = 512, PG = 1024, PAV = 1536, PAG = 1792, PCB = 2048, PCC = 2304, PCX = 2560;

constexpr size_t MiB = 1u << 20;
constexpr size_t WS_CTL = 0, CTL_ZERO_BYTES = 98304;
constexpr int LDS_CTL_OFF = 163584;
constexpr int CW_SAMPLE = 3840, CW_PANEL = 4096;
constexpr int CW_SCAN = 3584;
static_assert(XCD_BAR_WORDS <= CW_SCAN && (CW_SCAN + 64) * 4 <= CTL_ZERO_BYTES && (CW_PANEL + 4 * 4096) * 4 <= CTL_ZERO_BYTES, "ctl");
constexpr size_t WS_WIN = 1 * MiB, WS_WOUT = 12 * MiB, WS_W13 = 16 * MiB, WS_W2 = 38 * MiB, WS_MOD = 49 * MiB, WS_HM = 56 * MiB,
                 WS_T1 = 89 * MiB, WS_PROJ = 122 * MiB, WS_U = 212 * MiB, WS_SS = 228 * MiB, WS_X = 236 * MiB, WS_T1S = 240 * MiB, WS_END = 241 * MiB;
constexpr size_t WS_XB = WS_T1;
constexpr size_t WS_ADAT = WS_T1, WS_AC = WS_T1 + 24 * MiB;
static_assert(WS_WIN + (size_t)DEPTH * INW * D * 2 <= WS_WOUT && WS_WOUT + (size_t)DEPTH * D * D * 2 <= WS_W13 && WS_W13 + (size_t)DEPTH * NFF1 * D * 2 <= WS_W2 &&
              WS_W2 + (size_t)DEPTH * D * DFF * 2 <= WS_MOD && WS_MOD + (size_t)MODROWS * NMOD * 4 <= WS_HM && WS_HM + (size_t)MP * D * 2 <= WS_T1 &&
              WS_T1 + (size_t)MP * D * 2 <= WS_PROJ && WS_AC + 256 * D * 2 <= WS_PROJ && WS_PROJ + (size_t)MP * INW * 2 <= WS_U && WS_U + (size_t)512 * 8192 * 4 <= WS_SS && WS_SS + (size_t)512 * 8192 * 2 <= WS_END, "ws map");

constexpr size_t O_Y = 0, O_YS = (size_t)NP * D, O_RETP = O_YS + (size_t)NS * D, O_CAP = O_RETP + (size_t)DEPTH * NB * 4 * 64 * 128,
                 O_CCP = O_CAP + (size_t)DEPTH * NB * 30 * 256, O_RETS = O_CCP + (size_t)DEPTH * NB * 2 * 256,
                 O_CAS = O_RETS + (size_t)DEPTH * NS * 4 * 64 * 128, O_CCS = O_CAS + (size_t)DEPTH * NS * 30 * 256, O_END = O_CCS + (size_t)DEPTH * NS * 2 * 256;

struct Params { const float* in[24]; float* out; unsigned char* ws; };

__device__ const double kInvRev[32] = {
0.15915494309189535, 0.11934937021124886, 0.08949940160889101, 0.06711508300522726, 0.050329212104487035, 0.03774158471741977, 0.0283021958306234, 0.02122365276477766,
0.015915494309189534, 0.011934937021124886, 0.008949940160889102, 0.006711508300522725, 0.005032921210448704, 0.003774158471741977, 0.00283021958306234, 0.0021223652764777662,
0.0015915494309189536, 0.0011934937021124885, 0.0008949940160889102, 0.0006711508300522726, 0.0005032921210448703, 0.00037741584717419774, 0.00028302195830623395, 0.0002122365276477766,
0.00015915494309189535, 0.00011934937021124886, 8.949940160889102e-05, 6.711508300522725e-05, 5.0329212104487035e-05, 3.774158471741978e-05, 2.8302195830623396e-05, 2.122365276477766e-05};

__device__ __forceinline__ float bf2f(unsigned short b) { return __uint_as_float((unsigned)b << 16); }
__device__ __forceinline__ float bflo(unsigned w) { return __uint_as_float(w << 16); }
__device__ __forceinline__ float bfhi(unsigned w) { return __uint_as_float(w & 0xffff0000u); }
__device__ __forceinline__ f32x4 unpack4(u32x2 w) { return (f32x4){bflo(w.x), bfhi(w.x), bflo(w.y), bfhi(w.y)}; }
__device__ __forceinline__ u32x2 pack4(f32x4 v) { u32x2 w; w.x = pg8::cvt_pk_bf16(v[0], v[1]); w.y = pg8::cvt_pk_bf16(v[2], v[3]); return w; }
__device__ __forceinline__ float sigmoidf_(float x) { return __builtin_amdgcn_rcpf(1.0f + __expf(-x)); }
__device__ __forceinline__ float siluf_(float x) { return x * sigmoidf_(x); }
__device__ __forceinline__ float wave_sum(float v) {
#pragma unroll
    for (int o = 1; o < 64; o <<= 1) v += __shfl_xor(v, o);
    return v;
}
__device__ __forceinline__ float log2_gamma(int h) { return __log2f(1.0f - exp2f(-5.0f - (float)h)); }

struct EpiMod {
    static constexpr bool PERM = false, AFTER_DRAIN = false;
    float* O; const float* bias;
    __device__ __forceinline__ void operator()(const f32x4 (&acc)[2][2][4][2], const pg8::Unit& u, int wr, int wc, int fr, int fq) const {
        const int col0 = u.pn * 256 + wc * 32 + 4 * fq;
#pragma unroll
        for (int ai = 0; ai < 2; ++ai)
#pragma unroll
            for (int m = 0; m < 4; ++m) { const int row = u.pm * 256 + ai * 128 + wr * 64 + m * 16 + fr;
                if (row < MODROWS) {
#pragma unroll
                    for (int bj = 0; bj < 2; ++bj)
#pragma unroll
                        for (int n = 0; n < 2; ++n) { const int col = col0 + bj * 128 + n * 16; *(f32x4*)(O + (size_t)row * NMOD + col) = acc[ai][bj][m][n] + *(const f32x4*)(bias + col); } } }
    }
};
struct EpiSwiGLU {
    static constexpr bool PERM = true, AFTER_DRAIN = false;
    bf16_t* O;
    __device__ __forceinline__ void operator()(const f32x4 (&acc)[2][2][4][2], const pg8::Unit& u, int wr, int wc, int fr, int fq) const {
        const int col0 = u.pn * 128 + wc * 32 + 8 * fq;
#pragma unroll
        for (int ai = 0; ai < 2; ++ai)
#pragma unroll
            for (int m = 0; m < 4; ++m) { bf16_t* rowp = O + (size_t)(u.pm * 256 + ai * 128 + wr * 64 + m * 16 + fr) * DFF + col0;
                f32x4 a0 = acc[ai][0][m][0], a1 = acc[ai][0][m][1]; const f32x4 b0 = acc[ai][1][m][0], b1 = acc[ai][1][m][1];
#pragma unroll
                for (int i = 0; i < 4; ++i) { a0[i] = siluf_(a0[i]) * b0[i]; a1[i] = siluf_(a1[i]) * b1[i]; }
                u32x4 w; w.x = pg8::cvt_pk_bf16(a0[0], a0[1]); w.y = pg8::cvt_pk_bf16(a0[2], a0[3]); w.z = pg8::cvt_pk_bf16(a1[0], a1[1]); w.w = pg8::cvt_pk_bf16(a1[2], a1[3]);
                *(u32x4*)rowp = w; }
    }
};

__device__ __forceinline__ void p0_transpose_item(const float* W, int K, int N, bf16_t* WT, int k0, int n0, int orow, MK_LAS float* scr, int lane) {
    const int cq = lane & 15, r0 = lane >> 4;
    f32x4 v[16];
#pragma unroll
    for (int i = 0; i < 16; ++i) v[i] = *(const f32x4*)(W + (size_t)(k0 + 4 * i + r0) * N + n0 + 4 * cq);
#pragma unroll
    for (int i = 0; i < 16; ++i) { const int r = 4 * i + r0; *(MK_LAS f32x4*)(scr + r * 64 + ((4 * cq) ^ (8 * (r >> 3)))) = v[i]; }
    asm volatile("s_waitcnt lgkmcnt(0)" ::: "memory");
    const int c = lane & 7, nn0 = lane >> 3;
#pragma unroll
    for (int j = 0; j < 8; ++j) { const int nn = nn0 + 8 * j; const MK_LAS float* sp = scr + (8 * c) * 64 + (nn ^ (8 * c));
        u32x4 o; o.x = pg8::cvt_pk_bf16(sp[0 * 64], sp[1 * 64]); o.y = pg8::cvt_pk_bf16(sp[2 * 64], sp[3 * 64]); o.z = pg8::cvt_pk_bf16(sp[4 * 64], sp[5 * 64]); o.w = pg8::cvt_pk_bf16(sp[6 * 64], sp[7 * 64]);
        *(u32x4*)(WT + (size_t)(orow + nn) * K + k0 + 8 * c) = o; }
    asm volatile("s_waitcnt lgkmcnt(0)" ::: "memory");
}
__device__ __forceinline__ void p0_prologue(const Params& P, MK_LAS unsigned char* lds) {
    int tid_ = threadIdx.x; asm volatile("" : "+v"(tid_)); const int tid = tid_, lane = tid & 63, wave = __builtin_amdgcn_readfirstlane(tid >> 6); (void)tid; (void)lane; (void)wave;
    MK_LAS float* scr = (MK_LAS float*)(lds + wave * 16384);
    const int gw = blockIdx.x * NWAVES + wave, NGW = gridDim.x * NWAVES;
    unsigned char* ws = P.ws;
    constexpr int I_IN = 16 * 44, I_OUT = 16 * 16, I_F = 16 * 44, I_2 = 44 * 16, I_ADA = 16 * 96;
    constexpr int PER_L = I_IN + I_OUT + 2 * I_F + I_2 + I_ADA;
    for (int it = gw; it < DEPTH * PER_L; it += NGW) {
        const int l = it / PER_L; int r = it % PER_L;
        if (r < I_IN) { const int kb = r / 44, nb = r % 44; p0_transpose_item(P.in[13] + (size_t)l * D * INW, D, INW, (bf16_t*)(ws + WS_WIN) + (size_t)l * INW * D, 64 * kb, 64 * nb, 64 * nb, scr, lane); continue; } r -= I_IN;
        if (r < I_OUT) { const int kb = r / 16, nb = r % 16; p0_transpose_item(P.in[14] + (size_t)l * D * D, D, D, (bf16_t*)(ws + WS_WOUT) + (size_t)l * D * D, 64 * kb, 64 * nb, 64 * nb, scr, lane); continue; } r -= I_OUT;
        if (r < I_F) { const int kb = r / 44, nb = r % 44, n0 = 64 * nb; p0_transpose_item(P.in[21] + (size_t)l * D * DFF, D, DFF, (bf16_t*)(ws + WS_W13) + (size_t)l * NFF1 * D, 64 * kb, n0, 256 * (n0 >> 7) + (n0 & 127), scr, lane); continue; } r -= I_F;
        if (r < I_F) { const int kb = r / 44, nb = r % 44, n0 = 64 * nb; p0_transpose_item(P.in[22] + (size_t)l * D * DFF, D, DFF, (bf16_t*)(ws + WS_W13) + (size_t)l * NFF1 * D, 64 * kb, n0, 256 * (n0 >> 7) + 128 + (n0 & 127), scr, lane); continue; } r -= I_F;
        if (r < I_2) { const int kb = r / 16, nb = r % 16; p0_transpose_item(P.in[23] + (size_t)l * DFF * D, DFF, D, (bf16_t*)(ws + WS_W2) + (size_t)l * D * DFF, 64 * kb, 64 * nb, 64 * nb, scr, lane); continue; } r -= I_2;
        { const int kb = r / 96, nb = r % 96; p0_transpose_item(P.in[7] + (size_t)l * D * 6144, D, 6144, (bf16_t*)(ws + WS_ADAT), 64 * kb, 64 * nb, l * 6144 + 64 * nb, scr, lane); }
    }
    for (int r = gw; r < 256; r += NGW) {
        bf16_t* o = (bf16_t*)(ws + WS_AC) + (size_t)r * D;
        const float* src = r < NB ? P.in[2] + (size_t)r * D : P.in[3] + (size_t)(r - NB) * D;
#pragma unroll
        for (int j = 0; j < 4; ++j) { f32x4 v = (f32x4){0.f, 0.f, 0.f, 0.f};
            if (r < MODROWS) { v = *(const f32x4*)(src + 4 * lane + 256 * j); v[0] = siluf_(v[0]); v[1] = siluf_(v[1]); v[2] = siluf_(v[2]); v[3] = siluf_(v[3]); }
            *(u32x2*)(o + 4 * lane + 256 * j) = pack4(v); }
    }
}

template <int KIND>
__device__ __forceinline__ void rowpass_row(const Params& P, int l, int r, int lane) {
    unsigned char* ws = P.ws;
    const float* mod = (const float*)(ws + WS_MOD);
    bf16_t* HM = (bf16_t*)(ws + WS_HM); const bf16_t* T1 = (const bf16_t*)(ws + WS_T1S) - (size_t)NP * D;
    bf16_t* XB = (bf16_t*)(ws + WS_XB);
    {
        const int mrow = r < NP ? (r >> 11) : NB + (r - NP);
        const float* mp = mod + (size_t)mrow * NMOD + l * 6144;
        f32x4 x[4];
        if (KIND == 0) { const float* xin = r < NP ? P.in[0] + (size_t)r * D : P.in[1] + (size_t)(r - NP) * D;
#pragma unroll
            for (int j = 0; j < 4; ++j) { x[j] = *(const f32x4*)(xin + 4 * lane + 256 * j); *(u32x2*)(XB + (size_t)r * D + 4 * lane + 256 * j) = pack4(x[j]); } }
        else {
#pragma unroll
            for (int j = 0; j < 4; ++j) x[j] = unpack4(*(const u32x2*)(XB + (size_t)r * D + 4 * lane + 256 * j)); }
        if (KIND != 0) {
            f32x4 t[4]; float s = 0.f;
#pragma unroll
            for (int j = 0; j < 4; ++j) { t[j] = unpack4(*(const u32x2*)(T1 + (size_t)r * D + 4 * lane + 256 * j)); s += (t[j][0] * t[j][0] + t[j][1] * t[j][1]) + (t[j][2] * t[j][2] + t[j][3] * t[j][3]); }
            const float rstd = rsqrtf(wave_sum(s) * (1.0f / D) + EPS);
            const float* gpost = P.in[KIND == 1 ? 10 : 12] + l * D;
            const float* gt = mp + (KIND == 1 ? 2 : 5) * D;
#pragma unroll
            for (int j = 0; j < 4; ++j) { const f32x4 g = *(const f32x4*)(gpost + 4 * lane + 256 * j), gg = *(const f32x4*)(gt + 4 * lane + 256 * j);
                x[j] = x[j] + gg * (t[j] * rstd * g);
                if (KIND == 2 && l == DEPTH - 1) *(f32x4*)(P.out + (size_t)r * D + 4 * lane + 256 * j) = x[j];
                else *(u32x2*)(XB + (size_t)r * D + 4 * lane + 256 * j) = pack4(x[j]); }
        }
        if (KIND == 2 && l == DEPTH - 1) return;
        const int ln = (KIND == 2) ? l + 1 : l;
        const float* mpn = mod + (size_t)mrow * NMOD + ln * 6144;
        const float* gpre = P.in[KIND == 1 ? 11 : 9] + ln * D;
        const float* sh = mpn + (KIND == 1 ? 3 : 0) * D; const float* sc = mpn + (KIND == 1 ? 4 : 1) * D;
        float s = 0.f;
#pragma unroll
        for (int j = 0; j < 4; ++j) s += (x[j][0] * x[j][0] + x[j][1] * x[j][1]) + (x[j][2] * x[j][2] + x[j][3] * x[j][3]);
        const float rstd = rsqrtf(wave_sum(s) * (1.0f / D) + EPS);
#pragma unroll
        for (int j = 0; j < 4; ++j) { const f32x4 g = *(const f32x4*)(gpre + 4 * lane + 256 * j), a = *(const f32x4*)(sc + 4 * lane + 256 * j), b = *(const f32x4*)(sh + 4 * lane + 256 * j);
            const f32x4 h = (x[j] * rstd * g) * (a + 1.0f) + b;
            *(u32x2*)(HM + (size_t)r * D + 4 * lane + 256 * j) = pack4(h); }
    }
}
template <int KIND>
__device__ __forceinline__ void rowpass(const Params& P, int l) {
    int tid_ = threadIdx.x; asm volatile("" : "+v"(tid_)); const int tid = tid_, lane = tid & 63, wave = __builtin_amdgcn_readfirstlane(tid >> 6); (void)tid;
    const int gw = blockIdx.x * NWAVES + wave, NGW = gridDim.x * NWAVES;
    for (int r = gw; r < MR; r += NGW) rowpass_row<KIND>(P, l, r, lane);
}
template <int KIND>
__device__ __forceinline__ void sample_rowpass(const Params& P, int l, unsigned* cnt) {
    int tid_ = threadIdx.x; asm volatile("" : "+v"(tid_)); const int tid = tid_, lane = tid & 63, wave = __builtin_amdgcn_readfirstlane(tid >> 6);
    if (blockIdx.x < 64 || blockIdx.x >= 80) return;
    if (tid == 0) { unsigned sp = 0; while (__hip_atomic_load(cnt, __ATOMIC_RELAXED, __HIP_MEMORY_SCOPE_AGENT) < 256u) { __builtin_amdgcn_s_sleep(2); if (++sp > (1u << 22)) break; }
        __builtin_amdgcn_fence(__ATOMIC_ACQUIRE, "agent"); asm volatile("s_waitcnt vmcnt(0)" ::: "memory"); }
    __syncthreads();
    rowpass_row<KIND>(P, l, NP + (blockIdx.x - 64) * 8 + wave, lane);
}

struct EpiRmsFused {
    static constexpr bool PERM = false, AFTER_DRAIN = true;
    const Params* Pp; int l, kind;
    __device__ __forceinline__ void fused(f32x4 (&acc)[2][2][4][2], const pg8::Unit& u, int wr, int wc, int fr, int fq, MK_LAS unsigned char* lds, int wid, int lane) const {
        const Params& P = *Pp; unsigned char* ws = P.ws; asm volatile("" : "+s"(ws));
        const int ln = (kind == 2 && l + 1 < DEPTH) ? l + 1 : l; const int write_h = (kind == 2 && l + 1 >= DEPTH) ? 0 : 1; const int inst = 2 * l + (kind - 1);
        const bool final_out = (kind == 2 && l + 1 >= DEPTH);
        bf16_t* XB = (bf16_t*)(ws + WS_XB); float* xout = P.out; bf16_t* hout = (bf16_t*)(ws + WS_HM);
        MK_LAS u32x2* stash = (MK_LAS u32x2*)lds + (wid * 64 + lane);
        const float* gpost = P.in[kind == 1 ? 10 : 12] + l * D; const float* gpre = P.in[kind == 1 ? 11 : 9] + ln * D;
        const float* gt = (const float*)(ws + WS_MOD) + l * 6144 + (kind == 1 ? 2 : 5) * D;
        const float* sc = (const float*)(ws + WS_MOD) + ln * 6144 + (kind == 1 ? 4 : 1) * D; const float* sh = (const float*)(ws + WS_MOD) + ln * 6144 + (kind == 1 ? 3 : 0) * D;
        unsigned long long* xbuf = (unsigned long long*)(ws + WS_X + (size_t)inst * MiB); unsigned* cnt = (unsigned*)(ws + WS_CTL) + CW_PANEL + inst * 4096;
        MK_LAS f32x4* Pt = (MK_LAS f32x4*)(lds + 131072);
        MK_LAS f32x2v* St = (MK_LAS f32x2v*)(lds + 131072 + 16384);
        const int b = u.pm >> 3;
        const int col0 = u.pn * 256 + wc * 32 + 4 * fq;
        {   f32x4 av[2][2];
#pragma unroll
            for (int bj = 0; bj < 2; ++bj)
#pragma unroll
                for (int n = 0; n < 2; ++n) { const int col = col0 + bj * 128 + n * 16; av[bj][n] = *(const f32x4*)(gt + (size_t)b * NMOD + col) * *(const f32x4*)(gpost + col); }
#pragma unroll
            for (int ai = 0; ai < 2; ++ai)
#pragma unroll
                for (int m = 0; m < 4; ++m) { const int rl = ai * 128 + wr * 64 + m * 16 + fr; const size_t xo = (size_t)(u.pm * 256 + rl) * D + col0;
                    float sTT = 0.f, sxa = 0.f, saa = 0.f, sxx = 0.f;
#pragma unroll
                    for (int bj = 0; bj < 2; ++bj)
#pragma unroll
                        for (int n = 0; n < 2; ++n) { const f32x4 T = acc[ai][bj][m][n], aT = av[bj][n] * T;
                            const u32x2 xp = *(const u32x2*)(XB + xo + bj * 128 + n * 16);
                            stash[(((ai * 4 + m) * 2 + bj) * 2 + n) * 512] = xp; const f32x4 x = unpack4(xp);
                            sTT += (T[0] * T[0] + T[1] * T[1]) + (T[2] * T[2] + T[3] * T[3]); sxa += (x[0] * aT[0] + x[1] * aT[1]) + (x[2] * aT[2] + x[3] * aT[3]);
                            saa += (aT[0] * aT[0] + aT[1] * aT[1]) + (aT[2] * aT[2] + aT[3] * aT[3]); sxx += (x[0] * x[0] + x[1] * x[1]) + (x[2] * x[2] + x[3] * x[3]);
                            acc[ai][bj][m][n] = aT; }
                    sTT += __shfl_xor(sTT, 16); sTT += __shfl_xor(sTT, 32); sxa += __shfl_xor(sxa, 16); sxa += __shfl_xor(sxa, 32);
                    saa += __shfl_xor(saa, 16); saa += __shfl_xor(saa, 32); sxx += __shfl_xor(sxx, 16); sxx += __shfl_xor(sxx, 32);
                    if (fq == 0) Pt[rl * 4 + wc] = (f32x4){sTT, sxa, saa, sxx};
                    if (m & 1) asm volatile("" ::: "memory"); }
        }
        asm volatile("s_waitcnt lgkmcnt(0)" ::: "memory"); __builtin_amdgcn_s_barrier(); asm volatile("" ::: "memory");
        const int row = wid * 32 + (lane & 31);
        unsigned long long* slot = xbuf + ((size_t)(u.pm * 256 + row) * 4) * 2;
        if (lane < 32) { const f32x4 p = (Pt[row * 4 + 0] + Pt[row * 4 + 1]) + (Pt[row * 4 + 2] + Pt[row * 4 + 3]);
            __hip_atomic_store(slot + u.pn * 2 + 0, ((unsigned long long)__float_as_uint(p[1]) << 32) | __float_as_uint(p[0]), __ATOMIC_RELAXED, __HIP_MEMORY_SCOPE_AGENT);
            __hip_atomic_store(slot + u.pn * 2 + 1, ((unsigned long long)__float_as_uint(p[3]) << 32) | __float_as_uint(p[2]), __ATOMIC_RELAXED, __HIP_MEMORY_SCOPE_AGENT); }
        asm volatile("s_waitcnt vmcnt(0)" ::: "memory");
        if (lane == 0) __hip_atomic_fetch_add(cnt + 64 * u.pm, 1u, __ATOMIC_RELAXED, __HIP_MEMORY_SCOPE_AGENT);
        if (wid == 0) { unsigned sp = 0;
            while ((unsigned)__builtin_amdgcn_readfirstlane(__hip_atomic_load(cnt + 64 * u.pm, __ATOMIC_RELAXED, __HIP_MEMORY_SCOPE_AGENT)) < 32u) { __builtin_amdgcn_s_sleep(2); if (++sp > (1u << 22)) break; }
            __builtin_amdgcn_fence(__ATOMIC_ACQUIRE, "agent"); }
        asm volatile("s_waitcnt vmcnt(0) lgkmcnt(0)" ::: "memory"); __builtin_amdgcn_s_barrier(); asm volatile("" ::: "memory");
        if (lane < 32) { float TT = 0.f, xa = 0.f, aa = 0.f, xx = 0.f;
#pragma unroll
            for (int t = 0; t < 4; ++t) { const unsigned long long w0 = __hip_atomic_load(slot + t * 2 + 0, __ATOMIC_RELAXED, __HIP_MEMORY_SCOPE_AGENT), w1 = __hip_atomic_load(slot + t * 2 + 1, __ATOMIC_RELAXED, __HIP_MEMORY_SCOPE_AGENT);
                TT += __uint_as_float((unsigned)w0); xa += __uint_as_float((unsigned)(w0 >> 32)); aa += __uint_as_float((unsigned)w1); xx += __uint_as_float((unsigned)(w1 >> 32)); }
            const float rT = rsqrtf(TT * (1.0f / D) + EPS); const float q = xx + rT * ((xa + xa) + rT * aa);
            St[row] = (f32x2v){rT, rsqrtf(fmaxf(q, 0.f) * (1.0f / D) + EPS)}; }
        asm volatile("s_waitcnt lgkmcnt(0)" ::: "memory"); __builtin_amdgcn_s_barrier(); asm volatile("" ::: "memory");
#pragma unroll
        for (int bj = 0; bj < 2; ++bj)
#pragma unroll
            for (int n = 0; n < 2; ++n) { const int col = col0 + bj * 128 + n * 16;
                f32x4 gm = (f32x4){0.f, 0.f, 0.f, 0.f}, sv = gm;
                if (write_h) { gm = *(const f32x4*)(gpre + col) * (*(const f32x4*)(sc + (size_t)b * NMOD + col) + 1.0f); sv = *(const f32x4*)(sh + (size_t)b * NMOD + col); }
#pragma unroll
                for (int ai = 0; ai < 2; ++ai)
#pragma unroll
                    for (int m = 0; m < 4; ++m) { const int rl = ai * 128 + wr * 64 + m * 16 + fr; const f32x2v sr = St[rl]; const size_t off = (size_t)(u.pm * 256 + rl) * D + col;
                        const f32x4 x1 = unpack4(stash[(((ai * 4 + m) * 2 + bj) * 2 + n) * 512]) + acc[ai][bj][m][n] * sr.x;
                        if (final_out) *(f32x4*)(xout + off) = x1; else *(u32x2*)(XB + off) = pack4(x1);
                        if (write_h) *(u32x2*)(hout + off) = pack4(x1 * sr.y * gm + sv);
                        if (m & 1) asm volatile("" ::: "memory"); } }
    }
};

__device__ __forceinline__ bf16x8 lfrag(const MK_LAS bf16_t* base, int row, int stride, int k0, int fq) { return *(const MK_LAS bf16x8*)(base + row * stride + k0 + fq * 8); }
#define MK_MFMA(b, a, c) __builtin_amdgcn_mfma_f32_16x16x32_bf16((b), (a), (c), 0, 0, 0)

__device__ __forceinline__ void rope8(const bf16_t* src  , int j, float pos, float scale, u32x4& o1, u32x4& o2, float extra  ) {
    const u32x4 w1 = *(const u32x4*)(src + 8 * j), w2 = *(const u32x4*)(src + 32 + 8 * j);
    float a[8], b[8];
#pragma unroll
    for (int q = 0; q < 4; ++q) { a[2 * q] = bflo(w1[q]); a[2 * q + 1] = bfhi(w1[q]); b[2 * q] = bflo(w2[q]); b[2 * q + 1] = bfhi(w2[q]); }
    float r1[8], r2[8]; const float sc = scale * extra;
#pragma unroll
    for (int i = 0; i < 8; ++i) { const double rev = (double)pos * kInvRev[8 * j + i]; const float fr_ = (float)(rev - floor(rev));
        const float sn = __builtin_amdgcn_sinf(fr_), cs = __builtin_amdgcn_cosf(fr_);
        r1[i] = (a[i] * cs - b[i] * sn) * sc; r2[i] = (a[i] * sn + b[i] * cs) * sc; }
#pragma unroll
    for (int q = 0; q < 4; ++q) { o1[q] = pg8::cvt_pk_bf16(r1[2 * q], r1[2 * q + 1]); o2[q] = pg8::cvt_pk_bf16(r2[2 * q], r2[2 * q + 1]); }
}

constexpr int SQ = 72, SV = 136;
constexpr int L_QS = 0, L_KS = L_QS + 128 * SQ * 2, L_VT = L_KS + 128 * SQ * 2, L_PS = L_VT + 128 * SV * 2, L_ST = L_PS + 128 * SV * 2, L_RET_END = L_ST + 128 * SQ * 2;
static_assert(L_RET_END <= 131072, "retention LDS");

__device__ __forceinline__ void load_vt(const bf16_t* PROJ, int row0, int h, MK_LAS bf16_t* Vt, int wave, int lane) {
#pragma unroll
    for (int it = 0; it < 4; ++it) { const int chunk = wave * 2 + (it & 1), m = lane + 64 * (it >> 1);
        const u32x4 w = *(const u32x4*)(PROJ + (size_t)(row0 + m) * INW + PV + h * 128 + chunk * 8);
#pragma unroll
        for (int q = 0; q < 4; ++q) { Vt[(chunk * 8 + 2 * q) * SV + m] = (bf16_t)(w[q] & 0xffffu); Vt[(chunk * 8 + 2 * q + 1) * SV + m] = (bf16_t)(w[q] >> 16); } }
}

__device__ __forceinline__ void ret_u_item(const Params& P, MK_LAS unsigned char* lds, int item) {
    int tid_ = threadIdx.x; asm volatile("" : "+v"(tid_)); const int tid = tid_, lane = tid & 63, wave = __builtin_amdgcn_readfirstlane(tid >> 6); (void)tid; (void)lane; (void)wave;
    const int h = item & 3, c = (item >> 2) & 15, b = item >> 6;
    const bf16_t* PROJ = (const bf16_t*)(P.ws + WS_PROJ);
    float* UT = (float*)(P.ws + WS_U) + (size_t)((b * 4 + h) * 16 + c) * 8192;
    MK_LAS bf16_t* Kt = (MK_LAS bf16_t*)(lds + L_KS);
    MK_LAS bf16_t* Vt = (MK_LAS bf16_t*)(lds + L_VT);
    const int row0 = b * SEQ + c * 128; const float lg = log2_gamma(h);
    __syncthreads();
    load_vt(PROJ, row0, h, Vt, wave, lane);
    { const int m = tid & 127, j = tid >> 7; u32x4 o1, o2;
      rope8(PROJ + (size_t)(row0 + m) * INW + PK + h * 64, j, (float)(c * 128 + m), 0.125f, o1, o2, exp2f((float)(127 - m) * lg));
#pragma unroll
      for (int q = 0; q < 4; ++q) { Kt[(8 * j + 2 * q) * SV + m] = (bf16_t)(o1[q] & 0xffffu); Kt[(8 * j + 2 * q + 1) * SV + m] = (bf16_t)(o1[q] >> 16);
                                    Kt[(32 + 8 * j + 2 * q) * SV + m] = (bf16_t)(o2[q] & 0xffffu); Kt[(32 + 8 * j + 2 * q + 1) * SV + m] = (bf16_t)(o2[q] >> 16); } }
    __syncthreads();
    const int fr = lane & 15, fq = lane >> 4, e0 = 16 * wave;
    f32x4 u[4];
#pragma unroll
    for (int j = 0; j < 4; ++j) u[j] = (f32x4){0.f, 0.f, 0.f, 0.f};
#pragma unroll
    for (int ks = 0; ks < 4; ++ks) { const bf16x8 a = lfrag(Vt, e0 + fr, SV, ks * 32, fq);
#pragma unroll
        for (int j = 0; j < 4; ++j) { const bf16x8 bb = lfrag(Kt, 16 * j + fr, SV, ks * 32, fq); u[j] = MK_MFMA(bb, a, u[j]); } }
#pragma unroll
    for (int j = 0; j < 4; ++j) *(f32x4*)(UT + (e0 + fr) * 64 + 16 * j + 4 * fq) = u[j];
}

__device__ __forceinline__ void ret_o_item(const Params& P, MK_LAS unsigned char* lds, int l, int item) {
    int tid_ = threadIdx.x; asm volatile("" : "+v"(tid_)); const int tid = tid_, lane = tid & 63, wave = __builtin_amdgcn_readfirstlane(tid >> 6); (void)tid; (void)lane; (void)wave;
    const int h = item & 3, b = item >> 6, c = item < 256 ? (item >> 2) & 15 : 15 - ((item >> 2) & 15);
    const bf16_t* PROJ = (const bf16_t*)(P.ws + WS_PROJ);
    bf16_t* MIX = (bf16_t*)(P.ws + WS_HM);
    MK_LAS bf16_t* Qs = (MK_LAS bf16_t*)(lds + L_QS); MK_LAS bf16_t* Ks = (MK_LAS bf16_t*)(lds + L_KS); MK_LAS bf16_t* Vt = (MK_LAS bf16_t*)(lds + L_VT);
    MK_LAS bf16_t* Ps = (MK_LAS bf16_t*)(lds + L_PS); MK_LAS bf16_t* St = (MK_LAS bf16_t*)(lds + L_ST);
    const int row0 = b * SEQ + c * 128; const float lg = log2_gamma(h);
    __syncthreads();
    load_vt(PROJ, row0, h, Vt, wave, lane);
    { const int m = tid & 127, j = tid >> 7; u32x4 o1, o2; const float pos = (float)(c * 128 + m);
      rope8(PROJ + (size_t)(row0 + m) * INW + PQ + h * 64, j, pos, 1.0f, o1, o2, 1.0f);
      *(MK_LAS u32x4*)(Qs + m * SQ + 8 * j) = o1; *(MK_LAS u32x4*)(Qs + m * SQ + 32 + 8 * j) = o2;
      rope8(PROJ + (size_t)(row0 + m) * INW + PK + h * 64, j, pos, 0.125f, o1, o2, 1.0f);
      *(MK_LAS u32x4*)(Ks + m * SQ + 8 * j) = o1; *(MK_LAS u32x4*)(Ks + m * SQ + 32 + 8 * j) = o2; }
    { const float cd = exp2f(128.0f * lg);
      const float* UTb = (const float*)(P.ws + WS_U) + (size_t)((b * 4 + h) * 16) * 8192;
#pragma unroll 1
      for (int it = 0; it < 2; ++it) { const int idx0 = tid + 1024 * it, idx1 = idx0 + 512;
        f32x4 ua[15], ub[15];
#pragma unroll
        for (int j = 0; j < 15; ++j) { if (j < c) { ua[j] = *(const f32x4*)(UTb + (size_t)j * 8192 + 4 * idx0); ub[j] = *(const f32x4*)(UTb + (size_t)j * 8192 + 4 * idx1); }
                                       else { ua[j] = (f32x4){0.f, 0.f, 0.f, 0.f}; ub[j] = ua[j]; } }
        f32x4 sa = (f32x4){0.f, 0.f, 0.f, 0.f}, sb = sa;
#pragma unroll
        for (int j = 0; j < 15; ++j) { if (j < c) { sa = sa * cd + ua[j]; sb = sb * cd + ub[j]; } }
        *(MK_LAS u32x2*)(St + (idx0 >> 4) * SQ + 4 * (idx0 & 15)) = pack4(sa); *(MK_LAS u32x2*)(St + (idx1 >> 4) * SQ + 4 * (idx1 & 15)) = pack4(sb);
        if (c == 15) { sa = sa * cd + *(const f32x4*)(UTb + (size_t)15 * 8192 + 4 * idx0); sb = sb * cd + *(const f32x4*)(UTb + (size_t)15 * 8192 + 4 * idx1);
            float* o = P.out + O_RETP + (size_t)((l * NB + b) * 4 + h) * 8192;
#pragma unroll
            for (int i = 0; i < 4; ++i) { o[(4 * (idx0 & 15) + i) * 128 + (idx0 >> 4)] = sa[i]; o[(4 * (idx1 & 15) + i) * 128 + (idx1 >> 4)] = sb[i]; } } } }
    __syncthreads();
    const int fr = lane & 15, fq = lane >> 4, n0 = 16 * wave, n = n0 + fr;
    {
        f32x4 sc[8];
#pragma unroll
        for (int j = 0; j < 8; ++j) sc[j] = (f32x4){0.f, 0.f, 0.f, 0.f};
#pragma unroll
        for (int ks = 0; ks < 2; ++ks) { const bf16x8 a = lfrag(Qs, n, SQ, ks * 32, fq);
#pragma unroll
            for (int j = 0; j < 8; ++j) { const bf16x8 bb = lfrag(Ks, 16 * j + fr, SQ, ks * 32, fq); sc[j] = MK_MFMA(bb, a, sc[j]); } }
#pragma unroll
        for (int j = 0; j < 8; ++j) { f32x4 p;
#pragma unroll
            for (int i = 0; i < 4; ++i) { const int dlt = n - (16 * j + 4 * fq + i); p[i] = dlt >= 0 ? sc[j][i] * exp2f((float)dlt * lg) : 0.f; }
            *(MK_LAS u32x2*)(Ps + n * SV + 16 * j + 4 * fq) = pack4(p); }
    }
    __syncthreads();
    f32x4 o1[8], o2[8];
#pragma unroll
    for (int j = 0; j < 8; ++j) { o1[j] = (f32x4){0.f, 0.f, 0.f, 0.f}; o2[j] = (f32x4){0.f, 0.f, 0.f, 0.f}; }
#pragma unroll
    for (int ks = 0; ks < 4; ++ks) { const bf16x8 a = lfrag(Ps, n, SV, ks * 32, fq);
#pragma unroll
        for (int j = 0; j < 8; ++j) { const bf16x8 bb = lfrag(Vt, 16 * j + fr, SV, ks * 32, fq); o1[j] = MK_MFMA(bb, a, o1[j]); } }
#pragma unroll
    for (int ks = 0; ks < 2; ++ks) { const bf16x8 a = lfrag(Qs, n, SQ, ks * 32, fq);
#pragma unroll
        for (int j = 0; j < 8; ++j) { const bf16x8 bb = lfrag(St, 16 * j + fr, SQ, ks * 32, fq); o2[j] = MK_MFMA(bb, a, o2[j]); } }
    const float rd = exp2f((float)(n + 1) * lg);
    float s = 0.f;
#pragma unroll
    for (int j = 0; j < 8; ++j) { o1[j] = o1[j] + o2[j] * rd; s += (o1[j][0] + o1[j][1]) + (o1[j][2] + o1[j][3]); }
    s += __shfl_xor(s, 16); s += __shfl_xor(s, 32);
    const float mean = s * (1.0f / 128.0f); float q = 0.f;
#pragma unroll
    for (int j = 0; j < 8; ++j) { o1[j] = o1[j] - mean; q += (o1[j][0] * o1[j][0] + o1[j][1] * o1[j][1]) + (o1[j][2] * o1[j][2] + o1[j][3] * o1[j][3]); }
    q += __shfl_xor(q, 16); q += __shfl_xor(q, 32);
    const float rstd = rsqrtf(q * (1.0f / 128.0f) + EPS);
    const float* gn = P.in[15] + l * 512 + h * 128;
    const size_t row = (size_t)(row0 + n);
#pragma unroll
    for (int j = 0; j < 8; ++j) { const int e = 16 * j + 4 * fq;
        const f32x4 g = *(const f32x4*)(gn + e); const f32x4 gate = unpack4(*(const u32x2*)(PROJ + row * INW + PG + h * 128 + e));
        f32x4 o;
#pragma unroll
        for (int i = 0; i < 4; ++i) o[i] = o1[j][i] * rstd * g[i] * siluf_(gate[i]);
        *(u32x2*)(MIX + row * D + h * 128 + e) = pack4(o); }
}

__device__ __forceinline__ void conva_finish(const Params& P, int l, f32x4 acc, size_t row, int lane) {
    bf16_t* MIX = (bf16_t*)(P.ws + WS_HM);
    const float mean = wave_sum((acc[0] + acc[1]) + (acc[2] + acc[3])) * (1.0f / 256.0f);
    const f32x4 d = acc - mean;
    const float var = wave_sum((d[0] * d[0] + d[1] * d[1]) + (d[2] * d[2] + d[3] * d[3])) * (1.0f / 256.0f);
    const float rstd = rsqrtf(var + EPS);
    const f32x4 g = *(const f32x4*)(P.in[18] + l * 256 + 4 * lane), bb = *(const f32x4*)(P.in[19] + l * 256 + 4 * lane);
    f32x4 y = d * rstd * g + bb;
#pragma unroll
    for (int i = 0; i < 4; ++i) y[i] = siluf_(y[i]);
    *(u32x2*)(MIX + row * D + 512 + 4 * lane) = pack4(y);
}

__device__ __forceinline__ void conv_task(const Params& P, int l) {
    int tid_ = threadIdx.x; asm volatile("" : "+v"(tid_)); const int tid = tid_, lane = tid & 63, wave = __builtin_amdgcn_readfirstlane(tid >> 6);
    const int task = blockIdx.x * NWAVES + wave;
    if (task >= NP / 8) return;
    const int b = task >> 8, t0 = (task & 255) * 8;
    const bf16_t* PROJ = (const bf16_t*)(P.ws + WS_PROJ);
    bf16_t* MIX = (bf16_t*)(P.ws + WS_HM);
    const float* cw = P.in[16] + l * 31 * 256 + 4 * lane;
    f32x4 acc[8]; const f32x4 bias = *(const f32x4*)(P.in[17] + l * 256 + 4 * lane);
#pragma unroll
    for (int k = 0; k < 8; ++k) acc[k] = bias;
    {
        const bf16_t* pb = PROJ + (size_t)(b * SEQ) * INW + 4 * lane;
        f32x4 cur[8], nxt[8], wv[8]; u32x2 rv[8], rg[8];
#define MK_ROWADDR(r_) ({ const int t_ = t0 - 30 + (r_); const int tc_ = t_ < 0 ? 0 : (t_ > SEQ - 1 ? SEQ - 1 : t_); (size_t)tc_ * INW; })
#define MK_GLU(dst, v_, g_, r_) do { const float m_ = (t0 - 30 + (r_)) < 0 ? 0.f : 1.f; const f32x4 vv_ = unpack4(v_), gg_ = unpack4(g_); _Pragma("unroll") for (int i_ = 0; i_ < 4; ++i_) dst[i_] = m_ * vv_[i_] * sigmoidf_(gg_[i_]); } while (0)
#pragma unroll
        for (int k = 0; k < 8; ++k) { rv[k] = *(const u32x2*)(pb + MK_ROWADDR(k) + PAV); rg[k] = *(const u32x2*)(pb + MK_ROWADDR(k) + PAG); }
#pragma unroll
        for (int k = 0; k < 8; ++k) MK_GLU(cur[k], rv[k], rg[k], k);
#pragma unroll
        for (int k = 0; k < 8; ++k) { rv[k] = *(const u32x2*)(pb + MK_ROWADDR(8 + k) + PAV); rg[k] = *(const u32x2*)(pb + MK_ROWADDR(8 + k) + PAG); }
#pragma unroll
        for (int k = 0; k < 8; ++k) MK_GLU(nxt[k], rv[k], rg[k], 8 + k);
        if (t0 == SEQ - 8) {
#pragma unroll
            for (int k = 0; k < 8; ++k) *(f32x4*)(P.out + O_CAP + (size_t)((l * NB + b) * 30 + k) * 256 + 4 * lane) = nxt[k]; }
#pragma unroll
        for (int k = 0; k < 8; ++k) wv[k] = *(const f32x4*)(cw + k * 256);
#pragma unroll 1
        for (int jb = 0; jb < 4; ++jb) {
            f32x4 wn[8];
#pragma unroll
            for (int k = 0; k < 8; ++k) { const int r = 8 * jb + 16 + k; rv[k] = *(const u32x2*)(pb + MK_ROWADDR(r) + PAV); rg[k] = *(const u32x2*)(pb + MK_ROWADDR(r) + PAG);
                const int jn = 8 * jb + 8 + k; wn[k] = *(const f32x4*)(cw + (jn < 31 ? jn : 30) * 256); if (jn >= 31) wn[k] = (f32x4){0.f, 0.f, 0.f, 0.f}; }
#pragma unroll
            for (int jj = 0; jj < 8; ++jj)
#pragma unroll
                for (int k = 0; k < 8; ++k) acc[k] = acc[k] + wv[jj] * (jj + k < 8 ? cur[(jj + k) & 7] : nxt[(jj + k) & 7]);
#pragma unroll
            for (int k = 0; k < 8; ++k) { cur[k] = nxt[k]; wv[k] = wn[k]; }
#pragma unroll
            for (int k = 0; k < 8; ++k) MK_GLU(nxt[k], rv[k], rg[k], 8 * jb + 16 + k);
            if (t0 == SEQ - 8) {
#pragma unroll
                for (int k = 0; k < 8; ++k) { const int i = 8 * jb + 8 + k; if (i < 30) *(f32x4*)(P.out + O_CAP + (size_t)((l * NB + b) * 30 + i) * 256 + 4 * lane) = nxt[k]; } }
        }
#undef MK_ROWADDR
#undef MK_GLU
    }
#pragma unroll
    for (int k = 0; k < 8; ++k) conva_finish(P, l, acc[k], (size_t)(b * SEQ + t0 + k), lane);
    const f32x4 w0 = *(const f32x4*)(P.in[20] + l * 768 + 4 * lane), w1 = *(const f32x4*)(P.in[20] + l * 768 + 256 + 4 * lane), w2 = *(const f32x4*)(P.in[20] + l * 768 + 512 + 4 * lane);
    f32x4 zm2 = (f32x4){0.f, 0.f, 0.f, 0.f}, zm1 = zm2;
#pragma unroll
    for (int k = -2; k < 8; ++k) { const int t = t0 + k;
        f32x4 z = (f32x4){0.f, 0.f, 0.f, 0.f};
        if (t >= 0) { const bf16_t* rp = PROJ + (size_t)(b * SEQ + t) * INW; z = unpack4(*(const u32x2*)(rp + PCC + 4 * lane)) * unpack4(*(const u32x2*)(rp + PCX + 4 * lane)); }
        if (k >= 0) { const bf16_t* rp = PROJ + (size_t)(b * SEQ + t) * INW; const f32x4 cb = unpack4(*(const u32x2*)(rp + PCB + 4 * lane));
            const f32x4 o = cb * (w0 * zm2 + w1 * zm1 + w2 * z);
            *(u32x2*)(MIX + (size_t)(b * SEQ + t) * D + 768 + 4 * lane) = pack4(o);
            if (t >= SEQ - 2) *(f32x4*)(P.out + O_CCP + (size_t)((l * NB + b) * 2 + (t - (SEQ - 2))) * 256 + 4 * lane) = z; }
        zm2 = zm1; zm1 = z; }
}

__device__ __forceinline__ void sample_conv(const Params& P, int l) {
    int tid_ = threadIdx.x; asm volatile("" : "+v"(tid_)); const int tid = tid_, lane = tid & 63, wave = __builtin_amdgcn_readfirstlane(tid >> 6); (void)tid; (void)lane; (void)wave;
    if (wave != 2 || blockIdx.x >= NS) return;
    const int s = blockIdx.x;
    const bf16_t* PROJ = (const bf16_t*)(P.ws + WS_PROJ);
    bf16_t* MIX = (bf16_t*)(P.ws + WS_HM);
    const size_t row = (size_t)(NP + s); const bf16_t* rp = PROJ + row * INW;
    const f32x4 v = unpack4(*(const u32x2*)(rp + PAV + 4 * lane)), g = unpack4(*(const u32x2*)(rp + PAG + 4 * lane));
    f32x4 u;
#pragma unroll
    for (int i = 0; i < 4; ++i) u[i] = v[i] * sigmoidf_(g[i]);
    const float* buf = P.in[5] + (size_t)((l * NS + s) * 30) * 256 + 4 * lane; float* nb = P.out + O_CAS + (size_t)((l * NS + s) * 30) * 256 + 4 * lane;
    const float* cw = P.in[16] + l * 31 * 256 + 4 * lane;
    f32x4 acc = *(const f32x4*)(P.in[17] + l * 256 + 4 * lane);
#pragma unroll 15
    for (int j = 0; j < 30; ++j) { const f32x4 x = *(const f32x4*)(buf + j * 256); acc = acc + *(const f32x4*)(cw + j * 256) * x; if (j >= 1) *(f32x4*)(nb + (j - 1) * 256) = x; }
    acc = acc + *(const f32x4*)(cw + 30 * 256) * u; *(f32x4*)(nb + 29 * 256) = u;
    conva_finish(P, l, acc, row, lane);
    const f32x4 w0 = *(const f32x4*)(P.in[20] + l * 768 + 4 * lane), w1 = *(const f32x4*)(P.in[20] + l * 768 + 256 + 4 * lane), w2 = *(const f32x4*)(P.in[20] + l * 768 + 512 + 4 * lane);
    const float* bc = P.in[6] + (size_t)((l * NS + s) * 2) * 256 + 4 * lane; float* nc = P.out + O_CCS + (size_t)((l * NS + s) * 2) * 256 + 4 * lane;
    const f32x4 z0 = *(const f32x4*)bc, z1 = *(const f32x4*)(bc + 256);
    const f32x4 z = unpack4(*(const u32x2*)(rp + PCC + 4 * lane)) * unpack4(*(const u32x2*)(rp + PCX + 4 * lane));
    const f32x4 cb = unpack4(*(const u32x2*)(rp + PCB + 4 * lane));
    *(u32x2*)(MIX + row * D + 768 + 4 * lane) = pack4(cb * (w0 * z0 + w1 * z1 + w2 * z));
    *(f32x4*)nc = z1; *(f32x4*)(nc + 256) = z;
}

__device__ __forceinline__ void sample_ret(const Params& P, int l) {
    int tid_ = threadIdx.x; asm volatile("" : "+v"(tid_)); const int tid = tid_, lane = tid & 63, wave = __builtin_amdgcn_readfirstlane(tid >> 6); (void)tid; (void)lane; (void)wave;
    if (wave >= 2) return;
    const int s = (blockIdx.x * 2 + wave) >> 2, h = (blockIdx.x * 2 + wave) & 3;
    const bf16_t* PROJ = (const bf16_t*)(P.ws + WS_PROJ);
    bf16_t* MIX = (bf16_t*)(P.ws + WS_HM);
    const size_t row = (size_t)(NP + s); const bf16_t* rp = PROJ + row * INW;
    const float lg = log2_gamma(h), gam = exp2f(lg);
    const int i5 = lane & 31;
    const double rev = 16384.0 * kInvRev[i5]; const float fr_ = (float)(rev - floor(rev));
    const float sn = __builtin_amdgcn_sinf(fr_), cs = __builtin_amdgcn_cosf(fr_);
    const float q1 = bf2f(rp[PQ + h * 64 + i5]), q2 = bf2f(rp[PQ + h * 64 + 32 + i5]), k1 = bf2f(rp[PK + h * 64 + i5]), k2 = bf2f(rp[PK + h * 64 + 32 + i5]);
    const float qr = bflo(pg8::cvt_pk_bf16(lane < 32 ? q1 * cs - q2 * sn : q1 * sn + q2 * cs, 0.f));
    const float kr = bflo(pg8::cvt_pk_bf16((lane < 32 ? k1 * cs - k2 * sn : k1 * sn + k2 * cs) * 0.125f, 0.f));
    const int eq = lane & 31, dpar = lane >> 5;
    const f32x4 v = unpack4(*(const u32x2*)(rp + PV + h * 128 + 4 * eq));
    const float* S0 = P.in[4] + (size_t)((l * NS + s) * 4 + h) * 8192 + 4 * eq; float* S1 = P.out + O_RETS + (size_t)((l * NS + s) * 4 + h) * 8192 + 4 * eq;
    f32x4 o = (f32x4){0.f, 0.f, 0.f, 0.f};
#pragma unroll
    for (int it = 0; it < 32; ++it) { const int d = 2 * it + dpar;
        const float qa = __uint_as_float(__builtin_amdgcn_readlane(__float_as_uint(qr), 2 * it)), qb = __uint_as_float(__builtin_amdgcn_readlane(__float_as_uint(qr), 2 * it + 1));
        const float ka = __uint_as_float(__builtin_amdgcn_readlane(__float_as_uint(kr), 2 * it)), kb = __uint_as_float(__builtin_amdgcn_readlane(__float_as_uint(kr), 2 * it + 1));
        const float qd = dpar ? qb : qa, kd = dpar ? kb : ka;
        f32x4 sv = *(const f32x4*)(S0 + d * 128); sv = sv * gam + v * kd; *(f32x4*)(S1 + d * 128) = sv; o = o + sv * qd; }
#pragma unroll
    for (int i = 0; i < 4; ++i) o[i] += __shfl_xor(o[i], 32);
    float sm = (o[0] + o[1]) + (o[2] + o[3]);
#pragma unroll
    for (int x = 1; x < 32; x <<= 1) sm += __shfl_xor(sm, x);
    const float mean = sm * (1.0f / 128.0f); const f32x4 dd = o - mean; float qq = (dd[0] * dd[0] + dd[1] * dd[1]) + (dd[2] * dd[2] + dd[3] * dd[3]);
#pragma unroll
    for (int x = 1; x < 32; x <<= 1) qq += __shfl_xor(qq, x);
    const float rstd = rsqrtf(qq * (1.0f / 128.0f) + EPS);
    if (lane < 32) { const f32x4 g = *(const f32x4*)(P.in[15] + l * 512 + h * 128 + 4 * eq); const f32x4 gate = unpack4(*(const u32x2*)(rp + PG + h * 128 + 4 * eq));
        f32x4 y;
#pragma unroll
        for (int i = 0; i < 4; ++i) y[i] = dd[i] * rstd * g[i] * siluf_(gate[i]);
        *(u32x2*)(MIX + row * D + h * 128 + 4 * eq) = pack4(y); }
}


template <int KS>
__device__ __forceinline__ void skinny_gemm(const bf16_t* A  , const bf16_t* Bt  , bf16_t* O  , unsigned* cnt, MK_LAS unsigned char* lds) {
    int tid_ = threadIdx.x; asm volatile("" : "+v"(tid_)); const int tid = tid_, lane = tid & 63, wave = __builtin_amdgcn_readfirstlane(tid >> 6);
    const int fr = lane & 15, fq = lane >> 4; constexpr int K = KS * 32 * 8;
    for (int it = blockIdx.x; it < 256; it += gridDim.x) {
        const int rb = it & 7, ct = it >> 3;
        const bf16_t* ap = A + (size_t)(NP + 16 * rb + fr) * K + wave * (KS * 32) + 8 * fq;
        const bf16_t* bp = Bt + (size_t)(32 * ct + fr) * K + wave * (KS * 32) + 8 * fq;
        f32x4 acc0 = (f32x4){0.f, 0.f, 0.f, 0.f}, acc1 = acc0;
#pragma unroll
        for (int ks = 0; ks < KS; ++ks) { const bf16x8 a = *(const bf16x8*)(ap + ks * 32), b0 = *(const bf16x8*)(bp + ks * 32), b1 = *(const bf16x8*)(bp + (size_t)16 * K + ks * 32);
            acc0 = MK_MFMA(b0, a, acc0); acc1 = MK_MFMA(b1, a, acc1); }
        MK_LAS f32x4* red = (MK_LAS f32x4*)lds;
        red[(wave * 2 + 0) * 64 + lane] = acc0; red[(wave * 2 + 1) * 64 + lane] = acc1;
        __syncthreads();
        if (wave < 2) { f32x4 sum = red[wave * 64 + lane];
#pragma unroll
            for (int w = 1; w < 8; ++w) sum = sum + red[(w * 2 + wave) * 64 + lane];
            const u32x2 pk = pack4(sum);
            __hip_atomic_store((unsigned long long*)(O + (size_t)(NP + 16 * rb + fr) * D + 32 * ct + 16 * wave + 4 * fq), ((unsigned long long)pk.y << 32) | pk.x, __ATOMIC_RELAXED, __HIP_MEMORY_SCOPE_AGENT);
            asm volatile("s_waitcnt vmcnt(0)" ::: "memory"); }
        __syncthreads();
        if (tid == 0) __hip_atomic_fetch_add(cnt, 1u, __ATOMIC_RELAXED, __HIP_MEMORY_SCOPE_AGENT);
    }
}
__global__ void __launch_bounds__(NTHREADS, 2) mk_fwd(Params P) {
    extern __shared__ __attribute__((aligned(16))) unsigned char lds_raw[];
    MK_LAS unsigned char* lds = (MK_LAS unsigned char*)lds_raw;
    cg::grid_group grid = cg::this_grid();
    if (threadIdx.x < 16) ((MK_LAS unsigned*)(lds + LDS_CTL_OFF))[threadIdx.x] = 0u;
    __syncthreads();
    (void)xcd_barrier_post((unsigned*)(P.ws + WS_CTL), (volatile MK_LAS unsigned*)(lds + LDS_CTL_OFF));
#define GRID_BAR() do { XcdBarrier xb_; xb_.bar = (unsigned*)(P.ws + WS_CTL); xb_.x = xb_xcc_id(); xb_.st = (volatile MK_LAS unsigned*)(lds + LDS_CTL_OFF); xcd_barrier(xb_); } while (0)
    if (P.ws == nullptr) grid.sync();
    const int G = gridDim.x, bx = blockIdx.x;
    unsigned char* ws = P.ws;
    bf16_t* HM = (bf16_t*)(ws + WS_HM); bf16_t* T1 = (bf16_t*)(ws + WS_T1S) - (size_t)NP * D; bf16_t* PROJ = (bf16_t*)(ws + WS_PROJ);

    for (int rep = 0; rep < REP_P0; ++rep) p0_prologue(P, lds);
    GRID_BAR();
    { pg8::Gemm g{(const bf16_t*)(ws + WS_AC), (const bf16_t*)(ws + WS_ADAT), 256, NMOD, D}; pg8::StaticOrder S; S.init(256, NMOD, G, bx);
      EpiMod E{(float*)(ws + WS_MOD), P.in[8]};
      pg8::gemm_phase<EpiMod, pg8::StaticOrder, true, true>(lds, g, S, E); }
    GRID_BAR();
    for (int rep = 0; rep < REP_R0; ++rep) rowpass<0>(P, 0);
    GRID_BAR();
#pragma unroll 1
    for (int l = 0; l < DEPTH; ++l) {
        for (int rep = 0; rep < REP_WIN; ++rep)
        { pg8::Gemm g{HM, (const bf16_t*)(ws + WS_WIN) + (size_t)l * INW * D, MP, INW, D}; pg8::StaticOrder S; S.init(MP, INW, G, bx);
          pg8::EpiBf16<0> E{PROJ, INW, nullptr, 0, 0, 1.f};
          pg8::gemm_phase<pg8::EpiBf16<0>, pg8::StaticOrder, true, true>(lds, g, S, E); }
        GRID_BAR();
        for (int rep = 0; rep < REP_MIX; ++rep) {
        if (rep) GRID_BAR();
        sample_ret(P, l); sample_conv(P, l);
        conv_task(P, l);
        for (int it = bx; it < 512; it += G) ret_u_item(P, lds, it);
#ifdef DUP_M1
        GRID_BAR();
        sample_ret(P, l); sample_conv(P, l);
        conv_task(P, l);
        for (int it = bx; it < 512; it += G) ret_u_item(P, lds, it);
#endif
#ifdef DUP_RU
        GRID_BAR();
        for (int it = bx; it < 512; it += G) ret_u_item(P, lds, it);
#endif
#ifdef DUP_CV
        GRID_BAR();
        conv_task(P, l);
#endif
#ifdef DUP_SR
        GRID_BAR();
        sample_ret(P, l); sample_conv(P, l);
#endif
        GRID_BAR();
        for (int it = bx; it < 512; it += G) ret_o_item(P, lds, l, it);
#ifdef DUP_M2
        GRID_BAR();
        for (int it = bx; it < 512; it += G) ret_o_item(P, lds, l, it);
#endif
        }
        GRID_BAR();
        { unsigned* ctl = (unsigned*)(ws + WS_CTL); const int inst = 2 * l;
          skinny_gemm<4>(HM, (const bf16_t*)(ws + WS_WOUT) + (size_t)l * D * D, T1, ctl + CW_SAMPLE + 64 * inst, lds);
          pg8::Gemm g{HM, (const bf16_t*)(ws + WS_WOUT) + (size_t)l * D * D, NP, D, D}; pg8::StaticOrder S; S.init(NP, D, G, bx);
          EpiRmsFused E{&P, l, 1};
          pg8::gemm_phase<EpiRmsFused, pg8::StaticOrder, false, true>(lds, g, S, E);
          sample_rowpass<1>(P, l, ctl + CW_SAMPLE + 64 * inst); }
        GRID_BAR();
#ifndef REP_F1
#define REP_F1 1
#endif
        for (int rep = 0; rep < REP_F1; ++rep)
        { pg8::Gemm g{HM, (const bf16_t*)(ws + WS_W13) + (size_t)l * NFF1 * D, MP, NFF1, D}; pg8::StaticOrder S; S.init(MP, NFF1, G, bx);
          EpiSwiGLU E{PROJ};
          pg8::gemm_phase<EpiSwiGLU, pg8::StaticOrder, true, true>(lds, g, S, E); }
        GRID_BAR();
        { unsigned* ctl = (unsigned*)(ws + WS_CTL); const int inst = 2 * l + 1;
          skinny_gemm<11>(PROJ, (const bf16_t*)(ws + WS_W2) + (size_t)l * D * DFF, T1, ctl + CW_SAMPLE + 64 * inst, lds);
          pg8::Gemm g{PROJ, (const bf16_t*)(ws + WS_W2) + (size_t)l * D * DFF, NP, D, DFF}; pg8::StaticOrder S; S.init(NP, D, G, bx);
          EpiRmsFused E{&P, l, 2};
          pg8::gemm_phase<EpiRmsFused, pg8::StaticOrder, false, true>(lds, g, S, E);
          sample_rowpass<2>(P, l, ctl + CW_SAMPLE + 64 * inst); }
        if (l + 1 < DEPTH) GRID_BAR();
    }
}
}

extern "C" void kernel_launch(void* const* d_in, const int* in_sizes, int n_in, void* d_out, int out_size, void* d_ws, size_t ws_size, hipStream_t stream) {
    static int grid = 0;
    if (grid == 0) {
        if (n_in != 24 || (size_t)out_size != mk::O_END || ws_size < mk::WS_END) { fprintf(stderr, "kernel_launch: unexpected shapes: n_in %d out %d ws %zu\n", n_in, out_size, ws_size); grid = -1; return; }
        int dev = 0, cus = 0, per_cu = 0;
        hipGetDevice(&dev); hipDeviceGetAttribute(&cus, hipDeviceAttributeMultiprocessorCount, dev);
        hipFuncSetAttribute((const void*)mk::mk_fwd, hipFuncAttributeMaxDynamicSharedMemorySize, mk::LDS_BYTES);
        hipOccupancyMaxActiveBlocksPerMultiprocessor(&per_cu, (const void*)mk::mk_fwd, mk::NTHREADS, mk::LDS_BYTES);
        (void)hipGetLastError();
        if (per_cu < 1) { fprintf(stderr, "kernel_launch: occupancy query says %d blocks per CU\n", per_cu); per_cu = 1; }
        grid = cus;
    }
    if (grid < 0) return;
    if (hipMemsetAsync((char*)d_ws + mk::WS_CTL, 0, mk::CTL_ZERO_BYTES, stream) != hipSuccess) { fprintf(stderr, "kernel_launch: memset failed\n"); return; }
    mk::Params p{};
    for (int i = 0; i < 24; ++i) p.in[i] = (const float*)d_in[i];
    p.out = (float*)d_out; p.ws = (unsigned char*)d_ws;
    void* args[] = {&p};
    hipError_t e = hipLaunchCooperativeKernel((const void*)mk::mk_fwd, dim3(grid), dim3(mk::NTHREADS), args, mk::LDS_BYTES, stream);
    if (e != hipSuccess) fprintf(stderr, "kernel_launch: cooperative launch failed: %s (grid %d)\n", hipGetErrorString(e), grid);
}
```

```cpp
#include <hip/hip_runtime.h>
#include <cstdio>
#include <cstdint>
namespace pg8 {
#define PG8_LAS __attribute__((address_space(3)))
typedef unsigned short bf16_t;
typedef short bf16x8 __attribute__((ext_vector_type(8)));
typedef float f32x4 __attribute__((ext_vector_type(4)));
typedef unsigned u32x4 __attribute__((ext_vector_type(4)));
constexpr int BM = 256, BK = 64, HALF = 128, HTB = HALF * BK * 2  , STAGE_BYTES = 8 * HTB, NXCD = 8, WGM = 8;

__host__ __device__ __forceinline__ int lds_byte(int r, int c) { const int st = (r >> 4) * 2 + (c >> 5), rr = r & 15, cc = c & 31, ob = rr * 64 + cc * 2; return st * 1024 + (ob ^ (((ob >> 9) & 1) << 5)); }
__host__ __device__ __forceinline__ void stage_rc(int b, int& R, int& C) { const int st = b / 1024, sb = b % 1024, swz = sb ^ (((sb >> 9) & 1) << 5); R = (st >> 1) * 16 + swz / 64; C = (st & 1) * 32 + (swz % 64) / 2; }
__host__ __device__ __forceinline__ int perm32(int rho) { const int n = rho >> 4, i = rho & 15; return 8 * (i >> 2) + 4 * n + (i & 3); }

struct Unit { int pm, pn; };
struct Gemm { const bf16_t* A; const bf16_t* Bt; int M, N, K; };

struct StaticOrder {
    int nM, nN, nwg, G, c;
    __host__ __device__ void init(int M, int N, int G_, int c_) { nM = M / BM; nN = N / BM; nwg = nM * nN; G = G_; c = c_; }
    __host__ __device__ bool next(int i, Unit& u) const {
        const long L = (long)i * G + c; if (L >= nwg) return false;
        int wgid = (int)L; { const int q = nwg / NXCD, r = nwg % NXCD, xcd = wgid % NXCD, off = wgid / NXCD; wgid = (xcd < r ? xcd * (q + 1) : r * (q + 1) + (xcd - r) * q) + off; }
        const int nig = WGM * nN, gid = wgid / nig, fm = gid * WGM, gsz = (nM - fm) < WGM ? (nM - fm) : WGM;
        u.pm = fm + ((wgid % nig) % gsz); u.pn = (wgid % nig) / gsz; return true;
    }
    __device__ __forceinline__ void a_ready(const Unit&) const {}
    __device__ __forceinline__ void done(const Unit&) const {}
};

__device__ __forceinline__ unsigned cvt_pk_bf16(float lo, float hi) { unsigned r; asm volatile("v_cvt_pk_bf16_f32 %0, %1, %2" : "=v"(r) : "v"(lo), "v"(hi)); return r; }
typedef float f32x2 __attribute__((ext_vector_type(2)));
__device__ __forceinline__ f32x2 gelu_pk(f32x2 v) {
    const f32x2 av = __builtin_elementwise_abs(v), d = av * 0.2316418882f + 1.0f;
    f32x2 t; t.x = __builtin_amdgcn_rcpf(d.x); t.y = __builtin_amdgcn_rcpf(d.y);
    f32x2 q = t * 0.5307027145f + (-0.7265760135f); q = q * t + 0.7107068705f; q = q * t + (-0.142248368f); q = q * t + 0.127414796f; q = q * t;
    const f32x2 s = (v * v) * (-0.72134752044f);
    f32x2 e; e.x = __builtin_amdgcn_exp2f(s.x); e.y = __builtin_amdgcn_exp2f(s.y);
    const f32x2 m = v * (q * e), r = v - m;
    f32x2 o; o.x = v.x < 0.f ? m.x : r.x; o.y = v.y < 0.f ? m.y : r.y; return o;
}

template <int ACT  > struct EpiBf16 {
    static constexpr bool PERM = true, AFTER_DRAIN = false; static_assert(ACT == 0 || ACT == 1, "EpiBf16: ACT is 0 (none) or 1 (gelu_pk)");
    bf16_t* O; int ldc; const float* bias; int split_cols; size_t split_stride; float scale0;
    __device__ __forceinline__ void operator()(const f32x4 (&acc)[2][2][4][2], const Unit& u, int wr, int wc, int fr, int fq) const {
        const int row0 = u.pm * BM + wr * 64 + fr; int colt = u.pn * BM; bf16_t* base = O;
        float sc = 1.f; if (split_cols) { const int t = colt / split_cols; base += (size_t)t * split_stride; colt -= t * split_cols; if (t == 0) sc = scale0; }
        const int col0 = colt + wc * 32 + 8 * fq, bcol0 = u.pn * BM + wc * 32 + 8 * fq;
        f32x4 bv[2][2];
#pragma unroll
        for (int bj = 0; bj < 2; ++bj)
#pragma unroll
            for (int n = 0; n < 2; ++n) bv[bj][n] = bias ? *(const f32x4*)(bias + bcol0 + bj * HALF + 4 * n) : (f32x4){0.f, 0.f, 0.f, 0.f};
#pragma unroll
        for (int ai = 0; ai < 2; ++ai)
#pragma unroll
            for (int m = 0; m < 4; ++m) { bf16_t* rowp = base + (size_t)(row0 + ai * HALF + m * 16) * ldc + col0;
#pragma unroll
                for (int bj = 0; bj < 2; ++bj) { f32x4 v0 = acc[ai][bj][m][0] + bv[bj][0], v1 = acc[ai][bj][m][1] + bv[bj][1];
                    if (ACT == 1) { f32x2 a = gelu_pk((f32x2){v0[0], v0[1]}), b = gelu_pk((f32x2){v0[2], v0[3]}), c = gelu_pk((f32x2){v1[0], v1[1]}), d = gelu_pk((f32x2){v1[2], v1[3]});
                        v0 = (f32x4){a.x, a.y, b.x, b.y}; v1 = (f32x4){c.x, c.y, d.x, d.y}; }
                    v0 = v0 * sc; v1 = v1 * sc; u32x4 w; w.x = cvt_pk_bf16(v0[0], v0[1]); w.y = cvt_pk_bf16(v0[2], v0[3]); w.z = cvt_pk_bf16(v1[0], v1[1]); w.w = cvt_pk_bf16(v1[2], v1[3]);
                    *(u32x4*)(rowp + bj * HALF) = w; } }
    }
};

struct PanelStats {
    unsigned* xbuf;
    unsigned* cnt;
    unsigned* tmo;
    int ntn; float eps;
    unsigned code;
    __device__ __forceinline__ bool run(const f32x4 (&v)[2][2][4][2], const Unit& u, int wr, int wc, int fr, int fq, PG8_LAS unsigned char* lds, int wid, int lane) const {
        typedef float f32x2v __attribute__((ext_vector_type(2)));
        PG8_LAS f32x2v* P = (PG8_LAS f32x2v*)lds;
        PG8_LAS f32x2v* S = (PG8_LAS f32x2v*)(lds + 8192);
        PG8_LAS unsigned* flag = (PG8_LAS unsigned*)(lds + 8192 + 2048);
#pragma unroll
        for (int ai = 0; ai < 2; ++ai)
#pragma unroll
            for (int m = 0; m < 4; ++m) {
                float s = 0.f;
#pragma unroll
                for (int bj = 0; bj < 2; ++bj)
#pragma unroll
                    for (int n = 0; n < 2; ++n) { const f32x4 x = v[ai][bj][m][n]; s += (x[0] + x[1]) + (x[2] + x[3]); }
                s += __shfl_xor(s, 16); s += __shfl_xor(s, 32);
                const float mw = s * (1.0f / 64.0f); float q = 0.f;
#pragma unroll
                for (int bj = 0; bj < 2; ++bj)
#pragma unroll
                    for (int n = 0; n < 2; ++n) { const f32x4 d = v[ai][bj][m][n] - mw; q += (d[0] * d[0] + d[1] * d[1]) + (d[2] * d[2] + d[3] * d[3]); }
                q += __shfl_xor(q, 16); q += __shfl_xor(q, 32);
                if (fq == 0) P[(ai * HALF + wr * 64 + m * 16 + fr) * 4 + wc] = (f32x2v){mw, q};
            }
        asm volatile("s_waitcnt lgkmcnt(0)" ::: "memory"); __builtin_amdgcn_s_barrier(); asm volatile("" ::: "memory");
#if defined(BROKEN_EXCHANGE_NO_WAIT)
#warning BROKEN CONTROL BUILD: the row-statistics exchange does not wait; results are wrong by design
        if (blockIdx.x >= 64) { const long long t0_ = clock64(); while (clock64() - t0_ < 60000) __builtin_amdgcn_s_sleep(8); }
#endif
        const int row = wid * 32 + (lane & 31);
        if (lane < 32) {
            const f32x2v a = P[row * 4 + 0], b = P[row * 4 + 1], c = P[row * 4 + 2], d = P[row * 4 + 3];
            const float mt = (a.x + b.x + c.x + d.x) * 0.25f;
            const float da = a.x - mt, db = b.x - mt, dc = c.x - mt, dd = d.x - mt;
            const float m2 = (a.y + b.y) + (c.y + d.y) + 64.0f * ((da * da + db * db) + (dc * dc + dd * dd));
            unsigned long long* slot = (unsigned long long*)xbuf + ((size_t)(u.pm * BM + row) * 4 + u.pn);
            __hip_atomic_store(slot, ((unsigned long long)__float_as_uint(m2) << 32) | __float_as_uint(mt), __ATOMIC_RELAXED, __HIP_MEMORY_SCOPE_AGENT);
        }
        asm volatile("s_waitcnt vmcnt(0)" ::: "memory");
        if (lane == 0) __hip_atomic_fetch_add(cnt + 64 * u.pm, 1u, __ATOMIC_RELAXED, __HIP_MEMORY_SCOPE_AGENT);
        if (wid == 0) {
            bool dead = false; const unsigned long long t0 = __builtin_amdgcn_s_memrealtime(); const unsigned want = 8u * (unsigned)ntn;
            for (;;) {
#if defined(BROKEN_EXCHANGE_NO_WAIT)
                break;
#endif
                if ((unsigned)__builtin_amdgcn_readfirstlane(__hip_atomic_load(cnt + 64 * u.pm, __ATOMIC_RELAXED, __HIP_MEMORY_SCOPE_AGENT)) >= want) break;
                if (__builtin_amdgcn_s_memrealtime() - t0 > 2000000ull) {
                    if (lane == 0) { unsigned expect = 0u; __hip_atomic_compare_exchange_strong(tmo + 1, &expect, code | (unsigned)(u.pm & 0xff), __ATOMIC_RELAXED, __ATOMIC_RELAXED, __HIP_MEMORY_SCOPE_AGENT);
                                     __hip_atomic_store(tmo, 1u, __ATOMIC_RELAXED, __HIP_MEMORY_SCOPE_AGENT); }
                    dead = true; break; }
                __builtin_amdgcn_s_sleep(2);
            }
            __builtin_amdgcn_fence(__ATOMIC_ACQUIRE, "agent");
            if (lane == 0) flag[0] = dead ? 1u : 0u;
        }
        asm volatile("s_waitcnt vmcnt(0) lgkmcnt(0)" ::: "memory"); __builtin_amdgcn_s_barrier(); asm volatile("" ::: "memory");
        const bool bad = flag[0] != 0u;
        if (lane < 32) {
            const unsigned long long* slot = (const unsigned long long*)xbuf + (size_t)(u.pm * BM + row) * 4; float mt[4], m2[4]; float ms = 0.f;
#pragma unroll
            for (int t = 0; t < 4; ++t) { if (t < ntn) { const unsigned long long w = __hip_atomic_load(slot + t, __ATOMIC_RELAXED, __HIP_MEMORY_SCOPE_AGENT); mt[t] = __uint_as_float((unsigned)w); m2[t] = __uint_as_float((unsigned)(w >> 32)); } else { mt[t] = 0.f; m2[t] = 0.f; } ms += mt[t]; }
            const float mean = ms / (float)ntn; float q = 0.f;
#pragma unroll
            for (int t = 0; t < 4; ++t) if (t < ntn) { const float dm = mt[t] - mean; q += m2[t] + 256.0f * dm * dm; }
            S[row] = (f32x2v){mean, 1.0f / sqrtf(q / (256.0f * (float)ntn) + eps)};
        }
        asm volatile("s_waitcnt lgkmcnt(0)" ::: "memory"); __builtin_amdgcn_s_barrier(); asm volatile("" ::: "memory");
        return bad;
    }
};
struct EpiLnRes {
    static constexpr bool PERM = false, AFTER_DRAIN = true;
    const float* base; float* out; int ldc; const float* bias; PanelStats st; unsigned poison;
    __device__ __forceinline__ void fused(f32x4 (&acc)[2][2][4][2], const Unit& u, int wr, int wc, int fr, int fq, PG8_LAS unsigned char* lds, int wid, int lane) const {
        typedef float f32x2v __attribute__((ext_vector_type(2)));
        const PG8_LAS f32x2v* S = (const PG8_LAS f32x2v*)(lds + 8192);
        const int col0 = u.pn * BM + wc * 32 + 4 * fq;
#pragma unroll
        for (int bj = 0; bj < 2; ++bj)
#pragma unroll
            for (int n = 0; n < 2; ++n) { const f32x4 bv = bias ? *(const f32x4*)(bias + col0 + bj * HALF + n * 16) : (f32x4){0.f, 0.f, 0.f, 0.f};
#pragma unroll
                for (int ai = 0; ai < 2; ++ai)
#pragma unroll
                    for (int m = 0; m < 4; ++m) acc[ai][bj][m][n] += bv; }
        f32x4 pre[4][2][2];
#pragma unroll
        for (int m = 0; m < 4; ++m) { const size_t off = (size_t)(u.pm * BM + wr * 64 + m * 16 + fr) * ldc + col0;
#pragma unroll
            for (int bj = 0; bj < 2; ++bj)
#pragma unroll
                for (int n = 0; n < 2; ++n) pre[m][bj][n] = *(const f32x4*)(base + off + bj * HALF + n * 16); }
        const bool bad = st.run(acc, u, wr, wc, fr, fq, lds, wid, lane) || poison != 0u;
        const float qnan = __builtin_nanf("");
#pragma unroll
        for (int ai = 0; ai < 2; ++ai)
#pragma unroll
            for (int m = 0; m < 4; ++m) { const int r = ai * HALF + wr * 64 + m * 16 + fr; const f32x2v sr = S[r]; const size_t off = (size_t)(u.pm * BM + r) * ldc + col0;
#pragma unroll
                for (int bj = 0; bj < 2; ++bj)
#pragma unroll
                    for (int n = 0; n < 2; ++n) { const f32x4 bs = ai == 0 ? pre[m][bj][n] : *(const f32x4*)(base + off + bj * HALF + n * 16); f32x4 o = bs + (acc[ai][bj][m][n] - sr.x) * sr.y;
                        if (bad) o = (f32x4){qnan, qnan, qnan, qnan}; *(f32x4*)(out + off + bj * HALF + n * 16) = o; }
                if (m & 1) asm volatile("" ::: "memory"); }
    }
};
struct EpiLnResLn {
    static constexpr bool PERM = false, AFTER_DRAIN = true;
    const float* base; float* out; bf16_t* xn; int ldc; const float* bias; PanelStats st1, st2; unsigned poison;
    __device__ __forceinline__ void fused(f32x4 (&acc)[2][2][4][2], const Unit& u, int wr, int wc, int fr, int fq, PG8_LAS unsigned char* lds, int wid, int lane) const {
        typedef float f32x2v __attribute__((ext_vector_type(2))); typedef unsigned u32x2v __attribute__((ext_vector_type(2)));
        const PG8_LAS f32x2v* S = (const PG8_LAS f32x2v*)(lds + 8192);
        const int col0 = u.pn * BM + wc * 32 + 4 * fq;
#pragma unroll
        for (int bj = 0; bj < 2; ++bj)
#pragma unroll
            for (int n = 0; n < 2; ++n) { const f32x4 bv = bias ? *(const f32x4*)(bias + col0 + bj * HALF + n * 16) : (f32x4){0.f, 0.f, 0.f, 0.f};
#pragma unroll
                for (int ai = 0; ai < 2; ++ai)
#pragma unroll
                    for (int m = 0; m < 4; ++m) acc[ai][bj][m][n] += bv; }
        bool bad = st1.run(acc, u, wr, wc, fr, fq, lds, wid, lane) || poison != 0u;
        const float qnan = __builtin_nanf("");
#pragma unroll
        for (int ai = 0; ai < 2; ++ai)
#pragma unroll
            for (int m = 0; m < 4; ++m) { const int r = ai * HALF + wr * 64 + m * 16 + fr; const f32x2v sr = S[r]; const size_t off = (size_t)(u.pm * BM + r) * ldc + col0;
#pragma unroll
                for (int bj = 0; bj < 2; ++bj)
#pragma unroll
                    for (int n = 0; n < 2; ++n) { const f32x4 bs = *(const f32x4*)(base + off + bj * HALF + n * 16); acc[ai][bj][m][n] = bs + (acc[ai][bj][m][n] - sr.x) * sr.y; }
                asm volatile("" : "+v"(acc[ai][0][m][0]), "+v"(acc[ai][0][m][1]), "+v"(acc[ai][1][m][0]), "+v"(acc[ai][1][m][1]));
                if (m & 1) asm volatile("" ::: "memory"); }
        const bool bad1 = bad;
        bad = st2.run(acc, u, wr, wc, fr, fq, lds, wid, lane) || bad;
#pragma unroll
        for (int ai = 0; ai < 2; ++ai)
#pragma unroll
            for (int m = 0; m < 4; ++m) { const int r = ai * HALF + wr * 64 + m * 16 + fr; const f32x2v sr = S[r]; const size_t off = (size_t)(u.pm * BM + r) * ldc + col0;
#pragma unroll
                for (int bj = 0; bj < 2; ++bj)
#pragma unroll
                    for (int n = 0; n < 2; ++n) { const f32x4 x1 = acc[ai][bj][m][n]; *(f32x4*)(out + off + bj * HALF + n * 16) = bad1 ? (f32x4){qnan, qnan, qnan, qnan} : x1;
                        const f32x4 o = (x1 - sr.x) * sr.y; u32x2v w; w.x = cvt_pk_bf16(o[0], o[1]); w.y = cvt_pk_bf16(o[2], o[3]);
                        if (bad) { w.x = 0x7fc07fc0u; w.y = 0x7fc07fc0u; } *(u32x2v*)(xn + off + bj * HALF + n * 16) = w; }
                asm volatile("" ::: "memory"); }
    }
};

template <class Epi, class Sched, bool ALIGN_EPI = false, bool SP2 = false>
__device__ __forceinline__ void gemm_phase(PG8_LAS unsigned char* lds, const Gemm g, const Sched& S, const Epi& E) {
    int tid_ = threadIdx.x; asm volatile("" : "+v"(tid_));
    const int tid = tid_, wid = __builtin_amdgcn_readfirstlane(tid >> 6), lane = tid & 63, wr = wid >> 2, wc = wid & 3, fr = lane & 15, fq = lane >> 4;
    const int K = g.K, nt = K / BK;
    unsigned voffA[2], voffB[2];
#pragma unroll
    for (int i = 0; i < 2; ++i) { int R, C; stage_rc(tid * 16 + i * 8192, R, C); const int Rb = Epi::PERM ? ((R & ~31) + perm32(R & 31)) : R;
        voffA[i] = (unsigned)(R * K + C) * 2u; voffB[i] = (unsigned)(Rb * K + C) * 2u; }
    const size_t kstep = (size_t)(BK * 2);
    const size_t hstep = (size_t)HALF * K * 2;
    const size_t tstep = 2 * hstep;
    const unsigned ldsw = (unsigned)wid * 1024u;
    const int aoff = lds_byte(wr * 64 + fr, fq * 8), boff = lds_byte(wc * 32 + fr, fq * 8);
#define PG8_SA(b, h) (((b) * 2 + (h)) * HTB)
#define PG8_SB(b, h) ((4 + (b) * 2 + (h)) * HTB)
#define PG8_STAGE(bufoff, gbase, voff) do { _Pragma("unroll") for (int _i = 0; _i < 2; ++_i) \
        __builtin_amdgcn_global_load_lds((const unsigned*)((const char*)(gbase) + (voff)[_i]), (PG8_LAS unsigned*)(lds + (bufoff) + ldsw + _i * 8192), 16, 0, 0); } while (0)
#define PG8_LDA(dst, b, h) do { _Pragma("unroll") for (int m = 0; m < 4; ++m) _Pragma("unroll") for (int k = 0; k < 2; ++k) dst[m][k] = *(const PG8_LAS bf16x8*)(lds + PG8_SA(b, h) + aoff + m * 2048 + k * 1024); } while (0)
#define PG8_LDB(dst, b, h) do { _Pragma("unroll") for (int n = 0; n < 2; ++n) _Pragma("unroll") for (int k = 0; k < 2; ++k) dst[n][k] = *(const PG8_LAS bf16x8*)(lds + PG8_SB(b, h) + boff + n * 2048 + k * 1024); } while (0)
#define PG8_MMA(ai, bj, At, Bt) do { __builtin_amdgcn_s_setprio(1); _Pragma("unroll") for (int m = 0; m < 4; ++m) _Pragma("unroll") for (int n = 0; n < 2; ++n) _Pragma("unroll") for (int k = 0; k < 2; ++k) \
        acc[ai][bj][m][n] = __builtin_amdgcn_mfma_f32_16x16x32_bf16(Bt[n][k], At[m][k], acc[ai][bj][m][n], 0, 0, 0); __builtin_amdgcn_s_setprio(0); } while (0)
#define PG8_WAIT_V(n) asm volatile("s_waitcnt vmcnt(" #n ")" ::: "memory")
#define PG8_WAIT_L(n) asm volatile("s_waitcnt lgkmcnt(" #n ")" ::: "memory")
#define PG8_BAR __builtin_amdgcn_s_barrier()
#define PG8_SCHED __builtin_amdgcn_sched_barrier(0)
    Unit cur, nxt; int ui = 0;
    if (!S.next(0, cur)) return;
    f32x4 acc[2][2][4][2];
#pragma unroll
    for (int a = 0; a < 2; ++a)
#pragma unroll
        for (int b = 0; b < 2; ++b)
#pragma unroll
            for (int m = 0; m < 4; ++m)
#pragma unroll
                for (int n = 0; n < 2; ++n) acc[a][b][m][n] = (f32x4){0.f, 0.f, 0.f, 0.f};
    bf16x8 At[4][2], B0[2][2], B1[2][2];
    const char* cA = (const char*)g.A + (size_t)cur.pm * tstep; const char* cB = (const char*)g.Bt + (size_t)cur.pn * tstep;
    S.a_ready(cur);
    if constexpr (SP2) {
        PG8_STAGE(PG8_SB(0, 0), cB, voffB); PG8_STAGE(PG8_SB(0, 1), cB + hstep, voffB); PG8_STAGE(PG8_SA(0, 0), cA, voffA); PG8_STAGE(PG8_SA(0, 1), cA + hstep, voffA);
        if (wr == 1) PG8_BAR;
        PG8_WAIT_V(2); PG8_BAR;
        PG8_STAGE(PG8_SB(1, 0), cB + kstep, voffB); PG8_STAGE(PG8_SA(1, 0), cA + kstep, voffA); PG8_STAGE(PG8_SB(1, 1), cB + hstep + kstep, voffB);
        PG8_WAIT_V(6); PG8_BAR;
    } else {
        PG8_STAGE(PG8_SB(0, 0), cB, voffB); PG8_STAGE(PG8_SA(0, 0), cA, voffA); PG8_STAGE(PG8_SB(0, 1), cB + hstep, voffB); PG8_STAGE(PG8_SA(0, 1), cA + hstep, voffA);
        if (wr == 1) PG8_BAR;
        PG8_WAIT_V(4); PG8_BAR;
        PG8_STAGE(PG8_SB(1, 0), cB + kstep, voffB); PG8_STAGE(PG8_SA(1, 0), cA + kstep, voffA); PG8_STAGE(PG8_SB(1, 1), cB + hstep + kstep, voffB);
        PG8_WAIT_V(6); PG8_BAR;
    }
    for (;;) {
        const bool has_next = S.next(ui + 1, nxt);
        const char* nA = has_next ? (const char*)g.A + (size_t)nxt.pm * tstep : cA; const char* nB = has_next ? (const char*)g.Bt + (size_t)nxt.pn * tstep : cB;
        for (int t = 0; t < nt; t += 2) {
            const bool last = (t == nt - 2);
            const char* a1 = cA + (size_t)(t + 1) * kstep;
            const char* a2 = last ? nA : cA + (size_t)(t + 2) * kstep; const char* b2 = last ? nB : cB + (size_t)(t + 2) * kstep;
            const char* a3 = a2 + kstep; const char* b3 = b2 + kstep;
            if (last && has_next) S.a_ready(nxt);
            if constexpr (SP2) {
            PG8_LDB(B0, 0, 0); PG8_LDB(B1, 0, 1); PG8_SCHED; PG8_LDA(At, 0, 0); PG8_STAGE(PG8_SA(1, 1), a1 + hstep, voffA);
            PG8_WAIT_V(8); PG8_WAIT_L(0); PG8_BAR; PG8_MMA(0, 0, At, B0); PG8_MMA(0, 1, At, B1); PG8_BAR; PG8_SCHED;
            PG8_LDA(At, 0, 1); PG8_STAGE(PG8_SB(0, 0), b2, voffB); PG8_STAGE(PG8_SB(0, 1), b2 + hstep, voffB); PG8_STAGE(PG8_SA(0, 0), a2, voffA);
            PG8_WAIT_V(8); PG8_WAIT_L(0); PG8_BAR; PG8_MMA(1, 0, At, B0); PG8_MMA(1, 1, At, B1); PG8_BAR; PG8_SCHED;
            PG8_LDB(B0, 1, 0); PG8_LDB(B1, 1, 1); PG8_SCHED; PG8_LDA(At, 1, 0); PG8_STAGE(PG8_SA(0, 1), a2 + hstep, voffA);
            PG8_WAIT_V(8); PG8_WAIT_L(0); PG8_BAR; PG8_MMA(0, 0, At, B0); PG8_MMA(0, 1, At, B1); PG8_BAR; PG8_SCHED;
            PG8_LDA(At, 1, 1); PG8_STAGE(PG8_SB(1, 0), b3, voffB); PG8_STAGE(PG8_SB(1, 1), b3 + hstep, voffB); PG8_STAGE(PG8_SA(1, 0), a3, voffA);
            PG8_WAIT_V(8); PG8_WAIT_L(0); PG8_BAR; PG8_MMA(1, 0, At, B0); PG8_MMA(1, 1, At, B1); PG8_BAR; PG8_SCHED;
            } else {
            PG8_LDB(B0, 0, 0); PG8_SCHED; PG8_LDA(At, 0, 0); PG8_STAGE(PG8_SA(1, 1), a1 + hstep, voffA);
            PG8_WAIT_L(8); PG8_BAR; PG8_WAIT_L(0); PG8_MMA(0, 0, At, B0); PG8_BAR; PG8_SCHED;
            PG8_LDB(B1, 0, 1); PG8_STAGE(PG8_SB(0, 0), b2, voffB);
            PG8_BAR; PG8_WAIT_L(0); PG8_MMA(0, 1, At, B1); PG8_BAR;
            PG8_LDA(At, 0, 1); PG8_STAGE(PG8_SA(0, 0), a2, voffA);
            PG8_BAR; PG8_WAIT_L(0); PG8_MMA(1, 0, At, B0); PG8_BAR; PG8_SCHED;
            PG8_STAGE(PG8_SB(0, 1), b2 + hstep, voffB);
            PG8_WAIT_V(6); PG8_BAR; PG8_MMA(1, 1, At, B1); PG8_BAR;
            PG8_LDB(B0, 1, 0); PG8_SCHED; PG8_LDA(At, 1, 0); PG8_STAGE(PG8_SA(0, 1), a2 + hstep, voffA);
            PG8_WAIT_L(8); PG8_BAR; PG8_WAIT_L(0); PG8_MMA(0, 0, At, B0); PG8_BAR; PG8_SCHED;
            PG8_LDB(B1, 1, 1); PG8_STAGE(PG8_SB(1, 0), b3, voffB);
            PG8_BAR; PG8_WAIT_L(0); PG8_MMA(0, 1, At, B1); PG8_BAR;
            PG8_LDA(At, 1, 1); PG8_STAGE(PG8_SA(1, 0), a3, voffA);
            PG8_BAR; PG8_WAIT_L(0); PG8_MMA(1, 0, At, B0); PG8_BAR; PG8_SCHED;
            PG8_STAGE(PG8_SB(1, 1), b3 + hstep, voffB);
            PG8_WAIT_V(6); PG8_BAR; PG8_MMA(1, 1, At, B1); PG8_BAR;
            }
        }
        if constexpr (ALIGN_EPI) { if (wr == 0) PG8_BAR; }
        if constexpr (!Epi::AFTER_DRAIN) { E(acc, cur, wr, wc, fr, fq); S.done(cur); }
        if (!has_next) break;
#pragma unroll
        for (int a = 0; a < 2; ++a)
#pragma unroll
            for (int b = 0; b < 2; ++b)
#pragma unroll
                for (int m = 0; m < 4; ++m)
#pragma unroll
                    for (int n = 0; n < 2; ++n) acc[a][b][m][n] = (f32x4){0.f, 0.f, 0.f, 0.f};
        cur = nxt; cA = nA; cB = nB; ++ui;
        if constexpr (ALIGN_EPI) { if (wr == 1) PG8_BAR; }
    }
    PG8_WAIT_V(0);
    if constexpr (!ALIGN_EPI) { if (wr == 0) PG8_BAR; }
    PG8_BAR;
    if constexpr (Epi::AFTER_DRAIN) { E.fused(acc, cur, wr, wc, fr, fq, lds, wid, lane); S.done(cur); }
#undef PG8_SA
#undef PG8_SB
#undef PG8_STAGE
#undef PG8_LDA
#undef PG8_LDB
#undef PG8_MMA
#undef PG8_WAIT_V
#undef PG8_WAIT_L
#undef PG8_BAR
#undef PG8_SCHED
}
}

#include <hip/hip_cooperative_groups.h>
namespace cg = cooperative_groups;
namespace mk {
using pg8::bf16_t; using pg8::bf16x8; using pg8::f32x4; using pg8::u32x4;
#define MK_LAS __attribute__((address_space(3)))
typedef unsigned u32x2 __attribute__((ext_vector_type(2)));
typedef float f32x2v __attribute__((ext_vector_type(2)));

#define LAS MK_LAS
#define XB_TMO      128
#define XB_XCNT(j)  (256  + 64 * (j))
#define XB_XSUB(j)  (1280 + 64 * (j))
#define XB_XGEN(j)  (2304 + 64 * (j))
#define XB_TOP      3328
#define XB_TOPGEN   3392
#define XCD_BAR_WORDS 3456
#define XB_SPIN_CAP (1u << 18)

__device__ __forceinline__ unsigned xb_ld(unsigned* p)              { return __hip_atomic_load(p, __ATOMIC_RELAXED, __HIP_MEMORY_SCOPE_AGENT); }
__device__ __forceinline__ unsigned xb_add(unsigned* p, unsigned v) { return __hip_atomic_fetch_add(p, v, __ATOMIC_RELAXED, __HIP_MEMORY_SCOPE_AGENT); }
__device__ __forceinline__ unsigned xb_xcc_id() { return (unsigned)__builtin_amdgcn_s_getreg((3 << 11) | 20) & 0xFu; }
#define XB_SPIN(cond, bar) do { unsigned _sp = 0; while (cond) { __builtin_amdgcn_s_sleep(1); \
    if ((++_sp & 255u) == 0u) { if (xb_ld(&(bar)[XB_TMO])) break; if (_sp > XB_SPIN_CAP) { atomicAdd(&(bar)[XB_TMO], 1u); break; } } } } while (0)

struct XcdBarrier {
    unsigned* bar; unsigned x;
    volatile LAS unsigned* st;
};

__device__ __forceinline__ XcdBarrier xcd_barrier_post(unsigned* bar, volatile LAS unsigned* st) {
    XcdBarrier b; b.bar = bar; b.x = xb_xcc_id(); b.st = st;
    if (threadIdx.x == 0) (void)xb_add(&bar[XB_XCNT(b.x)], 1u);
    return b;
}
__device__ __forceinline__ void xcd_barrier_complete(unsigned* bar, unsigned x, unsigned& nloc, unsigned& nx) {
    const unsigned G = gridDim.x * gridDim.y * gridDim.z;
    unsigned sum, cnt, mine, sp = 0u;
    for (;;) {
        sum = 0u; cnt = 0u; mine = 0u;
#pragma unroll
        for (unsigned j = 0; j < 16; ++j) { const unsigned c = xb_ld(&bar[XB_XCNT(j)]); sum += c; cnt += (c > 0u) ? 1u : 0u; mine = (j == x) ? c : mine; }
        if (sum == G) break;
        __builtin_amdgcn_s_sleep(1);
        if ((++sp & 255u) == 0u) { if (xb_ld(&bar[XB_TMO])) break; if (sp > XB_SPIN_CAP) { atomicAdd(&bar[XB_TMO], 1u); break; } }
    }
    nloc = mine > 0u ? mine : 1u; nx = cnt > 0u ? cnt : 1u;
}

__device__ __forceinline__ void xcd_barrier(const XcdBarrier& b) {
    asm volatile("s_waitcnt vmcnt(0)" ::: "memory");
    __syncthreads();
    if (threadIdx.x == 0) {
        unsigned* bar = b.bar;
        __builtin_amdgcn_s_waitcnt(0);
        unsigned nloc = b.st[0], nx = b.st[1];
        if (nloc == 0u) { xcd_barrier_complete(bar, b.x, nloc, nx); b.st[0] = nloc; b.st[1] = nx; }
        const unsigned old = xb_add(&bar[XB_XSUB(b.x)], 1u);
        const unsigned gen = old / nloc;
        if (old + 1u == (gen + 1u) * nloc) {
            __builtin_amdgcn_fence(__ATOMIC_RELEASE, "agent");
            asm volatile("s_waitcnt vmcnt(0)" ::: "memory");
            const unsigned og = xb_add(&bar[XB_TOP], 1u);
            const unsigned tg = og / nx;
            if (og + 1u == (tg + 1u) * nx) xb_add(&bar[XB_TOPGEN], 1u);
            else XB_SPIN(xb_ld(&bar[XB_TOPGEN]) == tg, bar);
            __builtin_amdgcn_fence(__ATOMIC_ACQUIRE, "agent");
            xb_add(&bar[XB_XGEN(b.x)], 1u);
            asm volatile("s_waitcnt vmcnt(0)" ::: "memory");
        } else {
            XB_SPIN(xb_ld(&bar[XB_XGEN(b.x)]) == gen, bar);
            __builtin_amdgcn_fence(__ATOMIC_ACQUIRE, "agent");
            asm volatile("s_waitcnt vmcnt(0)" ::: "memory");
        }
    }
    __syncthreads();
}

#undef LAS
constexpr int D = 1024, NP = 16384, NS = 128, MR = NP + NS, MP = 16640, SEQ = 2048, NB = 8;
constexpr int INW = 2816, DFF = 2816, NFF1 = 5632, NMOD = 12288, MODROWS = 136, DEPTH = 2;
constexpr float EPS = 1e-6f;
constexpr int NWAVES = 8, NTHREADS = 512;
#ifndef REP_P0
#define REP_P0 1
#endif
#ifndef REP_MIX
#define REP_MIX 1
#endif
#ifndef REP_R0
#define REP_R0 1
#endif
#ifndef REP_WIN
#define REP_WIN 1
#endif
#ifndef REP_F2
#define REP_F2 1
#endif
constexpr int LDS_BYTES = 163840;

constexpr int LDP = 2304, PQ = 0, PK = 256, PV = 512, PG = 1024, PU = 1536, PCB = 1792, PZ = 2048;

constexpr size_t MiB = 1u << 20;
constexpr size_t WS_CTL = 0, CTL_ZERO_BYTES = 98304;
constexpr int LDS_CTL_OFF = 163584;
constexpr int CW_SAMPLE = 3840, CW_PANEL = 4096;
constexpr int CW_SCAN = 3584;
static_assert(XCD_BAR_WORDS <= CW_SCAN && (CW_SCAN + 64) * 4 <= CTL_ZERO_BYTES && (CW_PANEL + 4 * 4096) * 4 <= CTL_ZERO_BYTES, "ctl");
constexpr size_t WS_WIN = 1 * MiB, WS_WOUT = 12 * MiB, WS_W13 = 16 * MiB, WS_W2 = 38 * MiB, WS_MOD = 49 * MiB, WS_HM = 56 * MiB,
                 WS_T1 = 89 * MiB, WS_PROJ = 122 * MiB, WS_U = 212 * MiB, WS_SS = 228 * MiB, WS_X = 236 * MiB, WS_T1S = 240 * MiB, WS_END = 241 * MiB;
constexpr size_t WS_XB = WS_T1;
constexpr size_t WS_ADAT = WS_T1, WS_AC = WS_T1 + 24 * MiB;
static_assert(WS_WIN + (size_t)DEPTH * INW * D * 2 <= WS_WOUT && WS_WOUT + (size_t)DEPTH * D * D * 2 <= WS_W13 && WS_W13 + (size_t)DEPTH * NFF1 * D * 2 <= WS_W2 &&
              WS_W2 + (size_t)DEPTH * D * DFF * 2 <= WS_MOD && WS_MOD + (size_t)MODROWS * NMOD * 4 <= WS_HM && WS_HM + (size_t)MP * D * 2 <= WS_T1 &&
              WS_T1 + (size_t)MP * D * 2 <= WS_PROJ && WS_AC + 256 * D * 2 <= WS_PROJ && WS_PROJ + (size_t)MP * LDP * 2 <= WS_U && WS_U + (size_t)512 * 8192 * 4 <= WS_SS && WS_SS + (size_t)512 * 8192 * 2 <= WS_END, "ws map");

constexpr size_t O_Y = 0, O_YS = (size_t)NP * D, O_RETP = O_YS + (size_t)NS * D, O_CAP = O_RETP + (size_t)DEPTH * NB * 4 * 64 * 128,
                 O_CCP = O_CAP + (size_t)DEPTH * NB * 30 * 256, O_RETS = O_CCP + (size_t)DEPTH * NB * 2 * 256,
                 O_CAS = O_RETS + (size_t)DEPTH * NS * 4 * 64 * 128, O_CCS = O_CAS + (size_t)DEPTH * NS * 30 * 256, O_END = O_CCS + (size_t)DEPTH * NS * 2 * 256;

struct Params { const float* in[24]; float* out; unsigned char* ws; };

__device__ const double kInvRev[32] = {
0.15915494309189535, 0.11934937021124886, 0.08949940160889101, 0.06711508300522726, 0.050329212104487035, 0.03774158471741977, 0.0283021958306234, 0.02122365276477766,
0.015915494309189534, 0.011934937021124886, 0.008949940160889102, 0.006711508300522725, 0.005032921210448704, 0.003774158471741977, 0.00283021958306234, 0.0021223652764777662,
0.0015915494309189536, 0.0011934937021124885, 0.0008949940160889102, 0.0006711508300522726, 0.0005032921210448703, 0.00037741584717419774, 0.00028302195830623395, 0.0002122365276477766,
0.00015915494309189535, 0.00011934937021124886, 8.949940160889102e-05, 6.711508300522725e-05, 5.0329212104487035e-05, 3.774158471741978e-05, 2.8302195830623396e-05, 2.122365276477766e-05};

__device__ __forceinline__ float bf2f(unsigned short b) { return __uint_as_float((unsigned)b << 16); }
__device__ __forceinline__ float bflo(unsigned w) { return __uint_as_float(w << 16); }
__device__ __forceinline__ float bfhi(unsigned w) { return __uint_as_float(w & 0xffff0000u); }
__device__ __forceinline__ f32x4 unpack4(u32x2 w) { return (f32x4){bflo(w.x), bfhi(w.x), bflo(w.y), bfhi(w.y)}; }
__device__ __forceinline__ u32x2 pack4(f32x4 v) { u32x2 w; w.x = pg8::cvt_pk_bf16(v[0], v[1]); w.y = pg8::cvt_pk_bf16(v[2], v[3]); return w; }
__device__ __forceinline__ float sigmoidf_(float x) { return __builtin_amdgcn_rcpf(1.0f + __expf(-x)); }
__device__ __forceinline__ float siluf_(float x) { return x * sigmoidf_(x); }
__device__ __forceinline__ float wave_sum(float v) {
#pragma unroll
    for (int o = 1; o < 64; o <<= 1) v += __shfl_xor(v, o);
    return v;
}
__device__ __forceinline__ float log2_gamma(int h) { return __log2f(1.0f - exp2f(-5.0f - (float)h)); }

struct EpiMod {
    static constexpr bool PERM = false, AFTER_DRAIN = false;
    float* O; const float* bias;
    __device__ __forceinline__ void operator()(const f32x4 (&acc)[2][2][4][2], const pg8::Unit& u, int wr, int wc, int fr, int fq) const {
        const int col0 = u.pn * 256 + wc * 32 + 4 * fq;
#pragma unroll
        for (int ai = 0; ai < 2; ++ai)
#pragma unroll
            for (int m = 0; m < 4; ++m) { const int row = u.pm * 256 + ai * 128 + wr * 64 + m * 16 + fr;
                if (row < MODROWS) {
#pragma unroll
                    for (int bj = 0; bj < 2; ++bj)
#pragma unroll
                        for (int n = 0; n < 2; ++n) { const int col = col0 + bj * 128 + n * 16; *(f32x4*)(O + (size_t)row * NMOD + col) = acc[ai][bj][m][n] + *(const f32x4*)(bias + col); } } }
    }
};
struct EpiSwiGLU {
    static constexpr bool PERM = true, AFTER_DRAIN = false;
    bf16_t* O;
    __device__ __forceinline__ void operator()(const f32x4 (&acc)[2][2][4][2], const pg8::Unit& u, int wr, int wc, int fr, int fq) const {
        const int col0 = u.pn * 128 + wc * 32 + 8 * fq;
#pragma unroll
        for (int ai = 0; ai < 2; ++ai)
#pragma unroll
            for (int m = 0; m < 4; ++m) { bf16_t* rowp = O + (size_t)(u.pm * 256 + ai * 128 + wr * 64 + m * 16 + fr) * DFF + col0;
                f32x4 a0 = acc[ai][0][m][0], a1 = acc[ai][0][m][1]; const f32x4 b0 = acc[ai][1][m][0], b1 = acc[ai][1][m][1];
#pragma unroll
                for (int i = 0; i < 4; ++i) { a0[i] = siluf_(a0[i]) * b0[i]; a1[i] = siluf_(a1[i]) * b1[i]; }
                u32x4 w; w.x = pg8::cvt_pk_bf16(a0[0], a0[1]); w.y = pg8::cvt_pk_bf16(a0[2], a0[3]); w.z = pg8::cvt_pk_bf16(a1[0], a1[1]); w.w = pg8::cvt_pk_bf16(a1[2], a1[3]);
                *(u32x4*)rowp = w; }
    }
};

struct EpiProj {
    static constexpr bool PERM = true, AFTER_DRAIN = false;
    bf16_t* O;
    __device__ __forceinline__ void operator()(const f32x4 (&acc)[2][2][4][2], const pg8::Unit& u, int wr, int wc, int fr, int fq) const {
        const int pn = u.pn; const int mode = (pn == 6 || pn == 7) ? 1 : (pn >= 9 ? 2 : 0);
        const int cbase = mode == 0 ? (pn == 8 ? PCB : 256 * pn) : (mode == 1 ? PU + 128 * (pn - 6) : PZ + 128 * (pn - 9));
        const int col0 = cbase + wc * 32 + 8 * fq;
#pragma unroll
        for (int ai = 0; ai < 2; ++ai)
#pragma unroll
            for (int m = 0; m < 4; ++m) { bf16_t* rowp = O + (size_t)(u.pm * 256 + ai * 128 + wr * 64 + m * 16 + fr) * LDP + col0;
                if (mode == 0) {
#pragma unroll
                    for (int bj = 0; bj < 2; ++bj) { const f32x4 v0 = acc[ai][bj][m][0], v1 = acc[ai][bj][m][1];
                        u32x4 w; w.x = pg8::cvt_pk_bf16(v0[0], v0[1]); w.y = pg8::cvt_pk_bf16(v0[2], v0[3]); w.z = pg8::cvt_pk_bf16(v1[0], v1[1]); w.w = pg8::cvt_pk_bf16(v1[2], v1[3]);
                        *(u32x4*)(rowp + bj * 128) = w; }
                } else { f32x4 a0 = acc[ai][0][m][0], a1 = acc[ai][0][m][1]; const f32x4 b0 = acc[ai][1][m][0], b1 = acc[ai][1][m][1];
                    if (mode == 1) {
#pragma unroll
                        for (int i = 0; i < 4; ++i) { a0[i] = a0[i] * sigmoidf_(b0[i]); a1[i] = a1[i] * sigmoidf_(b1[i]); } }
                    else { a0 = a0 * b0; a1 = a1 * b1; }
                    u32x4 w; w.x = pg8::cvt_pk_bf16(a0[0], a0[1]); w.y = pg8::cvt_pk_bf16(a0[2], a0[3]); w.z = pg8::cvt_pk_bf16(a1[0], a1[1]); w.w = pg8::cvt_pk_bf16(a1[2], a1[3]);
                    *(u32x4*)rowp = w; } }
    }
};

__device__ __forceinline__ void p0_transpose_item(const float* W, int K, int N, bf16_t* WT, int k0, int n0, int orow, MK_LAS float* scr, int lane) {
    const int cq = lane & 15, r0 = lane >> 4;
    f32x4 v[16];
#pragma unroll
    for (int i = 0; i < 16; ++i) v[i] = *(const f32x4*)(W + (size_t)(k0 + 4 * i + r0) * N + n0 + 4 * cq);
#pragma unroll
    for (int i = 0; i < 16; ++i) { const int r = 4 * i + r0; *(MK_LAS f32x4*)(scr + r * 64 + ((4 * cq) ^ (8 * (r >> 3)))) = v[i]; }
    asm volatile("s_waitcnt lgkmcnt(0)" ::: "memory");
    const int c = lane & 7, nn0 = lane >> 3;
#pragma unroll
    for (int j = 0; j < 8; ++j) { const int nn = nn0 + 8 * j; const MK_LAS float* sp = scr + (8 * c) * 64 + (nn ^ (8 * c));
        u32x4 o; o.x = pg8::cvt_pk_bf16(sp[0 * 64], sp[1 * 64]); o.y = pg8::cvt_pk_bf16(sp[2 * 64], sp[3 * 64]); o.z = pg8::cvt_pk_bf16(sp[4 * 64], sp[5 * 64]); o.w = pg8::cvt_pk_bf16(sp[6 * 64], sp[7 * 64]);
        *(u32x4*)(WT + (size_t)(orow + nn) * K + k0 + 8 * c) = o; }
    asm volatile("s_waitcnt lgkmcnt(0)" ::: "memory");
}
__device__ __forceinline__ void p0_prologue(const Params& P, MK_LAS unsigned char* lds) {
    int tid_ = threadIdx.x; asm volatile("" : "+v"(tid_)); const int tid = tid_, lane = tid & 63, wave = __builtin_amdgcn_readfirstlane(tid >> 6); (void)tid; (void)lane; (void)wave;
    MK_LAS float* scr = (MK_LAS float*)(lds + wave * 16384);
    const int gw = blockIdx.x * NWAVES + wave, NGW = gridDim.x * NWAVES;
    unsigned char* ws = P.ws;
    constexpr int I_IN = 16 * 44, I_OUT = 16 * 16, I_F = 16 * 44, I_2 = 44 * 16, I_ADA = 16 * 96;
    constexpr int PER_L = I_IN + I_OUT + 2 * I_F + I_2 + I_ADA;
    for (int it = gw; it < DEPTH * PER_L; it += NGW) {
        const int l = it / PER_L; int r = it % PER_L;
        if (r < I_IN) { const int kb = r / 44, nb = r % 44, n0 = 64 * nb; int orow;
            if (n0 < 1536) orow = n0; else if (n0 < 1792) orow = 256 * (6 + ((n0 - 1536) >> 7)) + ((n0 - 1536) & 127); else if (n0 < 2048) orow = 256 * (6 + ((n0 - 1792) >> 7)) + 128 + ((n0 - 1792) & 127);
            else if (n0 < 2304) orow = 2048 + (n0 - 2048); else if (n0 < 2560) orow = 256 * (9 + ((n0 - 2304) >> 7)) + ((n0 - 2304) & 127); else orow = 256 * (9 + ((n0 - 2560) >> 7)) + 128 + ((n0 - 2560) & 127);
            p0_transpose_item(P.in[13] + (size_t)l * D * INW, D, INW, (bf16_t*)(ws + WS_WIN) + (size_t)l * INW * D, 64 * kb, n0, orow, scr, lane); continue; } r -= I_IN;
        if (r < I_OUT) { const int kb = r / 16, nb = r % 16; p0_transpose_item(P.in[14] + (size_t)l * D * D, D, D, (bf16_t*)(ws + WS_WOUT) + (size_t)l * D * D, 64 * kb, 64 * nb, 64 * nb, scr, lane); continue; } r -= I_OUT;
        if (r < I_F) { const int kb = r / 44, nb = r % 44, n0 = 64 * nb; p0_transpose_item(P.in[21] + (size_t)l * D * DFF, D, DFF, (bf16_t*)(ws + WS_W13) + (size_t)l * NFF1 * D, 64 * kb, n0, 256 * (n0 >> 7) + (n0 & 127), scr, lane); continue; } r -= I_F;
        if (r < I_F) { const int kb = r / 44, nb = r % 44, n0 = 64 * nb; p0_transpose_item(P.in[22] + (size_t)l * D * DFF, D, DFF, (bf16_t*)(ws + WS_W13) + (size_t)l * NFF1 * D, 64 * kb, n0, 256 * (n0 >> 7) + 128 + (n0 & 127), scr, lane); continue; } r -= I_F;
        if (r < I_2) { const int kb = r / 16, nb = r % 16; p0_transpose_item(P.in[23] + (size_t)l * DFF * D, DFF, D, (bf16_t*)(ws + WS_W2) + (size_t)l * D * DFF, 64 * kb, 64 * nb, 64 * nb, scr, lane); continue; } r -= I_2;
        { const int kb = r / 96, nb = r % 96; p0_transpose_item(P.in[7] + (size_t)l * D * 6144, D, 6144, (bf16_t*)(ws + WS_ADAT), 64 * kb, 64 * nb, l * 6144 + 64 * nb, scr, lane); }
    }
    for (int r = gw; r < 256; r += NGW) {
        bf16_t* o = (bf16_t*)(ws + WS_AC) + (size_t)r * D;
        const float* src = r < NB ? P.in[2] + (size_t)r * D : P.in[3] + (size_t)(r - NB) * D;
#pragma unroll
        for (int j = 0; j < 4; ++j) { f32x4 v = (f32x4){0.f, 0.f, 0.f, 0.f};
            if (r < MODROWS) { v = *(const f32x4*)(src + 4 * lane + 256 * j); v[0] = siluf_(v[0]); v[1] = siluf_(v[1]); v[2] = siluf_(v[2]); v[3] = siluf_(v[3]); }
            *(u32x2*)(o + 4 * lane + 256 * j) = pack4(v); }
    }
}

template <int KIND>
__device__ __forceinline__ void rowpass_row(const Params& P, int l, int r, int lane) {
    unsigned char* ws = P.ws;
    const float* mod = (const float*)(ws + WS_MOD);
    bf16_t* HM = (bf16_t*)(ws + WS_HM); const bf16_t* T1 = (const bf16_t*)(ws + WS_T1S) - (size_t)NP * D;
    bf16_t* XB = (bf16_t*)(ws + WS_XB);
    {
        const int mrow = r < NP ? (r >> 11) : NB + (r - NP);
        const float* mp = mod + (size_t)mrow * NMOD + l * 6144;
        f32x4 x[4];
        if (KIND == 0) { const float* xin = r < NP ? P.in[0] + (size_t)r * D : P.in[1] + (size_t)(r - NP) * D;
#pragma unroll
            for (int j = 0; j < 4; ++j) { x[j] = *(const f32x4*)(xin + 4 * lane + 256 * j); *(u32x2*)(XB + (size_t)r * D + 4 * lane + 256 * j) = pack4(x[j]); } }
        else {
#pragma unroll
            for (int j = 0; j < 4; ++j) x[j] = unpack4(*(const u32x2*)(XB + (size_t)r * D + 4 * lane + 256 * j)); }
        if (KIND != 0) {
            f32x4 t[4]; float s = 0.f;
#pragma unroll
            for (int j = 0; j < 4; ++j) { t[j] = unpack4(*(const u32x2*)(T1 + (size_t)r * D + 4 * lane + 256 * j)); s += (t[j][0] * t[j][0] + t[j][1] * t[j][1]) + (t[j][2] * t[j][2] + t[j][3] * t[j][3]); }
            const float rstd = rsqrtf(wave_sum(s) * (1.0f / D) + EPS);
            const float* gpost = P.in[KIND == 1 ? 10 : 12] + l * D;
            const float* gt = mp + (KIND == 1 ? 2 : 5) * D;
#pragma unroll
            for (int j = 0; j < 4; ++j) { const f32x4 g = *(const f32x4*)(gpost + 4 * lane + 256 * j), gg = *(const f32x4*)(gt + 4 * lane + 256 * j);
                x[j] = x[j] + gg * (t[j] * rstd * g);
                if (KIND == 2 && l == DEPTH - 1) *(f32x4*)(P.out + (size_t)r * D + 4 * lane + 256 * j) = x[j];
                else *(u32x2*)(XB + (size_t)r * D + 4 * lane + 256 * j) = pack4(x[j]); }
        }
        if (KIND == 2 && l == DEPTH - 1) return;
        const int ln = (KIND == 2) ? l + 1 : l;
        const float* mpn = mod + (size_t)mrow * NMOD + ln * 6144;
        const float* gpre = P.in[KIND == 1 ? 11 : 9] + ln * D;
        const float* sh = mpn + (KIND == 1 ? 3 : 0) * D; const float* sc = mpn + (KIND == 1 ? 4 : 1) * D;
        float s = 0.f;
#pragma unroll
        for (int j = 0; j < 4; ++j) s += (x[j][0] * x[j][0] + x[j][1] * x[j][1]) + (x[j][2] * x[j][2] + x[j][3] * x[j][3]);
        const float rstd = rsqrtf(wave_sum(s) * (1.0f / D) + EPS);
#pragma unroll
        for (int j = 0; j < 4; ++j) { const f32x4 g = *(const f32x4*)(gpre + 4 * lane + 256 * j), a = *(const f32x4*)(sc + 4 * lane + 256 * j), b = *(const f32x4*)(sh + 4 * lane + 256 * j);
            const f32x4 h = (x[j] * rstd * g) * (a + 1.0f) + b;
            *(u32x2*)(HM + (size_t)r * D + 4 * lane + 256 * j) = pack4(h); }
    }
}
template <int KIND>
__device__ __forceinline__ void rowpass(const Params& P, int l) {
    int tid_ = threadIdx.x; asm volatile("" : "+v"(tid_)); const int tid = tid_, lane = tid & 63, wave = __builtin_amdgcn_readfirstlane(tid >> 6); (void)tid;
    const int gw = blockIdx.x * NWAVES + wave, NGW = gridDim.x * NWAVES;
    for (int r = gw; r < MR; r += NGW) rowpass_row<KIND>(P, l, r, lane);
}
template <int KIND>
__device__ __forceinline__ void sample_rowpass(const Params& P, int l, unsigned* cnt) {
    int tid_ = threadIdx.x; asm volatile("" : "+v"(tid_)); const int tid = tid_, lane = tid & 63, wave = __builtin_amdgcn_readfirstlane(tid >> 6);
    if (blockIdx.x < 64 || blockIdx.x >= 80) return;
    if (tid == 0) { unsigned sp = 0; while (__hip_atomic_load(cnt, __ATOMIC_RELAXED, __HIP_MEMORY_SCOPE_AGENT) < 256u) { __builtin_amdgcn_s_sleep(2); if (++sp > (1u << 22)) break; }
        __builtin_amdgcn_fence(__ATOMIC_ACQUIRE, "agent"); asm volatile("s_waitcnt vmcnt(0)" ::: "memory"); }
    __syncthreads();
    rowpass_row<KIND>(P, l, NP + (blockIdx.x - 64) * 8 + wave, lane);
}

struct EpiRmsFused {
    static constexpr bool PERM = true, AFTER_DRAIN = true;
    const Params* Pp; int l, kind;
    __device__ __forceinline__ void fused(f32x4 (&acc)[2][2][4][2], const pg8::Unit& u, int wr, int wc, int fr, int fq, MK_LAS unsigned char* lds, int wid, int lane) const {
        const Params& P = *Pp; unsigned char* ws = P.ws; asm volatile("" : "+s"(ws));
        const int ln = (kind == 2 && l + 1 < DEPTH) ? l + 1 : l; const int write_h = (kind == 2 && l + 1 >= DEPTH) ? 0 : 1; const int inst = 2 * l + (kind - 1);
        const bool final_out = (kind == 2 && l + 1 >= DEPTH);
        bf16_t* XB = (bf16_t*)(ws + WS_XB); float* xout = P.out; bf16_t* hout = (bf16_t*)(ws + WS_HM);
        MK_LAS u32x4* stash = (MK_LAS u32x4*)lds + (wid * 64 + lane);
        const float* gpost = P.in[kind == 1 ? 10 : 12] + l * D; const float* gpre = P.in[kind == 1 ? 11 : 9] + ln * D;
        const float* gt = (const float*)(ws + WS_MOD) + l * 6144 + (kind == 1 ? 2 : 5) * D;
        const float* sc = (const float*)(ws + WS_MOD) + ln * 6144 + (kind == 1 ? 4 : 1) * D; const float* sh = (const float*)(ws + WS_MOD) + ln * 6144 + (kind == 1 ? 3 : 0) * D;
        unsigned long long* xbuf = (unsigned long long*)(ws + WS_X + (size_t)inst * MiB); unsigned* cnt = (unsigned*)(ws + WS_CTL) + CW_PANEL + inst * 4096;
        MK_LAS f32x4* Pt = (MK_LAS f32x4*)(lds + 131072);
        MK_LAS f32x2v* St = (MK_LAS f32x2v*)(lds + 131072 + 16384);
        const int b = u.pm >> 3;
        const int col0 = u.pn * 256 + wc * 32 + 8 * fq;
        {   f32x4 av[2][2];
#pragma unroll
            for (int bj = 0; bj < 2; ++bj)
#pragma unroll
                for (int n = 0; n < 2; ++n) { const int col = col0 + bj * 128 + n * 4; av[bj][n] = *(const f32x4*)(gt + (size_t)b * NMOD + col) * *(const f32x4*)(gpost + col); }
#pragma unroll
            for (int ai = 0; ai < 2; ++ai)
#pragma unroll
                for (int m = 0; m < 4; ++m) { const int rl = ai * 128 + wr * 64 + m * 16 + fr; const size_t xo = (size_t)(u.pm * 256 + rl) * D + col0;
                    float sTT = 0.f, sxa = 0.f, saa = 0.f, sxx = 0.f;
#pragma unroll
                    for (int bj = 0; bj < 2; ++bj) { const u32x4 xp = *(const u32x4*)(XB + xo + bj * 128); stash[((ai * 4 + m) * 2 + bj) * 512] = xp;
#pragma unroll
                        for (int n = 0; n < 2; ++n) { const f32x4 T = acc[ai][bj][m][n], aT = av[bj][n] * T;
                            const f32x4 x = n == 0 ? (f32x4){bflo(xp.x), bfhi(xp.x), bflo(xp.y), bfhi(xp.y)} : (f32x4){bflo(xp.z), bfhi(xp.z), bflo(xp.w), bfhi(xp.w)};
                            sTT += (T[0] * T[0] + T[1] * T[1]) + (T[2] * T[2] + T[3] * T[3]); sxa += (x[0] * aT[0] + x[1] * aT[1]) + (x[2] * aT[2] + x[3] * aT[3]);
                            saa += (aT[0] * aT[0] + aT[1] * aT[1]) + (aT[2] * aT[2] + aT[3] * aT[3]); sxx += (x[0] * x[0] + x[1] * x[1]) + (x[2] * x[2] + x[3] * x[3]);
                            acc[ai][bj][m][n] = aT; } }
                    sTT += __shfl_xor(sTT, 16); sTT += __shfl_xor(sTT, 32); sxa += __shfl_xor(sxa, 16); sxa += __shfl_xor(sxa, 32);
                    saa += __shfl_xor(saa, 16); saa += __shfl_xor(saa, 32); sxx += __shfl_xor(sxx, 16); sxx += __shfl_xor(sxx, 32);
                    if (fq == 0) Pt[rl * 4 + wc] = (f32x4){sTT, sxa, saa, sxx};
                    if (m == 3) asm volatile("" ::: "memory"); }
        }
        asm volatile("s_waitcnt lgkmcnt(0)" ::: "memory"); __builtin_amdgcn_s_barrier(); asm volatile("" ::: "memory");
        const int row = wid * 32 + (lane & 31);
        unsigned long long* slot = xbuf + ((size_t)(u.pm * 256 + row) * 4) * 2;
        if (lane < 32) { const f32x4 p = (Pt[row * 4 + 0] + Pt[row * 4 + 1]) + (Pt[row * 4 + 2] + Pt[row * 4 + 3]);
            __hip_atomic_store(slot + u.pn * 2 + 0, ((unsigned long long)__float_as_uint(p[1]) << 32) | __float_as_uint(p[0]), __ATOMIC_RELAXED, __HIP_MEMORY_SCOPE_AGENT);
            __hip_atomic_store(slot + u.pn * 2 + 1, ((unsigned long long)__float_as_uint(p[3]) << 32) | __float_as_uint(p[2]), __ATOMIC_RELAXED, __HIP_MEMORY_SCOPE_AGENT); }
        asm volatile("s_waitcnt vmcnt(0)" ::: "memory");
        if (lane == 0) __hip_atomic_fetch_add(cnt + 64 * u.pm, 1u, __ATOMIC_RELAXED, __HIP_MEMORY_SCOPE_AGENT);
        if (wid == 0) { unsigned sp = 0;
            while ((unsigned)__builtin_amdgcn_readfirstlane(__hip_atomic_load(cnt + 64 * u.pm, __ATOMIC_RELAXED, __HIP_MEMORY_SCOPE_AGENT)) < 32u) { __builtin_amdgcn_s_sleep(2); if (++sp > (1u << 22)) break; }
            __builtin_amdgcn_fence(__ATOMIC_ACQUIRE, "agent"); }
        asm volatile("s_waitcnt vmcnt(0) lgkmcnt(0)" ::: "memory"); __builtin_amdgcn_s_barrier(); asm volatile("" ::: "memory");
        if (lane < 32) { float TT = 0.f, xa = 0.f, aa = 0.f, xx = 0.f;
#pragma unroll
            for (int t = 0; t < 4; ++t) { const unsigned long long w0 = __hip_atomic_load(slot + t * 2 + 0, __ATOMIC_RELAXED, __HIP_MEMORY_SCOPE_AGENT), w1 = __hip_atomic_load(slot + t * 2 + 1, __ATOMIC_RELAXED, __HIP_MEMORY_SCOPE_AGENT);
                TT += __uint_as_float((unsigned)w0); xa += __uint_as_float((unsigned)(w0 >> 32)); aa += __uint_as_float((unsigned)w1); xx += __uint_as_float((unsigned)(w1 >> 32)); }
            const float rT = rsqrtf(TT * (1.0f / D) + EPS); const float q = xx + rT * ((xa + xa) + rT * aa);
            St[row] = (f32x2v){rT, rsqrtf(fmaxf(q, 0.f) * (1.0f / D) + EPS)}; }
        asm volatile("s_waitcnt lgkmcnt(0)" ::: "memory"); __builtin_amdgcn_s_barrier(); asm volatile("" ::: "memory");
#pragma unroll
        for (int bj = 0; bj < 2; ++bj) { const int col = col0 + bj * 128;
            f32x4 gm0 = (f32x4){0.f, 0.f, 0.f, 0.f}, gm1 = gm0, sv0 = gm0, sv1 = gm0;
            if (write_h) { gm0 = *(const f32x4*)(gpre + col) * (*(const f32x4*)(sc + (size_t)b * NMOD + col) + 1.0f); gm1 = *(const f32x4*)(gpre + col + 4) * (*(const f32x4*)(sc + (size_t)b * NMOD + col + 4) + 1.0f);
                           sv0 = *(const f32x4*)(sh + (size_t)b * NMOD + col); sv1 = *(const f32x4*)(sh + (size_t)b * NMOD + col + 4); }
#pragma unroll
            for (int ai = 0; ai < 2; ++ai)
#pragma unroll
                for (int m = 0; m < 4; ++m) { const int rl = ai * 128 + wr * 64 + m * 16 + fr; const f32x2v sr = St[rl]; const size_t off = (size_t)(u.pm * 256 + rl) * D + col;
                    const u32x4 xp = stash[((ai * 4 + m) * 2 + bj) * 512];
                    const f32x4 x1a = (f32x4){bflo(xp.x), bfhi(xp.x), bflo(xp.y), bfhi(xp.y)} + acc[ai][bj][m][0] * sr.x, x1b = (f32x4){bflo(xp.z), bfhi(xp.z), bflo(xp.w), bfhi(xp.w)} + acc[ai][bj][m][1] * sr.x;
                    if (final_out) { *(f32x4*)(xout + off) = x1a; *(f32x4*)(xout + off + 4) = x1b; }
                    else { u32x4 w; w.x = pg8::cvt_pk_bf16(x1a[0], x1a[1]); w.y = pg8::cvt_pk_bf16(x1a[2], x1a[3]); w.z = pg8::cvt_pk_bf16(x1b[0], x1b[1]); w.w = pg8::cvt_pk_bf16(x1b[2], x1b[3]); *(u32x4*)(XB + off) = w; }
                    if (write_h) { const f32x4 ha = x1a * sr.y * gm0 + sv0, hb = x1b * sr.y * gm1 + sv1;
                        u32x4 w; w.x = pg8::cvt_pk_bf16(ha[0], ha[1]); w.y = pg8::cvt_pk_bf16(ha[2], ha[3]); w.z = pg8::cvt_pk_bf16(hb[0], hb[1]); w.w = pg8::cvt_pk_bf16(hb[2], hb[3]); *(u32x4*)(hout + off) = w; }
                    if (m == 3) asm volatile("" ::: "memory"); } }
    }
};

__device__ __forceinline__ bf16x8 lfrag(const MK_LAS bf16_t* base, int row, int stride, int k0, int fq) { return *(const MK_LAS bf16x8*)(base + row * stride + k0 + fq * 8); }
#define MK_MFMA(b, a, c) __builtin_amdgcn_mfma_f32_16x16x32_bf16((b), (a), (c), 0, 0, 0)

__device__ __forceinline__ void rope8(const bf16_t* src  , int j, float pos, float scale, u32x4& o1, u32x4& o2, float extra  ) {
    const u32x4 w1 = *(const u32x4*)(src + 8 * j), w2 = *(const u32x4*)(src + 32 + 8 * j);
    float a[8], b[8];
#pragma unroll
    for (int q = 0; q < 4; ++q) { a[2 * q] = bflo(w1[q]); a[2 * q + 1] = bfhi(w1[q]); b[2 * q] = bflo(w2[q]); b[2 * q + 1] = bfhi(w2[q]); }
    float r1[8], r2[8]; const float sc = scale * extra;
#pragma unroll
    for (int i = 0; i < 8; ++i) { const double rev = (double)pos * kInvRev[8 * j + i]; const float fr_ = (float)(rev - floor(rev));
        const float sn = __builtin_amdgcn_sinf(fr_), cs = __builtin_amdgcn_cosf(fr_);
        r1[i] = (a[i] * cs - b[i] * sn) * sc; r2[i] = (a[i] * sn + b[i] * cs) * sc; }
#pragma unroll
    for (int q = 0; q < 4; ++q) { o1[q] = pg8::cvt_pk_bf16(r1[2 * q], r1[2 * q + 1]); o2[q] = pg8::cvt_pk_bf16(r2[2 * q], r2[2 * q + 1]); }
}

constexpr int SQ = 72, SV = 136;
constexpr int L_QS = 0, L_KS = L_QS + 128 * SQ * 2, L_VT = L_KS + 128 * SQ * 2, L_PS = L_VT + 128 * SV * 2, L_ST = L_PS + 128 * SV * 2, L_RET_END = L_ST + 128 * SQ * 2;
static_assert(L_RET_END <= 131072, "retention LDS");

__device__ __forceinline__ void load_vt(const bf16_t* PROJ, int row0, int h, MK_LAS bf16_t* Vt, int wave, int lane) {
#pragma unroll
    for (int it = 0; it < 4; ++it) { const int chunk = wave * 2 + (it & 1), m = lane + 64 * (it >> 1);
        const u32x4 w = *(const u32x4*)(PROJ + (size_t)(row0 + m) * LDP + PV + h * 128 + chunk * 8);
#pragma unroll
        for (int q = 0; q < 4; ++q) { Vt[(chunk * 8 + 2 * q) * SV + m] = (bf16_t)(w[q] & 0xffffu); Vt[(chunk * 8 + 2 * q + 1) * SV + m] = (bf16_t)(w[q] >> 16); } }
}

__device__ __forceinline__ void ret_u_item(const Params& P, MK_LAS unsigned char* lds, int item) {
    int tid_ = threadIdx.x; asm volatile("" : "+v"(tid_)); const int tid = tid_, lane = tid & 63, wave = __builtin_amdgcn_readfirstlane(tid >> 6); (void)tid; (void)lane; (void)wave;
    const int h = item & 3, c = (item >> 2) & 15, b = item >> 6;
    const bf16_t* PROJ = (const bf16_t*)(P.ws + WS_PROJ);
    float* UT = (float*)(P.ws + WS_U) + (size_t)((b * 4 + h) * 16 + c) * 8192;
    MK_LAS bf16_t* Kt = (MK_LAS bf16_t*)(lds + L_KS);
    MK_LAS bf16_t* Vt = (MK_LAS bf16_t*)(lds + L_VT);
    const int row0 = b * SEQ + c * 128; const float lg = log2_gamma(h);
    __syncthreads();
    load_vt(PROJ, row0, h, Vt, wave, lane);
    { const int m = tid & 127, j = tid >> 7; u32x4 o1, o2;
      rope8(PROJ + (size_t)(row0 + m) * LDP + PK + h * 64, j, (float)(c * 128 + m), 0.125f, o1, o2, exp2f((float)(127 - m) * lg));
#pragma unroll
      for (int q = 0; q < 4; ++q) { Kt[(8 * j + 2 * q) * SV + m] = (bf16_t)(o1[q] & 0xffffu); Kt[(8 * j + 2 * q + 1) * SV + m] = (bf16_t)(o1[q] >> 16);
                                    Kt[(32 + 8 * j + 2 * q) * SV + m] = (bf16_t)(o2[q] & 0xffffu); Kt[(32 + 8 * j + 2 * q + 1) * SV + m] = (bf16_t)(o2[q] >> 16); } }
    __syncthreads();
    const int fr = lane & 15, fq = lane >> 4, e0 = 16 * wave;
    f32x4 u[4];
#pragma unroll
    for (int j = 0; j < 4; ++j) u[j] = (f32x4){0.f, 0.f, 0.f, 0.f};
#pragma unroll
    for (int ks = 0; ks < 4; ++ks) { const bf16x8 a = lfrag(Vt, e0 + fr, SV, ks * 32, fq);
#pragma unroll
        for (int j = 0; j < 4; ++j) { const bf16x8 bb = lfrag(Kt, 16 * j + fr, SV, ks * 32, fq); u[j] = MK_MFMA(bb, a, u[j]); } }
#pragma unroll
    for (int j = 0; j < 4; ++j) *(f32x4*)(UT + (e0 + fr) * 64 + 16 * j + 4 * fq) = u[j];
}

__device__ __forceinline__ void ret_o_item(const Params& P, MK_LAS unsigned char* lds, int l, int item) {
    int tid_ = threadIdx.x; asm volatile("" : "+v"(tid_)); const int tid = tid_, lane = tid & 63, wave = __builtin_amdgcn_readfirstlane(tid >> 6); (void)tid; (void)lane; (void)wave;
    const int h = item & 3, b = item >> 6, c = item < 256 ? (item >> 2) & 15 : 15 - ((item >> 2) & 15);
    const bf16_t* PROJ = (const bf16_t*)(P.ws + WS_PROJ);
    bf16_t* MIX = (bf16_t*)(P.ws + WS_HM);
    MK_LAS bf16_t* Qs = (MK_LAS bf16_t*)(lds + L_QS); MK_LAS bf16_t* Ks = (MK_LAS bf16_t*)(lds + L_KS); MK_LAS bf16_t* Vt = (MK_LAS bf16_t*)(lds + L_VT);
    MK_LAS bf16_t* Ps = (MK_LAS bf16_t*)(lds + L_PS); MK_LAS bf16_t* St = (MK_LAS bf16_t*)(lds + L_ST);
    const int row0 = b * SEQ + c * 128; const float lg = log2_gamma(h);
    __syncthreads();
    load_vt(PROJ, row0, h, Vt, wave, lane);
    { const int m = tid & 127, j = tid >> 7; u32x4 o1, o2; const float pos = (float)(c * 128 + m);
      rope8(PROJ + (size_t)(row0 + m) * LDP + PQ + h * 64, j, pos, 1.0f, o1, o2, 1.0f);
      *(MK_LAS u32x4*)(Qs + m * SQ + 8 * j) = o1; *(MK_LAS u32x4*)(Qs + m * SQ + 32 + 8 * j) = o2;
      rope8(PROJ + (size_t)(row0 + m) * LDP + PK + h * 64, j, pos, 0.125f, o1, o2, 1.0f);
      *(MK_LAS u32x4*)(Ks + m * SQ + 8 * j) = o1; *(MK_LAS u32x4*)(Ks + m * SQ + 32 + 8 * j) = o2; }
    { const float cd = exp2f(128.0f * lg);
      const float* UTb = (const float*)(P.ws + WS_U) + (size_t)((b * 4 + h) * 16) * 8192;
#pragma unroll 1
      for (int it = 0; it < 2; ++it) { const int idx0 = tid + 1024 * it, idx1 = idx0 + 512;
        f32x4 ua[15], ub[15];
#pragma unroll
        for (int j = 0; j < 15; ++j) { if (j < c) { ua[j] = *(const f32x4*)(UTb + (size_t)j * 8192 + 4 * idx0); ub[j] = *(const f32x4*)(UTb + (size_t)j * 8192 + 4 * idx1); }
                                       else { ua[j] = (f32x4){0.f, 0.f, 0.f, 0.f}; ub[j] = ua[j]; } }
        f32x4 sa = (f32x4){0.f, 0.f, 0.f, 0.f}, sb = sa;
#pragma unroll
        for (int j = 0; j < 15; ++j) { if (j < c) { sa = sa * cd + ua[j]; sb = sb * cd + ub[j]; } }
        *(MK_LAS u32x2*)(St + (idx0 >> 4) * SQ + 4 * (idx0 & 15)) = pack4(sa); *(MK_LAS u32x2*)(St + (idx1 >> 4) * SQ + 4 * (idx1 & 15)) = pack4(sb);
        if (c == 15) { sa = sa * cd + *(const f32x4*)(UTb + (size_t)15 * 8192 + 4 * idx0); sb = sb * cd + *(const f32x4*)(UTb + (size_t)15 * 8192 + 4 * idx1);
            float* o = P.out + O_RETP + (size_t)((l * NB + b) * 4 + h) * 8192;
#pragma unroll
            for (int i = 0; i < 4; ++i) { o[(4 * (idx0 & 15) + i) * 128 + (idx0 >> 4)] = sa[i]; o[(4 * (idx1 & 15) + i) * 128 + (idx1 >> 4)] = sb[i]; } } } }
    __syncthreads();
    const int fr = lane & 15, fq = lane >> 4, n0 = 16 * wave, n = n0 + fr;
    {
        f32x4 sc[8];
#pragma unroll
        for (int j = 0; j < 8; ++j) sc[j] = (f32x4){0.f, 0.f, 0.f, 0.f};
#pragma unroll
        for (int ks = 0; ks < 2; ++ks) { const bf16x8 a = lfrag(Qs, n, SQ, ks * 32, fq);
#pragma unroll
            for (int j = 0; j < 8; ++j) { const bf16x8 bb = lfrag(Ks, 16 * j + fr, SQ, ks * 32, fq); sc[j] = MK_MFMA(bb, a, sc[j]); } }
#pragma unroll
        for (int j = 0; j < 8; ++j) { f32x4 p;
#pragma unroll
            for (int i = 0; i < 4; ++i) { const int dlt = n - (16 * j + 4 * fq + i); p[i] = dlt >= 0 ? sc[j][i] * exp2f((float)dlt * lg) : 0.f; }
            *(MK_LAS u32x2*)(Ps + n * SV + 16 * j + 4 * fq) = pack4(p); }
    }
    __syncthreads();
    f32x4 o1[8], o2[8];
#pragma unroll
    for (int j = 0; j < 8; ++j) { o1[j] = (f32x4){0.f, 0.f, 0.f, 0.f}; o2[j] = (f32x4){0.f, 0.f, 0.f, 0.f}; }
#pragma unroll
    for (int ks = 0; ks < 4; ++ks) { const bf16x8 a = lfrag(Ps, n, SV, ks * 32, fq);
#pragma unroll
        for (int j = 0; j < 8; ++j) { const bf16x8 bb = lfrag(Vt, 16 * j + fr, SV, ks * 32, fq); o1[j] = MK_MFMA(bb, a, o1[j]); } }
#pragma unroll
    for (int ks = 0; ks < 2; ++ks) { const bf16x8 a = lfrag(Qs, n, SQ, ks * 32, fq);
#pragma unroll
        for (int j = 0; j < 8; ++j) { const bf16x8 bb = lfrag(St, 16 * j + fr, SQ, ks * 32, fq); o2[j] = MK_MFMA(bb, a, o2[j]); } }
    const float rd = exp2f((float)(n + 1) * lg);
    float s = 0.f;
#pragma unroll
    for (int j = 0; j < 8; ++j) { o1[j] = o1[j] + o2[j] * rd; s += (o1[j][0] + o1[j][1]) + (o1[j][2] + o1[j][3]); }
    s += __shfl_xor(s, 16); s += __shfl_xor(s, 32);
    const float mean = s * (1.0f / 128.0f); float q = 0.f;
#pragma unroll
    for (int j = 0; j < 8; ++j) { o1[j] = o1[j] - mean; q += (o1[j][0] * o1[j][0] + o1[j][1] * o1[j][1]) + (o1[j][2] * o1[j][2] + o1[j][3] * o1[j][3]); }
    q += __shfl_xor(q, 16); q += __shfl_xor(q, 32);
    const float rstd = rsqrtf(q * (1.0f / 128.0f) + EPS);
    const float* gn = P.in[15] + l * 512 + h * 128;
    const size_t row = (size_t)(row0 + n);
#pragma unroll
    for (int j = 0; j < 8; ++j) { const int e = 16 * j + 4 * fq;
        const f32x4 g = *(const f32x4*)(gn + e); const f32x4 gate = unpack4(*(const u32x2*)(PROJ + row * LDP + PG + h * 128 + e));
        f32x4 o;
#pragma unroll
        for (int i = 0; i < 4; ++i) o[i] = o1[j][i] * rstd * g[i] * siluf_(gate[i]);
        *(u32x2*)(MIX + row * D + h * 128 + e) = pack4(o); }
}

__device__ __forceinline__ void conva_finish(const Params& P, int l, f32x4 acc, size_t row, int lane) {
    bf16_t* MIX = (bf16_t*)(P.ws + WS_HM);
    const float mean = wave_sum((acc[0] + acc[1]) + (acc[2] + acc[3])) * (1.0f / 256.0f);
    const f32x4 d = acc - mean;
    const float var = wave_sum((d[0] * d[0] + d[1] * d[1]) + (d[2] * d[2] + d[3] * d[3])) * (1.0f / 256.0f);
    const float rstd = rsqrtf(var + EPS);
    const f32x4 g = *(const f32x4*)(P.in[18] + l * 256 + 4 * lane), bb = *(const f32x4*)(P.in[19] + l * 256 + 4 * lane);
    f32x4 y = d * rstd * g + bb;
#pragma unroll
    for (int i = 0; i < 4; ++i) y[i] = siluf_(y[i]);
    *(u32x2*)(MIX + row * D + 512 + 4 * lane) = pack4(y);
}

__device__ __forceinline__ void conv_task(const Params& P, int l) {
    int tid_ = threadIdx.x; asm volatile("" : "+v"(tid_)); const int tid = tid_, lane = tid & 63, wave = __builtin_amdgcn_readfirstlane(tid >> 6);
    const int task = blockIdx.x * NWAVES + wave;
    if (task >= NP / 8) return;
    const int b = task >> 8, t0 = (task & 255) * 8;
    const bf16_t* PROJ = (const bf16_t*)(P.ws + WS_PROJ);
    bf16_t* MIX = (bf16_t*)(P.ws + WS_HM);
    const float* cw = P.in[16] + l * 31 * 256 + 4 * lane;
    f32x4 acc[8]; const f32x4 bias = *(const f32x4*)(P.in[17] + l * 256 + 4 * lane);
#pragma unroll
    for (int k = 0; k < 8; ++k) acc[k] = bias;
    {
        const bf16_t* pb = PROJ + (size_t)(b * SEQ) * LDP + 4 * lane;
        f32x4 cur[8], nxt[8], wv[8]; u32x2 rv[8];
#define MK_ROWADDR(r_) ({ const int t_ = t0 - 30 + (r_); const int tc_ = t_ < 0 ? 0 : (t_ > SEQ - 1 ? SEQ - 1 : t_); (size_t)tc_ * LDP; })
#define MK_GLU(dst, v_, r_) do { const float m_ = (t0 - 30 + (r_)) < 0 ? 0.f : 1.f; dst = unpack4(v_) * m_; } while (0)
#pragma unroll
        for (int k = 0; k < 8; ++k) { rv[k] = *(const u32x2*)(pb + MK_ROWADDR(k) + PU); }
#pragma unroll
        for (int k = 0; k < 8; ++k) MK_GLU(cur[k], rv[k], k);
#pragma unroll
        for (int k = 0; k < 8; ++k) { rv[k] = *(const u32x2*)(pb + MK_ROWADDR(8 + k) + PU); }
#pragma unroll
        for (int k = 0; k < 8; ++k) MK_GLU(nxt[k], rv[k], 8 + k);
        if (t0 == SEQ - 8) {
#pragma unroll
            for (int k = 0; k < 8; ++k) *(f32x4*)(P.out + O_CAP + (size_t)((l * NB + b) * 30 + k) * 256 + 4 * lane) = nxt[k]; }
#pragma unroll
        for (int k = 0; k < 8; ++k) wv[k] = *(const f32x4*)(cw + k * 256);
#pragma unroll 1
        for (int jb = 0; jb < 4; ++jb) {
            f32x4 wn[8];
#pragma unroll
            for (int k = 0; k < 8; ++k) { const int r = 8 * jb + 16 + k; rv[k] = *(const u32x2*)(pb + MK_ROWADDR(r) + PU);
                const int jn = 8 * jb + 8 + k; wn[k] = *(const f32x4*)(cw + (jn < 31 ? jn : 30) * 256); if (jn >= 31) wn[k] = (f32x4){0.f, 0.f, 0.f, 0.f}; }
#pragma unroll
            for (int jj = 0; jj < 8; ++jj)
#pragma unroll
                for (int k = 0; k < 8; ++k) acc[k] = acc[k] + wv[jj] * (jj + k < 8 ? cur[(jj + k) & 7] : nxt[(jj + k) & 7]);
#pragma unroll
            for (int k = 0; k < 8; ++k) { cur[k] = nxt[k]; wv[k] = wn[k]; }
#pragma unroll
            for (int k = 0; k < 8; ++k) MK_GLU(nxt[k], rv[k], 8 * jb + 16 + k);
            if (t0 == SEQ - 8) {
#pragma unroll
                for (int k = 0; k < 8; ++k) { const int i = 8 * jb + 8 + k; if (i < 30) *(f32x4*)(P.out + O_CAP + (size_t)((l * NB + b) * 30 + i) * 256 + 4 * lane) = nxt[k]; } }
        }
#undef MK_ROWADDR
#undef MK_GLU
    }
#pragma unroll
    for (int k = 0; k < 8; ++k) conva_finish(P, l, acc[k], (size_t)(b * SEQ + t0 + k), lane);
    const f32x4 w0 = *(const f32x4*)(P.in[20] + l * 768 + 4 * lane), w1 = *(const f32x4*)(P.in[20] + l * 768 + 256 + 4 * lane), w2 = *(const f32x4*)(P.in[20] + l * 768 + 512 + 4 * lane);
    f32x4 zm2 = (f32x4){0.f, 0.f, 0.f, 0.f}, zm1 = zm2;
#pragma unroll
    for (int k = -2; k < 8; ++k) { const int t = t0 + k;
        f32x4 z = (f32x4){0.f, 0.f, 0.f, 0.f};
        if (t >= 0) { const bf16_t* rp = PROJ + (size_t)(b * SEQ + t) * LDP; z = unpack4(*(const u32x2*)(rp + PZ + 4 * lane)); }
        if (k >= 0) { const bf16_t* rp = PROJ + (size_t)(b * SEQ + t) * LDP; const f32x4 cb = unpack4(*(const u32x2*)(rp + PCB + 4 * lane));
            const f32x4 o = cb * (w0 * zm2 + w1 * zm1 + w2 * z);
            *(u32x2*)(MIX + (size_t)(b * SEQ + t) * D + 768 + 4 * lane) = pack4(o);
            if (t >= SEQ - 2) *(f32x4*)(P.out + O_CCP + (size_t)((l * NB + b) * 2 + (t - (SEQ - 2))) * 256 + 4 * lane) = z; }
        zm2 = zm1; zm1 = z; }
}

__device__ __forceinline__ void sample_conv(const Params& P, int l) {
    int tid_ = threadIdx.x; asm volatile("" : "+v"(tid_)); const int tid = tid_, lane = tid & 63, wave = __builtin_amdgcn_readfirstlane(tid >> 6); (void)tid; (void)lane; (void)wave;
    if (wave != 2 || blockIdx.x >= NS) return;
    const int s = blockIdx.x;
    const bf16_t* PROJ = (const bf16_t*)(P.ws + WS_PROJ);
    bf16_t* MIX = (bf16_t*)(P.ws + WS_HM);
    const size_t row = (size_t)(NP + s); const bf16_t* rp = PROJ + row * LDP;
    const f32x4 u = unpack4(*(const u32x2*)(rp + PU + 4 * lane));
    const float* buf = P.in[5] + (size_t)((l * NS + s) * 30) * 256 + 4 * lane; float* nb = P.out + O_CAS + (size_t)((l * NS + s) * 30) * 256 + 4 * lane;
    const float* cw = P.in[16] + l * 31 * 256 + 4 * lane;
    f32x4 acc = *(const f32x4*)(P.in[17] + l * 256 + 4 * lane);
#pragma unroll 15
    for (int j = 0; j < 30; ++j) { const f32x4 x = *(const f32x4*)(buf + j * 256); acc = acc + *(const f32x4*)(cw + j * 256) * x; if (j >= 1) *(f32x4*)(nb + (j - 1) * 256) = x; }
    acc = acc + *(const f32x4*)(cw + 30 * 256) * u; *(f32x4*)(nb + 29 * 256) = u;
    conva_finish(P, l, acc, row, lane);
    const f32x4 w0 = *(const f32x4*)(P.in[20] + l * 768 + 4 * lane), w1 = *(const f32x4*)(P.in[20] + l * 768 + 256 + 4 * lane), w2 = *(const f32x4*)(P.in[20] + l * 768 + 512 + 4 * lane);
    const float* bc = P.in[6] + (size_t)((l * NS + s) * 2) * 256 + 4 * lane; float* nc = P.out + O_CCS + (size_t)((l * NS + s) * 2) * 256 + 4 * lane;
    const f32x4 z0 = *(const f32x4*)bc, z1 = *(const f32x4*)(bc + 256);
    const f32x4 z = unpack4(*(const u32x2*)(rp + PZ + 4 * lane));
    const f32x4 cb = unpack4(*(const u32x2*)(rp + PCB + 4 * lane));
    *(u32x2*)(MIX + row * D + 768 + 4 * lane) = pack4(cb * (w0 * z0 + w1 * z1 + w2 * z));
    *(f32x4*)nc = z1; *(f32x4*)(nc + 256) = z;
}

__device__ __forceinline__ void sample_ret(const Params& P, int l) {
    int tid_ = threadIdx.x; asm volatile("" : "+v"(tid_)); const int tid = tid_, lane = tid & 63, wave = __builtin_amdgcn_readfirstlane(tid >> 6); (void)tid; (void)lane; (void)wave;
    if (wave >= 2) return;
    const int s = (blockIdx.x * 2 + wave) >> 2, h = (blockIdx.x * 2 + wave) & 3;
    const bf16_t* PROJ = (const bf16_t*)(P.ws + WS_PROJ);
    bf16_t* MIX = (bf16_t*)(P.ws + WS_HM);
    const size_t row = (size_t)(NP + s); const bf16_t* rp = PROJ + row * LDP;
    const float lg = log2_gamma(h), gam = exp2f(lg);
    const int i5 = lane & 31;
    const double rev = 16384.0 * kInvRev[i5]; const float fr_ = (float)(rev - floor(rev));
    const float sn = __builtin_amdgcn_sinf(fr_), cs = __builtin_amdgcn_cosf(fr_);
    const float q1 = bf2f(rp[PQ + h * 64 + i5]), q2 = bf2f(rp[PQ + h * 64 + 32 + i5]), k1 = bf2f(rp[PK + h * 64 + i5]), k2 = bf2f(rp[PK + h * 64 + 32 + i5]);
    const float qr = bflo(pg8::cvt_pk_bf16(lane < 32 ? q1 * cs - q2 * sn : q1 * sn + q2 * cs, 0.f));
    const float kr = bflo(pg8::cvt_pk_bf16((lane < 32 ? k1 * cs - k2 * sn : k1 * sn + k2 * cs) * 0.125f, 0.f));
    const int eq = lane & 31, dpar = lane >> 5;
    const f32x4 v = unpack4(*(const u32x2*)(rp + PV + h * 128 + 4 * eq));
    const float* S0 = P.in[4] + (size_t)((l * NS + s) * 4 + h) * 8192 + 4 * eq; float* S1 = P.out + O_RETS + (size_t)((l * NS + s) * 4 + h) * 8192 + 4 * eq;
    f32x4 o = (f32x4){0.f, 0.f, 0.f, 0.f};
#pragma unroll
    for (int it = 0; it < 32; ++it) { const int d = 2 * it + dpar;
        const float qa = __uint_as_float(__builtin_amdgcn_readlane(__float_as_uint(qr), 2 * it)), qb = __uint_as_float(__builtin_amdgcn_readlane(__float_as_uint(qr), 2 * it + 1));
        const float ka = __uint_as_float(__builtin_amdgcn_readlane(__float_as_uint(kr), 2 * it)), kb = __uint_as_float(__builtin_amdgcn_readlane(__float_as_uint(kr), 2 * it + 1));
        const float qd = dpar ? qb : qa, kd = dpar ? kb : ka;
        f32x4 sv = *(const f32x4*)(S0 + d * 128); sv = sv * gam + v * kd; *(f32x4*)(S1 + d * 128) = sv; o = o + sv * qd; }
#pragma unroll
    for (int i = 0; i < 4; ++i) o[i] += __shfl_xor(o[i], 32);
    float sm = (o[0] + o[1]) + (o[2] + o[3]);
#pragma unroll
    for (int x = 1; x < 32; x <<= 1) sm += __shfl_xor(sm, x);
    const float mean = sm * (1.0f / 128.0f); const f32x4 dd = o - mean; float qq = (dd[0] * dd[0] + dd[1] * dd[1]) + (dd[2] * dd[2] + dd[3] * dd[3]);
#pragma unroll
    for (int x = 1; x < 32; x <<= 1) qq += __shfl_xor(qq, x);
    const float rstd = rsqrtf(qq * (1.0f / 128.0f) + EPS);
    if (lane < 32) { const f32x4 g = *(const f32x4*)(P.in[15] + l * 512 + h * 128 + 4 * eq); const f32x4 gate = unpack4(*(const u32x2*)(rp + PG + h * 128 + 4 * eq));
        f32x4 y;
#pragma unroll
        for (int i = 0; i < 4; ++i) y[i] = dd[i] * rstd * g[i] * siluf_(gate[i]);
        *(u32x2*)(MIX + row * D + h * 128 + 4 * eq) = pack4(y); }
}


template <int KS>
__device__ __forceinline__ void skinny_gemm(const bf16_t* A  , const bf16_t* Bt  , bf16_t* O  , unsigned* cnt, MK_LAS unsigned char* lds) {
    int tid_ = threadIdx.x; asm volatile("" : "+v"(tid_)); const int tid = tid_, lane = tid & 63, wave = __builtin_amdgcn_readfirstlane(tid >> 6);
    const int fr = lane & 15, fq = lane >> 4; constexpr int K = KS * 32 * 8;
    for (int it = blockIdx.x; it < 256; it += gridDim.x) {
        const int rb = it & 7, ct = it >> 3;
        const bf16_t* ap = A + (size_t)(NP + 16 * rb + fr) * K + wave * (KS * 32) + 8 * fq;
        const bf16_t* bp = Bt + (size_t)(32 * ct + fr) * K + wave * (KS * 32) + 8 * fq;
        f32x4 acc0 = (f32x4){0.f, 0.f, 0.f, 0.f}, acc1 = acc0;
#pragma unroll
        for (int ks = 0; ks < KS; ++ks) { const bf16x8 a = *(const bf16x8*)(ap + ks * 32), b0 = *(const bf16x8*)(bp + ks * 32), b1 = *(const bf16x8*)(bp + (size_t)16 * K + ks * 32);
            acc0 = MK_MFMA(b0, a, acc0); acc1 = MK_MFMA(b1, a, acc1); }
        MK_LAS f32x4* red = (MK_LAS f32x4*)lds;
        red[(wave * 2 + 0) * 64 + lane] = acc0; red[(wave * 2 + 1) * 64 + lane] = acc1;
        __syncthreads();
        if (wave < 2) { f32x4 sum = red[wave * 64 + lane];
#pragma unroll
            for (int w = 1; w < 8; ++w) sum = sum + red[(w * 2 + wave) * 64 + lane];
            const u32x2 pk = pack4(sum);
            __hip_atomic_store((unsigned long long*)(O + (size_t)(NP + 16 * rb + fr) * D + 32 * ct + 16 * wave + 4 * fq), ((unsigned long long)pk.y << 32) | pk.x, __ATOMIC_RELAXED, __HIP_MEMORY_SCOPE_AGENT);
            asm volatile("s_waitcnt vmcnt(0)" ::: "memory"); }
        __syncthreads();
        if (tid == 0) __hip_atomic_fetch_add(cnt, 1u, __ATOMIC_RELAXED, __HIP_MEMORY_SCOPE_AGENT);
    }
}
__global__ void __launch_bounds__(NTHREADS, 2) mk_fwd(Params P) {
    extern __shared__ __attribute__((aligned(16))) unsigned char lds_raw[];
    MK_LAS unsigned char* lds = (MK_LAS unsigned char*)lds_raw;
    cg::grid_group grid = cg::this_grid();
    if (threadIdx.x < 16) ((MK_LAS unsigned*)(lds + LDS_CTL_OFF))[threadIdx.x] = 0u;
    __syncthreads();
    (void)xcd_barrier_post((unsigned*)(P.ws + WS_CTL), (volatile MK_LAS unsigned*)(lds + LDS_CTL_OFF));
#define GRID_BAR() do { XcdBarrier xb_; xb_.bar = (unsigned*)(P.ws + WS_CTL); xb_.x = xb_xcc_id(); xb_.st = (volatile MK_LAS unsigned*)(lds + LDS_CTL_OFF); xcd_barrier(xb_); } while (0)
    if (P.ws == nullptr) grid.sync();
    const int G = gridDim.x, bx = blockIdx.x;
    unsigned char* ws = P.ws;
    bf16_t* HM = (bf16_t*)(ws + WS_HM); bf16_t* T1 = (bf16_t*)(ws + WS_T1S) - (size_t)NP * D; bf16_t* PROJ = (bf16_t*)(ws + WS_PROJ);

    for (int rep = 0; rep < REP_P0; ++rep) p0_prologue(P, lds);
    GRID_BAR();
    { pg8::Gemm g{(const bf16_t*)(ws + WS_AC), (const bf16_t*)(ws + WS_ADAT), 256, NMOD, D}; pg8::StaticOrder S; S.init(256, NMOD, G, bx);
      EpiMod E{(float*)(ws + WS_MOD), P.in[8]};
      pg8::gemm_phase<EpiMod, pg8::StaticOrder, true, true>(lds, g, S, E); }
    GRID_BAR();
    for (int rep = 0; rep < REP_R0; ++rep) rowpass<0>(P, 0);
    GRID_BAR();
#pragma unroll 1
    for (int l = 0; l < DEPTH; ++l) {
        for (int rep = 0; rep < REP_WIN; ++rep)
        { pg8::Gemm g{HM, (const bf16_t*)(ws + WS_WIN) + (size_t)l * INW * D, MP, INW, D}; pg8::StaticOrder S; S.init(MP, INW, G, bx);
          EpiProj E{PROJ};
          pg8::gemm_phase<EpiProj, pg8::StaticOrder, true, true>(lds, g, S, E); }
        GRID_BAR();
        for (int rep = 0; rep < REP_MIX; ++rep) {
        if (rep) GRID_BAR();
        sample_ret(P, l); sample_conv(P, l);
        conv_task(P, l);
        for (int it = bx; it < 512; it += G) ret_u_item(P, lds, it);
#ifdef DUP_M1
        GRID_BAR();
        sample_ret(P, l); sample_conv(P, l);
        conv_task(P, l);
        for (int it = bx; it < 512; it += G) ret_u_item(P, lds, it);
#endif
#ifdef DUP_RU
        GRID_BAR();
        for (int it = bx; it < 512; it += G) ret_u_item(P, lds, it);
#endif
#ifdef DUP_CV
        GRID_BAR();
        conv_task(P, l);
#endif
#ifdef DUP_SR
        GRID_BAR();
        sample_ret(P, l); sample_conv(P, l);
#endif
        GRID_BAR();
        for (int it = bx; it < 512; it += G) ret_o_item(P, lds, l, it);
#ifdef DUP_M2
        GRID_BAR();
        for (int it = bx; it < 512; it += G) ret_o_item(P, lds, l, it);
#endif
        }
        GRID_BAR();
        { unsigned* ctl = (unsigned*)(ws + WS_CTL); const int inst = 2 * l;
          skinny_gemm<4>(HM, (const bf16_t*)(ws + WS_WOUT) + (size_t)l * D * D, T1, ctl + CW_SAMPLE + 64 * inst, lds);
          pg8::Gemm g{HM, (const bf16_t*)(ws + WS_WOUT) + (size_t)l * D * D, NP, D, D}; pg8::StaticOrder S; S.init(NP, D, G, bx);
          EpiRmsFused E{&P, l, 1};
          pg8::gemm_phase<EpiRmsFused, pg8::StaticOrder, false, true>(lds, g, S, E);
          sample_rowpass<1>(P, l, ctl + CW_SAMPLE + 64 * inst); }
        GRID_BAR();
#ifndef REP_F1
#define REP_F1 1
#endif
        for (int rep = 0; rep < REP_F1; ++rep)
        { pg8::Gemm g{HM, (const bf16_t*)(ws + WS_W13) + (size_t)l * NFF1 * D, MP, NFF1, D}; pg8::StaticOrder S; S.init(MP, NFF1, G, bx);
          EpiSwiGLU E{PROJ};
          pg8::gemm_phase<EpiSwiGLU, pg8::StaticOrder, true, true>(lds, g, S, E); }
        GRID_BAR();
        { unsigned* ctl = (unsigned*)(ws + WS_CTL); const int inst = 2 * l + 1;
          skinny_gemm<11>(PROJ, (const bf16_t*)(ws + WS_W2) + (size_t)l * D * DFF, T1, ctl + CW_SAMPLE + 64 * inst, lds);
          pg8::Gemm g{PROJ, (const bf16_t*)(ws + WS_W2) + (size_t)l * D * DFF, NP, D, DFF}; pg8::StaticOrder S; S.init(NP, D, G, bx);
          EpiRmsFused E{&P, l, 2};
          pg8::gemm_phase<EpiRmsFused, pg8::StaticOrder, false, true>(lds, g, S, E);
          sample_rowpass<2>(P, l, ctl + CW_SAMPLE + 64 * inst); }
        if (l + 1 < DEPTH) GRID_BAR();
    }
}
}

extern "C" void kernel_launch(void* const* d_in, const int* in_sizes, int n_in, void* d_out, int out_size, void* d_ws, size_t ws_size, hipStream_t stream) {
    static int grid = 0;
    if (grid == 0) {
        if (n_in != 24 || (size_t)out_size != mk::O_END || ws_size < mk::WS_END) { fprintf(stderr, "kernel_launch: unexpected shapes: n_in %d out %d ws %zu\n", n_in, out_size, ws_size); grid = -1; return; }
        int dev = 0, cus = 0, per_cu = 0;
        hipGetDevice(&dev); hipDeviceGetAttribute(&cus, hipDeviceAttributeMultiprocessorCount, dev);
        hipFuncSetAttribute((const void*)mk::mk_fwd, hipFuncAttributeMaxDynamicSharedMemorySize, mk::LDS_BYTES);
        hipOccupancyMaxActiveBlocksPerMultiprocessor(&per_cu, (const void*)mk::mk_fwd, mk::NTHREADS, mk::LDS_BYTES);
        (void)hipGetLastError();
        if (per_cu < 1) { fprintf(stderr, "kernel_launch: occupancy query says %d blocks per CU\n", per_cu); per_cu = 1; }
        grid = cus;
    }
    if (grid < 0) return;
    if (hipMemsetAsync((char*)d_ws + mk::WS_CTL, 0, mk::CTL_ZERO_BYTES, stream) != hipSuccess) { fprintf(stderr, "kernel_launch: memset failed\n"); return; }
    mk::Params p{};
    for (int i = 0; i < 24; ++i) p.in[i] = (const float*)d_in[i];
    p.out = (float*)d_out; p.ws = (unsigned char*)d_ws;
    void* args[] = {&p};
    hipError_t e = hipLaunchCooperativeKernel((const void*)mk::mk_fwd, dim3(grid), dim3(mk::NTHREADS), args, mk::LDS_BYTES, stream);
    if (e != hipSuccess) fprintf(stderr, "kernel_launch: cooperative launch failed: %s (grid %d)\n", hipGetErrorString(e), grid);
}
```

```cpp
#include <hip/hip_runtime.h>
#include <cstdio>
#include <cstdint>
namespace pg8 {
#define PG8_LAS __attribute__((address_space(3)))
typedef unsigned short bf16_t;
typedef short bf16x8 __attribute__((ext_vector_type(8)));
typedef float f32x4 __attribute__((ext_vector_type(4)));
typedef unsigned u32x4 __attribute__((ext_vector_type(4)));
constexpr int BM = 256, BK = 64, HALF = 128, HTB = HALF * BK * 2  , STAGE_BYTES = 8 * HTB, NXCD = 8, WGM = 8;

__host__ __device__ __forceinline__ int lds_byte(int r, int c) { const int st = (r >> 4) * 2 + (c >> 5), rr = r & 15, cc = c & 31, ob = rr * 64 + cc * 2; return st * 1024 + (ob ^ (((ob >> 9) & 1) << 5)); }
__host__ __device__ __forceinline__ void stage_rc(int b, int& R, int& C) { const int st = b / 1024, sb = b % 1024, swz = sb ^ (((sb >> 9) & 1) << 5); R = (st >> 1) * 16 + swz / 64; C = (st & 1) * 32 + (swz % 64) / 2; }
__host__ __device__ __forceinline__ int perm32(int rho) { const int n = rho >> 4, i = rho & 15; return 8 * (i >> 2) + 4 * n + (i & 3); }

struct Unit { int pm, pn; };
struct Gemm { const bf16_t* A; const bf16_t* Bt; int M, N, K; };

struct StaticOrder {
    int nM, nN, nwg, G, c;
    __host__ __device__ void init(int M, int N, int G_, int c_) { nM = M / BM; nN = N / BM; nwg = nM * nN; G = G_; c = c_; }
    __host__ __device__ bool next(int i, Unit& u) const {
        const long L = (long)i * G + c; if (L >= nwg) return false;
        int wgid = (int)L; { const int q = nwg / NXCD, r = nwg % NXCD, xcd = wgid % NXCD, off = wgid / NXCD; wgid = (xcd < r ? xcd * (q + 1) : r * (q + 1) + (xcd - r) * q) + off; }
        const int nig = WGM * nN, gid = wgid / nig, fm = gid * WGM, gsz = (nM - fm) < WGM ? (nM - fm) : WGM;
        u.pm = fm + ((wgid % nig) % gsz); u.pn = (wgid % nig) / gsz; return true;
    }
    __device__ __forceinline__ void a_ready(const Unit&) const {}
    __device__ __forceinline__ void done(const Unit&) const {}
};

__device__ __forceinline__ unsigned cvt_pk_bf16(float lo, float hi) { unsigned r; asm volatile("v_cvt_pk_bf16_f32 %0, %1, %2" : "=v"(r) : "v"(lo), "v"(hi)); return r; }
typedef float f32x2 __attribute__((ext_vector_type(2)));
__device__ __forceinline__ f32x2 gelu_pk(f32x2 v) {
    const f32x2 av = __builtin_elementwise_abs(v), d = av * 0.2316418882f + 1.0f;
    f32x2 t; t.x = __builtin_amdgcn_rcpf(d.x); t.y = __builtin_amdgcn_rcpf(d.y);
    f32x2 q = t * 0.5307027145f + (-0.7265760135f); q = q * t + 0.7107068705f; q = q * t + (-0.142248368f); q = q * t + 0.127414796f; q = q * t;
    const f32x2 s = (v * v) * (-0.72134752044f);
    f32x2 e; e.x = __builtin_amdgcn_exp2f(s.x); e.y = __builtin_amdgcn_exp2f(s.y);
    const f32x2 m = v * (q * e), r = v - m;
    f32x2 o; o.x = v.x < 0.f ? m.x : r.x; o.y = v.y < 0.f ? m.y : r.y; return o;
}

template <int ACT  > struct EpiBf16 {
    static constexpr bool PERM = true, AFTER_DRAIN = false; static_assert(ACT == 0 || ACT == 1, "EpiBf16: ACT is 0 (none) or 1 (gelu_pk)");
    bf16_t* O; int ldc; const float* bias; int split_cols; size_t split_stride; float scale0;
    __device__ __forceinline__ void operator()(const f32x4 (&acc)[2][2][4][2], const Unit& u, int wr, int wc, int fr, int fq) const {
        const int row0 = u.pm * BM + wr * 64 + fr; int colt = u.pn * BM; bf16_t* base = O;
        float sc = 1.f; if (split_cols) { const int t = colt / split_cols; base += (size_t)t * split_stride; colt -= t * split_cols; if (t == 0) sc = scale0; }
        const int col0 = colt + wc * 32 + 8 * fq, bcol0 = u.pn * BM + wc * 32 + 8 * fq;
        f32x4 bv[2][2];
#pragma unroll
        for (int bj = 0; bj < 2; ++bj)
#pragma unroll
            for (int n = 0; n < 2; ++n) bv[bj][n] = bias ? *(const f32x4*)(bias + bcol0 + bj * HALF + 4 * n) : (f32x4){0.f, 0.f, 0.f, 0.f};
#pragma unroll
        for (int ai = 0; ai < 2; ++ai)
#pragma unroll
            for (int m = 0; m < 4; ++m) { bf16_t* rowp = base + (size_t)(row0 + ai * HALF + m * 16) * ldc + col0;
#pragma unroll
                for (int bj = 0; bj < 2; ++bj) { f32x4 v0 = acc[ai][bj][m][0] + bv[bj][0], v1 = acc[ai][bj][m][1] + bv[bj][1];
                    if (ACT == 1) { f32x2 a = gelu_pk((f32x2){v0[0], v0[1]}), b = gelu_pk((f32x2){v0[2], v0[3]}), c = gelu_pk((f32x2){v1[0], v1[1]}), d = gelu_pk((f32x2){v1[2], v1[3]});
                        v0 = (f32x4){a.x, a.y, b.x, b.y}; v1 = (f32x4){c.x, c.y, d.x, d.y}; }
                    v0 = v0 * sc; v1 = v1 * sc; u32x4 w; w.x = cvt_pk_bf16(v0[0], v0[1]); w.y = cvt_pk_bf16(v0[2], v0[3]); w.z = cvt_pk_bf16(v1[0], v1[1]); w.w = cvt_pk_bf16(v1[2], v1[3]);
                    *(u32x4*)(rowp + bj * HALF) = w; } }
    }
};

struct PanelStats {
    unsigned* xbuf;
    unsigned* cnt;
    unsigned* tmo;
    int ntn; float eps;
    unsigned code;
    __device__ __forceinline__ bool run(const f32x4 (&v)[2][2][4][2], const Unit& u, int wr, int wc, int fr, int fq, PG8_LAS unsigned char* lds, int wid, int lane) const {
        typedef float f32x2v __attribute__((ext_vector_type(2)));
        PG8_LAS f32x2v* P = (PG8_LAS f32x2v*)lds;
        PG8_LAS f32x2v* S = (PG8_LAS f32x2v*)(lds + 8192);
        PG8_LAS unsigned* flag = (PG8_LAS unsigned*)(lds + 8192 + 2048);
#pragma unroll
        for (int ai = 0; ai < 2; ++ai)
#pragma unroll
            for (int m = 0; m < 4; ++m) {
                float s = 0.f;
#pragma unroll
                for (int bj = 0; bj < 2; ++bj)
#pragma unroll
                    for (int n = 0; n < 2; ++n) { const f32x4 x = v[ai][bj][m][n]; s += (x[0] + x[1]) + (x[2] + x[3]); }
                s += __shfl_xor(s, 16); s += __shfl_xor(s, 32);
                const float mw = s * (1.0f / 64.0f); float q = 0.f;
#pragma unroll
                for (int bj = 0; bj < 2; ++bj)
#pragma unroll
                    for (int n = 0; n < 2; ++n) { const f32x4 d = v[ai][bj][m][n] - mw; q += (d[0] * d[0] + d[1] * d[1]) + (d[2] * d[2] + d[3] * d[3]); }
                q += __shfl_xor(q, 16); q += __shfl_xor(q, 32);
                if (fq == 0) P[(ai * HALF + wr * 64 + m * 16 + fr) * 4 + wc] = (f32x2v){mw, q};
            }
        asm volatile("s_waitcnt lgkmcnt(0)" ::: "memory"); __builtin_amdgcn_s_barrier(); asm volatile("" ::: "memory");
#if defined(BROKEN_EXCHANGE_NO_WAIT)
#warning BROKEN CONTROL BUILD: the row-statistics exchange does not wait; results are wrong by design
        if (blockIdx.x >= 64) { const long long t0_ = clock64(); while (clock64() - t0_ < 60000) __builtin_amdgcn_s_sleep(8); }
#endif
        const int row = wid * 32 + (lane & 31);
        if (lane < 32) {
            const f32x2v a = P[row * 4 + 0], b = P[row * 4 + 1], c = P[row * 4 + 2], d = P[row * 4 + 3];
            const float mt = (a.x + b.x + c.x + d.x) * 0.25f;
            const float da = a.x - mt, db = b.x - mt, dc = c.x - mt, dd = d.x - mt;
            const float m2 = (a.y + b.y) + (c.y + d.y) + 64.0f * ((da * da + db * db) + (dc * dc + dd * dd));
            unsigned long long* slot = (unsigned long long*)xbuf + ((size_t)(u.pm * BM + row) * 4 + u.pn);
            __hip_atomic_store(slot, ((unsigned long long)__float_as_uint(m2) << 32) | __float_as_uint(mt), __ATOMIC_RELAXED, __HIP_MEMORY_SCOPE_AGENT);
        }
        asm volatile("s_waitcnt vmcnt(0)" ::: "memory");
        if (lane == 0) __hip_atomic_fetch_add(cnt + 64 * u.pm, 1u, __ATOMIC_RELAXED, __HIP_MEMORY_SCOPE_AGENT);
        if (wid == 0) {
            bool dead = false; const unsigned long long t0 = __builtin_amdgcn_s_memrealtime(); const unsigned want = 8u * (unsigned)ntn;
            for (;;) {
#if defined(BROKEN_EXCHANGE_NO_WAIT)
                break;
#endif
                if ((unsigned)__builtin_amdgcn_readfirstlane(__hip_atomic_load(cnt + 64 * u.pm, __ATOMIC_RELAXED, __HIP_MEMORY_SCOPE_AGENT)) >= want) break;
                if (__builtin_amdgcn_s_memrealtime() - t0 > 2000000ull) {
                    if (lane == 0) { unsigned expect = 0u; __hip_atomic_compare_exchange_strong(tmo + 1, &expect, code | (unsigned)(u.pm & 0xff), __ATOMIC_RELAXED, __ATOMIC_RELAXED, __HIP_MEMORY_SCOPE_AGENT);
                                     __hip_atomic_store(tmo, 1u, __ATOMIC_RELAXED, __HIP_MEMORY_SCOPE_AGENT); }
                    dead = true; break; }
                __builtin_amdgcn_s_sleep(2);
            }
            __builtin_amdgcn_fence(__ATOMIC_ACQUIRE, "agent");
            if (lane == 0) flag[0] = dead ? 1u : 0u;
        }
        asm volatile("s_waitcnt vmcnt(0) lgkmcnt(0)" ::: "memory"); __builtin_amdgcn_s_barrier(); asm volatile("" ::: "memory");
        const bool bad = flag[0] != 0u;
        if (lane < 32) {
            const unsigned long long* slot = (const unsigned long long*)xbuf + (size_t)(u.pm * BM + row) * 4; float mt[4], m2[4]; float ms = 0.f;
#pragma unroll
            for (int t = 0; t < 4; ++t) { if (t < ntn) { const unsigned long long w = __hip_atomic_load(slot + t, __ATOMIC_RELAXED, __HIP_MEMORY_SCOPE_AGENT); mt[t] = __uint_as_float((unsigned)w); m2[t] = __uint_as_float((unsigned)(w >> 32)); } else { mt[t] = 0.f; m2[t] = 0.f; } ms += mt[t]; }
            const float mean = ms / (float)ntn; float q = 0.f;
#pragma unroll
            for (int t = 0; t < 4; ++t) if (t < ntn) { const float dm = mt[t] - mean; q += m2[t] + 256.0f * dm * dm; }
            S[row] = (f32x2v){mean, 1.0f / sqrtf(q / (256.0f * (float)ntn) + eps)};
        }
        asm volatile("s_waitcnt lgkmcnt(0)" ::: "memory"); __builtin_amdgcn_s_barrier(); asm volatile("" ::: "memory");
        return bad;
    }
};
struct EpiLnRes {
    static constexpr bool PERM = false, AFTER_DRAIN = true;
    const float* base; float* out; int ldc; const float* bias; PanelStats st; unsigned poison;
    __device__ __forceinline__ void fused(f32x4 (&acc)[2][2][4][2], const Unit& u, int wr, int wc, int fr, int fq, PG8_LAS unsigned char* lds, int wid, int lane) const {
        typedef float f32x2v __attribute__((ext_vector_type(2)));
        const PG8_LAS f32x2v* S = (const PG8_LAS f32x2v*)(lds + 8192);
        const int col0 = u.pn * BM + wc * 32 + 4 * fq;
#pragma unroll
        for (int bj = 0; bj < 2; ++bj)
#pragma unroll
            for (int n = 0; n < 2; ++n) { const f32x4 bv = bias ? *(const f32x4*)(bias + col0 + bj * HALF + n * 16) : (f32x4){0.f, 0.f, 0.f, 0.f};
#pragma unroll
                for (int ai = 0; ai < 2; ++ai)
#pragma unroll
                    for (int m = 0; m < 4; ++m) acc[ai][bj][m][n] += bv; }
        f32x4 pre[4][2][2];
#pragma unroll
        for (int m = 0; m < 4; ++m) { const size_t off = (size_t)(u.pm * BM + wr * 64 + m * 16 + fr) * ldc + col0;
#pragma unroll
            for (int bj = 0; bj < 2; ++bj)
#pragma unroll
                for (int n = 0; n < 2; ++n) pre[m][bj][n] = *(const f32x4*)(base + off + bj * HALF + n * 16); }
        const bool bad = st.run(acc, u, wr, wc, fr, fq, lds, wid, lane) || poison != 0u;
        const float qnan = __builtin_nanf("");
#pragma unroll
        for (int ai = 0; ai < 2; ++ai)
#pragma unroll
            for (int m = 0; m < 4; ++m) { const int r = ai * HALF + wr * 64 + m * 16 + fr; const f32x2v sr = S[r]; const size_t off = (size_t)(u.pm * BM + r) * ldc + col0;
#pragma unroll
                for (int bj = 0; bj < 2; ++bj)
#pragma unroll
                    for (int n = 0; n < 2; ++n) { const f32x4 bs = ai == 0 ? pre[m][bj][n] : *(const f32x4*)(base + off + bj * HALF + n * 16); f32x4 o = bs + (acc[ai][bj][m][n] - sr.x) * sr.y;
                        if (bad) o = (f32x4){qnan, qnan, qnan, qnan}; *(f32x4*)(out + off + bj * HALF + n * 16) = o; }
                if (m & 1) asm volatile("" ::: "memory"); }
    }
};
struct EpiLnResLn {
    static constexpr bool PERM = false, AFTER_DRAIN = true;
    const float* base; float* out; bf16_t* xn; int ldc; const float* bias; PanelStats st1, st2; unsigned poison;
    __device__ __forceinline__ void fused(f32x4 (&acc)[2][2][4][2], const Unit& u, int wr, int wc, int fr, int fq, PG8_LAS unsigned char* lds, int wid, int lane) const {
        typedef float f32x2v __attribute__((ext_vector_type(2))); typedef unsigned u32x2v __attribute__((ext_vector_type(2)));
        const PG8_LAS f32x2v* S = (const PG8_LAS f32x2v*)(lds + 8192);
        const int col0 = u.pn * BM + wc * 32 + 4 * fq;
#pragma unroll
        for (int bj = 0; bj < 2; ++bj)
#pragma unroll
            for (int n = 0; n < 2; ++n) { const f32x4 bv = bias ? *(const f32x4*)(bias + col0 + bj * HALF + n * 16) : (f32x4){0.f, 0.f, 0.f, 0.f};
#pragma unroll
                for (int ai = 0; ai < 2; ++ai)
#pragma unroll
                    for (int m = 0; m < 4; ++m) acc[ai][bj][m][n] += bv; }
        bool bad = st1.run(acc, u, wr, wc, fr, fq, lds, wid, lane) || poison != 0u;
        const float qnan = __builtin_nanf("");
#pragma unroll
        for (int ai = 0; ai < 2; ++ai)
#pragma unroll
            for (int m = 0; m < 4; ++m) { const int r = ai * HALF + wr * 64 + m * 16 + fr; const f32x2v sr = S[r]; const size_t off = (size_t)(u.pm * BM + r) * ldc + col0;
#pragma unroll
                for (int bj = 0; bj < 2; ++bj)
#pragma unroll
                    for (int n = 0; n < 2; ++n) { const f32x4 bs = *(const f32x4*)(base + off + bj * HALF + n * 16); acc[ai][bj][m][n] = bs + (acc[ai][bj][m][n] - sr.x) * sr.y; }
                asm volatile("" : "+v"(acc[ai][0][m][0]), "+v"(acc[ai][0][m][1]), "+v"(acc[ai][1][m][0]), "+v"(acc[ai][1][m][1]));
                if (m & 1) asm volatile("" ::: "memory"); }
        const bool bad1 = bad;
        bad = st2.run(acc, u, wr, wc, fr, fq, lds, wid, lane) || bad;
#pragma unroll
        for (int ai = 0; ai < 2; ++ai)
#pragma unroll
            for (int m = 0; m < 4; ++m) { const int r = ai * HALF + wr * 64 + m * 16 + fr; const f32x2v sr = S[r]; const size_t off = (size_t)(u.pm * BM + r) * ldc + col0;
#pragma unroll
                for (int bj = 0; bj < 2; ++bj)
#pragma unroll
                    for (int n = 0; n < 2; ++n) { const f32x4 x1 = acc[ai][bj][m][n]; *(f32x4*)(out + off + bj * HALF + n * 16) = bad1 ? (f32x4){qnan, qnan, qnan, qnan} : x1;
                        const f32x4 o = (x1 - sr.x) * sr.y; u32x2v w; w.x = cvt_pk_bf16(o[0], o[1]); w.y = cvt_pk_bf16(o[2], o[3]);
                        if (bad) { w.x = 0x7fc07fc0u; w.y = 0x7fc07fc0u; } *(u32x2v*)(xn + off + bj * HALF + n * 16) = w; }
                asm volatile("" ::: "memory"); }
    }
};

template <class Epi, class Sched, bool ALIGN_EPI = false, bool SP2 = false>
__device__ __forceinline__ void gemm_phase(PG8_LAS unsigned char* lds, const Gemm g, const Sched& S, const Epi& E) {
    int tid_ = threadIdx.x; asm volatile("" : "+v"(tid_));
    const int tid = tid_, wid = __builtin_amdgcn_readfirstlane(tid >> 6), lane = tid & 63, wr = wid >> 2, wc = wid & 3, fr = lane & 15, fq = lane >> 4;
    const int K = g.K, nt = K / BK;
    unsigned voffA[2], voffB[2];
#pragma unroll
    for (int i = 0; i < 2; ++i) { int R, C; stage_rc(tid * 16 + i * 8192, R, C); const int Rb = Epi::PERM ? ((R & ~31) + perm32(R & 31)) : R;
        voffA[i] = (unsigned)(R * K + C) * 2u; voffB[i] = (unsigned)(Rb * K + C) * 2u; }
    const size_t kstep = (size_t)(BK * 2);
    const size_t hstep = (size_t)HALF * K * 2;
    const size_t tstep = 2 * hstep;
    const unsigned ldsw = (unsigned)wid * 1024u;
    const int aoff = lds_byte(wr * 64 + fr, fq * 8), boff = lds_byte(wc * 32 + fr, fq * 8);
#define PG8_SA(b, h) (((b) * 2 + (h)) * HTB)
#define PG8_SB(b, h) ((4 + (b) * 2 + (h)) * HTB)
#define PG8_STAGE(bufoff, gbase, voff) do { _Pragma("unroll") for (int _i = 0; _i < 2; ++_i) \
        __builtin_amdgcn_global_load_lds((const unsigned*)((const char*)(gbase) + (voff)[_i]), (PG8_LAS unsigned*)(lds + (bufoff) + ldsw + _i * 8192), 16, 0, 0); } while (0)
#define PG8_LDA(dst, b, h) do { _Pragma("unroll") for (int m = 0; m < 4; ++m) _Pragma("unroll") for (int k = 0; k < 2; ++k) dst[m][k] = *(const PG8_LAS bf16x8*)(lds + PG8_SA(b, h) + aoff + m * 2048 + k * 1024); } while (0)
#define PG8_LDB(dst, b, h) do { _Pragma("unroll") for (int n = 0; n < 2; ++n) _Pragma("unroll") for (int k = 0; k < 2; ++k) dst[n][k] = *(const PG8_LAS bf16x8*)(lds + PG8_SB(b, h) + boff + n * 2048 + k * 1024); } while (0)
#define PG8_MMA(ai, bj, At, Bt) do { __builtin_amdgcn_s_setprio(1); _Pragma("unroll") for (int m = 0; m < 4; ++m) _Pragma("unroll") for (int n = 0; n < 2; ++n) _Pragma("unroll") for (int k = 0; k < 2; ++k) \
        acc[ai][bj][m][n] = __builtin_amdgcn_mfma_f32_16x16x32_bf16(Bt[n][k], At[m][k], acc[ai][bj][m][n], 0, 0, 0); __builtin_amdgcn_s_setprio(0); } while (0)
#define PG8_WAIT_V(n) asm volatile("s_waitcnt vmcnt(" #n ")" ::: "memory")
#define PG8_WAIT_L(n) asm volatile("s_waitcnt lgkmcnt(" #n ")" ::: "memory")
#define PG8_BAR __builtin_amdgcn_s_barrier()
#define PG8_SCHED __builtin_amdgcn_sched_barrier(0)
    Unit cur, nxt; int ui = 0;
    if (!S.next(0, cur)) return;
    f32x4 acc[2][2][4][2];
#pragma unroll
    for (int a = 0; a < 2; ++a)
#pragma unroll
        for (int b = 0; b < 2; ++b)
#pragma unroll
            for (int m = 0; m < 4; ++m)
#pragma unroll
                for (int n = 0; n < 2; ++n) acc[a][b][m][n] = (f32x4){0.f, 0.f, 0.f, 0.f};
    bf16x8 At[4][2], B0[2][2], B1[2][2];
    const char* cA = (const char*)g.A + (size_t)cur.pm * tstep; const char* cB = (const char*)g.Bt + (size_t)cur.pn * tstep;
    S.a_ready(cur);
    if constexpr (SP2) {
        PG8_STAGE(PG8_SB(0, 0), cB, voffB); PG8_STAGE(PG8_SB(0, 1), cB + hstep, voffB); PG8_STAGE(PG8_SA(0, 0), cA, voffA); PG8_STAGE(PG8_SA(0, 1), cA + hstep, voffA);
        if (wr == 1) PG8_BAR;
        PG8_WAIT_V(2); PG8_BAR;
        PG8_STAGE(PG8_SB(1, 0), cB + kstep, voffB); PG8_STAGE(PG8_SA(1, 0), cA + kstep, voffA); PG8_STAGE(PG8_SB(1, 1), cB + hstep + kstep, voffB);
        PG8_WAIT_V(6); PG8_BAR;
    } else {
        PG8_STAGE(PG8_SB(0, 0), cB, voffB); PG8_STAGE(PG8_SA(0, 0), cA, voffA); PG8_STAGE(PG8_SB(0, 1), cB + hstep, voffB); PG8_STAGE(PG8_SA(0, 1), cA + hstep, voffA);
        if (wr == 1) PG8_BAR;
        PG8_WAIT_V(4); PG8_BAR;
        PG8_STAGE(PG8_SB(1, 0), cB + kstep, voffB); PG8_STAGE(PG8_SA(1, 0), cA + kstep, voffA); PG8_STAGE(PG8_SB(1, 1), cB + hstep + kstep, voffB);
        PG8_WAIT_V(6); PG8_BAR;
    }
    for (;;) {
        const bool has_next = S.next(ui + 1, nxt);
        const char* nA = has_next ? (const char*)g.A + (size_t)nxt.pm * tstep : cA; const char* nB = has_next ? (const char*)g.Bt + (size_t)nxt.pn * tstep : cB;
        for (int t = 0; t < nt; t += 2) {
            const bool last = (t == nt - 2);
            const char* a1 = cA + (size_t)(t + 1) * kstep;
            const char* a2 = last ? nA : cA + (size_t)(t + 2) * kstep; const char* b2 = last ? nB : cB + (size_t)(t + 2) * kstep;
            const char* a3 = a2 + kstep; const char* b3 = b2 + kstep;
            if (last && has_next) S.a_ready(nxt);
            if constexpr (SP2) {
            PG8_LDB(B0, 0, 0); PG8_LDB(B1, 0, 1); PG8_SCHED; PG8_LDA(At, 0, 0); PG8_STAGE(PG8_SA(1, 1), a1 + hstep, voffA);
            PG8_WAIT_V(8); PG8_WAIT_L(0); PG8_BAR; PG8_MMA(0, 0, At, B0); PG8_MMA(0, 1, At, B1); PG8_BAR; PG8_SCHED;
            PG8_LDA(At, 0, 1); PG8_STAGE(PG8_SB(0, 0), b2, voffB); PG8_STAGE(PG8_SB(0, 1), b2 + hstep, voffB); PG8_STAGE(PG8_SA(0, 0), a2, voffA);
            PG8_WAIT_V(8); PG8_WAIT_L(0); PG8_BAR; PG8_MMA(1, 0, At, B0); PG8_MMA(1, 1, At, B1); PG8_BAR; PG8_SCHED;
            PG8_LDB(B0, 1, 0); PG8_LDB(B1, 1, 1); PG8_SCHED; PG8_LDA(At, 1, 0); PG8_STAGE(PG8_SA(0, 1), a2 + hstep, voffA);
            PG8_WAIT_V(8); PG8_WAIT_L(0); PG8_BAR; PG8_MMA(0, 0, At, B0); PG8_MMA(0, 1, At, B1); PG8_BAR; PG8_SCHED;
            PG8_LDA(At, 1, 1); PG8_STAGE(PG8_SB(1, 0), b3, voffB); PG8_STAGE(PG8_SB(1, 1), b3 + hstep, voffB); PG8_STAGE(PG8_SA(1, 0), a3, voffA);
            PG8_WAIT_V(8); PG8_WAIT_L(0); PG8_BAR; PG8_MMA(1, 0, At, B0); PG8_MMA(1, 1, At, B1); PG8_BAR; PG8_SCHED;
            } else {
            PG8_LDB(B0, 0, 0); PG8_SCHED; PG8_LDA(At, 0, 0); PG8_STAGE(PG8_SA(1, 1), a1 + hstep, voffA);
            PG8_WAIT_L(8); PG8_BAR; PG8_WAIT_L(0); PG8_MMA(0, 0, At, B0); PG8_BAR; PG8_SCHED;
            PG8_LDB(B1, 0, 1); PG8_STAGE(PG8_SB(0, 0), b2, voffB);
            PG8_BAR; PG8_WAIT_L(0); PG8_MMA(0, 1, At, B1); PG8_BAR;
            PG8_LDA(At, 0, 1); PG8_STAGE(PG8_SA(0, 0), a2, voffA);
            PG8_BAR; PG8_WAIT_L(0); PG8_MMA(1, 0, At, B0); PG8_BAR; PG8_SCHED;
            PG8_STAGE(PG8_SB(0, 1), b2 + hstep, voffB);
            PG8_WAIT_V(6); PG8_BAR; PG8_MMA(1, 1, At, B1); PG8_BAR;
            PG8_LDB(B0, 1, 0); PG8_SCHED; PG8_LDA(At, 1, 0); PG8_STAGE(PG8_SA(0, 1), a2 + hstep, voffA);
            PG8_WAIT_L(8); PG8_BAR; PG8_WAIT_L(0); PG8_MMA(0, 0, At, B0); PG8_BAR; PG8_SCHED;
            PG8_LDB(B1, 1, 1); PG8_STAGE(PG8_SB(1, 0), b3, voffB);
            PG8_BAR; PG8_WAIT_L(0); PG8_MMA(0, 1, At, B1); PG8_BAR;
            PG8_LDA(At, 1, 1); PG8_STAGE(PG8_SA(1, 0), a3, voffA);
            PG8_BAR; PG8_WAIT_L(0); PG8_MMA(1, 0, At, B0); PG8_BAR; PG8_SCHED;
            PG8_STAGE(PG8_SB(1, 1), b3 + hstep, voffB);
            PG8_WAIT_V(6); PG8_BAR; PG8_MMA(1, 1, At, B1); PG8_BAR;
            }
        }
        if constexpr (ALIGN_EPI) { if (wr == 0) PG8_BAR; }
        if constexpr (!Epi::AFTER_DRAIN) { E(acc, cur, wr, wc, fr, fq); S.done(cur); }
        if (!has_next) break;
#pragma unroll
        for (int a = 0; a < 2; ++a)
#pragma unroll
            for (int b = 0; b < 2; ++b)
#pragma unroll
                for (int m = 0; m < 4; ++m)
#pragma unroll
                    for (int n = 0; n < 2; ++n) acc[a][b][m][n] = (f32x4){0.f, 0.f, 0.f, 0.f};
        cur = nxt; cA = nA; cB = nB; ++ui;
        if constexpr (ALIGN_EPI) { if (wr == 1) PG8_BAR; }
    }
    PG8_WAIT_V(0);
    if constexpr (!ALIGN_EPI) { if (wr == 0) PG8_BAR; }
    PG8_BAR;
    if constexpr (Epi::AFTER_DRAIN) { E.fused(acc, cur, wr, wc, fr, fq, lds, wid, lane); S.done(cur); }
#undef PG8_SA
#undef PG8_SB
#undef PG8_STAGE
#undef PG8_LDA
#undef PG8_LDB
#undef PG8_MMA
#undef PG8_WAIT_V
#undef PG8_WAIT_L
#undef PG8_BAR
#undef PG8_SCHED
}
}

#include <hip/hip_cooperative_groups.h>
namespace cg = cooperative_groups;
namespace mk {
using pg8::bf16_t; using pg8::bf16x8; using pg8::f32x4; using pg8::u32x4;
#define MK_LAS __attribute__((address_space(3)))
typedef unsigned u32x2 __attribute__((ext_vector_type(2)));
typedef float f32x2v __attribute__((ext_vector_type(2)));

#define LAS MK_LAS
#define XB_TMO      128
#define XB_XCNT(j)  (256  + 64 * (j))
#define XB_XSUB(j)  (1280 + 64 * (j))
#define XB_XGEN(j)  (2304 + 64 * (j))
#define XB_TOP      3328
#define XB_TOPGEN   3392
#define XCD_BAR_WORDS 3456
#define XB_SPIN_CAP (1u << 18)

__device__ __forceinline__ unsigned xb_ld(unsigned* p)              { return __hip_atomic_load(p, __ATOMIC_RELAXED, __HIP_MEMORY_SCOPE_AGENT); }
__device__ __forceinline__ unsigned xb_add(unsigned* p, unsigned v) { return __hip_atomic_fetch_add(p, v, __ATOMIC_RELAXED, __HIP_MEMORY_SCOPE_AGENT); }
__device__ __forceinline__ unsigned xb_xcc_id() { return (unsigned)__builtin_amdgcn_s_getreg((3 << 11) | 20) & 0xFu; }
#define XB_SPIN(cond, bar) do { unsigned _sp = 0; while (cond) { __builtin_amdgcn_s_sleep(1); \
    if ((++_sp & 255u) == 0u) { if (xb_ld(&(bar)[XB_TMO])) break; if (_sp > XB_SPIN_CAP) { atomicAdd(&(bar)[XB_TMO], 1u); break; } } } } while (0)

struct XcdBarrier {
    unsigned* bar; unsigned x;
    volatile LAS unsigned* st;
};

__device__ __forceinline__ XcdBarrier xcd_barrier_post(unsigned* bar, volatile LAS unsigned* st) {
    XcdBarrier b; b.bar = bar; b.x = xb_xcc_id(); b.st = st;
    if (threadIdx.x == 0) (void)xb_add(&bar[XB_XCNT(b.x)], 1u);
    return b;
}
__device__ __forceinline__ void xcd_barrier_complete(unsigned* bar, unsigned x, unsigned& nloc, unsigned& nx) {
    const unsigned G = gridDim.x * gridDim.y * gridDim.z;
    unsigned sum, cnt, mine, sp = 0u;
    for (;;) {
        sum = 0u; cnt = 0u; mine = 0u;
#pragma unroll
        for (unsigned j = 0; j < 16; ++j) { const unsigned c = xb_ld(&bar[XB_XCNT(j)]); sum += c; cnt += (c > 0u) ? 1u : 0u; mine = (j == x) ? c : mine; }
        if (sum == G) break;
        __builtin_amdgcn_s_sleep(1);
        if ((++sp & 255u) == 0u) { if (xb_ld(&bar[XB_TMO])) break; if (sp > XB_SPIN_CAP) { atomicAdd(&bar[XB_TMO], 1u); break; } }
    }
    nloc = mine > 0u ? mine : 1u; nx = cnt > 0u ? cnt : 1u;
}

__device__ __forceinline__ void xcd_barrier(const XcdBarrier& b) {
    asm volatile("s_waitcnt vmcnt(0)" ::: "memory");
    __syncthreads();
    if (threadIdx.x == 0) {
        unsigned* bar = b.bar;
        __builtin_amdgcn_s_waitcnt(0);
        unsigned nloc = b.st[0], nx = b.st[1];
        if (nloc == 0u) { xcd_barrier_complete(bar, b.x, nloc, nx); b.st[0] = nloc; b.st[1] = nx; }
        const unsigned old = xb_add(&bar[XB_XSUB(b.x)], 1u);
        const unsigned gen = old / nloc;
        if (old + 1u == (gen + 1u) * nloc) {
            __builtin_amdgcn_fence(__ATOMIC_RELEASE, "agent");
            asm volatile("s_waitcnt vmcnt(0)" ::: "memory");
            const unsigned og = xb_add(&bar[XB_TOP], 1u);
            const unsigned tg = og / nx;
            if (og + 1u == (tg + 1u) * nx) xb_add(&bar[XB_TOPGEN], 1u);
            else XB_SPIN(xb_ld(&bar[XB_TOPGEN]) == tg, bar);
            __builtin_amdgcn_fence(__ATOMIC_ACQUIRE, "agent");
            xb_add(&bar[XB_XGEN(b.x)], 1u);
            asm volatile("s_waitcnt vmcnt(0)" ::: "memory");
        } else {
            XB_SPIN(xb_ld(&bar[XB_XGEN(b.x)]) == gen, bar);
            __builtin_amdgcn_fence(__ATOMIC_ACQUIRE, "agent");
            asm volatile("s_waitcnt vmcnt(0)" ::: "memory");
        }
    }
    __syncthreads();
}

#undef LAS
constexpr int D = 1024, NP = 16384, NS = 128, MR = NP + NS, MP = 16640, SEQ = 2048, NB = 8;
constexpr int INW = 2816, DFF = 2816, NFF1 = 5632, NMOD = 12288, MODROWS = 136, DEPTH = 2;
constexpr float EPS = 1e-6f;
constexpr int NWAVES = 8, NTHREADS = 512;
#ifndef REP_P0
#define REP_P0 1
#endif
#ifndef REP_MIX
#define REP_MIX 1
#endif
#ifndef REP_R0
#define REP_R0 1
#endif
#ifndef REP_WIN
#define REP_WIN 1
#endif
#ifndef REP_F2
#define REP_F2 1
#endif
constexpr int LDS_BYTES = 163840;

constexpr int LDP = 2304, PQ = 0, PK = 256, PV = 512, PG = 1024, PU = 1536, PCB = 1792, PZ = 2048;

constexpr size_t MiB = 1u << 20;
constexpr size_t WS_CTL = 0, CTL_ZERO_BYTES = 98304;
constexpr int LDS_CTL_OFF = 163584;
constexpr int CW_SAMPLE = 3840, CW_PANEL = 4096;
constexpr int CW_SCAN = 3584;
static_assert(XCD_BAR_WORDS <= CW_SCAN && (CW_SCAN + 64) * 4 <= CTL_ZERO_BYTES && (CW_PANEL + 4 * 4096) * 4 <= CTL_ZERO_BYTES, "ctl");
constexpr size_t WS_WIN = 1 * MiB, WS_WOUT = 12 * MiB, WS_W13 = 16 * MiB, WS_W2 = 38 * MiB, WS_MOD = 49 * MiB, WS_HM = 56 * MiB,
                 WS_T1 = 89 * MiB, WS_PROJ = 122 * MiB, WS_U = 212 * MiB, WS_SS = 228 * MiB, WS_X = 236 * MiB, WS_T1S = 240 * MiB, WS_END = 241 * MiB;
constexpr size_t WS_XB = WS_T1;
constexpr size_t WS_ADAT = WS_T1, WS_AC = WS_T1 + 24 * MiB;
static_assert(WS_WIN + (size_t)DEPTH * INW * D * 2 <= WS_WOUT && WS_WOUT + (size_t)DEPTH * D * D * 2 <= WS_W13 && WS_W13 + (size_t)DEPTH * NFF1 * D * 2 <= WS_W2 &&
              WS_W2 + (size_t)DEPTH * D * DFF * 2 <= WS_MOD && WS_MOD + (size_t)MODROWS * NMOD * 4 <= WS_HM && WS_HM + (size_t)MP * D * 2 <= WS_T1 &&
              WS_T1 + (size_t)MP * D * 2 <= WS_PROJ && WS_AC + 256 * D * 2 <= WS_PROJ && WS_PROJ + (size_t)MP * LDP * 2 <= WS_U && WS_U + (size_t)512 * 8192 * 4 <= WS_SS && WS_SS + (size_t)512 * 8192 * 2 <= WS_END, "ws map");

constexpr size_t O_Y = 0, O_YS = (size_t)NP * D, O_RETP = O_YS + (size_t)NS * D, O_CAP = O_RETP + (size_t)DEPTH * NB * 4 * 64 * 128,
                 O_CCP = O_CAP + (size_t)DEPTH * NB * 30 * 256, O_RETS = O_CCP + (size_t)DEPTH * NB * 2 * 256,
                 O_CAS = O_RETS + (size_t)DEPTH * NS * 4 * 64 * 128, O_CCS = O_CAS + (size_t)DEPTH * NS * 30 * 256, O_END = O_CCS + (size_t)DEPTH * NS * 2 * 256;

struct Params { const float* in[24]; float* out; unsigned char* ws; };

__device__ const double kInvRev[32] = {
0.15915494309189535, 0.11934937021124886, 0.08949940160889101, 0.06711508300522726, 0.050329212104487035, 0.03774158471741977, 0.0283021958306234, 0.02122365276477766,
0.015915494309189534, 0.011934937021124886, 0.008949940160889102, 0.006711508300522725, 0.005032921210448704, 0.003774158471741977, 0.00283021958306234, 0.0021223652764777662,
0.0015915494309189536, 0.0011934937021124885, 0.0008949940160889102, 0.0006711508300522726, 0.0005032921210448703, 0.00037741584717419774, 0.00028302195830623395, 0.0002122365276477766,
0.00015915494309189535, 0.00011934937021124886, 8.949940160889102e-05, 6.711508300522725e-05, 5.0329212104487035e-05, 3.774158471741978e-05, 2.8302195830623396e-05, 2.122365276477766e-05};

__device__ __forceinline__ float bf2f(unsigned short b) { return __uint_as_float((unsigned)b << 16); }
__device__ __forceinline__ float bflo(unsigned w) { return __uint_as_float(w << 16); }
__device__ __forceinline__ float bfhi(unsigned w) { return __uint_as_float(w & 0xffff0000u); }
__device__ __forceinline__ f32x4 unpack4(u32x2 w) { return (f32x4){bflo(w.x), bfhi(w.x), bflo(w.y), bfhi(w.y)}; }
__device__ __forceinline__ u32x2 pack4(f32x4 v) { u32x2 w; w.x = pg8::cvt_pk_bf16(v[0], v[1]); w.y = pg8::cvt_pk_bf16(v[2], v[3]); return w; }
__device__ __forceinline__ float sigmoidf_(float x) { return __builtin_amdgcn_rcpf(1.0f + __expf(-x)); }
__device__ __forceinline__ float siluf_(float x) { return x * sigmoidf_(x); }
__device__ __forceinline__ float wave_sum(float v) {
#pragma unroll
    for (int o = 1; o < 64; o <<= 1) v += __shfl_xor(v, o);
    return v;
}
__device__ __forceinline__ float log2_gamma(int h) { return __log2f(1.0f - exp2f(-5.0f - (float)h)); }

struct EpiMod {
    static constexpr bool PERM = false, AFTER_DRAIN = false;
    float* O; const float* bias;
    __device__ __forceinline__ void operator()(const f32x4 (&acc)[2][2][4][2], const pg8::Unit& u, int wr, int wc, int fr, int fq) const {
        const int col0 = u.pn * 256 + wc * 32 + 4 * fq;
#pragma unroll
        for (int ai = 0; ai < 2; ++ai)
#pragma unroll
            for (int m = 0; m < 4; ++m) { const int row = u.pm * 256 + ai * 128 + wr * 64 + m * 16 + fr;
                if (row < MODROWS) {
#pragma unroll
                    for (int bj = 0; bj < 2; ++bj)
#pragma unroll
                        for (int n = 0; n < 2; ++n) { const int col = col0 + bj * 128 + n * 16; *(f32x4*)(O + (size_t)row * NMOD + col) = acc[ai][bj][m][n] + *(const f32x4*)(bias + col); } } }
    }
};
struct EpiSwiGLU {
    static constexpr bool PERM = true, AFTER_DRAIN = false;
    bf16_t* O;
    __device__ __forceinline__ void operator()(const f32x4 (&acc)[2][2][4][2], const pg8::Unit& u, int wr, int wc, int fr, int fq) const {
        const int col0 = u.pn * 128 + wc * 32 + 8 * fq;
#pragma unroll
        for (int ai = 0; ai < 2; ++ai)
#pragma unroll
            for (int m = 0; m < 4; ++m) { bf16_t* rowp = O + (size_t)(u.pm * 256 + ai * 128 + wr * 64 + m * 16 + fr) * DFF + col0;
                f32x4 a0 = acc[ai][0][m][0], a1 = acc[ai][0][m][1]; const f32x4 b0 = acc[ai][1][m][0], b1 = acc[ai][1][m][1];
#pragma unroll
                for (int i = 0; i < 4; ++i) { a0[i] = siluf_(a0[i]) * b0[i]; a1[i] = siluf_(a1[i]) * b1[i]; }
                u32x4 w; w.x = pg8::cvt_pk_bf16(a0[0], a0[1]); w.y = pg8::cvt_pk_bf16(a0[2], a0[3]); w.z = pg8::cvt_pk_bf16(a1[0], a1[1]); w.w = pg8::cvt_pk_bf16(a1[2], a1[3]);
                *(u32x4*)rowp = w; }
    }
};

struct EpiProj {
    static constexpr bool PERM = true, AFTER_DRAIN = false;
    bf16_t* O;
    __device__ __forceinline__ void operator()(const f32x4 (&acc)[2][2][4][2], const pg8::Unit& u, int wr, int wc, int fr, int fq) const {
        const int pn = u.pn; const int mode = (pn == 6 || pn == 7) ? 1 : (pn >= 9 ? 2 : 0);
        const int cbase = mode == 0 ? (pn == 8 ? PCB : 256 * pn) : (mode == 1 ? PU + 128 * (pn - 6) : PZ + 128 * (pn - 9));
        const int col0 = cbase + wc * 32 + 8 * fq;
#pragma unroll
        for (int ai = 0; ai < 2; ++ai)
#pragma unroll
            for (int m = 0; m < 4; ++m) { bf16_t* rowp = O + (size_t)(u.pm * 256 + ai * 128 + wr * 64 + m * 16 + fr) * LDP + col0;
                if (mode == 0) {
#pragma unroll
                    for (int bj = 0; bj < 2; ++bj) { const f32x4 v0 = acc[ai][bj][m][0], v1 = acc[ai][bj][m][1];
                        u32x4 w; w.x = pg8::cvt_pk_bf16(v0[0], v0[1]); w.y = pg8::cvt_pk_bf16(v0[2], v0[3]); w.z = pg8::cvt_pk_bf16(v1[0], v1[1]); w.w = pg8::cvt_pk_bf16(v1[2], v1[3]);
                        *(u32x4*)(rowp + bj * 128) = w; }
                } else { f32x4 a0 = acc[ai][0][m][0], a1 = acc[ai][0][m][1]; const f32x4 b0 = acc[ai][1][m][0], b1 = acc[ai][1][m][1];
                    if (mode == 1) {
#pragma unroll
                        for (int i = 0; i < 4; ++i) { a0[i] = a0[i] * sigmoidf_(b0[i]); a1[i] = a1[i] * sigmoidf_(b1[i]); } }
                    else { a0 = a0 * b0; a1 = a1 * b1; }
                    u32x4 w; w.x = pg8::cvt_pk_bf16(a0[0], a0[1]); w.y = pg8::cvt_pk_bf16(a0[2], a0[3]); w.z = pg8::cvt_pk_bf16(a1[0], a1[1]); w.w = pg8::cvt_pk_bf16(a1[2], a1[3]);
                    *(u32x4*)rowp = w; } }
    }
};

__device__ __forceinline__ void p0_transpose_item(const float* W, int K, int N, bf16_t* WT, int k0, int n0, int orow, MK_LAS float* scr, int lane) {
    const int cq = lane & 15, r0 = lane >> 4;
    f32x4 v[16];
#pragma unroll
    for (int i = 0; i < 16; ++i) v[i] = *(const f32x4*)(W + (size_t)(k0 + 4 * i + r0) * N + n0 + 4 * cq);
#pragma unroll
    for (int i = 0; i < 16; ++i) { const int r = 4 * i + r0; *(MK_LAS f32x4*)(scr + r * 64 + ((4 * cq) ^ (8 * (r >> 3)))) = v[i]; }
    asm volatile("s_waitcnt lgkmcnt(0)" ::: "memory");
    const int c = lane & 7, nn0 = lane >> 3;
#pragma unroll
    for (int j = 0; j < 8; ++j) { const int nn = nn0 + 8 * j; const MK_LAS float* sp = scr + (8 * c) * 64 + (nn ^ (8 * c));
        u32x4 o; o.x = pg8::cvt_pk_bf16(sp[0 * 64], sp[1 * 64]); o.y = pg8::cvt_pk_bf16(sp[2 * 64], sp[3 * 64]); o.z = pg8::cvt_pk_bf16(sp[4 * 64], sp[5 * 64]); o.w = pg8::cvt_pk_bf16(sp[6 * 64], sp[7 * 64]);
        *(u32x4*)(WT + (size_t)(orow + nn) * K + k0 + 8 * c) = o; }
    asm volatile("s_waitcnt lgkmcnt(0)" ::: "memory");
}
template <int SET>
__device__ __forceinline__ void p0_convert(const Params& P, MK_LAS unsigned char* lds, int rank, int nworkers) {
    int tid_ = threadIdx.x; asm volatile("" : "+v"(tid_)); const int tid = tid_, lane = tid & 63, wave = __builtin_amdgcn_readfirstlane(tid >> 6); (void)tid; (void)lane; (void)wave;
    MK_LAS float* scr = (MK_LAS float*)(lds + wave * 16384);
    const int gw = rank * NWAVES + wave, NGW = nworkers * NWAVES;
    unsigned char* ws = P.ws;
    constexpr int I_IN = 16 * 44, I_OUT = 16 * 16, I_F = 16 * 44, I_2 = 44 * 16, I_ADA = 16 * 96;
    constexpr int PER_L = I_IN + I_OUT + 2 * I_F + I_2;
    if (SET == 0) {
        for (int it = gw; it < DEPTH * I_ADA; it += NGW) { const int l = it / I_ADA, r = it % I_ADA, kb = r / 96, nb = r % 96;
            p0_transpose_item(P.in[7] + (size_t)l * D * 6144, D, 6144, (bf16_t*)(ws + WS_ADAT), 64 * kb, 64 * nb, l * 6144 + 64 * nb, scr, lane); }
        for (int r = gw; r < 256; r += NGW) {
            bf16_t* o = (bf16_t*)(ws + WS_AC) + (size_t)r * D;
            const float* src = r < NB ? P.in[2] + (size_t)r * D : P.in[3] + (size_t)(r - NB) * D;
#pragma unroll
            for (int j = 0; j < 4; ++j) { f32x4 v = (f32x4){0.f, 0.f, 0.f, 0.f};
                if (r < MODROWS) { v = *(const f32x4*)(src + 4 * lane + 256 * j); v[0] = siluf_(v[0]); v[1] = siluf_(v[1]); v[2] = siluf_(v[2]); v[3] = siluf_(v[3]); }
                *(u32x2*)(o + 4 * lane + 256 * j) = pack4(v); }
        }
        return;
    }
    const int l = SET - 1;
    for (int it = gw; it < PER_L; it += NGW) {
        int r = it;
        if (r < I_IN) { const int kb = r / 44, nb = r % 44, n0 = 64 * nb; int orow;
            if (n0 < 1536) orow = n0; else if (n0 < 1792) orow = 256 * (6 + ((n0 - 1536) >> 7)) + ((n0 - 1536) & 127); else if (n0 < 2048) orow = 256 * (6 + ((n0 - 1792) >> 7)) + 128 + ((n0 - 1792) & 127);
            else if (n0 < 2304) orow = 2048 + (n0 - 2048); else if (n0 < 2560) orow = 256 * (9 + ((n0 - 2304) >> 7)) + ((n0 - 2304) & 127); else orow = 256 * (9 + ((n0 - 2560) >> 7)) + 128 + ((n0 - 2560) & 127);
            p0_transpose_item(P.in[13] + (size_t)l * D * INW, D, INW, (bf16_t*)(ws + WS_WIN) + (size_t)l * INW * D, 64 * kb, n0, orow, scr, lane); continue; } r -= I_IN;
        if (r < I_OUT) { const int kb = r / 16, nb = r % 16; p0_transpose_item(P.in[14] + (size_t)l * D * D, D, D, (bf16_t*)(ws + WS_WOUT) + (size_t)l * D * D, 64 * kb, 64 * nb, 64 * nb, scr, lane); continue; } r -= I_OUT;
        if (r < I_F) { const int kb = r / 44, nb = r % 44, n0 = 64 * nb; p0_transpose_item(P.in[21] + (size_t)l * D * DFF, D, DFF, (bf16_t*)(ws + WS_W13) + (size_t)l * NFF1 * D, 64 * kb, n0, 256 * (n0 >> 7) + (n0 & 127), scr, lane); continue; } r -= I_F;
        if (r < I_F) { const int kb = r / 44, nb = r % 44, n0 = 64 * nb; p0_transpose_item(P.in[22] + (size_t)l * D * DFF, D, DFF, (bf16_t*)(ws + WS_W13) + (size_t)l * NFF1 * D, 64 * kb, n0, 256 * (n0 >> 7) + 128 + (n0 & 127), scr, lane); continue; } r -= I_F;
        { const int kb = r / 16, nb = r % 16; p0_transpose_item(P.in[23] + (size_t)l * DFF * D, DFF, D, (bf16_t*)(ws + WS_W2) + (size_t)l * D * DFF, 64 * kb, 64 * nb, 64 * nb, scr, lane); }
    }
}

template <int KIND>
__device__ __forceinline__ void rowpass_row(const Params& P, int l, int r, int lane) {
    unsigned char* ws = P.ws;
    const float* mod = (const float*)(ws + WS_MOD);
    bf16_t* HM = (bf16_t*)(ws + WS_HM); const bf16_t* T1 = (const bf16_t*)(ws + WS_T1S) - (size_t)NP * D;
    bf16_t* XB = (bf16_t*)(ws + WS_XB);
    {
        const int mrow = r < NP ? (r >> 11) : NB + (r - NP);
        const float* mp = mod + (size_t)mrow * NMOD + l * 6144;
        f32x4 x[4];
        if (KIND == 0) { const float* xin = r < NP ? P.in[0] + (size_t)r * D : P.in[1] + (size_t)(r - NP) * D;
#pragma unroll
            for (int j = 0; j < 4; ++j) { x[j] = *(const f32x4*)(xin + 4 * lane + 256 * j); *(u32x2*)(XB + (size_t)r * D + 4 * lane + 256 * j) = pack4(x[j]); } }
        else {
#pragma unroll
            for (int j = 0; j < 4; ++j) x[j] = unpack4(*(const u32x2*)(XB + (size_t)r * D + 4 * lane + 256 * j)); }
        if (KIND != 0) {
            f32x4 t[4]; float s = 0.f;
#pragma unroll
            for (int j = 0; j < 4; ++j) { t[j] = unpack4(*(const u32x2*)(T1 + (size_t)r * D + 4 * lane + 256 * j)); s += (t[j][0] * t[j][0] + t[j][1] * t[j][1]) + (t[j][2] * t[j][2] + t[j][3] * t[j][3]); }
            const float rstd = rsqrtf(wave_sum(s) * (1.0f / D) + EPS);
            const float* gpost = P.in[KIND == 1 ? 10 : 12] + l * D;
            const float* gt = mp + (KIND == 1 ? 2 : 5) * D;
#pragma unroll
            for (int j = 0; j < 4; ++j) { const f32x4 g = *(const f32x4*)(gpost + 4 * lane + 256 * j), gg = *(const f32x4*)(gt + 4 * lane + 256 * j);
                x[j] = x[j] + gg * (t[j] * rstd * g);
                if (KIND == 2 && l == DEPTH - 1) *(f32x4*)(P.out + (size_t)r * D + 4 * lane + 256 * j) = x[j];
                else *(u32x2*)(XB + (size_t)r * D + 4 * lane + 256 * j) = pack4(x[j]); }
        }
        if (KIND == 2 && l == DEPTH - 1) return;
        const int ln = (KIND == 2) ? l + 1 : l;
        const float* mpn = mod + (size_t)mrow * NMOD + ln * 6144;
        const float* gpre = P.in[KIND == 1 ? 11 : 9] + ln * D;
        const float* sh = mpn + (KIND == 1 ? 3 : 0) * D; const float* sc = mpn + (KIND == 1 ? 4 : 1) * D;
        float s = 0.f;
#pragma unroll
        for (int j = 0; j < 4; ++j) s += (x[j][0] * x[j][0] + x[j][1] * x[j][1]) + (x[j][2] * x[j][2] + x[j][3] * x[j][3]);
        const float rstd = rsqrtf(wave_sum(s) * (1.0f / D) + EPS);
#pragma unroll
        for (int j = 0; j < 4; ++j) { const f32x4 g = *(const f32x4*)(gpre + 4 * lane + 256 * j), a = *(const f32x4*)(sc + 4 * lane + 256 * j), b = *(const f32x4*)(sh + 4 * lane + 256 * j);
            const f32x4 h = (x[j] * rstd * g) * (a + 1.0f) + b;
            *(u32x2*)(HM + (size_t)r * D + 4 * lane + 256 * j) = pack4(h); }
    }
}
__device__ __forceinline__ void rowpass0(const Params& P) {
    int tid_ = threadIdx.x; asm volatile("" : "+v"(tid_)); const int tid = tid_, lane = tid & 63, wave = __builtin_amdgcn_readfirstlane(tid >> 6); (void)tid;
    const int gw = blockIdx.x * NWAVES + wave, NGW = gridDim.x * NWAVES;
    unsigned char* ws = P.ws; const float* mod = (const float*)(ws + WS_MOD);
    bf16_t* HM = (bf16_t*)(ws + WS_HM); bf16_t* XB = (bf16_t*)(ws + WS_XB);
    const float* gpre = P.in[9];
    for (int r0 = gw; r0 < MR; r0 += 4 * NGW) {
        f32x4 x[4][4]; float ss[4];
#pragma unroll
        for (int k = 0; k < 4; ++k) { const int r = r0 + k * NGW < MR ? r0 + k * NGW : r0; const float* xin = r < NP ? P.in[0] + (size_t)r * D : P.in[1] + (size_t)(r - NP) * D;
#pragma unroll
            for (int j = 0; j < 4; ++j) x[k][j] = *(const f32x4*)(xin + 4 * lane + 256 * j); }
#pragma unroll
        for (int k = 0; k < 4; ++k) { float s_ = 0.f;
#pragma unroll
            for (int j = 0; j < 4; ++j) s_ += (x[k][j][0] * x[k][j][0] + x[k][j][1] * x[k][j][1]) + (x[k][j][2] * x[k][j][2] + x[k][j][3] * x[k][j][3]);
            ss[k] = s_; }
#pragma unroll
        for (int o = 1; o < 64; o <<= 1) {
#pragma unroll
            for (int k = 0; k < 4; ++k) ss[k] += __shfl_xor(ss[k], o); }
#pragma unroll
        for (int k = 0; k < 4; ++k) { const int r = r0 + k * NGW; if (r < MR) {
            const int mrow = r < NP ? (r >> 11) : NB + (r - NP); const float* mp = mod + (size_t)mrow * NMOD;
            const float rstd = rsqrtf(ss[k] * (1.0f / D) + EPS);
#pragma unroll
            for (int j = 0; j < 4; ++j) { const f32x4 g = *(const f32x4*)(gpre + 4 * lane + 256 * j), a = *(const f32x4*)(mp + D + 4 * lane + 256 * j), b = *(const f32x4*)(mp + 4 * lane + 256 * j);
                *(u32x2*)(XB + (size_t)r * D + 4 * lane + 256 * j) = pack4(x[k][j]);
                *(u32x2*)(HM + (size_t)r * D + 4 * lane + 256 * j) = pack4((x[k][j] * rstd * g) * (a + 1.0f) + b); } } }
    }
}
template <int KIND>
__device__ __forceinline__ void sample_rowpass(const Params& P, int l, unsigned* cnt) {
    int tid_ = threadIdx.x; asm volatile("" : "+v"(tid_)); const int tid = tid_, lane = tid & 63, wave = __builtin_amdgcn_readfirstlane(tid >> 6);
    if (blockIdx.x < 64 || blockIdx.x >= 80) return;
    if (tid == 0) { unsigned sp = 0; while (__hip_atomic_load(cnt, __ATOMIC_RELAXED, __HIP_MEMORY_SCOPE_AGENT) < 256u) { __builtin_amdgcn_s_sleep(2); if (++sp > (1u << 22)) break; }
        __builtin_amdgcn_fence(__ATOMIC_ACQUIRE, "agent"); asm volatile("s_waitcnt vmcnt(0)" ::: "memory"); }
    __syncthreads();
    rowpass_row<KIND>(P, l, NP + (blockIdx.x - 64) * 8 + wave, lane);
}

struct EpiRmsFused {
    static constexpr bool PERM = true, AFTER_DRAIN = true;
    const Params* Pp; int l, kind;
    __device__ __forceinline__ void fused(f32x4 (&acc)[2][2][4][2], const pg8::Unit& u, int wr, int wc, int fr, int fq, MK_LAS unsigned char* lds, int wid, int lane) const {
        const Params& P = *Pp; unsigned char* ws = P.ws; asm volatile("" : "+s"(ws));
        const int ln = (kind == 2 && l + 1 < DEPTH) ? l + 1 : l; const int write_h = (kind == 2 && l + 1 >= DEPTH) ? 0 : 1; const int inst = 2 * l + (kind - 1);
        const bool final_out = (kind == 2 && l + 1 >= DEPTH);
        bf16_t* XB = (bf16_t*)(ws + WS_XB); float* xout = P.out; bf16_t* hout = (bf16_t*)(ws + WS_HM);
        MK_LAS u32x4* stash = (MK_LAS u32x4*)lds + (wid * 64 + lane);
        const float* gpost = P.in[kind == 1 ? 10 : 12] + l * D; const float* gpre = P.in[kind == 1 ? 11 : 9] + ln * D;
        const float* gt = (const float*)(ws + WS_MOD) + l * 6144 + (kind == 1 ? 2 : 5) * D;
        const float* sc = (const float*)(ws + WS_MOD) + ln * 6144 + (kind == 1 ? 4 : 1) * D; const float* sh = (const float*)(ws + WS_MOD) + ln * 6144 + (kind == 1 ? 3 : 0) * D;
        unsigned long long* xbuf = (unsigned long long*)(ws + WS_X + (size_t)inst * MiB); unsigned* cnt = (unsigned*)(ws + WS_CTL) + CW_PANEL + inst * 4096;
        MK_LAS f32x4* Pt = (MK_LAS f32x4*)(lds + 131072);
        MK_LAS f32x2v* St = (MK_LAS f32x2v*)(lds + 131072 + 16384);
        const int b = u.pm >> 3;
        const int col0 = u.pn * 256 + wc * 32 + 8 * fq;
        {   f32x4 av[2][2];
#pragma unroll
            for (int bj = 0; bj < 2; ++bj)
#pragma unroll
                for (int n = 0; n < 2; ++n) { const int col = col0 + bj * 128 + n * 4; av[bj][n] = *(const f32x4*)(gt + (size_t)b * NMOD + col) * *(const f32x4*)(gpost + col); }
#pragma unroll
            for (int ai = 0; ai < 2; ++ai)
#pragma unroll
                for (int m = 0; m < 4; ++m) { const int rl = ai * 128 + wr * 64 + m * 16 + fr; const size_t xo = (size_t)(u.pm * 256 + rl) * D + col0;
                    float sTT = 0.f, sxa = 0.f, saa = 0.f, sxx = 0.f;
#pragma unroll
                    for (int bj = 0; bj < 2; ++bj) { const u32x4 xp = *(const u32x4*)(XB + xo + bj * 128); stash[((ai * 4 + m) * 2 + bj) * 512] = xp;
#pragma unroll
                        for (int n = 0; n < 2; ++n) { const f32x4 T = acc[ai][bj][m][n], aT = av[bj][n] * T;
                            const f32x4 x = n == 0 ? (f32x4){bflo(xp.x), bfhi(xp.x), bflo(xp.y), bfhi(xp.y)} : (f32x4){bflo(xp.z), bfhi(xp.z), bflo(xp.w), bfhi(xp.w)};
                            sTT += (T[0] * T[0] + T[1] * T[1]) + (T[2] * T[2] + T[3] * T[3]); sxa += (x[0] * aT[0] + x[1] * aT[1]) + (x[2] * aT[2] + x[3] * aT[3]);
                            saa += (aT[0] * aT[0] + aT[1] * aT[1]) + (aT[2] * aT[2] + aT[3] * aT[3]); sxx += (x[0] * x[0] + x[1] * x[1]) + (x[2] * x[2] + x[3] * x[3]);
                            acc[ai][bj][m][n] = aT; } }
                    sTT += __shfl_xor(sTT, 16); sTT += __shfl_xor(sTT, 32); sxa += __shfl_xor(sxa, 16); sxa += __shfl_xor(sxa, 32);
                    saa += __shfl_xor(saa, 16); saa += __shfl_xor(saa, 32); sxx += __shfl_xor(sxx, 16); sxx += __shfl_xor(sxx, 32);
                    if (fq == 0) Pt[rl * 4 + wc] = (f32x4){sTT, sxa, saa, sxx};
                    if (m == 3) asm volatile("" ::: "memory"); }
        }
        asm volatile("s_waitcnt lgkmcnt(0)" ::: "memory"); __builtin_amdgcn_s_barrier(); asm volatile("" ::: "memory");
        const int row = wid * 32 + (lane & 31);
        unsigned long long* slot = xbuf + ((size_t)(u.pm * 256 + row) * 4) * 2;
        if (lane < 32) { const f32x4 p = (Pt[row * 4 + 0] + Pt[row * 4 + 1]) + (Pt[row * 4 + 2] + Pt[row * 4 + 3]);
            __hip_atomic_store(slot + u.pn * 2 + 0, ((unsigned long long)__float_as_uint(p[1]) << 32) | __float_as_uint(p[0]), __ATOMIC_RELAXED, __HIP_MEMORY_SCOPE_AGENT);
            __hip_atomic_store(slot + u.pn * 2 + 1, ((unsigned long long)__float_as_uint(p[3]) << 32) | __float_as_uint(p[2]), __ATOMIC_RELAXED, __HIP_MEMORY_SCOPE_AGENT); }
        asm volatile("s_waitcnt vmcnt(0)" ::: "memory");
        if (lane == 0) __hip_atomic_fetch_add(cnt + 64 * u.pm, 1u, __ATOMIC_RELAXED, __HIP_MEMORY_SCOPE_AGENT);
        if (wid == 0) { unsigned sp = 0;
            while ((unsigned)__builtin_amdgcn_readfirstlane(__hip_atomic_load(cnt + 64 * u.pm, __ATOMIC_RELAXED, __HIP_MEMORY_SCOPE_AGENT)) < 32u) { __builtin_amdgcn_s_sleep(2); if (++sp > (1u << 22)) break; }
            __builtin_amdgcn_fence(__ATOMIC_ACQUIRE, "agent"); }
        asm volatile("s_waitcnt vmcnt(0) lgkmcnt(0)" ::: "memory"); __builtin_amdgcn_s_barrier(); asm volatile("" ::: "memory");
        if (lane < 32) { float TT = 0.f, xa = 0.f, aa = 0.f, xx = 0.f;
#pragma unroll
            for (int t = 0; t < 4; ++t) { const unsigned long long w0 = __hip_atomic_load(slot + t * 2 + 0, __ATOMIC_RELAXED, __HIP_MEMORY_SCOPE_AGENT), w1 = __hip_atomic_load(slot + t * 2 + 1, __ATOMIC_RELAXED, __HIP_MEMORY_SCOPE_AGENT);
                TT += __uint_as_float((unsigned)w0); xa += __uint_as_float((unsigned)(w0 >> 32)); aa += __uint_as_float((unsigned)w1); xx += __uint_as_float((unsigned)(w1 >> 32)); }
            const float rT = rsqrtf(TT * (1.0f / D) + EPS); const float q = xx + rT * ((xa + xa) + rT * aa);
            St[row] = (f32x2v){rT, rsqrtf(fmaxf(q, 0.f) * (1.0f / D) + EPS)}; }
        asm volatile("s_waitcnt lgkmcnt(0)" ::: "memory"); __builtin_amdgcn_s_barrier(); asm volatile("" ::: "memory");
#pragma unroll
        for (int bj = 0; bj < 2; ++bj) { const int col = col0 + bj * 128;
            f32x4 gm0 = (f32x4){0.f, 0.f, 0.f, 0.f}, gm1 = gm0, sv0 = gm0, sv1 = gm0;
            if (write_h) { gm0 = *(const f32x4*)(gpre + col) * (*(const f32x4*)(sc + (size_t)b * NMOD + col) + 1.0f); gm1 = *(const f32x4*)(gpre + col + 4) * (*(const f32x4*)(sc + (size_t)b * NMOD + col + 4) + 1.0f);
                           sv0 = *(const f32x4*)(sh + (size_t)b * NMOD + col); sv1 = *(const f32x4*)(sh + (size_t)b * NMOD + col + 4); }
#pragma unroll
            for (int ai = 0; ai < 2; ++ai)
#pragma unroll
                for (int m = 0; m < 4; ++m) { const int rl = ai * 128 + wr * 64 + m * 16 + fr; const f32x2v sr = St[rl]; const size_t off = (size_t)(u.pm * 256 + rl) * D + col;
                    const u32x4 xp = stash[((ai * 4 + m) * 2 + bj) * 512];
                    const f32x4 x1a = (f32x4){bflo(xp.x), bfhi(xp.x), bflo(xp.y), bfhi(xp.y)} + acc[ai][bj][m][0] * sr.x, x1b = (f32x4){bflo(xp.z), bfhi(xp.z), bflo(xp.w), bfhi(xp.w)} + acc[ai][bj][m][1] * sr.x;
                    if (final_out) { *(f32x4*)(xout + off) = x1a; *(f32x4*)(xout + off + 4) = x1b; }
                    else { u32x4 w; w.x = pg8::cvt_pk_bf16(x1a[0], x1a[1]); w.y = pg8::cvt_pk_bf16(x1a[2], x1a[3]); w.z = pg8::cvt_pk_bf16(x1b[0], x1b[1]); w.w = pg8::cvt_pk_bf16(x1b[2], x1b[3]); *(u32x4*)(XB + off) = w; }
                    if (write_h) { const f32x4 ha = x1a * sr.y * gm0 + sv0, hb = x1b * sr.y * gm1 + sv1;
                        u32x4 w; w.x = pg8::cvt_pk_bf16(ha[0], ha[1]); w.y = pg8::cvt_pk_bf16(ha[2], ha[3]); w.z = pg8::cvt_pk_bf16(hb[0], hb[1]); w.w = pg8::cvt_pk_bf16(hb[2], hb[3]); *(u32x4*)(hout + off) = w; }
                    if (m == 3) asm volatile("" ::: "memory"); } }
    }
};

__device__ __forceinline__ bf16x8 lfrag(const MK_LAS bf16_t* base, int row, int stride, int k0, int fq) { return *(const MK_LAS bf16x8*)(base + row * stride + k0 + fq * 8); }
#define MK_MFMA(b, a, c) __builtin_amdgcn_mfma_f32_16x16x32_bf16((b), (a), (c), 0, 0, 0)

__device__ __forceinline__ void rope8(const bf16_t* src  , int j, float pos, float scale, u32x4& o1, u32x4& o2, float extra  ) {
    const u32x4 w1 = *(const u32x4*)(src + 8 * j), w2 = *(const u32x4*)(src + 32 + 8 * j);
    float a[8], b[8];
#pragma unroll
    for (int q = 0; q < 4; ++q) { a[2 * q] = bflo(w1[q]); a[2 * q + 1] = bfhi(w1[q]); b[2 * q] = bflo(w2[q]); b[2 * q + 1] = bfhi(w2[q]); }
    float r1[8], r2[8]; const float sc = scale * extra;
#pragma unroll
    for (int i = 0; i < 8; ++i) { const double rev = (double)pos * kInvRev[8 * j + i]; const float fr_ = (float)(rev - floor(rev));
        const float sn = __builtin_amdgcn_sinf(fr_), cs = __builtin_amdgcn_cosf(fr_);
        r1[i] = (a[i] * cs - b[i] * sn) * sc; r2[i] = (a[i] * sn + b[i] * cs) * sc; }
#pragma unroll
    for (int q = 0; q < 4; ++q) { o1[q] = pg8::cvt_pk_bf16(r1[2 * q], r1[2 * q + 1]); o2[q] = pg8::cvt_pk_bf16(r2[2 * q], r2[2 * q + 1]); }
}

constexpr int SQ = 72, SV = 136;
constexpr int L_QS = 0, L_KS = L_QS + 128 * SQ * 2, L_VT = L_KS + 128 * SQ * 2, L_PS = L_VT + 128 * SV * 2, L_ST = L_PS + 128 * SV * 2, L_RET_END = L_ST + 128 * SQ * 2;
static_assert(L_RET_END <= 131072, "retention LDS");

__device__ __forceinline__ void load_vt(const bf16_t* PROJ, int row0, int h, MK_LAS bf16_t* Vt, int wave, int lane) {
#pragma unroll
    for (int it = 0; it < 4; ++it) { const int chunk = wave * 2 + (it & 1), m = lane + 64 * (it >> 1);
        const u32x4 w = *(const u32x4*)(PROJ + (size_t)(row0 + m) * LDP + PV + h * 128 + chunk * 8);
#pragma unroll
        for (int q = 0; q < 4; ++q) { Vt[(chunk * 8 + 2 * q) * SV + m] = (bf16_t)(w[q] & 0xffffu); Vt[(chunk * 8 + 2 * q + 1) * SV + m] = (bf16_t)(w[q] >> 16); } }
}

__device__ __forceinline__ void ret_u_item(const Params& P, MK_LAS unsigned char* lds, int item) {
    int tid_ = threadIdx.x; asm volatile("" : "+v"(tid_)); const int tid = tid_, lane = tid & 63, wave = __builtin_amdgcn_readfirstlane(tid >> 6); (void)tid; (void)lane; (void)wave;
    const int h = item & 3, c = (item >> 2) & 15, b = item >> 6;
    const bf16_t* PROJ = (const bf16_t*)(P.ws + WS_PROJ);
    float* UT = (float*)(P.ws + WS_U) + (size_t)((b * 4 + h) * 16 + c) * 8192;
    MK_LAS bf16_t* Kt = (MK_LAS bf16_t*)(lds + L_KS);
    MK_LAS bf16_t* Vt = (MK_LAS bf16_t*)(lds + L_VT);
    const int row0 = b * SEQ + c * 128; const float lg = log2_gamma(h);
    __syncthreads();
    load_vt(PROJ, row0, h, Vt, wave, lane);
    { const int m = tid & 127, j = tid >> 7; u32x4 o1, o2;
      rope8(PROJ + (size_t)(row0 + m) * LDP + PK + h * 64, j, (float)(c * 128 + m), 0.125f, o1, o2, exp2f((float)(127 - m) * lg));
#pragma unroll
      for (int q = 0; q < 4; ++q) { Kt[(8 * j + 2 * q) * SV + m] = (bf16_t)(o1[q] & 0xffffu); Kt[(8 * j + 2 * q + 1) * SV + m] = (bf16_t)(o1[q] >> 16);
                                    Kt[(32 + 8 * j + 2 * q) * SV + m] = (bf16_t)(o2[q] & 0xffffu); Kt[(32 + 8 * j + 2 * q + 1) * SV + m] = (bf16_t)(o2[q] >> 16); } }
    __syncthreads();
    const int fr = lane & 15, fq = lane >> 4, e0 = 16 * wave;
    f32x4 u[4];
#pragma unroll
    for (int j = 0; j < 4; ++j) u[j] = (f32x4){0.f, 0.f, 0.f, 0.f};
#pragma unroll
    for (int ks = 0; ks < 4; ++ks) { const bf16x8 a = lfrag(Vt, e0 + fr, SV, ks * 32, fq);
#pragma unroll
        for (int j = 0; j < 4; ++j) { const bf16x8 bb = lfrag(Kt, 16 * j + fr, SV, ks * 32, fq); u[j] = MK_MFMA(bb, a, u[j]); } }
#pragma unroll
    for (int j = 0; j < 4; ++j) *(f32x4*)(UT + (e0 + fr) * 64 + 16 * j + 4 * fq) = u[j];
}

__device__ __forceinline__ void ret_o_item(const Params& P, MK_LAS unsigned char* lds, int l, int item) {
    int tid_ = threadIdx.x; asm volatile("" : "+v"(tid_)); const int tid = tid_, lane = tid & 63, wave = __builtin_amdgcn_readfirstlane(tid >> 6); (void)tid; (void)lane; (void)wave;
    const int h = item & 3, b = item >> 6, c = item < 256 ? (item >> 2) & 15 : 15 - ((item >> 2) & 15);
    const bf16_t* PROJ = (const bf16_t*)(P.ws + WS_PROJ);
    bf16_t* MIX = (bf16_t*)(P.ws + WS_HM);
    MK_LAS bf16_t* Qs = (MK_LAS bf16_t*)(lds + L_QS); MK_LAS bf16_t* Ks = (MK_LAS bf16_t*)(lds + L_KS); MK_LAS bf16_t* Vt = (MK_LAS bf16_t*)(lds + L_VT);
    MK_LAS bf16_t* Ps = (MK_LAS bf16_t*)(lds + L_PS); MK_LAS bf16_t* St = (MK_LAS bf16_t*)(lds + L_ST);
    const int row0 = b * SEQ + c * 128; const float lg = log2_gamma(h);
    __syncthreads();
    load_vt(PROJ, row0, h, Vt, wave, lane);
    { const int m = tid & 127, j = tid >> 7; u32x4 o1, o2; const float pos = (float)(c * 128 + m);
      rope8(PROJ + (size_t)(row0 + m) * LDP + PQ + h * 64, j, pos, 1.0f, o1, o2, 1.0f);
      *(MK_LAS u32x4*)(Qs + m * SQ + 8 * j) = o1; *(MK_LAS u32x4*)(Qs + m * SQ + 32 + 8 * j) = o2;
      rope8(PROJ + (size_t)(row0 + m) * LDP + PK + h * 64, j, pos, 0.125f, o1, o2, 1.0f);
      *(MK_LAS u32x4*)(Ks + m * SQ + 8 * j) = o1; *(MK_LAS u32x4*)(Ks + m * SQ + 32 + 8 * j) = o2; }
    { const float cd = exp2f(128.0f * lg);
      const float* UTb = (const float*)(P.ws + WS_U) + (size_t)((b * 4 + h) * 16) * 8192;
#pragma unroll 1
      for (int it = 0; it < 2; ++it) { const int idx0 = tid + 1024 * it, idx1 = idx0 + 512;
        f32x4 ua[15], ub[15];
#pragma unroll
        for (int j = 0; j < 15; ++j) { if (j < c) { ua[j] = *(const f32x4*)(UTb + (size_t)j * 8192 + 4 * idx0); ub[j] = *(const f32x4*)(UTb + (size_t)j * 8192 + 4 * idx1); }
                                       else { ua[j] = (f32x4){0.f, 0.f, 0.f, 0.f}; ub[j] = ua[j]; } }
        f32x4 sa = (f32x4){0.f, 0.f, 0.f, 0.f}, sb = sa;
#pragma unroll
        for (int j = 0; j < 15; ++j) { if (j < c) { sa = sa * cd + ua[j]; sb = sb * cd + ub[j]; } }
        *(MK_LAS u32x2*)(St + (idx0 >> 4) * SQ + 4 * (idx0 & 15)) = pack4(sa); *(MK_LAS u32x2*)(St + (idx1 >> 4) * SQ + 4 * (idx1 & 15)) = pack4(sb);
        if (c == 15) { sa = sa * cd + *(const f32x4*)(UTb + (size_t)15 * 8192 + 4 * idx0); sb = sb * cd + *(const f32x4*)(UTb + (size_t)15 * 8192 + 4 * idx1);
            float* o = P.out + O_RETP + (size_t)((l * NB + b) * 4 + h) * 8192;
#pragma unroll
            for (int i = 0; i < 4; ++i) { o[(4 * (idx0 & 15) + i) * 128 + (idx0 >> 4)] = sa[i]; o[(4 * (idx1 & 15) + i) * 128 + (idx1 >> 4)] = sb[i]; } } } }
    __syncthreads();
    const int fr = lane & 15, fq = lane >> 4, n0 = 16 * wave, n = n0 + fr;
    {
        f32x4 sc[8];
#pragma unroll
        for (int j = 0; j < 8; ++j) sc[j] = (f32x4){0.f, 0.f, 0.f, 0.f};
#pragma unroll
        for (int ks = 0; ks < 2; ++ks) { const bf16x8 a = lfrag(Qs, n, SQ, ks * 32, fq);
#pragma unroll
            for (int j = 0; j < 8; ++j) { const bf16x8 bb = lfrag(Ks, 16 * j + fr, SQ, ks * 32, fq); sc[j] = MK_MFMA(bb, a, sc[j]); } }
#pragma unroll
        for (int j = 0; j < 8; ++j) { f32x4 p;
#pragma unroll
            for (int i = 0; i < 4; ++i) { const int dlt = n - (16 * j + 4 * fq + i); p[i] = dlt >= 0 ? sc[j][i] * exp2f((float)dlt * lg) : 0.f; }
            *(MK_LAS u32x2*)(Ps + n * SV + 16 * j + 4 * fq) = pack4(p); }
    }
    __syncthreads();
    f32x4 o1[8], o2[8];
#pragma unroll
    for (int j = 0; j < 8; ++j) { o1[j] = (f32x4){0.f, 0.f, 0.f, 0.f}; o2[j] = (f32x4){0.f, 0.f, 0.f, 0.f}; }
#pragma unroll
    for (int ks = 0; ks < 4; ++ks) { const bf16x8 a = lfrag(Ps, n, SV, ks * 32, fq);
#pragma unroll
        for (int j = 0; j < 8; ++j) { const bf16x8 bb = lfrag(Vt, 16 * j + fr, SV, ks * 32, fq); o1[j] = MK_MFMA(bb, a, o1[j]); } }
#pragma unroll
    for (int ks = 0; ks < 2; ++ks) { const bf16x8 a = lfrag(Qs, n, SQ, ks * 32, fq);
#pragma unroll
        for (int j = 0; j < 8; ++j) { const bf16x8 bb = lfrag(St, 16 * j + fr, SQ, ks * 32, fq); o2[j] = MK_MFMA(bb, a, o2[j]); } }
    const float rd = exp2f((float)(n + 1) * lg);
    float s = 0.f;
#pragma unroll
    for (int j = 0; j < 8; ++j) { o1[j] = o1[j] + o2[j] * rd; s += (o1[j][0] + o1[j][1]) + (o1[j][2] + o1[j][3]); }
    s += __shfl_xor(s, 16); s += __shfl_xor(s, 32);
    const float mean = s * (1.0f / 128.0f); float q = 0.f;
#pragma unroll
    for (int j = 0; j < 8; ++j) { o1[j] = o1[j] - mean; q += (o1[j][0] * o1[j][0] + o1[j][1] * o1[j][1]) + (o1[j][2] * o1[j][2] + o1[j][3] * o1[j][3]); }
    q += __shfl_xor(q, 16); q += __shfl_xor(q, 32);
    const float rstd = rsqrtf(q * (1.0f / 128.0f) + EPS);
    const float* gn = P.in[15] + l * 512 + h * 128;
    const size_t row = (size_t)(row0 + n);
#pragma unroll
    for (int j = 0; j < 8; ++j) { const int e = 16 * j + 4 * fq;
        const f32x4 g = *(const f32x4*)(gn + e); const f32x4 gate = unpack4(*(const u32x2*)(PROJ + row * LDP + PG + h * 128 + e));
        f32x4 o;
#pragma unroll
        for (int i = 0; i < 4; ++i) o[i] = o1[j][i] * rstd * g[i] * siluf_(gate[i]);
        *(u32x2*)(MIX + row * D + h * 128 + e) = pack4(o); }
}

__device__ __forceinline__ void conva_finish(const Params& P, int l, f32x4 acc, size_t row, int lane) {
    bf16_t* MIX = (bf16_t*)(P.ws + WS_HM);
    const float mean = wave_sum((acc[0] + acc[1]) + (acc[2] + acc[3])) * (1.0f / 256.0f);
    const f32x4 d = acc - mean;
    const float var = wave_sum((d[0] * d[0] + d[1] * d[1]) + (d[2] * d[2] + d[3] * d[3])) * (1.0f / 256.0f);
    const float rstd = rsqrtf(var + EPS);
    const f32x4 g = *(const f32x4*)(P.in[18] + l * 256 + 4 * lane), bb = *(const f32x4*)(P.in[19] + l * 256 + 4 * lane);
    f32x4 y = d * rstd * g + bb;
#pragma unroll
    for (int i = 0; i < 4; ++i) y[i] = siluf_(y[i]);
    *(u32x2*)(MIX + row * D + 512 + 4 * lane) = pack4(y);
}

__device__ __forceinline__ void conv_task(const Params& P, int l) {
    int tid_ = threadIdx.x; asm volatile("" : "+v"(tid_)); const int tid = tid_, lane = tid & 63, wave = __builtin_amdgcn_readfirstlane(tid >> 6);
    const int task = blockIdx.x * NWAVES + wave;
    if (task >= NP / 8) return;
    const int b = task >> 8, t0 = (task & 255) * 8;
    const bf16_t* PROJ = (const bf16_t*)(P.ws + WS_PROJ);
    bf16_t* MIX = (bf16_t*)(P.ws + WS_HM);
    const float* cw = P.in[16] + l * 31 * 256 + 4 * lane;
    f32x4 acc[8]; const f32x4 bias = *(const f32x4*)(P.in[17] + l * 256 + 4 * lane);
#pragma unroll
    for (int k = 0; k < 8; ++k) acc[k] = bias;
    {
        const bf16_t* pb = PROJ + (size_t)(b * SEQ) * LDP + 4 * lane;
        f32x4 cur[8], nxt[8], wv[8]; u32x2 rv[8];
#define MK_ROWADDR(r_) ({ const int t_ = t0 - 30 + (r_); const int tc_ = t_ < 0 ? 0 : (t_ > SEQ - 1 ? SEQ - 1 : t_); (size_t)tc_ * LDP; })
#define MK_GLU(dst, v_, r_) do { const float m_ = (t0 - 30 + (r_)) < 0 ? 0.f : 1.f; dst = unpack4(v_) * m_; } while (0)
#pragma unroll
        for (int k = 0; k < 8; ++k) { rv[k] = *(const u32x2*)(pb + MK_ROWADDR(k) + PU); }
#pragma unroll
        for (int k = 0; k < 8; ++k) MK_GLU(cur[k], rv[k], k);
#pragma unroll
        for (int k = 0; k < 8; ++k) { rv[k] = *(const u32x2*)(pb + MK_ROWADDR(8 + k) + PU); }
#pragma unroll
        for (int k = 0; k < 8; ++k) MK_GLU(nxt[k], rv[k], 8 + k);
        if (t0 == SEQ - 8) {
#pragma unroll
            for (int k = 0; k < 8; ++k) *(f32x4*)(P.out + O_CAP + (size_t)((l * NB + b) * 30 + k) * 256 + 4 * lane) = nxt[k]; }
#pragma unroll
        for (int k = 0; k < 8; ++k) wv[k] = *(const f32x4*)(cw + k * 256);
#pragma unroll 1
        for (int jb = 0; jb < 4; ++jb) {
            f32x4 wn[8];
#pragma unroll
            for (int k = 0; k < 8; ++k) { const int r = 8 * jb + 16 + k; rv[k] = *(const u32x2*)(pb + MK_ROWADDR(r) + PU);
                const int jn = 8 * jb + 8 + k; wn[k] = *(const f32x4*)(cw + (jn < 31 ? jn : 30) * 256); if (jn >= 31) wn[k] = (f32x4){0.f, 0.f, 0.f, 0.f}; }
#pragma unroll
            for (int jj = 0; jj < 8; ++jj)
#pragma unroll
                for (int k = 0; k < 8; ++k) acc[k] = acc[k] + wv[jj] * (jj + k < 8 ? cur[(jj + k) & 7] : nxt[(jj + k) & 7]);
#pragma unroll
            for (int k = 0; k < 8; ++k) { cur[k] = nxt[k]; wv[k] = wn[k]; }
#pragma unroll
            for (int k = 0; k < 8; ++k) MK_GLU(nxt[k], rv[k], 8 * jb + 16 + k);
            if (t0 == SEQ - 8) {
#pragma unroll
                for (int k = 0; k < 8; ++k) { const int i = 8 * jb + 8 + k; if (i < 30) *(f32x4*)(P.out + O_CAP + (size_t)((l * NB + b) * 30 + i) * 256 + 4 * lane) = nxt[k]; } }
        }
#undef MK_ROWADDR
#undef MK_GLU
    }
#pragma unroll
    for (int k = 0; k < 8; ++k) conva_finish(P, l, acc[k], (size_t)(b * SEQ + t0 + k), lane);
    const f32x4 w0 = *(const f32x4*)(P.in[20] + l * 768 + 4 * lane), w1 = *(const f32x4*)(P.in[20] + l * 768 + 256 + 4 * lane), w2 = *(const f32x4*)(P.in[20] + l * 768 + 512 + 4 * lane);
    f32x4 zm2 = (f32x4){0.f, 0.f, 0.f, 0.f}, zm1 = zm2;
#pragma unroll
    for (int k = -2; k < 8; ++k) { const int t = t0 + k;
        f32x4 z = (f32x4){0.f, 0.f, 0.f, 0.f};
        if (t >= 0) { const bf16_t* rp = PROJ + (size_t)(b * SEQ + t) * LDP; z = unpack4(*(const u32x2*)(rp + PZ + 4 * lane)); }
        if (k >= 0) { const bf16_t* rp = PROJ + (size_t)(b * SEQ + t) * LDP; const f32x4 cb = unpack4(*(const u32x2*)(rp + PCB + 4 * lane));
            const f32x4 o = cb * (w0 * zm2 + w1 * zm1 + w2 * z);
            *(u32x2*)(MIX + (size_t)(b * SEQ + t) * D + 768 + 4 * lane) = pack4(o);
            if (t >= SEQ - 2) *(f32x4*)(P.out + O_CCP + (size_t)((l * NB + b) * 2 + (t - (SEQ - 2))) * 256 + 4 * lane) = z; }
        zm2 = zm1; zm1 = z; }
}

__device__ __forceinline__ void sample_conv(const Params& P, int l) {
    int tid_ = threadIdx.x; asm volatile("" : "+v"(tid_)); const int tid = tid_, lane = tid & 63, wave = __builtin_amdgcn_readfirstlane(tid >> 6); (void)tid; (void)lane; (void)wave;
    if (wave != 2 || blockIdx.x >= NS) return;
    const int s = blockIdx.x;
    const bf16_t* PROJ = (const bf16_t*)(P.ws + WS_PROJ);
    bf16_t* MIX = (bf16_t*)(P.ws + WS_HM);
    const size_t row = (size_t)(NP + s); const bf16_t* rp = PROJ + row * LDP;
    const f32x4 u = unpack4(*(const u32x2*)(rp + PU + 4 * lane));
    const float* buf = P.in[5] + (size_t)((l * NS + s) * 30) * 256 + 4 * lane; float* nb = P.out + O_CAS + (size_t)((l * NS + s) * 30) * 256 + 4 * lane;
    const float* cw = P.in[16] + l * 31 * 256 + 4 * lane;
    f32x4 acc = *(const f32x4*)(P.in[17] + l * 256 + 4 * lane);
#pragma unroll 15
    for (int j = 0; j < 30; ++j) { const f32x4 x = *(const f32x4*)(buf + j * 256); acc = acc + *(const f32x4*)(cw + j * 256) * x; if (j >= 1) *(f32x4*)(nb + (j - 1) * 256) = x; }
    acc = acc + *(const f32x4*)(cw + 30 * 256) * u; *(f32x4*)(nb + 29 * 256) = u;
    conva_finish(P, l, acc, row, lane);
    const f32x4 w0 = *(const f32x4*)(P.in[20] + l * 768 + 4 * lane), w1 = *(const f32x4*)(P.in[20] + l * 768 + 256 + 4 * lane), w2 = *(const f32x4*)(P.in[20] + l * 768 + 512 + 4 * lane);
    const float* bc = P.in[6] + (size_t)((l * NS + s) * 2) * 256 + 4 * lane; float* nc = P.out + O_CCS + (size_t)((l * NS + s) * 2) * 256 + 4 * lane;
    const f32x4 z0 = *(const f32x4*)bc, z1 = *(const f32x4*)(bc + 256);
    const f32x4 z = unpack4(*(const u32x2*)(rp + PZ + 4 * lane));
    const f32x4 cb = unpack4(*(const u32x2*)(rp + PCB + 4 * lane));
    *(u32x2*)(MIX + row * D + 768 + 4 * lane) = pack4(cb * (w0 * z0 + w1 * z1 + w2 * z));
    *(f32x4*)nc = z1; *(f32x4*)(nc + 256) = z;
}

__device__ __forceinline__ void sample_ret(const Params& P, int l) {
    int tid_ = threadIdx.x; asm volatile("" : "+v"(tid_)); const int tid = tid_, lane = tid & 63, wave = __builtin_amdgcn_readfirstlane(tid >> 6); (void)tid; (void)lane; (void)wave;
    if (wave >= 2) return;
    const int s = (blockIdx.x * 2 + wave) >> 2, h = (blockIdx.x * 2 + wave) & 3;
    const bf16_t* PROJ = (const bf16_t*)(P.ws + WS_PROJ);
    bf16_t* MIX = (bf16_t*)(P.ws + WS_HM);
    const size_t row = (size_t)(NP + s); const bf16_t* rp = PROJ + row * LDP;
    const float lg = log2_gamma(h), gam = exp2f(lg);
    const int i5 = lane & 31;
    const double rev = 16384.0 * kInvRev[i5]; const float fr_ = (float)(rev - floor(rev));
    const float sn = __builtin_amdgcn_sinf(fr_), cs = __builtin_amdgcn_cosf(fr_);
    const float q1 = bf2f(rp[PQ + h * 64 + i5]), q2 = bf2f(rp[PQ + h * 64 + 32 + i5]), k1 = bf2f(rp[PK + h * 64 + i5]), k2 = bf2f(rp[PK + h * 64 + 32 + i5]);
    const float qr = bflo(pg8::cvt_pk_bf16(lane < 32 ? q1 * cs - q2 * sn : q1 * sn + q2 * cs, 0.f));
    const float kr = bflo(pg8::cvt_pk_bf16((lane < 32 ? k1 * cs - k2 * sn : k1 * sn + k2 * cs) * 0.125f, 0.f));
    const int eq = lane & 31, dpar = lane >> 5;
    const f32x4 v = unpack4(*(const u32x2*)(rp + PV + h * 128 + 4 * eq));
    const float* S0 = P.in[4] + (size_t)((l * NS + s) * 4 + h) * 8192 + 4 * eq; float* S1 = P.out + O_RETS + (size_t)((l * NS + s) * 4 + h) * 8192 + 4 * eq;
    f32x4 o = (f32x4){0.f, 0.f, 0.f, 0.f};
#pragma unroll
    for (int it = 0; it < 32; ++it) { const int d = 2 * it + dpar;
        const float qa = __uint_as_float(__builtin_amdgcn_readlane(__float_as_uint(qr), 2 * it)), qb = __uint_as_float(__builtin_amdgcn_readlane(__float_as_uint(qr), 2 * it + 1));
        const float ka = __uint_as_float(__builtin_amdgcn_readlane(__float_as_uint(kr), 2 * it)), kb = __uint_as_float(__builtin_amdgcn_readlane(__float_as_uint(kr), 2 * it + 1));
        const float qd = dpar ? qb : qa, kd = dpar ? kb : ka;
        f32x4 sv = *(const f32x4*)(S0 + d * 128); sv = sv * gam + v * kd; *(f32x4*)(S1 + d * 128) = sv; o = o + sv * qd; }
#pragma unroll
    for (int i = 0; i < 4; ++i) o[i] += __shfl_xor(o[i], 32);
    float sm = (o[0] + o[1]) + (o[2] + o[3]);
#pragma unroll
    for (int x = 1; x < 32; x <<= 1) sm += __shfl_xor(sm, x);
    const float mean = sm * (1.0f / 128.0f); const f32x4 dd = o - mean; float qq = (dd[0] * dd[0] + dd[1] * dd[1]) + (dd[2] * dd[2] + dd[3] * dd[3]);
#pragma unroll
    for (int x = 1; x < 32; x <<= 1) qq += __shfl_xor(qq, x);
    const float rstd = rsqrtf(qq * (1.0f / 128.0f) + EPS);
    if (lane < 32) { const f32x4 g = *(const f32x4*)(P.in[15] + l * 512 + h * 128 + 4 * eq); const f32x4 gate = unpack4(*(const u32x2*)(rp + PG + h * 128 + 4 * eq));
        f32x4 y;
#pragma unroll
        for (int i = 0; i < 4; ++i) y[i] = dd[i] * rstd * g[i] * siluf_(gate[i]);
        *(u32x2*)(MIX + row * D + h * 128 + 4 * eq) = pack4(y); }
}


template <int KS>
__device__ __forceinline__ void skinny_gemm(const bf16_t* A  , const bf16_t* Bt  , bf16_t* O  , unsigned* cnt, MK_LAS unsigned char* lds) {
    int tid_ = threadIdx.x; asm volatile("" : "+v"(tid_)); const int tid = tid_, lane = tid & 63, wave = __builtin_amdgcn_readfirstlane(tid >> 6);
    const int fr = lane & 15, fq = lane >> 4; constexpr int K = KS * 32 * 8;
    for (int it = blockIdx.x; it < 256; it += gridDim.x) {
        const int rb = it & 7, ct = it >> 3;
        const bf16_t* ap = A + (size_t)(NP + 16 * rb + fr) * K + wave * (KS * 32) + 8 * fq;
        const bf16_t* bp = Bt + (size_t)(32 * ct + fr) * K + wave * (KS * 32) + 8 * fq;
        f32x4 acc0 = (f32x4){0.f, 0.f, 0.f, 0.f}, acc1 = acc0;
#pragma unroll
        for (int ks = 0; ks < KS; ++ks) { const bf16x8 a = *(const bf16x8*)(ap + ks * 32), b0 = *(const bf16x8*)(bp + ks * 32), b1 = *(const bf16x8*)(bp + (size_t)16 * K + ks * 32);
            acc0 = MK_MFMA(b0, a, acc0); acc1 = MK_MFMA(b1, a, acc1); }
        MK_LAS f32x4* red = (MK_LAS f32x4*)lds;
        red[(wave * 2 + 0) * 64 + lane] = acc0; red[(wave * 2 + 1) * 64 + lane] = acc1;
        __syncthreads();
        if (wave < 2) { f32x4 sum = red[wave * 64 + lane];
#pragma unroll
            for (int w = 1; w < 8; ++w) sum = sum + red[(w * 2 + wave) * 64 + lane];
            const u32x2 pk = pack4(sum);
            __hip_atomic_store((unsigned long long*)(O + (size_t)(NP + 16 * rb + fr) * D + 32 * ct + 16 * wave + 4 * fq), ((unsigned long long)pk.y << 32) | pk.x, __ATOMIC_RELAXED, __HIP_MEMORY_SCOPE_AGENT);
            asm volatile("s_waitcnt vmcnt(0)" ::: "memory"); }
        __syncthreads();
        if (tid == 0) __hip_atomic_fetch_add(cnt, 1u, __ATOMIC_RELAXED, __HIP_MEMORY_SCOPE_AGENT);
    }
}
__global__ void __launch_bounds__(NTHREADS, 2) mk_fwd(Params P) {
    extern __shared__ __attribute__((aligned(16))) unsigned char lds_raw[];
    MK_LAS unsigned char* lds = (MK_LAS unsigned char*)lds_raw;
    cg::grid_group grid = cg::this_grid();
    if (threadIdx.x < 16) ((MK_LAS unsigned*)(lds + LDS_CTL_OFF))[threadIdx.x] = 0u;
    __syncthreads();
    (void)xcd_barrier_post((unsigned*)(P.ws + WS_CTL), (volatile MK_LAS unsigned*)(lds + LDS_CTL_OFF));
#define GRID_BAR() do { XcdBarrier xb_; xb_.bar = (unsigned*)(P.ws + WS_CTL); xb_.x = xb_xcc_id(); xb_.st = (volatile MK_LAS unsigned*)(lds + LDS_CTL_OFF); xcd_barrier(xb_); } while (0)
    if (P.ws == nullptr) grid.sync();
    const int G = gridDim.x, bx = blockIdx.x;
    unsigned char* ws = P.ws;
    bf16_t* HM = (bf16_t*)(ws + WS_HM); bf16_t* T1 = (bf16_t*)(ws + WS_T1S) - (size_t)NP * D; bf16_t* PROJ = (bf16_t*)(ws + WS_PROJ);

    p0_convert<0>(P, lds, bx, G);
    GRID_BAR();
    { pg8::Gemm g{(const bf16_t*)(ws + WS_AC), (const bf16_t*)(ws + WS_ADAT), 256, NMOD, D}; pg8::StaticOrder S; S.init(256, NMOD, G, bx);
      EpiMod E{(float*)(ws + WS_MOD), P.in[8]};
      pg8::gemm_phase<EpiMod, pg8::StaticOrder, true, true>(lds, g, S, E); }
    if (bx >= 48 && G > 48) p0_convert<1>(P, lds, bx - 48, G - 48);
    GRID_BAR();
    rowpass0(P);
    GRID_BAR();
#pragma unroll 1
    for (int l = 0; l < DEPTH; ++l) {
        for (int rep = 0; rep < REP_WIN; ++rep)
        { pg8::Gemm g{HM, (const bf16_t*)(ws + WS_WIN) + (size_t)l * INW * D, MP, INW, D}; pg8::StaticOrder S; S.init(MP, INW, G, bx);
          EpiProj E{PROJ};
          pg8::gemm_phase<EpiProj, pg8::StaticOrder, true, true>(lds, g, S, E); }
        GRID_BAR();
        for (int rep = 0; rep < REP_MIX; ++rep) {
        if (rep) GRID_BAR();
        sample_ret(P, l); sample_conv(P, l);
        conv_task(P, l);
        for (int it = bx; it < 512; it += G) ret_u_item(P, lds, it);
#ifdef DUP_M1
        GRID_BAR();
        sample_ret(P, l); sample_conv(P, l);
        conv_task(P, l);
        for (int it = bx; it < 512; it += G) ret_u_item(P, lds, it);
#endif
#ifdef DUP_RU
        GRID_BAR();
        for (int it = bx; it < 512; it += G) ret_u_item(P, lds, it);
#endif
#ifdef DUP_CV
        GRID_BAR();
        conv_task(P, l);
#endif
#ifdef DUP_SR
        GRID_BAR();
        sample_ret(P, l); sample_conv(P, l);
#endif
        GRID_BAR();
        for (int it = bx; it < 512; it += G) ret_o_item(P, lds, l, it);
#ifdef DUP_M2
        GRID_BAR();
        for (int it = bx; it < 512; it += G) ret_o_item(P, lds, l, it);
#endif
        }
        GRID_BAR();
        { unsigned* ctl = (unsigned*)(ws + WS_CTL); const int inst = 2 * l;
          skinny_gemm<4>(HM, (const bf16_t*)(ws + WS_WOUT) + (size_t)l * D * D, T1, ctl + CW_SAMPLE + 64 * inst, lds);
          pg8::Gemm g{HM, (const bf16_t*)(ws + WS_WOUT) + (size_t)l * D * D, NP, D, D}; pg8::StaticOrder S; S.init(NP, D, G, bx);
          EpiRmsFused E{&P, l, 1};
          pg8::gemm_phase<EpiRmsFused, pg8::StaticOrder, false, true>(lds, g, S, E);
          sample_rowpass<1>(P, l, ctl + CW_SAMPLE + 64 * inst); }
        GRID_BAR();
#ifndef REP_F1
#define REP_F1 1
#endif
        for (int rep = 0; rep < REP_F1; ++rep)
        { pg8::Gemm g{HM, (const bf16_t*)(ws + WS_W13) + (size_t)l * NFF1 * D, MP, NFF1, D}; pg8::StaticOrder S; S.init(MP, NFF1, G, bx);
          EpiSwiGLU E{PROJ};
          pg8::gemm_phase<EpiSwiGLU, pg8::StaticOrder, true, true>(lds, g, S, E);
          pg8::Unit ud; if (l == 0 && !S.next(5, ud)) { const int first_idle = (MP / 256) * (NFF1 / 256) - 5 * G;
              if (first_idle >= 0 && first_idle < G) p0_convert<2>(P, lds, bx - first_idle, G - first_idle); } }
        GRID_BAR();
        { unsigned* ctl = (unsigned*)(ws + WS_CTL); const int inst = 2 * l + 1;
          skinny_gemm<11>(PROJ, (const bf16_t*)(ws + WS_W2) + (size_t)l * D * DFF, T1, ctl + CW_SAMPLE + 64 * inst, lds);
          pg8::Gemm g{PROJ, (const bf16_t*)(ws + WS_W2) + (size_t)l * D * DFF, NP, D, DFF}; pg8::StaticOrder S; S.init(NP, D, G, bx);
          EpiRmsFused E{&P, l, 2};
          pg8::gemm_phase<EpiRmsFused, pg8::StaticOrder, false, true>(lds, g, S, E);
          sample_rowpass<2>(P, l, ctl + CW_SAMPLE + 64 * inst); }
        if (l + 1 < DEPTH) GRID_BAR();
    }
}
}

extern "C" void kernel_launch(void* const* d_in, const int* in_sizes, int n_in, void* d_out, int out_size, void* d_ws, size_t ws_size, hipStream_t stream) {
    static int grid = 0;
    if (grid == 0) {
        if (n_in != 24 || (size_t)out_size != mk::O_END || ws_size < mk::WS_END) { fprintf(stderr, "kernel_launch: unexpected shapes: n_in %d out %d ws %zu\n", n_in, out_size, ws_size); grid = -1; return; }
        int dev = 0, cus = 0, per_cu = 0;
        hipGetDevice(&dev); hipDeviceGetAttribute(&cus, hipDeviceAttributeMultiprocessorCount, dev);
        hipFuncSetAttribute((const void*)mk::mk_fwd, hipFuncAttributeMaxDynamicSharedMemorySize, mk::LDS_BYTES);
        hipOccupancyMaxActiveBlocksPerMultiprocessor(&per_cu, (const void*)mk::mk_fwd, mk::NTHREADS, mk::LDS_BYTES);
        (void)hipGetLastError();
        if (per_cu < 1) { fprintf(stderr, "kernel_launch: occupancy query says %d blocks per CU\n", per_cu); per_cu = 1; }
        grid = cus;
    }
    if (grid < 0) return;
    if (hipMemsetAsync((char*)d_ws + mk::WS_CTL, 0, mk::CTL_ZERO_BYTES, stream) != hipSuccess) { fprintf(stderr, "kernel_launch: memset failed\n"); return; }
    mk::Params p{};
    for (int i = 0; i < 24; ++i) p.in[i] = (const float*)d_in[i];
    p.out = (float*)d_out; p.ws = (unsigned char*)d_ws;
    void* args[] = {&p};
    hipError_t e = hipLaunchCooperativeKernel((const void*)mk::mk_fwd, dim3(grid), dim3(mk::NTHREADS), args, mk::LDS_BYTES, stream);
    if (e != hipSuccess) fprintf(stderr, "kernel_launch: cooperative launch failed: %s (grid %d)\n", hipGetErrorString(e), grid);
}
```

```cpp
#include <hip/hip_runtime.h>
#include <cstdio>
#include <cstdint>
namespace pg8 {
#define PG8_LAS __attribute__((address_space(3)))
typedef unsigned short bf16_t;
typedef short bf16x8 __attribute__((ext_vector_type(8)));
typedef float f32x4 __attribute__((ext_vector_type(4)));
typedef unsigned u32x4 __attribute__((ext_vector_type(4)));
constexpr int BM = 256, BK = 64, HALF = 128, HTB = HALF * BK * 2  , STAGE_BYTES = 8 * HTB, NXCD = 8, WGM = 8;

__host__ __device__ __forceinline__ int lds_byte(int r, int c) { const int st = (r >> 4) * 2 + (c >> 5), rr = r & 15, cc = c & 31, ob = rr * 64 + cc * 2; return st * 1024 + (ob ^ (((ob >> 9) & 1) << 5)); }
__host__ __device__ __forceinline__ void stage_rc(int b, int& R, int& C) { const int st = b / 1024, sb = b % 1024, swz = sb ^ (((sb >> 9) & 1) << 5); R = (st >> 1) * 16 + swz / 64; C = (st & 1) * 32 + (swz % 64) / 2; }
__host__ __device__ __forceinline__ int perm32(int rho) { const int n = rho >> 4, i = rho & 15; return 8 * (i >> 2) + 4 * n + (i & 3); }

struct Unit { int pm, pn; };
struct Gemm { const bf16_t* A; const bf16_t* Bt; int M, N, K; };

struct StaticOrder {
    int nM, nN, nwg, G, c;
    __host__ __device__ void init(int M, int N, int G_, int c_) { nM = M / BM; nN = N / BM; nwg = nM * nN; G = G_; c = c_; }
    __host__ __device__ bool next(int i, Unit& u) const {
        const long L = (long)i * G + c; if (L >= nwg) return false;
        int wgid = (int)L; { const int q = nwg / NXCD, r = nwg % NXCD, xcd = wgid % NXCD, off = wgid / NXCD; wgid = (xcd < r ? xcd * (q + 1) : r * (q + 1) + (xcd - r) * q) + off; }
        const int nig = WGM * nN, gid = wgid / nig, fm = gid * WGM, gsz = (nM - fm) < WGM ? (nM - fm) : WGM;
        u.pm = fm + ((wgid % nig) % gsz); u.pn = (wgid % nig) / gsz; return true;
    }
    __device__ __forceinline__ void a_ready(const Unit&) const {}
    __device__ __forceinline__ void done(const Unit&) const {}
};

__device__ __forceinline__ unsigned cvt_pk_bf16(float lo, float hi) { unsigned r; asm volatile("v_cvt_pk_bf16_f32 %0, %1, %2" : "=v"(r) : "v"(lo), "v"(hi)); return r; }
typedef float f32x2 __attribute__((ext_vector_type(2)));
__device__ __forceinline__ f32x2 gelu_pk(f32x2 v) {
    const f32x2 av = __builtin_elementwise_abs(v), d = av * 0.2316418882f + 1.0f;
    f32x2 t; t.x = __builtin_amdgcn_rcpf(d.x); t.y = __builtin_amdgcn_rcpf(d.y);
    f32x2 q = t * 0.5307027145f + (-0.7265760135f); q = q * t + 0.7107068705f; q = q * t + (-0.142248368f); q = q * t + 0.127414796f; q = q * t;
    const f32x2 s = (v * v) * (-0.72134752044f);
    f32x2 e; e.x = __builtin_amdgcn_exp2f(s.x); e.y = __builtin_amdgcn_exp2f(s.y);
    const f32x2 m = v * (q * e), r = v - m;
    f32x2 o; o.x = v.x < 0.f ? m.x : r.x; o.y = v.y < 0.f ? m.y : r.y; return o;
}

template <int ACT  > struct EpiBf16 {
    static constexpr bool PERM = true, AFTER_DRAIN = false; static_assert(ACT == 0 || ACT == 1, "EpiBf16: ACT is 0 (none) or 1 (gelu_pk)");
    bf16_t* O; int ldc; const float* bias; int split_cols; size_t split_stride; float scale0;
    __device__ __forceinline__ void operator()(const f32x4 (&acc)[2][2][4][2], const Unit& u, int wr, int wc, int fr, int fq) const {
        const int row0 = u.pm * BM + wr * 64 + fr; int colt = u.pn * BM; bf16_t* base = O;
        float sc = 1.f; if (split_cols) { const int t = colt / split_cols; base += (size_t)t * split_stride; colt -= t * split_cols; if (t == 0) sc = scale0; }
        const int col0 = colt + wc * 32 + 8 * fq, bcol0 = u.pn * BM + wc * 32 + 8 * fq;
        f32x4 bv[2][2];
#pragma unroll
        for (int bj = 0; bj < 2; ++bj)
#pragma unroll
            for (int n = 0; n < 2; ++n) bv[bj][n] = bias ? *(const f32x4*)(bias + bcol0 + bj * HALF + 4 * n) : (f32x4){0.f, 0.f, 0.f, 0.f};
#pragma unroll
        for (int ai = 0; ai < 2; ++ai)
#pragma unroll
            for (int m = 0; m < 4; ++m) { bf16_t* rowp = base + (size_t)(row0 + ai * HALF + m * 16) * ldc + col0;
#pragma unroll
                for (int bj = 0; bj < 2; ++bj) { f32x4 v0 = acc[ai][bj][m][0] + bv[bj][0], v1 = acc[ai][bj][m][1] + bv[bj][1];
                    if (ACT == 1) { f32x2 a = gelu_pk((f32x2){v0[0], v0[1]}), b = gelu_pk((f32x2){v0[2], v0[3]}), c = gelu_pk((f32x2){v1[0], v1[1]}), d = gelu_pk((f32x2){v1[2], v1[3]});
                        v0 = (f32x4){a.x, a.y, b.x, b.y}; v1 = (f32x4){c.x, c.y, d.x, d.y}; }
                    v0 = v0 * sc; v1 = v1 * sc; u32x4 w; w.x = cvt_pk_bf16(v0[0], v0[1]); w.y = cvt_pk_bf16(v0[2], v0[3]); w.z = cvt_pk_bf16(v1[0], v1[1]); w.w = cvt_pk_bf16(v1[2], v1[3]);
                    *(u32x4*)(rowp + bj * HALF) = w; } }
    }
};

struct PanelStats {
    unsigned* xbuf;
    unsigned* cnt;
    unsigned* tmo;
    int ntn; float eps;
    unsigned code;
    __device__ __forceinline__ bool run(const f32x4 (&v)[2][2][4][2], const Unit& u, int wr, int wc, int fr, int fq, PG8_LAS unsigned char* lds, int wid, int lane) const {
        typedef float f32x2v __attribute__((ext_vector_type(2)));
        PG8_LAS f32x2v* P = (PG8_LAS f32x2v*)lds;
        PG8_LAS f32x2v* S = (PG8_LAS f32x2v*)(lds + 8192);
        PG8_LAS unsigned* flag = (PG8_LAS unsigned*)(lds + 8192 + 2048);
#pragma unroll
        for (int ai = 0; ai < 2; ++ai)
#pragma unroll
            for (int m = 0; m < 4; ++m) {
                float s = 0.f;
#pragma unroll
                for (int bj = 0; bj < 2; ++bj)
#pragma unroll
                    for (int n = 0; n < 2; ++n) { const f32x4 x = v[ai][bj][m][n]; s += (x[0] + x[1]) + (x[2] + x[3]); }
                s += __shfl_xor(s, 16); s += __shfl_xor(s, 32);
                const float mw = s * (1.0f / 64.0f); float q = 0.f;
#pragma unroll
                for (int bj = 0; bj < 2; ++bj)
#pragma unroll
                    for (int n = 0; n < 2; ++n) { const f32x4 d = v[ai][bj][m][n] - mw; q += (d[0] * d[0] + d[1] * d[1]) + (d[2] * d[2] + d[3] * d[3]); }
                q += __shfl_xor(q, 16); q += __shfl_xor(q, 32);
                if (fq == 0) P[(ai * HALF + wr * 64 + m * 16 + fr) * 4 + wc] = (f32x2v){mw, q};
            }
        asm volatile("s_waitcnt lgkmcnt(0)" ::: "memory"); __builtin_amdgcn_s_barrier(); asm volatile("" ::: "memory");
#if defined(BROKEN_EXCHANGE_NO_WAIT)
#warning BROKEN CONTROL BUILD: the row-statistics exchange does not wait; results are wrong by design
        if (blockIdx.x >= 64) { const long long t0_ = clock64(); while (clock64() - t0_ < 60000) __builtin_amdgcn_s_sleep(8); }
#endif
        const int row = wid * 32 + (lane & 31);
        if (lane < 32) {
            const f32x2v a = P[row * 4 + 0], b = P[row * 4 + 1], c = P[row * 4 + 2], d = P[row * 4 + 3];
            const float mt = (a.x + b.x + c.x + d.x) * 0.25f;
            const float da = a.x - mt, db = b.x - mt, dc = c.x - mt, dd = d.x - mt;
            const float m2 = (a.y + b.y) + (c.y + d.y) + 64.0f * ((da * da + db * db) + (dc * dc + dd * dd));
            unsigned long long* slot = (unsigned long long*)xbuf + ((size_t)(u.pm * BM + row) * 4 + u.pn);
            __hip_atomic_store(slot, ((unsigned long long)__float_as_uint(m2) << 32) | __float_as_uint(mt), __ATOMIC_RELAXED, __HIP_MEMORY_SCOPE_AGENT);
        }
        asm volatile("s_waitcnt vmcnt(0)" ::: "memory");
        if (lane == 0) __hip_atomic_fetch_add(cnt + 64 * u.pm, 1u, __ATOMIC_RELAXED, __HIP_MEMORY_SCOPE_AGENT);
        if (wid == 0) {
            bool dead = false; const unsigned long long t0 = __builtin_amdgcn_s_memrealtime(); const unsigned want = 8u * (unsigned)ntn;
            for (;;) {
#if defined(BROKEN_EXCHANGE_NO_WAIT)
                break;
#endif
                if ((unsigned)__builtin_amdgcn_readfirstlane(__hip_atomic_load(cnt + 64 * u.pm, __ATOMIC_RELAXED, __HIP_MEMORY_SCOPE_AGENT)) >= want) break;
                if (__builtin_amdgcn_s_memrealtime() - t0 > 2000000ull) {
                    if (lane == 0) { unsigned expect = 0u; __hip_atomic_compare_exchange_strong(tmo + 1, &expect, code | (unsigned)(u.pm & 0xff), __ATOMIC_RELAXED, __ATOMIC_RELAXED, __HIP_MEMORY_SCOPE_AGENT);
                                     __hip_atomic_store(tmo, 1u, __ATOMIC_RELAXED, __HIP_MEMORY_SCOPE_AGENT); }
                    dead = true; break; }
                __builtin_amdgcn_s_sleep(2);
            }
            __builtin_amdgcn_fence(__ATOMIC_ACQUIRE, "agent");
            if (lane == 0) flag[0] = dead ? 1u : 0u;
        }
        asm volatile("s_waitcnt vmcnt(0) lgkmcnt(0)" ::: "memory"); __builtin_amdgcn_s_barrier(); asm volatile("" ::: "memory");
        const bool bad = flag[0] != 0u;
        if (lane < 32) {
            const unsigned long long* slot = (const unsigned long long*)xbuf + (size_t)(u.pm * BM + row) * 4; float mt[4], m2[4]; float ms = 0.f;
#pragma unroll
            for (int t = 0; t < 4; ++t) { if (t < ntn) { const unsigned long long w = __hip_atomic_load(slot + t, __ATOMIC_RELAXED, __HIP_MEMORY_SCOPE_AGENT); mt[t] = __uint_as_float((unsigned)w); m2[t] = __uint_as_float((unsigned)(w >> 32)); } else { mt[t] = 0.f; m2[t] = 0.f; } ms += mt[t]; }
            const float mean = ms / (float)ntn; float q = 0.f;
#pragma unroll
            for (int t = 0; t < 4; ++t) if (t < ntn) { const float dm = mt[t] - mean; q += m2[t] + 256.0f * dm * dm; }
            S[row] = (f32x2v){mean, 1.0f / sqrtf(q / (256.0f * (float)ntn) + eps)};
        }
        asm volatile("s_waitcnt lgkmcnt(0)" ::: "memory"); __builtin_amdgcn_s_barrier(); asm volatile("" ::: "memory");
        return bad;
    }
};
struct EpiLnRes {
    static constexpr bool PERM = false, AFTER_DRAIN = true;
    const float* base; float* out; int ldc; const float* bias; PanelStats st; unsigned poison;
    __device__ __forceinline__ void fused(f32x4 (&acc)[2][2][4][2], const Unit& u, int wr, int wc, int fr, int fq, PG8_LAS unsigned char* lds, int wid, int lane) const {
        typedef float f32x2v __attribute__((ext_vector_type(2)));
        const PG8_LAS f32x2v* S = (const PG8_LAS f32x2v*)(lds + 8192);
        const int col0 = u.pn * BM + wc * 32 + 4 * fq;
#pragma unroll
        for (int bj = 0; bj < 2; ++bj)
#pragma unroll
            for (int n = 0; n < 2; ++n) { const f32x4 bv = bias ? *(const f32x4*)(bias + col0 + bj * HALF + n * 16) : (f32x4){0.f, 0.f, 0.f, 0.f};
#pragma unroll
                for (int ai = 0; ai < 2; ++ai)
#pragma unroll
                    for (int m = 0; m < 4; ++m) acc[ai][bj][m][n] += bv; }
        f32x4 pre[4][2][2];
#pragma unroll
        for (int m = 0; m < 4; ++m) { const size_t off = (size_t)(u.pm * BM + wr * 64 + m * 16 + fr) * ldc + col0;
#pragma unroll
            for (int bj = 0; bj < 2; ++bj)
#pragma unroll
                for (int n = 0; n < 2; ++n) pre[m][bj][n] = *(const f32x4*)(base + off + bj * HALF + n * 16); }
        const bool bad = st.run(acc, u, wr, wc, fr, fq, lds, wid, lane) || poison != 0u;
        const float qnan = __builtin_nanf("");
#pragma unroll
        for (int ai = 0; ai < 2; ++ai)
#pragma unroll
            for (int m = 0; m < 4; ++m) { const int r = ai * HALF + wr * 64 + m * 16 + fr; const f32x2v sr = S[r]; const size_t off = (size_t)(u.pm * BM + r) * ldc + col0;
#pragma unroll
                for (int bj = 0; bj < 2; ++bj)
#pragma unroll
                    for (int n = 0; n < 2; ++n) { const f32x4 bs = ai == 0 ? pre[m][bj][n] : *(const f32x4*)(base + off + bj * HALF + n * 16); f32x4 o = bs + (acc[ai][bj][m][n] - sr.x) * sr.y;
                        if (bad) o = (f32x4){qnan, qnan, qnan, qnan}; *(f32x4*)(out + off + bj * HALF + n * 16) = o; }
                if (m & 1) asm volatile("" ::: "memory"); }
    }
};
struct EpiLnResLn {
    static constexpr bool PERM = false, AFTER_DRAIN = true;
    const float* base; float* out; bf16_t* xn; int ldc; const float* bias; PanelStats st1, st2; unsigned poison;
    __device__ __forceinline__ void fused(f32x4 (&acc)[2][2][4][2], const Unit& u, int wr, int wc, int fr, int fq, PG8_LAS unsigned char* lds, int wid, int lane) const {
        typedef float f32x2v __attribute__((ext_vector_type(2))); typedef unsigned u32x2v __attribute__((ext_vector_type(2)));
        const PG8_LAS f32x2v* S = (const PG8_LAS f32x2v*)(lds + 8192);
        const int col0 = u.pn * BM + wc * 32 + 4 * fq;
#pragma unroll
        for (int bj = 0; bj < 2; ++bj)
#pragma unroll
            for (int n = 0; n < 2; ++n) { const f32x4 bv = bias ? *(const f32x4*)(bias + col0 + bj * HALF + n * 16) : (f32x4){0.f, 0.f, 0.f, 0.f};
#pragma unroll
                for (int ai = 0; ai < 2; ++ai)
#pragma unroll
                    for (int m = 0; m < 4; ++m) acc[ai][bj][m][n] += bv; }
        bool bad = st1.run(acc, u, wr, wc, fr, fq, lds, wid, lane) || poison != 0u;
        const float qnan = __builtin_nanf("");
#pragma unroll
        for (int ai = 0; ai < 2; ++ai)
#pragma unroll
            for (int m = 0; m < 4; ++m) { const int r = ai * HALF + wr * 64 + m * 16 + fr; const f32x2v sr = S[r]; const size_t off = (size_t)(u.pm * BM + r) * ldc + col0;
#pragma unroll
                for (int bj = 0; bj < 2; ++bj)
#pragma unroll
                    for (int n = 0; n < 2; ++n) { const f32x4 bs = *(const f32x4*)(base + off + bj * HALF + n * 16); acc[ai][bj][m][n] = bs + (acc[ai][bj][m][n] - sr.x) * sr.y; }
                asm volatile("" : "+v"(acc[ai][0][m][0]), "+v"(acc[ai][0][m][1]), "+v"(acc[ai][1][m][0]), "+v"(acc[ai][1][m][1]));
                if (m & 1) asm volatile("" ::: "memory"); }
        const bool bad1 = bad;
        bad = st2.run(acc, u, wr, wc, fr, fq, lds, wid, lane) || bad;
#pragma unroll
        for (int ai = 0; ai < 2; ++ai)
#pragma unroll
            for (int m = 0; m < 4; ++m) { const int r = ai * HALF + wr * 64 + m * 16 + fr; const f32x2v sr = S[r]; const size_t off = (size_t)(u.pm * BM + r) * ldc + col0;
#pragma unroll
                for (int bj = 0; bj < 2; ++bj)
#pragma unroll
                    for (int n = 0; n < 2; ++n) { const f32x4 x1 = acc[ai][bj][m][n]; *(f32x4*)(out + off + bj * HALF + n * 16) = bad1 ? (f32x4){qnan, qnan, qnan, qnan} : x1;
                        const f32x4 o = (x1 - sr.x) * sr.y; u32x2v w; w.x = cvt_pk_bf16(o[0], o[1]); w.y = cvt_pk_bf16(o[2], o[3]);
                        if (bad) { w.x = 0x7fc07fc0u; w.y = 0x7fc07fc0u; } *(u32x2v*)(xn + off + bj * HALF + n * 16) = w; }
                asm volatile("" ::: "memory"); }
    }
};

template <class Epi, class Sched, bool ALIGN_EPI = false, bool SP2 = false>
__device__ __forceinline__ void gemm_phase(PG8_LAS unsigned char* lds, const Gemm g, const Sched& S, const Epi& E) {
    int tid_ = threadIdx.x; asm volatile("" : "+v"(tid_));
    const int tid = tid_, wid = __builtin_amdgcn_readfirstlane(tid >> 6), lane = tid & 63, wr = wid >> 2, wc = wid & 3, fr = lane & 15, fq = lane >> 4;
    const int K = g.K, nt = K / BK;
    unsigned voffA[2], voffB[2];
#pragma unroll
    for (int i = 0; i < 2; ++i) { int R, C; stage_rc(tid * 16 + i * 8192, R, C); const int Rb = Epi::PERM ? ((R & ~31) + perm32(R & 31)) : R;
        voffA[i] = (unsigned)(R * K + C) * 2u; voffB[i] = (unsigned)(Rb * K + C) * 2u; }
    const size_t kstep = (size_t)(BK * 2);
    const size_t hstep = (size_t)HALF * K * 2;
    const size_t tstep = 2 * hstep;
    const unsigned ldsw = (unsigned)wid * 1024u;
    const int aoff = lds_byte(wr * 64 + fr, fq * 8), boff = lds_byte(wc * 32 + fr, fq * 8);
#define PG8_SA(b, h) (((b) * 2 + (h)) * HTB)
#define PG8_SB(b, h) ((4 + (b) * 2 + (h)) * HTB)
#define PG8_STAGE(bufoff, gbase, voff) do { _Pragma("unroll") for (int _i = 0; _i < 2; ++_i) \
        __builtin_amdgcn_global_load_lds((const unsigned*)((const char*)(gbase) + (voff)[_i]), (PG8_LAS unsigned*)(lds + (bufoff) + ldsw + _i * 8192), 16, 0, 0); } while (0)
#define PG8_LDA(dst, b, h) do { _Pragma("unroll") for (int m = 0; m < 4; ++m) _Pragma("unroll") for (int k = 0; k < 2; ++k) dst[m][k] = *(const PG8_LAS bf16x8*)(lds + PG8_SA(b, h) + aoff + m * 2048 + k * 1024); } while (0)
#define PG8_LDB(dst, b, h) do { _Pragma("unroll") for (int n = 0; n < 2; ++n) _Pragma("unroll") for (int k = 0; k < 2; ++k) dst[n][k] = *(const PG8_LAS bf16x8*)(lds + PG8_SB(b, h) + boff + n * 2048 + k * 1024); } while (0)
#define PG8_MMA(ai, bj, At, Bt) do { __builtin_amdgcn_s_setprio(1); _Pragma("unroll") for (int m = 0; m < 4; ++m) _Pragma("unroll") for (int n = 0; n < 2; ++n) _Pragma("unroll") for (int k = 0; k < 2; ++k) \
        acc[ai][bj][m][n] = __builtin_amdgcn_mfma_f32_16x16x32_bf16(Bt[n][k], At[m][k], acc[ai][bj][m][n], 0, 0, 0); __builtin_amdgcn_s_setprio(0); } while (0)
#define PG8_WAIT_V(n) asm volatile("s_waitcnt vmcnt(" #n ")" ::: "memory")
#define PG8_WAIT_L(n) asm volatile("s_waitcnt lgkmcnt(" #n ")" ::: "memory")
#define PG8_BAR __builtin_amdgcn_s_barrier()
#define PG8_SCHED __builtin_amdgcn_sched_barrier(0)
    Unit cur, nxt; int ui = 0;
    if (!S.next(0, cur)) return;
    f32x4 acc[2][2][4][2];
#pragma unroll
    for (int a = 0; a < 2; ++a)
#pragma unroll
        for (int b = 0; b < 2; ++b)
#pragma unroll
            for (int m = 0; m < 4; ++m)
#pragma unroll
                for (int n = 0; n < 2; ++n) acc[a][b][m][n] = (f32x4){0.f, 0.f, 0.f, 0.f};
    bf16x8 At[4][2], B0[2][2], B1[2][2];
    const char* cA = (const char*)g.A + (size_t)cur.pm * tstep; const char* cB = (const char*)g.Bt + (size_t)cur.pn * tstep;
    S.a_ready(cur);
    if constexpr (SP2) {
        PG8_STAGE(PG8_SB(0, 0), cB, voffB); PG8_STAGE(PG8_SB(0, 1), cB + hstep, voffB); PG8_STAGE(PG8_SA(0, 0), cA, voffA); PG8_STAGE(PG8_SA(0, 1), cA + hstep, voffA);
        if (wr == 1) PG8_BAR;
        PG8_WAIT_V(2); PG8_BAR;
        PG8_STAGE(PG8_SB(1, 0), cB + kstep, voffB); PG8_STAGE(PG8_SA(1, 0), cA + kstep, voffA); PG8_STAGE(PG8_SB(1, 1), cB + hstep + kstep, voffB);
        PG8_WAIT_V(6); PG8_BAR;
    } else {
        PG8_STAGE(PG8_SB(0, 0), cB, voffB); PG8_STAGE(PG8_SA(0, 0), cA, voffA); PG8_STAGE(PG8_SB(0, 1), cB + hstep, voffB); PG8_STAGE(PG8_SA(0, 1), cA + hstep, voffA);
        if (wr == 1) PG8_BAR;
        PG8_WAIT_V(4); PG8_BAR;
        PG8_STAGE(PG8_SB(1, 0), cB + kstep, voffB); PG8_STAGE(PG8_SA(1, 0), cA + kstep, voffA); PG8_STAGE(PG8_SB(1, 1), cB + hstep + kstep, voffB);
        PG8_WAIT_V(6); PG8_BAR;
    }
    for (;;) {
        const bool has_next = S.next(ui + 1, nxt);
        const char* nA = has_next ? (const char*)g.A + (size_t)nxt.pm * tstep : cA; const char* nB = has_next ? (const char*)g.Bt + (size_t)nxt.pn * tstep : cB;
        for (int t = 0; t < nt; t += 2) {
            const bool last = (t == nt - 2);
            const char* a1 = cA + (size_t)(t + 1) * kstep;
            const char* a2 = last ? nA : cA + (size_t)(t + 2) * kstep; const char* b2 = last ? nB : cB + (size_t)(t + 2) * kstep;
            const char* a3 = a2 + kstep; const char* b3 = b2 + kstep;
            if (last && has_next) S.a_ready(nxt);
            if constexpr (SP2) {
            PG8_LDB(B0, 0, 0); PG8_LDB(B1, 0, 1); PG8_SCHED; PG8_LDA(At, 0, 0); PG8_STAGE(PG8_SA(1, 1), a1 + hstep, voffA);
            PG8_WAIT_V(8); PG8_WAIT_L(0); PG8_BAR; PG8_MMA(0, 0, At, B0); PG8_MMA(0, 1, At, B1); PG8_BAR; PG8_SCHED;
            PG8_LDA(At, 0, 1); PG8_STAGE(PG8_SB(0, 0), b2, voffB); PG8_STAGE(PG8_SB(0, 1), b2 + hstep, voffB); PG8_STAGE(PG8_SA(0, 0), a2, voffA);
            PG8_WAIT_V(8); PG8_WAIT_L(0); PG8_BAR; PG8_MMA(1, 0, At, B0); PG8_MMA(1, 1, At, B1); PG8_BAR; PG8_SCHED;
            PG8_LDB(B0, 1, 0); PG8_LDB(B1, 1, 1); PG8_SCHED; PG8_LDA(At, 1, 0); PG8_STAGE(PG8_SA(0, 1), a2 + hstep, voffA);
            PG8_WAIT_V(8); PG8_WAIT_L(0); PG8_BAR; PG8_MMA(0, 0, At, B0); PG8_MMA(0, 1, At, B1); PG8_BAR; PG8_SCHED;
            PG8_LDA(At, 1, 1); PG8_STAGE(PG8_SB(1, 0), b3, voffB); PG8_STAGE(PG8_SB(1, 1), b3 + hstep, voffB); PG8_STAGE(PG8_SA(1, 0), a3, voffA);
            PG8_WAIT_V(8); PG8_WAIT_L(0); PG8_BAR; PG8_MMA(1, 0, At, B0); PG8_MMA(1, 1, At, B1); PG8_BAR; PG8_SCHED;
            } else {
            PG8_LDB(B0, 0, 0); PG8_SCHED; PG8_LDA(At, 0, 0); PG8_STAGE(PG8_SA(1, 1), a1 + hstep, voffA);
            PG8_WAIT_L(8); PG8_BAR; PG8_WAIT_L(0); PG8_MMA(0, 0, At, B0); PG8_BAR; PG8_SCHED;
            PG8_LDB(B1, 0, 1); PG8_STAGE(PG8_SB(0, 0), b2, voffB);
            PG8_BAR; PG8_WAIT_L(0); PG8_MMA(0, 1, At, B1); PG8_BAR;
            PG8_LDA(At, 0, 1); PG8_STAGE(PG8_SA(0, 0), a2, voffA);
            PG8_BAR; PG8_WAIT_L(0); PG8_MMA(1, 0, At, B0); PG8_BAR; PG8_SCHED;
            PG8_STAGE(PG8_SB(0, 1), b2 + hstep, voffB);
            PG8_WAIT_V(6); PG8_BAR; PG8_MMA(1, 1, At, B1); PG8_BAR;
            PG8_LDB(B0, 1, 0); PG8_SCHED; PG8_LDA(At, 1, 0); PG8_STAGE(PG8_SA(0, 1), a2 + hstep, voffA);
            PG8_WAIT_L(8); PG8_BAR; PG8_WAIT_L(0); PG8_MMA(0, 0, At, B0); PG8_BAR; PG8_SCHED;
            PG8_LDB(B1, 1, 1); PG8_STAGE(PG8_SB(1, 0), b3, voffB);
            PG8_BAR; PG8_WAIT_L(0); PG8_MMA(0, 1, At, B1); PG8_BAR;
            PG8_LDA(At, 1, 1); PG8_STAGE(PG8_SA(1, 0), a3, voffA);
            PG8_BAR; PG8_WAIT_L(0); PG8_MMA(1, 0, At, B0); PG8_BAR; PG8_SCHED;
            PG8_STAGE(PG8_SB(1, 1), b3 + hstep, voffB);
            PG8_WAIT_V(6); PG8_BAR; PG8_MMA(1, 1, At, B1); PG8_BAR;
            }
        }
        if constexpr (ALIGN_EPI) { if (wr == 0) PG8_BAR; }
        if constexpr (!Epi::AFTER_DRAIN) { E(acc, cur, wr, wc, fr, fq); S.done(cur); }
        if (!has_next) break;
#pragma unroll
        for (int a = 0; a < 2; ++a)
#pragma unroll
            for (int b = 0; b < 2; ++b)
#pragma unroll
                for (int m = 0; m < 4; ++m)
#pragma unroll
                    for (int n = 0; n < 2; ++n) acc[a][b][m][n] = (f32x4){0.f, 0.f, 0.f, 0.f};
        cur = nxt; cA = nA; cB = nB; ++ui;
        if constexpr (ALIGN_EPI) { if (wr == 1) PG8_BAR; }
    }
    PG8_WAIT_V(0);
    if constexpr (!ALIGN_EPI) { if (wr == 0) PG8_BAR; }
    PG8_BAR;
    if constexpr (Epi::AFTER_DRAIN) { E.fused(acc, cur, wr, wc, fr, fq, lds, wid, lane); S.done(cur); }
#undef PG8_SA
#undef PG8_SB
#undef PG8_STAGE
#undef PG8_LDA
#undef PG8_LDB
#undef PG8_MMA
#undef PG8_WAIT_V
#undef PG8_WAIT_L
#undef PG8_BAR
#undef PG8_SCHED
}
}

#include <hip/hip_cooperative_groups.h>
namespace cg = cooperative_groups;
namespace mk {
using pg8::bf16_t; using pg8::bf16x8; using pg8::f32x4; using pg8::u32x4;
#define MK_LAS __attribute__((address_space(3)))
typedef unsigned u32x2 __attribute__((ext_vector_type(2)));
typedef float f32x2v __attribute__((ext_vector_type(2)));

#define LAS MK_LAS
#define XB_TMO      128
#define XB_XCNT(j)  (256  + 64 * (j))
#define XB_XSUB(j)  (1280 + 64 * (j))
#define XB_XGEN(j)  (2304 + 64 * (j))
#define XB_TOP      3328
#define XB_TOPGEN   3392
#define XCD_BAR_WORDS 3456
#define XB_SPIN_CAP (1u << 18)

__device__ __forceinline__ unsigned xb_ld(unsigned* p)              { return __hip_atomic_load(p, __ATOMIC_RELAXED, __HIP_MEMORY_SCOPE_AGENT); }
__device__ __forceinline__ unsigned xb_add(unsigned* p, unsigned v) { return __hip_atomic_fetch_add(p, v, __ATOMIC_RELAXED, __HIP_MEMORY_SCOPE_AGENT); }
__device__ __forceinline__ unsigned xb_xcc_id() { return (unsigned)__builtin_amdgcn_s_getreg((3 << 11) | 20) & 0xFu; }
#define XB_SPIN(cond, bar) do { unsigned _sp = 0; while (cond) { __builtin_amdgcn_s_sleep(1); \
    if ((++_sp & 255u) == 0u) { if (xb_ld(&(bar)[XB_TMO])) break; if (_sp > XB_SPIN_CAP) { atomicAdd(&(bar)[XB_TMO], 1u); break; } } } } while (0)

struct XcdBarrier {
    unsigned* bar; unsigned x;
    volatile LAS unsigned* st;
};

__device__ __forceinline__ XcdBarrier xcd_barrier_post(unsigned* bar, volatile LAS unsigned* st) {
    XcdBarrier b; b.bar = bar; b.x = xb_xcc_id(); b.st = st;
    if (threadIdx.x == 0) (void)xb_add(&bar[XB_XCNT(b.x)], 1u);
    return b;
}
__device__ __forceinline__ void xcd_barrier_complete(unsigned* bar, unsigned x, unsigned& nloc, unsigned& nx) {
    const unsigned G = gridDim.x * gridDim.y * gridDim.z;
    unsigned sum, cnt, mine, sp = 0u;
    for (;;) {
        sum = 0u; cnt = 0u; mine = 0u;
#pragma unroll
        for (unsigned j = 0; j < 16; ++j) { const unsigned c = xb_ld(&bar[XB_XCNT(j)]); sum += c; cnt += (c > 0u) ? 1u : 0u; mine = (j == x) ? c : mine; }
        if (sum == G) break;
        __builtin_amdgcn_s_sleep(1);
        if ((++sp & 255u) == 0u) { if (xb_ld(&bar[XB_TMO])) break; if (sp > XB_SPIN_CAP) { atomicAdd(&bar[XB_TMO], 1u); break; } }
    }
    nloc = mine > 0u ? mine : 1u; nx = cnt > 0u ? cnt : 1u;
}

__device__ __forceinline__ void xcd_barrier(const XcdBarrier& b) {
    asm volatile("s_waitcnt vmcnt(0)" ::: "memory");
    __syncthreads();
    if (threadIdx.x == 0) {
        unsigned* bar = b.bar;
        __builtin_amdgcn_s_waitcnt(0);
        unsigned nloc = b.st[0], nx = b.st[1];
        if (nloc == 0u) { xcd_barrier_complete(bar, b.x, nloc, nx); b.st[0] = nloc; b.st[1] = nx; }
        const unsigned old = xb_add(&bar[XB_XSUB(b.x)], 1u);
        const unsigned gen = old / nloc;
        if (old + 1u == (gen + 1u) * nloc) {
            __builtin_amdgcn_fence(__ATOMIC_RELEASE, "agent");
            asm volatile("s_waitcnt vmcnt(0)" ::: "memory");
            const unsigned og = xb_add(&bar[XB_TOP], 1u);
            const unsigned tg = og / nx;
            if (og + 1u == (tg + 1u) * nx) xb_add(&bar[XB_TOPGEN], 1u);
            else XB_SPIN(xb_ld(&bar[XB_TOPGEN]) == tg, bar);
            __builtin_amdgcn_fence(__ATOMIC_ACQUIRE, "agent");
            xb_add(&bar[XB_XGEN(b.x)], 1u);
            asm volatile("s_waitcnt vmcnt(0)" ::: "memory");
        } else {
            XB_SPIN(xb_ld(&bar[XB_XGEN(b.x)]) == gen, bar);
            __builtin_amdgcn_fence(__ATOMIC_ACQUIRE, "agent");
            asm volatile("s_waitcnt vmcnt(0)" ::: "memory");
        }
    }
    __syncthreads();
}

#undef LAS
constexpr int D = 1024, NP = 16384, NS = 128, MR = NP + NS, MP = 16640, SEQ = 2048, NB = 8;
constexpr int INW = 2816, DFF = 2816, NFF1 = 5632, NMOD = 12288, MODROWS = 136, DEPTH = 2;
constexpr float EPS = 1e-6f;
constexpr int NWAVES = 8, NTHREADS = 512;
#ifndef REP_P0
#define REP_P0 1
#endif
#ifndef REP_MIX
#define REP_MIX 1
#endif
#ifndef REP_R0
#define REP_R0 1
#endif
#ifndef REP_WIN
#define REP_WIN 1
#endif
#ifndef REP_F2
#define REP_F2 1
#endif
constexpr int LDS_BYTES = 163840;

constexpr int LDP = 2304, PQ = 0, PK = 256, PV = 512, PG = 1024, PU = 1536, PCB = 1792, PZ = 2048;

constexpr size_t MiB = 1u << 20;
constexpr size_t WS_CTL = 0, CTL_ZERO_BYTES = 98304;
constexpr int LDS_CTL_OFF = 163584;
constexpr int CW_SAMPLE = 3840, CW_PANEL = 4096;
constexpr int CW_SCAN = 3584;
static_assert(XCD_BAR_WORDS <= CW_SCAN && (CW_SCAN + 64) * 4 <= CTL_ZERO_BYTES && (CW_PANEL + 4 * 4096) * 4 <= CTL_ZERO_BYTES, "ctl");
constexpr size_t WS_WIN = 1 * MiB, WS_WOUT = 12 * MiB, WS_W13 = 16 * MiB, WS_W2 = 38 * MiB, WS_MOD = 49 * MiB, WS_HM = 56 * MiB,
                 WS_T1 = 89 * MiB, WS_PROJ = 122 * MiB, WS_U = 212 * MiB, WS_SS = 228 * MiB, WS_X = 236 * MiB, WS_T1S = 240 * MiB, WS_END = 241 * MiB;
constexpr size_t WS_XB = WS_T1;
constexpr size_t WS_ADAT = WS_T1, WS_AC = WS_T1 + 24 * MiB;
static_assert(WS_WIN + (size_t)DEPTH * INW * D * 2 <= WS_WOUT && WS_WOUT + (size_t)DEPTH * D * D * 2 <= WS_W13 && WS_W13 + (size_t)DEPTH * NFF1 * D * 2 <= WS_W2 &&
              WS_W2 + (size_t)DEPTH * D * DFF * 2 <= WS_MOD && WS_MOD + (size_t)MODROWS * NMOD * 4 <= WS_HM && WS_HM + (size_t)MP * D * 2 <= WS_T1 &&
              WS_T1 + (size_t)MP * D * 2 <= WS_PROJ && WS_AC + 256 * D * 2 <= WS_PROJ && WS_PROJ + (size_t)MP * LDP * 2 <= WS_U && WS_U + (size_t)512 * 8192 * 4 <= WS_SS && WS_SS + (size_t)512 * 8192 * 2 <= WS_END, "ws map");

constexpr size_t O_Y = 0, O_YS = (size_t)NP * D, O_RETP = O_YS + (size_t)NS * D, O_CAP = O_RETP + (size_t)DEPTH * NB * 4 * 64 * 128,
                 O_CCP = O_CAP + (size_t)DEPTH * NB * 30 * 256, O_RETS = O_CCP + (size_t)DEPTH * NB * 2 * 256,
                 O_CAS = O_RETS + (size_t)DEPTH * NS * 4 * 64 * 128, O_CCS = O_CAS + (size_t)DEPTH * NS * 30 * 256, O_END = O_CCS + (size_t)DEPTH * NS * 2 * 256;

struct Params { const float* in[24]; float* out; unsigned char* ws; };

__device__ const double kInvRev[32] = {
0.15915494309189535, 0.11934937021124886, 0.08949940160889101, 0.06711508300522726, 0.050329212104487035, 0.03774158471741977, 0.0283021958306234, 0.02122365276477766,
0.015915494309189534, 0.011934937021124886, 0.008949940160889102, 0.006711508300522725, 0.005032921210448704, 0.003774158471741977, 0.00283021958306234, 0.0021223652764777662,
0.0015915494309189536, 0.0011934937021124885, 0.0008949940160889102, 0.0006711508300522726, 0.0005032921210448703, 0.00037741584717419774, 0.00028302195830623395, 0.0002122365276477766,
0.00015915494309189535, 0.00011934937021124886, 8.949940160889102e-05, 6.711508300522725e-05, 5.0329212104487035e-05, 3.774158471741978e-05, 2.8302195830623396e-05, 2.122365276477766e-05};

__device__ __forceinline__ float bf2f(unsigned short b) { return __uint_as_float((unsigned)b << 16); }
__device__ __forceinline__ float bflo(unsigned w) { return __uint_as_float(w << 16); }
__device__ __forceinline__ float bfhi(unsigned w) { return __uint_as_float(w & 0xffff0000u); }
__device__ __forceinline__ f32x4 unpack4(u32x2 w) { return (f32x4){bflo(w.x), bfhi(w.x), bflo(w.y), bfhi(w.y)}; }
__device__ __forceinline__ u32x2 pack4(f32x4 v) { u32x2 w; w.x = pg8::cvt_pk_bf16(v[0], v[1]); w.y = pg8::cvt_pk_bf16(v[2], v[3]); return w; }
__device__ __forceinline__ float sigmoidf_(float x) { return __builtin_amdgcn_rcpf(1.0f + __expf(-x)); }
__device__ __forceinline__ float siluf_(float x) { return x * sigmoidf_(x); }
__device__ __forceinline__ float wave_sum(float v) {
#pragma unroll
    for (int o = 1; o < 64; o <<= 1) v += __shfl_xor(v, o);
    return v;
}
__device__ __forceinline__ float log2_gamma(int h) { return __log2f(1.0f - exp2f(-5.0f - (float)h)); }

struct EpiMod {
    static constexpr bool PERM = false, AFTER_DRAIN = false;
    float* O; const float* bias;
    __device__ __forceinline__ void operator()(const f32x4 (&acc)[2][2][4][2], const pg8::Unit& u, int wr, int wc, int fr, int fq) const {
        const int col0 = u.pn * 256 + wc * 32 + 4 * fq;
        f32x4 bv[2][2];
#pragma unroll
        for (int bj = 0; bj < 2; ++bj)
#pragma unroll
            for (int n = 0; n < 2; ++n) bv[bj][n] = *(const f32x4*)(bias + col0 + bj * 128 + n * 16);
#pragma unroll
        for (int ai = 0; ai < 2; ++ai)
#pragma unroll
            for (int m = 0; m < 4; ++m) { const int row = u.pm * 256 + ai * 128 + wr * 64 + m * 16 + fr;
                if (row < MODROWS) {
#pragma unroll
                    for (int bj = 0; bj < 2; ++bj)
#pragma unroll
                        for (int n = 0; n < 2; ++n) { const int col = col0 + bj * 128 + n * 16; *(f32x4*)(O + (size_t)row * NMOD + col) = acc[ai][bj][m][n] + bv[bj][n]; } } }
    }
};
struct EpiSwiGLU {
    static constexpr bool PERM = true, AFTER_DRAIN = false;
    bf16_t* O;
    __device__ __forceinline__ void operator()(const f32x4 (&acc)[2][2][4][2], const pg8::Unit& u, int wr, int wc, int fr, int fq) const {
        const int col0 = u.pn * 128 + wc * 32 + 8 * fq;
#pragma unroll
        for (int ai = 0; ai < 2; ++ai)
#pragma unroll
            for (int m = 0; m < 4; ++m) { bf16_t* rowp = O + (size_t)(u.pm * 256 + ai * 128 + wr * 64 + m * 16 + fr) * DFF + col0;
                f32x4 a0 = acc[ai][0][m][0], a1 = acc[ai][0][m][1]; const f32x4 b0 = acc[ai][1][m][0], b1 = acc[ai][1][m][1];
#pragma unroll
                for (int i = 0; i < 4; ++i) { a0[i] = siluf_(a0[i]) * b0[i]; a1[i] = siluf_(a1[i]) * b1[i]; }
                u32x4 w; w.x = pg8::cvt_pk_bf16(a0[0], a0[1]); w.y = pg8::cvt_pk_bf16(a0[2], a0[3]); w.z = pg8::cvt_pk_bf16(a1[0], a1[1]); w.w = pg8::cvt_pk_bf16(a1[2], a1[3]);
                *(u32x4*)rowp = w; }
    }
};

struct EpiProj {
    static constexpr bool PERM = true, AFTER_DRAIN = false;
    bf16_t* O;
    __device__ __forceinline__ void operator()(const f32x4 (&acc)[2][2][4][2], const pg8::Unit& u, int wr, int wc, int fr, int fq) const {
        const int pn = u.pn; const int mode = (pn == 6 || pn == 7) ? 1 : (pn >= 9 ? 2 : 0);
        const int cbase = mode == 0 ? (pn == 8 ? PCB : 256 * pn) : (mode == 1 ? PU + 128 * (pn - 6) : PZ + 128 * (pn - 9));
        const int col0 = cbase + wc * 32 + 8 * fq;
#pragma unroll
        for (int ai = 0; ai < 2; ++ai)
#pragma unroll
            for (int m = 0; m < 4; ++m) { bf16_t* rowp = O + (size_t)(u.pm * 256 + ai * 128 + wr * 64 + m * 16 + fr) * LDP + col0;
                if (mode == 0) {
#pragma unroll
                    for (int bj = 0; bj < 2; ++bj) { const f32x4 v0 = acc[ai][bj][m][0], v1 = acc[ai][bj][m][1];
                        u32x4 w; w.x = pg8::cvt_pk_bf16(v0[0], v0[1]); w.y = pg8::cvt_pk_bf16(v0[2], v0[3]); w.z = pg8::cvt_pk_bf16(v1[0], v1[1]); w.w = pg8::cvt_pk_bf16(v1[2], v1[3]);
                        *(u32x4*)(rowp + bj * 128) = w; }
                } else { f32x4 a0 = acc[ai][0][m][0], a1 = acc[ai][0][m][1]; const f32x4 b0 = acc[ai][1][m][0], b1 = acc[ai][1][m][1];
                    if (mode == 1) {
#pragma unroll
                        for (int i = 0; i < 4; ++i) { a0[i] = a0[i] * sigmoidf_(b0[i]); a1[i] = a1[i] * sigmoidf_(b1[i]); } }
                    else { a0 = a0 * b0; a1 = a1 * b1; }
                    u32x4 w; w.x = pg8::cvt_pk_bf16(a0[0], a0[1]); w.y = pg8::cvt_pk_bf16(a0[2], a0[3]); w.z = pg8::cvt_pk_bf16(a1[0], a1[1]); w.w = pg8::cvt_pk_bf16(a1[2], a1[3]);
                    *(u32x4*)rowp = w; } }
    }
};

__device__ __forceinline__ void p0_transpose_item(const float* W, int K, int N, bf16_t* WT, int k0, int n0, int orow, MK_LAS float* scr, int lane) {
    const int cq = lane & 15, r0 = lane >> 4;
    f32x4 v[16];
#pragma unroll
    for (int i = 0; i < 16; ++i) v[i] = *(const f32x4*)(W + (size_t)(k0 + 4 * i + r0) * N + n0 + 4 * cq);
#pragma unroll
    for (int i = 0; i < 16; ++i) { const int r = 4 * i + r0; *(MK_LAS f32x4*)(scr + r * 64 + ((4 * cq) ^ (8 * (r >> 3)))) = v[i]; }
    asm volatile("s_waitcnt lgkmcnt(0)" ::: "memory");
    const int c = lane & 7, nn0 = lane >> 3;
#pragma unroll
    for (int j = 0; j < 8; ++j) { const int nn = nn0 + 8 * j; const MK_LAS float* sp = scr + (8 * c) * 64 + (nn ^ (8 * c));
        u32x4 o; o.x = pg8::cvt_pk_bf16(sp[0 * 64], sp[1 * 64]); o.y = pg8::cvt_pk_bf16(sp[2 * 64], sp[3 * 64]); o.z = pg8::cvt_pk_bf16(sp[4 * 64], sp[5 * 64]); o.w = pg8::cvt_pk_bf16(sp[6 * 64], sp[7 * 64]);
        *(u32x4*)(WT + (size_t)(orow + nn) * K + k0 + 8 * c) = o; }
    asm volatile("s_waitcnt lgkmcnt(0)" ::: "memory");
}
template <int SET>
__device__ __forceinline__ void p0_convert(const Params& P, MK_LAS unsigned char* lds, int rank, int nworkers) {
    int tid_ = threadIdx.x; asm volatile("" : "+v"(tid_)); const int tid = tid_, lane = tid & 63, wave = __builtin_amdgcn_readfirstlane(tid >> 6); (void)tid; (void)lane; (void)wave;
    MK_LAS float* scr = (MK_LAS float*)(lds + wave * 16384);
    const int gw = rank * NWAVES + wave, NGW = nworkers * NWAVES;
    unsigned char* ws = P.ws;
    constexpr int I_IN = 16 * 44, I_OUT = 16 * 16, I_F = 16 * 44, I_2 = 44 * 16, I_ADA = 16 * 96;
    constexpr int PER_L = I_IN + I_OUT + 2 * I_F + I_2;
    if (SET == 0) {
        for (int it = gw; it < DEPTH * I_ADA; it += NGW) { const int l = it / I_ADA, r = it % I_ADA, kb = r / 96, nb = r % 96;
            p0_transpose_item(P.in[7] + (size_t)l * D * 6144, D, 6144, (bf16_t*)(ws + WS_ADAT), 64 * kb, 64 * nb, l * 6144 + 64 * nb, scr, lane); }
        for (int r = gw; r < 256; r += NGW) {
            bf16_t* o = (bf16_t*)(ws + WS_AC) + (size_t)r * D;
            const float* src = r < NB ? P.in[2] + (size_t)r * D : P.in[3] + (size_t)(r - NB) * D;
#pragma unroll
            for (int j = 0; j < 4; ++j) { f32x4 v = (f32x4){0.f, 0.f, 0.f, 0.f};
                if (r < MODROWS) { v = *(const f32x4*)(src + 4 * lane + 256 * j); v[0] = siluf_(v[0]); v[1] = siluf_(v[1]); v[2] = siluf_(v[2]); v[3] = siluf_(v[3]); }
                *(u32x2*)(o + 4 * lane + 256 * j) = pack4(v); }
        }
        return;
    }
    const int l = SET - 1;
    for (int it = gw; it < PER_L; it += NGW) {
        int r = it;
        if (r < I_IN) { const int kb = r / 44, nb = r % 44, n0 = 64 * nb; int orow;
            if (n0 < 1536) orow = n0; else if (n0 < 1792) orow = 256 * (6 + ((n0 - 1536) >> 7)) + ((n0 - 1536) & 127); else if (n0 < 2048) orow = 256 * (6 + ((n0 - 1792) >> 7)) + 128 + ((n0 - 1792) & 127);
            else if (n0 < 2304) orow = 2048 + (n0 - 2048); else if (n0 < 2560) orow = 256 * (9 + ((n0 - 2304) >> 7)) + ((n0 - 2304) & 127); else orow = 256 * (9 + ((n0 - 2560) >> 7)) + 128 + ((n0 - 2560) & 127);
            p0_transpose_item(P.in[13] + (size_t)l * D * INW, D, INW, (bf16_t*)(ws + WS_WIN) + (size_t)l * INW * D, 64 * kb, n0, orow, scr, lane); continue; } r -= I_IN;
        if (r < I_OUT) { const int kb = r / 16, nb = r % 16; p0_transpose_item(P.in[14] + (size_t)l * D * D, D, D, (bf16_t*)(ws + WS_WOUT) + (size_t)l * D * D, 64 * kb, 64 * nb, 64 * nb, scr, lane); continue; } r -= I_OUT;
        if (r < I_F) { const int kb = r / 44, nb = r % 44, n0 = 64 * nb; p0_transpose_item(P.in[21] + (size_t)l * D * DFF, D, DFF, (bf16_t*)(ws + WS_W13) + (size_t)l * NFF1 * D, 64 * kb, n0, 256 * (n0 >> 7) + (n0 & 127), scr, lane); continue; } r -= I_F;
        if (r < I_F) { const int kb = r / 44, nb = r % 44, n0 = 64 * nb; p0_transpose_item(P.in[22] + (size_t)l * D * DFF, D, DFF, (bf16_t*)(ws + WS_W13) + (size_t)l * NFF1 * D, 64 * kb, n0, 256 * (n0 >> 7) + 128 + (n0 & 127), scr, lane); continue; } r -= I_F;
        { const int kb = r / 16, nb = r % 16; p0_transpose_item(P.in[23] + (size_t)l * DFF * D, DFF, D, (bf16_t*)(ws + WS_W2) + (size_t)l * D * DFF, 64 * kb, 64 * nb, 64 * nb, scr, lane); }
    }
}

template <int KIND>
__device__ __forceinline__ void rowpass_row(const Params& P, int l, int r, int lane) {
    unsigned char* ws = P.ws;
    const float* mod = (const float*)(ws + WS_MOD);
    bf16_t* HM = (bf16_t*)(ws + WS_HM); const bf16_t* T1 = (const bf16_t*)(ws + WS_T1S) - (size_t)NP * D;
    bf16_t* XB = (bf16_t*)(ws + WS_XB);
    {
        const int mrow = r < NP ? (r >> 11) : NB + (r - NP);
        const float* mp = mod + (size_t)mrow * NMOD + l * 6144;
        f32x4 x[4];
        if (KIND == 0) { const float* xin = r < NP ? P.in[0] + (size_t)r * D : P.in[1] + (size_t)(r - NP) * D;
#pragma unroll
            for (int j = 0; j < 4; ++j) { x[j] = *(const f32x4*)(xin + 4 * lane + 256 * j); *(u32x2*)(XB + (size_t)r * D + 4 * lane + 256 * j) = pack4(x[j]); } }
        else {
#pragma unroll
            for (int j = 0; j < 4; ++j) x[j] = unpack4(*(const u32x2*)(XB + (size_t)r * D + 4 * lane + 256 * j)); }
        if (KIND != 0) {
            f32x4 t[4]; float s = 0.f;
#pragma unroll
            for (int j = 0; j < 4; ++j) { t[j] = unpack4(*(const u32x2*)(T1 + (size_t)r * D + 4 * lane + 256 * j)); s += (t[j][0] * t[j][0] + t[j][1] * t[j][1]) + (t[j][2] * t[j][2] + t[j][3] * t[j][3]); }
            const float rstd = rsqrtf(wave_sum(s) * (1.0f / D) + EPS);
            const float* gpost = P.in[KIND == 1 ? 10 : 12] + l * D;
            const float* gt = mp + (KIND == 1 ? 2 : 5) * D;
            f32x4 gpv[4], gtv[4];
#pragma unroll
            for (int j = 0; j < 4; ++j) { gpv[j] = *(const f32x4*)(gpost + 4 * lane + 256 * j); gtv[j] = *(const f32x4*)(gt + 4 * lane + 256 * j); }
#pragma unroll
            for (int j = 0; j < 4; ++j) x[j] = x[j] + gtv[j] * (t[j] * rstd * gpv[j]);
        }
        const bool last = (KIND == 2 && l == DEPTH - 1);
        const int ln = (KIND == 2 && !last) ? l + 1 : l;
        const float* mpn = mod + (size_t)mrow * NMOD + ln * 6144;
        const float* gpre = P.in[KIND == 1 ? 11 : 9] + ln * D;
        const float* sh = mpn + (KIND == 1 ? 3 : 0) * D; const float* sc = mpn + (KIND == 1 ? 4 : 1) * D;
        f32x4 g2[4], a2[4], b2[4];
#pragma unroll
        for (int j = 0; j < 4; ++j) { g2[j] = *(const f32x4*)(gpre + 4 * lane + 256 * j); a2[j] = *(const f32x4*)(sc + 4 * lane + 256 * j); b2[j] = *(const f32x4*)(sh + 4 * lane + 256 * j); }
        if (KIND != 0) {
#pragma unroll
            for (int j = 0; j < 4; ++j) {
                if (last) *(f32x4*)(P.out + (size_t)r * D + 4 * lane + 256 * j) = x[j];
                else *(u32x2*)(XB + (size_t)r * D + 4 * lane + 256 * j) = pack4(x[j]); }
        }
        if (last) return;
        float s = 0.f;
#pragma unroll
        for (int j = 0; j < 4; ++j) s += (x[j][0] * x[j][0] + x[j][1] * x[j][1]) + (x[j][2] * x[j][2] + x[j][3] * x[j][3]);
        const float rstd = rsqrtf(wave_sum(s) * (1.0f / D) + EPS);
#pragma unroll
        for (int j = 0; j < 4; ++j) { const f32x4 h = (x[j] * rstd * g2[j]) * (a2[j] + 1.0f) + b2[j];
            *(u32x2*)(HM + (size_t)r * D + 4 * lane + 256 * j) = pack4(h); }
    }
}
__device__ __forceinline__ void rowpass0(const Params& P) {
    int tid_ = threadIdx.x; asm volatile("" : "+v"(tid_)); const int tid = tid_, lane = tid & 63, wave = __builtin_amdgcn_readfirstlane(tid >> 6); (void)tid;
    const int gw = blockIdx.x * NWAVES + wave, NGW = gridDim.x * NWAVES;
    unsigned char* ws = P.ws; const float* mod = (const float*)(ws + WS_MOD);
    bf16_t* HM = (bf16_t*)(ws + WS_HM); bf16_t* XB = (bf16_t*)(ws + WS_XB);
    const float* gpre = P.in[9];
    for (int r0 = gw; r0 < MR; r0 += 4 * NGW) {
        f32x4 x[4][4]; float ss[4];
#pragma unroll
        for (int k = 0; k < 4; ++k) { const int r = r0 + k * NGW < MR ? r0 + k * NGW : r0; const float* xin = r < NP ? P.in[0] + (size_t)r * D : P.in[1] + (size_t)(r - NP) * D;
#pragma unroll
            for (int j = 0; j < 4; ++j) x[k][j] = *(const f32x4*)(xin + 4 * lane + 256 * j); }
#pragma unroll
        for (int k = 0; k < 4; ++k) { float s_ = 0.f;
#pragma unroll
            for (int j = 0; j < 4; ++j) s_ += (x[k][j][0] * x[k][j][0] + x[k][j][1] * x[k][j][1]) + (x[k][j][2] * x[k][j][2] + x[k][j][3] * x[k][j][3]);
            ss[k] = s_; }
#pragma unroll
        for (int o = 1; o < 64; o <<= 1) {
#pragma unroll
            for (int k = 0; k < 4; ++k) ss[k] += __shfl_xor(ss[k], o); }
        f32x4 gv[4];
#pragma unroll
        for (int j = 0; j < 4; ++j) gv[j] = *(const f32x4*)(gpre + 4 * lane + 256 * j);
        f32x4 gm[4][4], bb[4][4];
#pragma unroll
        for (int k = 0; k < 4; ++k) { const int r = r0 + k * NGW < MR ? r0 + k * NGW : r0; const int mrow = r < NP ? (r >> 11) : NB + (r - NP); const float* mp = mod + (size_t)mrow * NMOD;
#pragma unroll
            for (int j = 0; j < 4; ++j) { gm[k][j] = *(const f32x4*)(mp + D + 4 * lane + 256 * j); bb[k][j] = *(const f32x4*)(mp + 4 * lane + 256 * j); } }
#pragma unroll
        for (int k = 0; k < 4; ++k) { const int r = r0 + k * NGW; if (r < MR) {
            const float rstd = rsqrtf(ss[k] * (1.0f / D) + EPS);
#pragma unroll
            for (int j = 0; j < 4; ++j) {
                *(u32x2*)(XB + (size_t)r * D + 4 * lane + 256 * j) = pack4(x[k][j]);
                *(u32x2*)(HM + (size_t)r * D + 4 * lane + 256 * j) = pack4((x[k][j] * rstd * gv[j]) * (gm[k][j] + 1.0f) + bb[k][j]); } } }
    }
}
template <int KIND>
__device__ __forceinline__ void sample_rowpass(const Params& P, int l, unsigned* cnt) {
    int tid_ = threadIdx.x; asm volatile("" : "+v"(tid_)); const int tid = tid_, lane = tid & 63, wave = __builtin_amdgcn_readfirstlane(tid >> 6);
    if (blockIdx.x < 64 || blockIdx.x >= 80) return;
    if (tid == 0) { unsigned sp = 0; while (__hip_atomic_load(cnt, __ATOMIC_RELAXED, __HIP_MEMORY_SCOPE_AGENT) < 256u) { __builtin_amdgcn_s_sleep(2); if (++sp > (1u << 22)) break; }
        __builtin_amdgcn_fence(__ATOMIC_ACQUIRE, "agent"); asm volatile("s_waitcnt vmcnt(0)" ::: "memory"); }
    __syncthreads();
    rowpass_row<KIND>(P, l, NP + (blockIdx.x - 64) * 8 + wave, lane);
}

struct EpiRmsFused {
    static constexpr bool PERM = true, AFTER_DRAIN = true;
    const Params* Pp; int l, kind, dummy;
    __device__ __forceinline__ void fused(f32x4 (&acc)[2][2][4][2], const pg8::Unit& u, int wr, int wc, int fr, int fq, MK_LAS unsigned char* lds, int wid, int lane) const {
        const Params& P = *Pp; unsigned char* ws = P.ws; asm volatile("" : "+s"(ws));
        const int ln = (kind == 2 && l + 1 < DEPTH) ? l + 1 : l; const int write_h = (kind == 2 && l + 1 >= DEPTH) ? 0 : 1; const int inst = 2 * l + (kind - 1);
        const bool final_out = (kind == 2 && l + 1 >= DEPTH);
        bf16_t* XB = (bf16_t*)(ws + WS_XB); float* xout = P.out; bf16_t* hout = (bf16_t*)(ws + WS_HM);
        bf16_t* XBo = (dummy && kind == 1) ? (bf16_t*)(ws + WS_PROJ) : XB; if (dummy && kind == 1) hout = (bf16_t*)(ws + WS_PROJ + 40 * MiB);
        const bool skip_x1 = (dummy && kind == 2);
        MK_LAS u32x4* stash = (MK_LAS u32x4*)lds + (wid * 64 + lane);
        const float* gpost = P.in[kind == 1 ? 10 : 12] + l * D; const float* gpre = P.in[kind == 1 ? 11 : 9] + ln * D;
        const float* gt = (const float*)(ws + WS_MOD) + l * 6144 + (kind == 1 ? 2 : 5) * D;
        const float* sc = (const float*)(ws + WS_MOD) + ln * 6144 + (kind == 1 ? 4 : 1) * D; const float* sh = (const float*)(ws + WS_MOD) + ln * 6144 + (kind == 1 ? 3 : 0) * D;
        unsigned long long* xbuf = (unsigned long long*)(ws + WS_X + (size_t)inst * MiB); unsigned* cnt = (unsigned*)(ws + WS_CTL) + CW_PANEL + inst * 4096;
        MK_LAS f32x4* Pt = (MK_LAS f32x4*)(lds + 131072);
        MK_LAS f32x2v* St = (MK_LAS f32x2v*)(lds + 131072 + 16384);
        const int b = u.pm >> 3;
        const int col0 = u.pn * 256 + wc * 32 + 8 * fq;
        {   f32x4 av[2][2];
#pragma unroll
            for (int bj = 0; bj < 2; ++bj)
#pragma unroll
                for (int n = 0; n < 2; ++n) { const int col = col0 + bj * 128 + n * 4; av[bj][n] = *(const f32x4*)(gt + (size_t)b * NMOD + col) * *(const f32x4*)(gpost + col); }
#pragma unroll
            for (int ai = 0; ai < 2; ++ai)
#pragma unroll
                for (int m = 0; m < 4; ++m) { const int rl = ai * 128 + wr * 64 + m * 16 + fr; const size_t xo = (size_t)(u.pm * 256 + rl) * D + col0;
                    float sTT = 0.f, sxa = 0.f, saa = 0.f, sxx = 0.f;
#pragma unroll
                    for (int bj = 0; bj < 2; ++bj) { const u32x4 xp = *(const u32x4*)(XB + xo + bj * 128); stash[((ai * 4 + m) * 2 + bj) * 512] = xp;
#pragma unroll
                        for (int n = 0; n < 2; ++n) { const f32x4 T = acc[ai][bj][m][n], aT = av[bj][n] * T;
                            const f32x4 x = n == 0 ? (f32x4){bflo(xp.x), bfhi(xp.x), bflo(xp.y), bfhi(xp.y)} : (f32x4){bflo(xp.z), bfhi(xp.z), bflo(xp.w), bfhi(xp.w)};
                            sTT += (T[0] * T[0] + T[1] * T[1]) + (T[2] * T[2] + T[3] * T[3]); sxa += (x[0] * aT[0] + x[1] * aT[1]) + (x[2] * aT[2] + x[3] * aT[3]);
                            saa += (aT[0] * aT[0] + aT[1] * aT[1]) + (aT[2] * aT[2] + aT[3] * aT[3]); sxx += (x[0] * x[0] + x[1] * x[1]) + (x[2] * x[2] + x[3] * x[3]);
                            acc[ai][bj][m][n] = aT; } }
                    sTT += __shfl_xor(sTT, 16); sTT += __shfl_xor(sTT, 32); sxa += __shfl_xor(sxa, 16); sxa += __shfl_xor(sxa, 32);
                    saa += __shfl_xor(saa, 16); saa += __shfl_xor(saa, 32); sxx += __shfl_xor(sxx, 16); sxx += __shfl_xor(sxx, 32);
                    if (fq == 0) Pt[rl * 4 + wc] = (f32x4){sTT, sxa, saa, sxx};
                    if (m == 3) asm volatile("" ::: "memory"); }
        }
        asm volatile("s_waitcnt lgkmcnt(0)" ::: "memory"); __builtin_amdgcn_s_barrier(); asm volatile("" ::: "memory");
        const int row = wid * 32 + (lane & 31);
        unsigned long long* slot = xbuf + ((size_t)(u.pm * 256 + row) * 4) * 2;
        if (lane < 32) { const f32x4 p = (Pt[row * 4 + 0] + Pt[row * 4 + 1]) + (Pt[row * 4 + 2] + Pt[row * 4 + 3]);
            __hip_atomic_store(slot + u.pn * 2 + 0, ((unsigned long long)__float_as_uint(p[1]) << 32) | __float_as_uint(p[0]), __ATOMIC_RELAXED, __HIP_MEMORY_SCOPE_AGENT);
            __hip_atomic_store(slot + u.pn * 2 + 1, ((unsigned long long)__float_as_uint(p[3]) << 32) | __float_as_uint(p[2]), __ATOMIC_RELAXED, __HIP_MEMORY_SCOPE_AGENT); }
        asm volatile("s_waitcnt vmcnt(0)" ::: "memory");
        if (lane == 0) __hip_atomic_fetch_add(cnt + 64 * u.pm, 1u, __ATOMIC_RELAXED, __HIP_MEMORY_SCOPE_AGENT);
        if (wid == 0) { unsigned sp = 0;
            while ((unsigned)__builtin_amdgcn_readfirstlane(__hip_atomic_load(cnt + 64 * u.pm, __ATOMIC_RELAXED, __HIP_MEMORY_SCOPE_AGENT)) < 32u) { __builtin_amdgcn_s_sleep(2); if (++sp > (1u << 22)) break; }
            __builtin_amdgcn_fence(__ATOMIC_ACQUIRE, "agent"); }
        asm volatile("s_waitcnt vmcnt(0) lgkmcnt(0)" ::: "memory"); __builtin_amdgcn_s_barrier(); asm volatile("" ::: "memory");
        if (lane < 32) { float TT = 0.f, xa = 0.f, aa = 0.f, xx = 0.f;
#pragma unroll
            for (int t = 0; t < 4; ++t) { const unsigned long long w0 = __hip_atomic_load(slot + t * 2 + 0, __ATOMIC_RELAXED, __HIP_MEMORY_SCOPE_AGENT), w1 = __hip_atomic_load(slot + t * 2 + 1, __ATOMIC_RELAXED, __HIP_MEMORY_SCOPE_AGENT);
                TT += __uint_as_float((unsigned)w0); xa += __uint_as_float((unsigned)(w0 >> 32)); aa += __uint_as_float((unsigned)w1); xx += __uint_as_float((unsigned)(w1 >> 32)); }
            const float rT = rsqrtf(TT * (1.0f / D) + EPS); const float q = xx + rT * ((xa + xa) + rT * aa);
            St[row] = (f32x2v){rT, rsqrtf(fmaxf(q, 0.f) * (1.0f / D) + EPS)}; }
        asm volatile("s_waitcnt lgkmcnt(0)" ::: "memory"); __builtin_amdgcn_s_barrier(); asm volatile("" ::: "memory");
        f32x4 gmA[2], gmB[2], svA[2], svB[2];
#pragma unroll
        for (int bj = 0; bj < 2; ++bj) { const int col = col0 + bj * 128; gmA[bj] = (f32x4){0.f, 0.f, 0.f, 0.f}; gmB[bj] = gmA[bj]; svA[bj] = gmA[bj]; svB[bj] = gmA[bj];
            if (write_h) { gmA[bj] = *(const f32x4*)(gpre + col) * (*(const f32x4*)(sc + (size_t)b * NMOD + col) + 1.0f); gmB[bj] = *(const f32x4*)(gpre + col + 4) * (*(const f32x4*)(sc + (size_t)b * NMOD + col + 4) + 1.0f);
                           svA[bj] = *(const f32x4*)(sh + (size_t)b * NMOD + col); svB[bj] = *(const f32x4*)(sh + (size_t)b * NMOD + col + 4); } }
#pragma unroll
        for (int bj = 0; bj < 2; ++bj) { const int col = col0 + bj * 128;
            const f32x4 gm0 = gmA[bj], gm1 = gmB[bj], sv0 = svA[bj], sv1 = svB[bj];
#pragma unroll
            for (int ai = 0; ai < 2; ++ai)
#pragma unroll
                for (int m = 0; m < 4; ++m) { const int rl = ai * 128 + wr * 64 + m * 16 + fr; const f32x2v sr = St[rl]; const size_t off = (size_t)(u.pm * 256 + rl) * D + col;
                    const u32x4 xp = stash[((ai * 4 + m) * 2 + bj) * 512];
                    const f32x4 x1a = (f32x4){bflo(xp.x), bfhi(xp.x), bflo(xp.y), bfhi(xp.y)} + acc[ai][bj][m][0] * sr.x, x1b = (f32x4){bflo(xp.z), bfhi(xp.z), bflo(xp.w), bfhi(xp.w)} + acc[ai][bj][m][1] * sr.x;
                    if (skip_x1) {} else if (final_out) { *(f32x4*)(xout + off) = x1a; *(f32x4*)(xout + off + 4) = x1b; }
                    else { u32x4 w; w.x = pg8::cvt_pk_bf16(x1a[0], x1a[1]); w.y = pg8::cvt_pk_bf16(x1a[2], x1a[3]); w.z = pg8::cvt_pk_bf16(x1b[0], x1b[1]); w.w = pg8::cvt_pk_bf16(x1b[2], x1b[3]); *(u32x4*)(XBo + off) = w; }
                    if (write_h) { const f32x4 ha = x1a * sr.y * gm0 + sv0, hb = x1b * sr.y * gm1 + sv1;
                        u32x4 w; w.x = pg8::cvt_pk_bf16(ha[0], ha[1]); w.y = pg8::cvt_pk_bf16(ha[2], ha[3]); w.z = pg8::cvt_pk_bf16(hb[0], hb[1]); w.w = pg8::cvt_pk_bf16(hb[2], hb[3]); *(u32x4*)(hout + off) = w; }
                    if (m == 3) asm volatile("" ::: "memory"); } }
    }
};

__device__ __forceinline__ bf16x8 lfrag(const MK_LAS bf16_t* base, int row, int stride, int k0, int fq) { return *(const MK_LAS bf16x8*)(base + row * stride + k0 + fq * 8); }
#define MK_MFMA(b, a, c) __builtin_amdgcn_mfma_f32_16x16x32_bf16((b), (a), (c), 0, 0, 0)

__device__ __forceinline__ void rope8(const bf16_t* src  , int j, float pos, float scale, u32x4& o1, u32x4& o2, float extra  ) {
    const u32x4 w1 = *(const u32x4*)(src + 8 * j), w2 = *(const u32x4*)(src + 32 + 8 * j);
    float a[8], b[8];
#pragma unroll
    for (int q = 0; q < 4; ++q) { a[2 * q] = bflo(w1[q]); a[2 * q + 1] = bfhi(w1[q]); b[2 * q] = bflo(w2[q]); b[2 * q + 1] = bfhi(w2[q]); }
    float r1[8], r2[8]; const float sc = scale * extra;
#pragma unroll
    for (int i = 0; i < 8; ++i) { const double rev = (double)pos * kInvRev[8 * j + i]; const float fr_ = (float)(rev - floor(rev));
        const float sn = __builtin_amdgcn_sinf(fr_), cs = __builtin_amdgcn_cosf(fr_);
        r1[i] = (a[i] * cs - b[i] * sn) * sc; r2[i] = (a[i] * sn + b[i] * cs) * sc; }
#pragma unroll
    for (int q = 0; q < 4; ++q) { o1[q] = pg8::cvt_pk_bf16(r1[2 * q], r1[2 * q + 1]); o2[q] = pg8::cvt_pk_bf16(r2[2 * q], r2[2 * q + 1]); }
}

constexpr int SQ = 72, SV = 136;
constexpr int L_QS = 0, L_KS = L_QS + 128 * SQ * 2, L_VT = L_KS + 128 * SQ * 2, L_PS = L_VT + 128 * SV * 2, L_ST = L_PS + 128 * SV * 2, L_RET_END = L_ST + 128 * SQ * 2;
static_assert(L_RET_END <= 131072, "retention LDS");

__device__ __forceinline__ void load_vt(const bf16_t* PROJ, int row0, int h, MK_LAS bf16_t* Vt, int wave, int lane) {
#pragma unroll
    for (int it = 0; it < 4; ++it) { const int chunk = wave * 2 + (it & 1), m = lane + 64 * (it >> 1);
        const u32x4 w = *(const u32x4*)(PROJ + (size_t)(row0 + m) * LDP + PV + h * 128 + chunk * 8);
#pragma unroll
        for (int q = 0; q < 4; ++q) { Vt[(chunk * 8 + 2 * q) * SV + m] = (bf16_t)(w[q] & 0xffffu); Vt[(chunk * 8 + 2 * q + 1) * SV + m] = (bf16_t)(w[q] >> 16); } }
}

__device__ __forceinline__ void ret_u_item(const Params& P, MK_LAS unsigned char* lds, int item) {
    int tid_ = threadIdx.x; asm volatile("" : "+v"(tid_)); const int tid = tid_, lane = tid & 63, wave = __builtin_amdgcn_readfirstlane(tid >> 6); (void)tid; (void)lane; (void)wave;
    const int h = item & 3, c = (item >> 2) & 15, b = item >> 6;
    const bf16_t* PROJ = (const bf16_t*)(P.ws + WS_PROJ);
    float* UT = (float*)(P.ws + WS_U) + (size_t)((b * 4 + h) * 16 + c) * 8192;
    MK_LAS bf16_t* Kt = (MK_LAS bf16_t*)(lds + L_KS);
    MK_LAS bf16_t* Vt = (MK_LAS bf16_t*)(lds + L_VT);
    const int row0 = b * SEQ + c * 128; const float lg = log2_gamma(h);
    __syncthreads();
    load_vt(PROJ, row0, h, Vt, wave, lane);
    { const int m = tid & 127, j = tid >> 7; u32x4 o1, o2;
      rope8(PROJ + (size_t)(row0 + m) * LDP + PK + h * 64, j, (float)(c * 128 + m), 0.125f, o1, o2, exp2f((float)(127 - m) * lg));
#pragma unroll
      for (int q = 0; q < 4; ++q) { Kt[(8 * j + 2 * q) * SV + m] = (bf16_t)(o1[q] & 0xffffu); Kt[(8 * j + 2 * q + 1) * SV + m] = (bf16_t)(o1[q] >> 16);
                                    Kt[(32 + 8 * j + 2 * q) * SV + m] = (bf16_t)(o2[q] & 0xffffu); Kt[(32 + 8 * j + 2 * q + 1) * SV + m] = (bf16_t)(o2[q] >> 16); } }
    __syncthreads();
    const int fr = lane & 15, fq = lane >> 4, e0 = 16 * wave;
    f32x4 u[4];
#pragma unroll
    for (int j = 0; j < 4; ++j) u[j] = (f32x4){0.f, 0.f, 0.f, 0.f};
#pragma unroll
    for (int ks = 0; ks < 4; ++ks) { const bf16x8 a = lfrag(Vt, e0 + fr, SV, ks * 32, fq);
#pragma unroll
        for (int j = 0; j < 4; ++j) { const bf16x8 bb = lfrag(Kt, 16 * j + fr, SV, ks * 32, fq); u[j] = MK_MFMA(bb, a, u[j]); } }
#pragma unroll
    for (int j = 0; j < 4; ++j) *(f32x4*)(UT + (e0 + fr) * 64 + 16 * j + 4 * fq) = u[j];
}

__device__ __forceinline__ void ret_o_item(const Params& P, MK_LAS unsigned char* lds, int l, int item) {
    int tid_ = threadIdx.x; asm volatile("" : "+v"(tid_)); const int tid = tid_, lane = tid & 63, wave = __builtin_amdgcn_readfirstlane(tid >> 6); (void)tid; (void)lane; (void)wave;
    const int h = item & 3, b = item >> 6, c = item < 256 ? (item >> 2) & 15 : 15 - ((item >> 2) & 15);
    const bf16_t* PROJ = (const bf16_t*)(P.ws + WS_PROJ);
    bf16_t* MIX = (bf16_t*)(P.ws + WS_HM);
    MK_LAS bf16_t* Qs = (MK_LAS bf16_t*)(lds + L_QS); MK_LAS bf16_t* Ks = (MK_LAS bf16_t*)(lds + L_KS); MK_LAS bf16_t* Vt = (MK_LAS bf16_t*)(lds + L_VT);
    MK_LAS bf16_t* Ps = (MK_LAS bf16_t*)(lds + L_PS); MK_LAS bf16_t* St = (MK_LAS bf16_t*)(lds + L_ST);
    const int row0 = b * SEQ + c * 128; const float lg = log2_gamma(h);
    __syncthreads();
    load_vt(PROJ, row0, h, Vt, wave, lane);
    { const int m = tid & 127, j = tid >> 7; u32x4 o1, o2; const float pos = (float)(c * 128 + m);
      rope8(PROJ + (size_t)(row0 + m) * LDP + PQ + h * 64, j, pos, 1.0f, o1, o2, 1.0f);
      *(MK_LAS u32x4*)(Qs + m * SQ + 8 * j) = o1; *(MK_LAS u32x4*)(Qs + m * SQ + 32 + 8 * j) = o2;
      rope8(PROJ + (size_t)(row0 + m) * LDP + PK + h * 64, j, pos, 0.125f, o1, o2, 1.0f);
      *(MK_LAS u32x4*)(Ks + m * SQ + 8 * j) = o1; *(MK_LAS u32x4*)(Ks + m * SQ + 32 + 8 * j) = o2; }
    { const float cd = exp2f(128.0f * lg);
      const float* UTb = (const float*)(P.ws + WS_U) + (size_t)((b * 4 + h) * 16) * 8192;
#pragma unroll 1
      for (int it = 0; it < 2; ++it) { const int idx0 = tid + 1024 * it, idx1 = idx0 + 512;
        f32x4 ua[15], ub[15];
#pragma unroll
        for (int j = 0; j < 15; ++j) { if (j < c) { ua[j] = *(const f32x4*)(UTb + (size_t)j * 8192 + 4 * idx0); ub[j] = *(const f32x4*)(UTb + (size_t)j * 8192 + 4 * idx1); }
                                       else { ua[j] = (f32x4){0.f, 0.f, 0.f, 0.f}; ub[j] = ua[j]; } }
        f32x4 sa = (f32x4){0.f, 0.f, 0.f, 0.f}, sb = sa;
#pragma unroll
        for (int j = 0; j < 15; ++j) { if (j < c) { sa = sa * cd + ua[j]; sb = sb * cd + ub[j]; } }
        *(MK_LAS u32x2*)(St + (idx0 >> 4) * SQ + 4 * (idx0 & 15)) = pack4(sa); *(MK_LAS u32x2*)(St + (idx1 >> 4) * SQ + 4 * (idx1 & 15)) = pack4(sb);
        if (c == 15) { sa = sa * cd + *(const f32x4*)(UTb + (size_t)15 * 8192 + 4 * idx0); sb = sb * cd + *(const f32x4*)(UTb + (size_t)15 * 8192 + 4 * idx1);
            float* o = P.out + O_RETP + (size_t)((l * NB + b) * 4 + h) * 8192;
#pragma unroll
            for (int i = 0; i < 4; ++i) { o[(4 * (idx0 & 15) + i) * 128 + (idx0 >> 4)] = sa[i]; o[(4 * (idx1 & 15) + i) * 128 + (idx1 >> 4)] = sb[i]; } } } }
    __syncthreads();
    const int fr = lane & 15, fq = lane >> 4, n0 = 16 * wave, n = n0 + fr;
    {
        f32x4 sc[8];
#pragma unroll
        for (int j = 0; j < 8; ++j) sc[j] = (f32x4){0.f, 0.f, 0.f, 0.f};
#pragma unroll
        for (int ks = 0; ks < 2; ++ks) { const bf16x8 a = lfrag(Qs, n, SQ, ks * 32, fq);
#pragma unroll
            for (int j = 0; j < 8; ++j) { const bf16x8 bb = lfrag(Ks, 16 * j + fr, SQ, ks * 32, fq); sc[j] = MK_MFMA(bb, a, sc[j]); } }
#pragma unroll
        for (int j = 0; j < 8; ++j) { f32x4 p;
#pragma unroll
            for (int i = 0; i < 4; ++i) { const int dlt = n - (16 * j + 4 * fq + i); p[i] = dlt >= 0 ? sc[j][i] * exp2f((float)dlt * lg) : 0.f; }
            *(MK_LAS u32x2*)(Ps + n * SV + 16 * j + 4 * fq) = pack4(p); }
    }
    __syncthreads();
    f32x4 o1[8], o2[8];
#pragma unroll
    for (int j = 0; j < 8; ++j) { o1[j] = (f32x4){0.f, 0.f, 0.f, 0.f}; o2[j] = (f32x4){0.f, 0.f, 0.f, 0.f}; }
#pragma unroll
    for (int ks = 0; ks < 4; ++ks) { const bf16x8 a = lfrag(Ps, n, SV, ks * 32, fq);
#pragma unroll
        for (int j = 0; j < 8; ++j) { const bf16x8 bb = lfrag(Vt, 16 * j + fr, SV, ks * 32, fq); o1[j] = MK_MFMA(bb, a, o1[j]); } }
#pragma unroll
    for (int ks = 0; ks < 2; ++ks) { const bf16x8 a = lfrag(Qs, n, SQ, ks * 32, fq);
#pragma unroll
        for (int j = 0; j < 8; ++j) { const bf16x8 bb = lfrag(St, 16 * j + fr, SQ, ks * 32, fq); o2[j] = MK_MFMA(bb, a, o2[j]); } }
    const float rd = exp2f((float)(n + 1) * lg);
    float s = 0.f;
#pragma unroll
    for (int j = 0; j < 8; ++j) { o1[j] = o1[j] + o2[j] * rd; s += (o1[j][0] + o1[j][1]) + (o1[j][2] + o1[j][3]); }
    s += __shfl_xor(s, 16); s += __shfl_xor(s, 32);
    const float mean = s * (1.0f / 128.0f); float q = 0.f;
#pragma unroll
    for (int j = 0; j < 8; ++j) { o1[j] = o1[j] - mean; q += (o1[j][0] * o1[j][0] + o1[j][1] * o1[j][1]) + (o1[j][2] * o1[j][2] + o1[j][3] * o1[j][3]); }
    q += __shfl_xor(q, 16); q += __shfl_xor(q, 32);
    const float rstd = rsqrtf(q * (1.0f / 128.0f) + EPS);
    const float* gn = P.in[15] + l * 512 + h * 128;
    const size_t row = (size_t)(row0 + n);
    asm volatile("" ::: "memory");
    f32x4 gv[8]; u32x2 gtr[8];
#pragma unroll
    for (int j = 0; j < 8; ++j) { const int e = 16 * j + 4 * fq; gv[j] = *(const f32x4*)(gn + e); gtr[j] = *(const u32x2*)(PROJ + row * LDP + PG + h * 128 + e); }
#pragma unroll
    for (int j = 0; j < 8; ++j) { const int e = 16 * j + 4 * fq;
        const f32x4 g = gv[j]; const f32x4 gate = unpack4(gtr[j]);
        f32x4 o;
#pragma unroll
        for (int i = 0; i < 4; ++i) o[i] = o1[j][i] * rstd * g[i] * siluf_(gate[i]);
        *(u32x2*)(MIX + row * D + h * 128 + e) = pack4(o); }
}

__device__ __forceinline__ void conva_finish(const Params& P, f32x4 g, f32x4 bb, f32x4 acc, size_t row, int lane) {
    bf16_t* MIX = (bf16_t*)(P.ws + WS_HM);
    const float mean = wave_sum((acc[0] + acc[1]) + (acc[2] + acc[3])) * (1.0f / 256.0f);
    const f32x4 d = acc - mean;
    const float var = wave_sum((d[0] * d[0] + d[1] * d[1]) + (d[2] * d[2] + d[3] * d[3])) * (1.0f / 256.0f);
    const float rstd = rsqrtf(var + EPS);
    f32x4 y = d * rstd * g + bb;
#pragma unroll
    for (int i = 0; i < 4; ++i) y[i] = siluf_(y[i]);
    *(u32x2*)(MIX + row * D + 512 + 4 * lane) = pack4(y);
}

__device__ __forceinline__ void conv_task(const Params& P, int l) {
    int tid_ = threadIdx.x; asm volatile("" : "+v"(tid_)); const int tid = tid_, lane = tid & 63, wave = __builtin_amdgcn_readfirstlane(tid >> 6);
    const int task = blockIdx.x * NWAVES + wave;
    if (task >= NP / 8) return;
    const int b = task >> 8, t0 = (task & 255) * 8;
    const bf16_t* PROJ = (const bf16_t*)(P.ws + WS_PROJ);
    bf16_t* MIX = (bf16_t*)(P.ws + WS_HM);
    const float* cw = P.in[16] + l * 31 * 256 + 4 * lane;
    f32x4 acc[8]; const f32x4 bias = *(const f32x4*)(P.in[17] + l * 256 + 4 * lane);
#pragma unroll
    for (int k = 0; k < 8; ++k) acc[k] = bias;
    {
        const bf16_t* pb = PROJ + (size_t)(b * SEQ) * LDP + 4 * lane;
        f32x4 cur[8], nxt[8], wv[8]; u32x2 rv[8];
#define MK_ROWADDR(r_) ({ const int t_ = t0 - 30 + (r_); const int tc_ = t_ < 0 ? 0 : (t_ > SEQ - 1 ? SEQ - 1 : t_); (size_t)tc_ * LDP; })
#define MK_GLU(dst, v_, r_) do { const float m_ = (t0 - 30 + (r_)) < 0 ? 0.f : 1.f; dst = unpack4(v_) * m_; } while (0)
#pragma unroll
        for (int k = 0; k < 8; ++k) { rv[k] = *(const u32x2*)(pb + MK_ROWADDR(k) + PU); }
#pragma unroll
        for (int k = 0; k < 8; ++k) MK_GLU(cur[k], rv[k], k);
#pragma unroll
        for (int k = 0; k < 8; ++k) { rv[k] = *(const u32x2*)(pb + MK_ROWADDR(8 + k) + PU); }
#pragma unroll
        for (int k = 0; k < 8; ++k) MK_GLU(nxt[k], rv[k], 8 + k);
        if (t0 == SEQ - 8) {
#pragma unroll
            for (int k = 0; k < 8; ++k) *(f32x4*)(P.out + O_CAP + (size_t)((l * NB + b) * 30 + k) * 256 + 4 * lane) = nxt[k]; }
#pragma unroll
        for (int k = 0; k < 8; ++k) wv[k] = *(const f32x4*)(cw + k * 256);
#pragma unroll 1
        for (int jb = 0; jb < 4; ++jb) {
            f32x4 wn[8];
#pragma unroll
            for (int k = 0; k < 8; ++k) { const int r = 8 * jb + 16 + k; rv[k] = *(const u32x2*)(pb + MK_ROWADDR(r) + PU);
                const int jn = 8 * jb + 8 + k; wn[k] = *(const f32x4*)(cw + (jn < 31 ? jn : 30) * 256); if (jn >= 31) wn[k] = (f32x4){0.f, 0.f, 0.f, 0.f}; }
#pragma unroll
            for (int jj = 0; jj < 8; ++jj)
#pragma unroll
                for (int k = 0; k < 8; ++k) acc[k] = acc[k] + wv[jj] * (jj + k < 8 ? cur[(jj + k) & 7] : nxt[(jj + k) & 7]);
#pragma unroll
            for (int k = 0; k < 8; ++k) { cur[k] = nxt[k]; wv[k] = wn[k]; }
#pragma unroll
            for (int k = 0; k < 8; ++k) MK_GLU(nxt[k], rv[k], 8 * jb + 16 + k);
            if (t0 == SEQ - 8) {
#pragma unroll
                for (int k = 0; k < 8; ++k) { const int i = 8 * jb + 8 + k; if (i < 30) *(f32x4*)(P.out + O_CAP + (size_t)((l * NB + b) * 30 + i) * 256 + 4 * lane) = nxt[k]; } }
        }
#undef MK_ROWADDR
#undef MK_GLU
    }
    const f32x4 lng = *(const f32x4*)(P.in[18] + l * 256 + 4 * lane), lnb = *(const f32x4*)(P.in[19] + l * 256 + 4 * lane);
    u32x2 zr[10], cbr[8];
#pragma unroll
    for (int k = -2; k < 8; ++k) { const int t = t0 + k, tc = t < 0 ? 0 : t; zr[k + 2] = *(const u32x2*)(PROJ + (size_t)(b * SEQ + tc) * LDP + PZ + 4 * lane); }
#pragma unroll
    for (int k = 0; k < 8; ++k) cbr[k] = *(const u32x2*)(PROJ + (size_t)(b * SEQ + t0 + k) * LDP + PCB + 4 * lane);
    const f32x4 w0 = *(const f32x4*)(P.in[20] + l * 768 + 4 * lane), w1 = *(const f32x4*)(P.in[20] + l * 768 + 256 + 4 * lane), w2 = *(const f32x4*)(P.in[20] + l * 768 + 512 + 4 * lane);
#pragma unroll
    for (int k = 0; k < 8; ++k) conva_finish(P, lng, lnb, acc[k], (size_t)(b * SEQ + t0 + k), lane);
    f32x4 zm2 = (f32x4){0.f, 0.f, 0.f, 0.f}, zm1 = zm2;
#pragma unroll
    for (int k = -2; k < 8; ++k) { const int t = t0 + k;
        const f32x4 z = unpack4(zr[k + 2]) * (t < 0 ? 0.f : 1.f);
        if (k >= 0) { const f32x4 o = unpack4(cbr[k]) * (w0 * zm2 + w1 * zm1 + w2 * z);
            *(u32x2*)(MIX + (size_t)(b * SEQ + t) * D + 768 + 4 * lane) = pack4(o);
            if (t >= SEQ - 2) *(f32x4*)(P.out + O_CCP + (size_t)((l * NB + b) * 2 + (t - (SEQ - 2))) * 256 + 4 * lane) = z; }
        zm2 = zm1; zm1 = z; }
}

__device__ __forceinline__ void sample_conv(const Params& P, int l) {
    int tid_ = threadIdx.x; asm volatile("" : "+v"(tid_)); const int tid = tid_, lane = tid & 63, wave = __builtin_amdgcn_readfirstlane(tid >> 6); (void)tid; (void)lane; (void)wave;
    if (wave != 2 || blockIdx.x >= NS) return;
    const int s = blockIdx.x;
    const bf16_t* PROJ = (const bf16_t*)(P.ws + WS_PROJ);
    bf16_t* MIX = (bf16_t*)(P.ws + WS_HM);
    const size_t row = (size_t)(NP + s); const bf16_t* rp = PROJ + row * LDP;
    const f32x4 u = unpack4(*(const u32x2*)(rp + PU + 4 * lane));
    const float* buf = P.in[5] + (size_t)((l * NS + s) * 30) * 256 + 4 * lane; float* nb = P.out + O_CAS + (size_t)((l * NS + s) * 30) * 256 + 4 * lane;
    const float* cw = P.in[16] + l * 31 * 256 + 4 * lane;
    const f32x4 lng = *(const f32x4*)(P.in[18] + l * 256 + 4 * lane), lnb = *(const f32x4*)(P.in[19] + l * 256 + 4 * lane);
    const f32x4 w0 = *(const f32x4*)(P.in[20] + l * 768 + 4 * lane), w1 = *(const f32x4*)(P.in[20] + l * 768 + 256 + 4 * lane), w2 = *(const f32x4*)(P.in[20] + l * 768 + 512 + 4 * lane);
    const float* bc = P.in[6] + (size_t)((l * NS + s) * 2) * 256 + 4 * lane; float* nc = P.out + O_CCS + (size_t)((l * NS + s) * 2) * 256 + 4 * lane;
    const f32x4 z0 = *(const f32x4*)bc, z1 = *(const f32x4*)(bc + 256);
    const f32x4 z = unpack4(*(const u32x2*)(rp + PZ + 4 * lane));
    const f32x4 cb = unpack4(*(const u32x2*)(rp + PCB + 4 * lane));
    f32x4 acc = *(const f32x4*)(P.in[17] + l * 256 + 4 * lane);
#pragma unroll
    for (int hf = 0; hf < 2; ++hf) { f32x4 xr[15];
#pragma unroll
        for (int j = 0; j < 15; ++j) xr[j] = *(const f32x4*)(buf + (15 * hf + j) * 256);
#pragma unroll
        for (int j = 0; j < 15; ++j) acc = acc + *(const f32x4*)(cw + (15 * hf + j) * 256) * xr[j];
#pragma unroll
        for (int j = 0; j < 15; ++j) { if (15 * hf + j >= 1) *(f32x4*)(nb + (15 * hf + j - 1) * 256) = xr[j]; }
        asm volatile("" ::: "memory"); }
    acc = acc + *(const f32x4*)(cw + 30 * 256) * u;
    *(f32x4*)(nb + 29 * 256) = u;
    conva_finish(P, lng, lnb, acc, row, lane);
    *(u32x2*)(MIX + row * D + 768 + 4 * lane) = pack4(cb * (w0 * z0 + w1 * z1 + w2 * z));
    *(f32x4*)nc = z1; *(f32x4*)(nc + 256) = z;
}

__device__ __forceinline__ void sample_ret(const Params& P, int l) {
    int tid_ = threadIdx.x; asm volatile("" : "+v"(tid_)); const int tid = tid_, lane = tid & 63, wave = __builtin_amdgcn_readfirstlane(tid >> 6); (void)tid; (void)lane; (void)wave;
    if (wave >= 2) return;
    const int s = (blockIdx.x * 2 + wave) >> 2, h = (blockIdx.x * 2 + wave) & 3;
    const bf16_t* PROJ = (const bf16_t*)(P.ws + WS_PROJ);
    bf16_t* MIX = (bf16_t*)(P.ws + WS_HM);
    const size_t row = (size_t)(NP + s); const bf16_t* rp = PROJ + row * LDP;
    const float lg = log2_gamma(h), gam = exp2f(lg);
    const int i5 = lane & 31;
    const double rev = 16384.0 * kInvRev[i5]; const float fr_ = (float)(rev - floor(rev));
    const float sn = __builtin_amdgcn_sinf(fr_), cs = __builtin_amdgcn_cosf(fr_);
    const float q1 = bf2f(rp[PQ + h * 64 + i5]), q2 = bf2f(rp[PQ + h * 64 + 32 + i5]), k1 = bf2f(rp[PK + h * 64 + i5]), k2 = bf2f(rp[PK + h * 64 + 32 + i5]);
    const float qr = bflo(pg8::cvt_pk_bf16(lane < 32 ? q1 * cs - q2 * sn : q1 * sn + q2 * cs, 0.f));
    const float kr = bflo(pg8::cvt_pk_bf16((lane < 32 ? k1 * cs - k2 * sn : k1 * sn + k2 * cs) * 0.125f, 0.f));
    const int eq = lane & 31, dpar = lane >> 5;
    const f32x4 v = unpack4(*(const u32x2*)(rp + PV + h * 128 + 4 * eq));
    const float* S0 = P.in[4] + (size_t)((l * NS + s) * 4 + h) * 8192 + 4 * eq; float* S1 = P.out + O_RETS + (size_t)((l * NS + s) * 4 + h) * 8192 + 4 * eq;
    f32x4 o = (f32x4){0.f, 0.f, 0.f, 0.f};
    const f32x4 gng = *(const f32x4*)(P.in[15] + l * 512 + h * 128 + 4 * eq); const f32x4 gatev = unpack4(*(const u32x2*)(rp + PG + h * 128 + 4 * eq));
#pragma unroll
    for (int hf = 0; hf < 2; ++hf) {
        f32x4 svr[16];
#pragma unroll
        for (int i2 = 0; i2 < 16; ++i2) svr[i2] = *(const f32x4*)(S0 + (2 * (16 * hf + i2) + dpar) * 128);
#pragma unroll
        for (int i2 = 0; i2 < 16; ++i2) { const int it = 16 * hf + i2, d = 2 * it + dpar;
            const float qa = __uint_as_float(__builtin_amdgcn_readlane(__float_as_uint(qr), 2 * it)), qb = __uint_as_float(__builtin_amdgcn_readlane(__float_as_uint(qr), 2 * it + 1));
            const float ka = __uint_as_float(__builtin_amdgcn_readlane(__float_as_uint(kr), 2 * it)), kb = __uint_as_float(__builtin_amdgcn_readlane(__float_as_uint(kr), 2 * it + 1));
            const float qd = dpar ? qb : qa, kd = dpar ? kb : ka;
            const f32x4 sv = svr[i2] * gam + v * kd; *(f32x4*)(S1 + d * 128) = sv; o = o + sv * qd; }
        asm volatile("" ::: "memory"); }
#pragma unroll
    for (int i = 0; i < 4; ++i) o[i] += __shfl_xor(o[i], 32);
    float sm = (o[0] + o[1]) + (o[2] + o[3]);
#pragma unroll
    for (int x = 1; x < 32; x <<= 1) sm += __shfl_xor(sm, x);
    const float mean = sm * (1.0f / 128.0f); const f32x4 dd = o - mean; float qq = (dd[0] * dd[0] + dd[1] * dd[1]) + (dd[2] * dd[2] + dd[3] * dd[3]);
#pragma unroll
    for (int x = 1; x < 32; x <<= 1) qq += __shfl_xor(qq, x);
    const float rstd = rsqrtf(qq * (1.0f / 128.0f) + EPS);
    if (lane < 32) { const f32x4 g = gng; const f32x4 gate = gatev;
        f32x4 y;
#pragma unroll
        for (int i = 0; i < 4; ++i) y[i] = dd[i] * rstd * g[i] * siluf_(gate[i]);
        *(u32x2*)(MIX + row * D + h * 128 + 4 * eq) = pack4(y); }
}


template <int KS>
__device__ __forceinline__ void skinny_gemm(const bf16_t* A  , const bf16_t* Bt  , bf16_t* O  , unsigned* cnt, MK_LAS unsigned char* lds) {
    int tid_ = threadIdx.x; asm volatile("" : "+v"(tid_)); const int tid = tid_, lane = tid & 63, wave = __builtin_amdgcn_readfirstlane(tid >> 6);
    const int fr = lane & 15, fq = lane >> 4; constexpr int K = KS * 32 * 8;
    for (int it = blockIdx.x; it < 256; it += gridDim.x) {
        const int rb = it & 7, ct = it >> 3;
        const bf16_t* ap = A + (size_t)(NP + 16 * rb + fr) * K + wave * (KS * 32) + 8 * fq;
        const bf16_t* bp = Bt + (size_t)(32 * ct + fr) * K + wave * (KS * 32) + 8 * fq;
        f32x4 acc0 = (f32x4){0.f, 0.f, 0.f, 0.f}, acc1 = acc0;
#pragma unroll
        for (int ks = 0; ks < KS; ++ks) { const bf16x8 a = *(const bf16x8*)(ap + ks * 32), b0 = *(const bf16x8*)(bp + ks * 32), b1 = *(const bf16x8*)(bp + (size_t)16 * K + ks * 32);
            acc0 = MK_MFMA(b0, a, acc0); acc1 = MK_MFMA(b1, a, acc1); }
        MK_LAS f32x4* red = (MK_LAS f32x4*)lds;
        red[(wave * 2 + 0) * 64 + lane] = acc0; red[(wave * 2 + 1) * 64 + lane] = acc1;
        __syncthreads();
        if (wave < 2) { f32x4 sum = red[wave * 64 + lane];
#pragma unroll
            for (int w = 1; w < 8; ++w) sum = sum + red[(w * 2 + wave) * 64 + lane];
            const u32x2 pk = pack4(sum);
            __hip_atomic_store((unsigned long long*)(O + (size_t)(NP + 16 * rb + fr) * D + 32 * ct + 16 * wave + 4 * fq), ((unsigned long long)pk.y << 32) | pk.x, __ATOMIC_RELAXED, __HIP_MEMORY_SCOPE_AGENT);
            asm volatile("s_waitcnt vmcnt(0)" ::: "memory"); }
        __syncthreads();
        if (tid == 0) __hip_atomic_fetch_add(cnt, 1u, __ATOMIC_RELAXED, __HIP_MEMORY_SCOPE_AGENT);
    }
}
__global__ void __launch_bounds__(NTHREADS, 2) mk_fwd(Params P) {
    extern __shared__ __attribute__((aligned(16))) unsigned char lds_raw[];
    MK_LAS unsigned char* lds = (MK_LAS unsigned char*)lds_raw;
    cg::grid_group grid = cg::this_grid();
    if (threadIdx.x < 16) ((MK_LAS unsigned*)(lds + LDS_CTL_OFF))[threadIdx.x] = 0u;
    __syncthreads();
    (void)xcd_barrier_post((unsigned*)(P.ws + WS_CTL), (volatile MK_LAS unsigned*)(lds + LDS_CTL_OFF));
#define GRID_BAR() do { XcdBarrier xb_; xb_.bar = (unsigned*)(P.ws + WS_CTL); xb_.x = xb_xcc_id(); xb_.st = (volatile MK_LAS unsigned*)(lds + LDS_CTL_OFF); xcd_barrier(xb_); } while (0)
    if (P.ws == nullptr) grid.sync();
    const int G = gridDim.x, bx = blockIdx.x;
    unsigned char* ws = P.ws;
    bf16_t* HM = (bf16_t*)(ws + WS_HM); bf16_t* T1 = (bf16_t*)(ws + WS_T1S) - (size_t)NP * D; bf16_t* PROJ = (bf16_t*)(ws + WS_PROJ);

#ifndef REP_PRO
#define REP_PRO 1
#endif
    for (int pr = 0; pr < REP_PRO; ++pr) {
    p0_convert<0>(P, lds, bx, G);
    GRID_BAR();
    { pg8::Gemm g{(const bf16_t*)(ws + WS_AC), (const bf16_t*)(ws + WS_ADAT), 256, NMOD, D}; pg8::StaticOrder S; S.init(256, NMOD, G, bx);
      EpiMod E{(float*)(ws + WS_MOD), P.in[8]};
      pg8::gemm_phase<EpiMod, pg8::StaticOrder, true, true>(lds, g, S, E); }
    if (bx >= 48 && G > 48) p0_convert<1>(P, lds, bx - 48, G - 48);
    GRID_BAR();
    rowpass0(P);
    GRID_BAR();
    }
#pragma unroll 1
    for (int l = 0; l < DEPTH; ++l) {
        for (int rep = 0; rep < REP_WIN; ++rep)
        { pg8::Gemm g{HM, (const bf16_t*)(ws + WS_WIN) + (size_t)l * INW * D, MP, INW, D}; pg8::StaticOrder S; S.init(MP, INW, G, bx);
          EpiProj E{PROJ};
          pg8::gemm_phase<EpiProj, pg8::StaticOrder, true, true>(lds, g, S, E); }
        GRID_BAR();
        for (int rep = 0; rep < REP_MIX; ++rep) {
        if (rep) GRID_BAR();
        sample_ret(P, l); sample_conv(P, l);
        conv_task(P, l);
        for (int it = bx; it < 512; it += G) ret_u_item(P, lds, it);
#ifdef DUP_M1
        GRID_BAR();
        sample_ret(P, l); sample_conv(P, l);
        conv_task(P, l);
        for (int it = bx; it < 512; it += G) ret_u_item(P, lds, it);
#endif
#ifdef DUP_RU
        GRID_BAR();
        for (int it = bx; it < 512; it += G) ret_u_item(P, lds, it);
#endif
#ifdef DUP_CV
        GRID_BAR();
        conv_task(P, l);
#endif
#ifdef DUP_SR
        GRID_BAR();
        sample_ret(P, l); sample_conv(P, l);
#endif
        GRID_BAR();
        for (int it = bx; it < 512; it += G) ret_o_item(P, lds, l, it);
#ifdef DUP_M2
        GRID_BAR();
        for (int it = bx; it < 512; it += G) ret_o_item(P, lds, l, it);
#endif
        }
        GRID_BAR();
#ifdef DUP_WO
        for (int dmy = 1; dmy >= 0; --dmy)
#else
        constexpr int dmy = 0;
#endif
        { unsigned* ctl = (unsigned*)(ws + WS_CTL); const int inst = 2 * l;
          skinny_gemm<4>(HM, (const bf16_t*)(ws + WS_WOUT) + (size_t)l * D * D, T1, ctl + CW_SAMPLE + 64 * inst, lds);
          pg8::Gemm g{HM, (const bf16_t*)(ws + WS_WOUT) + (size_t)l * D * D, NP, D, D}; pg8::StaticOrder S; S.init(NP, D, G, bx);
          EpiRmsFused E{&P, l, 1, dmy};
          pg8::gemm_phase<EpiRmsFused, pg8::StaticOrder, false, true>(lds, g, S, E);
          if (!dmy) sample_rowpass<1>(P, l, ctl + CW_SAMPLE + 64 * inst); else GRID_BAR(); }
        GRID_BAR();
#ifndef REP_F1
#define REP_F1 1
#endif
        for (int rep = 0; rep < REP_F1; ++rep)
        { pg8::Gemm g{HM, (const bf16_t*)(ws + WS_W13) + (size_t)l * NFF1 * D, MP, NFF1, D}; pg8::StaticOrder S; S.init(MP, NFF1, G, bx);
          EpiSwiGLU E{PROJ};
          pg8::gemm_phase<EpiSwiGLU, pg8::StaticOrder, true, true>(lds, g, S, E);
          pg8::Unit ud; if (l == 0 && !S.next(5, ud)) { const int first_idle = (MP / 256) * (NFF1 / 256) - 5 * G;
              if (first_idle >= 0 && first_idle < G) p0_convert<2>(P, lds, bx - first_idle, G - first_idle); } }
        GRID_BAR();
#ifdef DUP_F2
        for (int dmy2 = 1; dmy2 >= 0; --dmy2)
#else
        constexpr int dmy2 = 0;
#endif
        { unsigned* ctl = (unsigned*)(ws + WS_CTL); const int inst = 2 * l + 1;
          skinny_gemm<11>(PROJ, (const bf16_t*)(ws + WS_W2) + (size_t)l * D * DFF, T1, ctl + CW_SAMPLE + 64 * inst, lds);
          pg8::Gemm g{PROJ, (const bf16_t*)(ws + WS_W2) + (size_t)l * D * DFF, NP, D, DFF}; pg8::StaticOrder S; S.init(NP, D, G, bx);
          EpiRmsFused E{&P, l, 2, dmy2};
          pg8::gemm_phase<EpiRmsFused, pg8::StaticOrder, false, true>(lds, g, S, E);
          if (!dmy2) sample_rowpass<2>(P, l, ctl + CW_SAMPLE + 64 * inst); else GRID_BAR(); }
        if (l + 1 < DEPTH) GRID_BAR();
    }
}
}

extern "C" void kernel_launch(void* const* d_in, const int* in_sizes, int n_in, void* d_out, int out_size, void* d_ws, size_t ws_size, hipStream_t stream) {
    static int grid = 0;
    if (grid == 0) {
        if (n_in != 24 || (size_t)out_size != mk::O_END || ws_size < mk::WS_END) { fprintf(stderr, "kernel_launch: unexpected shapes: n_in %d out %d ws %zu\n", n_in, out_size, ws_size); grid = -1; return; }
        int dev = 0, cus = 0, per_cu = 0;
        hipGetDevice(&dev); hipDeviceGetAttribute(&cus, hipDeviceAttributeMultiprocessorCount, dev);
        hipFuncSetAttribute((const void*)mk::mk_fwd, hipFuncAttributeMaxDynamicSharedMemorySize, mk::LDS_BYTES);
        hipOccupancyMaxActiveBlocksPerMultiprocessor(&per_cu, (const void*)mk::mk_fwd, mk::NTHREADS, mk::LDS_BYTES);
        (void)hipGetLastError();
        if (per_cu < 1) { fprintf(stderr, "kernel_launch: occupancy query says %d blocks per CU\n", per_cu); per_cu = 1; }
        grid = cus;
    }
    if (grid < 0) return;
    if (hipMemsetAsync((char*)d_ws + mk::WS_CTL, 0, mk::CTL_ZERO_BYTES, stream) != hipSuccess) { fprintf(stderr, "kernel_launch: memset failed\n"); return; }
    mk::Params p{};
    for (int i = 0; i < 24; ++i) p.in[i] = (const float*)d_in[i];
    p.out = (float*)d_out; p.ws = (unsigned char*)d_ws;
    void* args[] = {&p};
    hipError_t e = hipLaunchCooperativeKernel((const void*)mk::mk_fwd, dim3(grid), dim3(mk::NTHREADS), args, mk::LDS_BYTES, stream);
    if (e != hipSuccess) fprintf(stderr, "kernel_launch: cooperative launch failed: %s (grid %d)\n", hipGetErrorString(e), grid);
}
```
